# Optimizing an MI355X kernel written in HIP

```python
import math
import jax, jax.numpy as jnp
from jax import lax
import numpy as np

D_MODEL = 1024
BATCH = 8
SEQ = 2048
DEPTH = 4

N_MIXERS = 2
N_ATTN_LAYERS = (DEPTH + N_MIXERS - 1) // N_MIXERS
N_CONV_LAYERS = DEPTH // N_MIXERS
HEAD_DIM = 64
N_Q_HEADS = D_MODEL // HEAD_DIM
N_KV_HEADS = 4
GQA_GROUP = N_Q_HEADS // N_KV_HEADS
WINDOW = 128
Q_DIM = N_Q_HEADS * HEAD_DIM
KV_DIM = N_KV_HEADS * HEAD_DIM
QKV_DIM = Q_DIM + 2 * KV_DIM
NUM_BUCKETS = 32
MAX_EXACT = NUM_BUCKETS // 2
MAX_DISTANCE = 128
CONV_CHANNELS = D_MODEL
CONV_WIDTH = 31
N_EXPERTS = 32
TOP_K = 4
D_EXPERT = D_MODEL
SWIGLU_LIMIT = 7.0
SWIGLU_ALPHA = 1.702
EXPERT_BLOCK = 128
NORM_EPS = 1e-5
NEG_INF = -1e30

kernel_name = "hybrid_swa_conformer_moe_adaln"


def _rmsnorm(x, g):
    xf = x.astype(jnp.float32)
    y = xf * lax.rsqrt(jnp.mean(xf * xf, axis=-1, keepdims=True) + NORM_EPS)
    return (y * g.astype(jnp.float32)).astype(x.dtype)


def _layernorm(x, g, b):
    xf = x.astype(jnp.float32)
    mu = jnp.mean(xf, axis=-1, keepdims=True)
    var = jnp.mean(jnp.square(xf - mu), axis=-1, keepdims=True)
    y = (xf - mu) * lax.rsqrt(var + NORM_EPS)
    return (y * g.astype(jnp.float32) + b.astype(jnp.float32)).astype(x.dtype)


def _band_geometry():
    dist = jnp.arange(WINDOW)[:, None] + WINDOW - jnp.arange(2 * WINDOW)[None, :]
    n = jnp.maximum(dist, 0)
    nf = jnp.maximum(n, 1).astype(jnp.float32)
    large = MAX_EXACT + (jnp.log(nf / MAX_EXACT) / math.log(MAX_DISTANCE / MAX_EXACT)
                         * (NUM_BUCKETS - MAX_EXACT)).astype(jnp.int32)
    large = jnp.minimum(large, NUM_BUCKETS - 1)
    bucket = jnp.where(n < MAX_EXACT, n, large)
    return dist, bucket


def _rel_bias(table):
    _, bucket = _band_geometry()
    bias = table[bucket]
    return jnp.transpose(bias, (2, 0, 1)).reshape(N_KV_HEADS, GQA_GROUP, WINDOW, 2 * WINDOW)


def _sliding_window_attention(h, w_qkv, b_qkv, w_o, b_o, sinks, rel_bias):
    bsz, seq, _ = h.shape
    nb = seq // WINDOW
    qkv = h @ w_qkv + b_qkv
    q, k, v = jnp.split(qkv, [Q_DIM, Q_DIM + KV_DIM], axis=-1)
    q = q.reshape(bsz, nb, WINDOW, N_KV_HEADS, GQA_GROUP, HEAD_DIM) * (HEAD_DIM ** -0.5)
    k = k.reshape(bsz, nb, WINDOW, N_KV_HEADS, HEAD_DIM)
    v = v.reshape(bsz, nb, WINDOW, N_KV_HEADS, HEAD_DIM)
    pad = ((0, 0), (1, 0), (0, 0), (0, 0), (0, 0))
    kw = jnp.concatenate([jnp.pad(k, pad)[:, :-1], k], axis=2)
    vw = jnp.concatenate([jnp.pad(v, pad)[:, :-1], v], axis=2)
    scores = jnp.einsum('bnqhgd,bnshd->bnhgqs', q, kw).astype(jnp.float32)
    scores = scores + rel_bias.astype(jnp.float32)[None, None]
    dist, _ = _band_geometry()
    in_window = (dist >= 0) & (dist < WINDOW)
    key_pos = jnp.arange(nb)[:, None] * WINDOW + jnp.arange(2 * WINDOW)[None, :] - WINDOW
    valid = in_window[None] & (key_pos >= 0)[:, None, :]
    scores = jnp.where(valid[None, :, None, None], scores, NEG_INF)
    sink = sinks.astype(jnp.float32).reshape(N_KV_HEADS, GQA_GROUP)[None, None, :, :, None, None]
    sink = jnp.broadcast_to(sink, scores.shape[:-1] + (1,))
    probs = jax.nn.softmax(jnp.concatenate([scores, sink], axis=-1), axis=-1)[..., :-1]
    out = jnp.einsum('bnhgqs,bnshd->bnqhgd', probs.astype(vw.dtype), vw)
    return out.reshape(bsz, seq, Q_DIM) @ w_o + b_o


def _conformer_conv(h, w_in, b_in, w_dw, b_dw, ln_g, ln_b, w_out, b_out):
    u = h @ w_in + b_in
    a, g = jnp.split(u, 2, axis=-1)
    u = a * jax.nn.sigmoid(g)
    y = lax.conv_general_dilated(u, w_dw[:, None, :], window_strides=(1,),
                                 padding=[(CONV_WIDTH - 1, 0)],
                                 dimension_numbers=('NWC', 'WIO', 'NWC'),
                                 feature_group_count=CONV_CHANNELS) + b_dw
    y = jax.nn.silu(_layernorm(y, ln_g, ln_b))
    return y @ w_out + b_out


def _clamped_swiglu(u):
    glu, lin = jnp.split(u, 2, axis=-1)
    glu = jnp.minimum(glu, SWIGLU_LIMIT)
    lin = jnp.clip(lin, -SWIGLU_LIMIT, SWIGLU_LIMIT)
    return glu * jax.nn.sigmoid(SWIGLU_ALPHA * glu) * (lin + 1.0)


def _moe(h, w_r, b_r, w_in, b_in, w_out, b_out):
    bsz, seq, d = h.shape
    n_tok = bsz * seq
    n_slot = n_tok * TOP_K
    hf = h.reshape(n_tok, d)
    logits = hf @ w_r + b_r
    top_val, top_idx = lax.top_k(logits, TOP_K)
    gates = jax.nn.softmax(top_val.astype(jnp.float32), axis=-1).astype(h.dtype)
    flat_e = top_idx.reshape(-1)
    flat_t = jnp.repeat(jnp.arange(n_tok, dtype=jnp.int32), TOP_K)
    flat_g = gates.reshape(-1)
    order = jnp.argsort(flat_e)
    se = flat_e[order]
    counts = jnp.bincount(flat_e, length=N_EXPERTS)
    padded = (counts + EXPERT_BLOCK - 1) // EXPERT_BLOCK * EXPERT_BLOCK
    ustart = jnp.cumsum(counts) - counts
    pend = jnp.cumsum(padded)
    pstart = pend - padded
    dest = pstart[se] + jnp.arange(n_slot) - ustart[se]
    n_pad = n_slot + N_EXPERTS * EXPERT_BLOCK
    n_blk = n_pad // EXPERT_BLOCK
    tok_pad = jnp.zeros((n_pad,), jnp.int32).at[dest].set(flat_t[order])
    g_pad = jnp.zeros((n_pad,), h.dtype).at[dest].set(flat_g[order])
    blk_e = jnp.minimum(jnp.searchsorted(pend, jnp.arange(n_blk) * EXPERT_BLOCK, side='right'),
                        N_EXPERTS - 1)
    xs = hf[tok_pad].reshape(n_blk, EXPERT_BLOCK, d)

    def expert_block(args):
        xb, e = args
        u = xb @ w_in[e] + b_in[e]
        return _clamped_swiglu(u) @ w_out[e] + b_out[e]

    ys = lax.map(expert_block, (xs, blk_e)).reshape(n_pad, d)
    out = jnp.zeros((n_tok, d), h.dtype).at[tok_pad].add(ys * g_pad[:, None])
    return out.reshape(bsz, seq, d)


def setup_inputs(seed: int = 0) -> dict:
    key = jax.random.key(seed)
    ks = jax.random.split(key, 32)
    D, E, F = D_MODEL, N_EXPERTS, D_EXPERT
    nrm = lambda k, shape, s: jax.random.normal(k, shape, jnp.float32) * s
    return {
        "x": nrm(ks[0], (BATCH, SEQ, D), 1.0),
        "c": nrm(ks[1], (BATCH, D), 1.0),
        "w_mod": nrm(ks[2], (DEPTH, D, 6 * D), 0.5 * D ** -0.5),
        "b_mod": nrm(ks[3], (DEPTH, 6 * D), 0.02),
        "norm_mix_g": 1.0 + nrm(ks[4], (DEPTH, D), 0.02),
        "norm_ffn_g": 1.0 + nrm(ks[5], (DEPTH, D), 0.02),
        "attn_w_qkv": nrm(ks[6], (N_ATTN_LAYERS, D, QKV_DIM), D ** -0.5),
        "attn_b_qkv": nrm(ks[7], (N_ATTN_LAYERS, QKV_DIM), 0.02),
        "attn_w_o": nrm(ks[8], (N_ATTN_LAYERS, Q_DIM, D), Q_DIM ** -0.5),
        "attn_b_o": nrm(ks[9], (N_ATTN_LAYERS, D), 0.02),
        "attn_sinks": nrm(ks[10], (N_ATTN_LAYERS, N_Q_HEADS), 0.5),
        "rel_bias_table": nrm(ks[11], (NUM_BUCKETS, N_Q_HEADS), 0.5),
        "conv_w_in": nrm(ks[12], (N_CONV_LAYERS, D, 2 * CONV_CHANNELS), D ** -0.5),
        "conv_b_in": nrm(ks[13], (N_CONV_LAYERS, 2 * CONV_CHANNELS), 0.02),
        "conv_w_dw": nrm(ks[14], (N_CONV_LAYERS, CONV_WIDTH, CONV_CHANNELS), CONV_WIDTH ** -0.5),
        "conv_b_dw": nrm(ks[15], (N_CONV_LAYERS, CONV_CHANNELS), 0.02),
        "conv_ln_g": 1.0 + nrm(ks[16], (N_CONV_LAYERS, CONV_CHANNELS), 0.02),
        "conv_ln_b": nrm(ks[17], (N_CONV_LAYERS, CONV_CHANNELS), 0.02),
        "conv_w_out": nrm(ks[18], (N_CONV_LAYERS, CONV_CHANNELS, D), CONV_CHANNELS ** -0.5),
        "conv_b_out": nrm(ks[19], (N_CONV_LAYERS, D), 0.02),
        "router_w": nrm(ks[20], (DEPTH, D, E), D ** -0.5),
        "router_b": nrm(ks[21], (DEPTH, E), 0.01),
        "moe_w_in": nrm(ks[22], (DEPTH, E, D, 2 * F), D ** -0.5),
        "moe_b_in": nrm(ks[23], (DEPTH, E, 2 * F), 0.02),
        "moe_w_out": nrm(ks[24], (DEPTH, E, F, D), F ** -0.5),
        "moe_b_out": nrm(ks[25], (DEPTH, E, D), 0.02),
        "final_norm_g": 1.0 + nrm(ks[26], (D,), 0.02),
    }


def reference(x, c, w_mod, b_mod, norm_mix_g, norm_ffn_g, attn_w_qkv, attn_b_qkv, attn_w_o, attn_b_o,
              attn_sinks, rel_bias_table, conv_w_in, conv_b_in, conv_w_dw, conv_b_dw, conv_ln_g, conv_ln_b,
              conv_w_out, conv_b_out, router_w, router_b, moe_w_in, moe_b_in, moe_w_out, moe_b_out,
              final_norm_g):
    rel_bias = _rel_bias(rel_bias_table)
    c_act = jax.nn.silu(c)
    for i in range(DEPTH):
        mod = c_act @ w_mod[i] + b_mod[i]
        sh_m, sc_m, g_m, sh_f, sc_f, g_f = jnp.split(mod, 6, axis=-1)
        h = _rmsnorm(x, norm_mix_g[i]) * (1.0 + sc_m[:, None]) + sh_m[:, None]
        j = i // N_MIXERS
        if i % N_MIXERS == 0:
            m = _sliding_window_attention(h, attn_w_qkv[j], attn_b_qkv[j], attn_w_o[j], attn_b_o[j],
                                          attn_sinks[j], rel_bias)
        else:
            m = _conformer_conv(h, conv_w_in[j], conv_b_in[j], conv_w_dw[j], conv_b_dw[j],
                                conv_ln_g[j], conv_ln_b[j], conv_w_out[j], conv_b_out[j])
        x = x + g_m[:, None] * m
        h = _rmsnorm(x, norm_ffn_g[i]) * (1.0 + sc_f[:, None]) + sh_f[:, None]
        x = x + g_f[:, None] * _moe(h, router_w[i], router_b[i], moe_w_in[i], moe_b_in[i],
                                     moe_w_out[i], moe_b_out[i])
    return _rmsnorm(x, final_norm_g)
```

```cpp
#include <hip/hip_runtime.h>
#include <cstdio>
#include <cstdint>
namespace nv {
constexpr int T = 16384, D = 1024, SEQ = 2048, NB = 8, E = 32, TOPK = 4, NSLOT = T * TOPK;
__device__ __forceinline__ float sigmoidf_(float v) { return 1.0f / (1.0f + __expf(-v)); }
__device__ const unsigned char kBucket[128] = {0, 1, 2, 3, 4, 5, 6, 7, 8, 9, 10, 11, 12, 13, 14, 15, 16, 16, 16, 17, 17, 18, 18, 18, 19, 19, 19, 20, 20, 20, 20, 21, 21, 21, 21, 22, 22, 22, 22, 22, 23, 23, 23, 23, 23, 23, 24, 24, 24, 24, 24, 24, 25, 25, 25, 25, 25, 25, 25, 26, 26, 26, 26, 26, 26, 26, 26, 27, 27, 27, 27, 27, 27, 27, 27, 27, 27, 28, 28, 28, 28, 28, 28, 28, 28, 28, 28, 29, 29, 29, 29, 29, 29, 29, 29, 29, 29, 29, 29, 30, 30, 30, 30, 30, 30, 30, 30, 30, 30, 30, 30, 30, 30, 31, 31, 31, 31, 31, 31, 31, 31, 31, 31, 31, 31, 31, 31, 31};

__global__ void k_mod(const float* c, const float* w_mod, const float* b_mod, float* mod) {
    const int idx = blockIdx.x * blockDim.x + threadIdx.x; if (idx >= 4 * NB * 6 * D) return;
    const int n = idx % (6 * D), b = (idx / (6 * D)) % NB, i = idx / (6 * D * NB);
    const float* W = w_mod + (size_t)i * D * 6 * D; float s = 0.f;
    for (int k = 0; k < D; ++k) { const float cv = c[b * D + k]; s += cv * sigmoidf_(cv) * W[(size_t)k * 6 * D + n]; }
    mod[idx] = s + b_mod[i * 6 * D + n];
}
__global__ void k_norm(const float* x, const float* g, const float* sc, const float* sh, int mod_stride, float* h) {
    __shared__ float red[256];
    const int t = blockIdx.x, b = t / SEQ; const float* xr = x + (size_t)t * D; float s = 0.f;
    for (int k = threadIdx.x; k < D; k += 256) s += xr[k] * xr[k];
    red[threadIdx.x] = s; __syncthreads();
    for (int o = 128; o > 0; o >>= 1) { if (threadIdx.x < o) red[threadIdx.x] += red[threadIdx.x + o]; __syncthreads(); }
    const float rstd = rsqrtf(red[0] / D + 1e-5f);
    for (int k = threadIdx.x; k < D; k += 256) { float v = xr[k] * rstd * g[k]; if (sc) v = v * (1.0f + sc[(size_t)b * mod_stride + k]) + sh[(size_t)b * mod_stride + k]; h[(size_t)t * D + k] = v; }
}
struct GemmP {
    const float* A; int lda; const int* rowlist; int rowlist_stride; int row_shift;
    const int* counts; const int* offs;
    int a_use_off;
    const float* W; size_t w_stride; const float* bias; size_t b_stride;
    float* C; int ldc; int M, N, K;
    int mode; const float* Xin; const float* gate; int gate_stride;
};
__global__ __launch_bounds__(256) void k_gemm(GemmP p) {
    __shared__ float As[16][65], Ws[16][65];
    const int e = blockIdx.z, m0 = blockIdx.y * 64, n0 = blockIdx.x * 64;
    const int cnt = p.counts ? p.counts[e] : p.M; if (m0 >= cnt) return;
    const int coff = p.offs ? p.offs[e] : 0;
    const float* W = p.W + (size_t)e * p.w_stride; const float* bias = p.bias + (size_t)e * p.b_stride;
    const int tx = threadIdx.x % 16, ty = threadIdx.x / 16;
    float acc[4][4];
#pragma unroll
    for (int i = 0; i < 4; ++i)
#pragma unroll
        for (int j = 0; j < 4; ++j) acc[i][j] = 0.f;
    const int lr = threadIdx.x / 4, lk = (threadIdx.x % 4) * 4; const int r = m0 + lr; int arow = -1;
    if (r < cnt) arow = p.rowlist ? (p.rowlist[(size_t)e * p.rowlist_stride + r] >> p.row_shift) : ((p.a_use_off ? coff : 0) + r);
    const int wk = threadIdx.x / 16, wn = (threadIdx.x % 16) * 4;
    for (int k0 = 0; k0 < p.K; k0 += 16) {
        float4 av = make_float4(0.f, 0.f, 0.f, 0.f); if (arow >= 0) av = *(const float4*)(p.A + (size_t)arow * p.lda + k0 + lk);
        const float4 wv = *(const float4*)(W + (size_t)(k0 + wk) * p.N + n0 + wn);
        As[lk + 0][lr] = av.x; As[lk + 1][lr] = av.y; As[lk + 2][lr] = av.z; As[lk + 3][lr] = av.w;
        Ws[wk][wn + 0] = wv.x; Ws[wk][wn + 1] = wv.y; Ws[wk][wn + 2] = wv.z; Ws[wk][wn + 3] = wv.w;
        __syncthreads();
#pragma unroll
        for (int kk = 0; kk < 16; ++kk) { float a[4], w[4];
#pragma unroll
            for (int i = 0; i < 4; ++i) { a[i] = As[kk][ty * 4 + i]; w[i] = Ws[kk][tx * 4 + i]; }
#pragma unroll
            for (int i = 0; i < 4; ++i)
#pragma unroll
                for (int j = 0; j < 4; ++j) acc[i][j] += a[i] * w[j]; }
        __syncthreads();
    }
#pragma unroll
    for (int i = 0; i < 4; ++i) { const int rr = m0 + ty * 4 + i; if (rr >= cnt) continue; const size_t crow = (size_t)coff + rr;
#pragma unroll
        for (int j = 0; j < 4; ++j) { const int n = n0 + tx * 4 + j; float v = acc[i][j] + bias[n];
            if (p.mode == 1) { const int b = (int)(crow / SEQ); v = p.Xin[crow * p.ldc + n] + p.gate[(size_t)b * p.gate_stride + n] * v; }
            p.C[crow * p.ldc + n] = v; } }
}
__global__ __launch_bounds__(64) void k_attn(const float* qkv, const float* sinks, const float* table, float* out) {
    const int idx = blockIdx.x * blockDim.x + threadIdx.x; if (idx >= T * 16) return;
    const int hq = idx % 16, t = idx / 16, tin = t % SEQ, kvh = hq / 4;
    float q[64], o[64];
    const float* qp = qkv + (size_t)t * 1536 + hq * 64;
#pragma unroll
    for (int d = 0; d < 64; ++d) { q[d] = qp[d] * 0.125f; o[d] = 0.f; }
    const float sink = sinks[hq]; float m = sink;
    const int nd = tin < 127 ? tin + 1 : 128;
    for (int dist = 0; dist < nd; ++dist) { const float* kp = qkv + (size_t)(t - dist) * 1536 + 1024 + kvh * 64; float s = 0.f;
#pragma unroll
        for (int d = 0; d < 64; ++d) s += q[d] * kp[d];
        s += table[kBucket[dist] * 16 + hq]; m = fmaxf(m, s); }
    float l = __expf(sink - m);
    for (int dist = 0; dist < nd; ++dist) { const float* kp = qkv + (size_t)(t - dist) * 1536 + 1024 + kvh * 64; const float* vp = kp + 256; float s = 0.f;
#pragma unroll
        for (int d = 0; d < 64; ++d) s += q[d] * kp[d];
        s += table[kBucket[dist] * 16 + hq]; const float pe = __expf(s - m); l += pe;
#pragma unroll
        for (int d = 0; d < 64; ++d) o[d] += pe * vp[d]; }
    const float inv = 1.0f / l; float* op = out + (size_t)t * D + hq * 64;
#pragma unroll
    for (int d = 0; d < 64; ++d) op[d] = o[d] * inv;
}
__global__ void k_glu(const float* u2, float* u) { const size_t idx = (size_t)blockIdx.x * blockDim.x + threadIdx.x; if (idx >= (size_t)T * D) return; const size_t t = idx / D, c = idx % D; u[idx] = u2[t * 2 * D + c] * sigmoidf_(u2[t * 2 * D + D + c]); }
__global__ void k_dwconv(const float* u, const float* w, const float* b, float* y) { const size_t idx = (size_t)blockIdx.x * blockDim.x + threadIdx.x; if (idx >= (size_t)T * D) return; const int t = (int)(idx / D), c = (int)(idx % D), tin = t % SEQ; float s = b[c];
    for (int j = 0; j < 31; ++j) { const int tt = tin - 30 + j; if (tt >= 0) s += w[j * D + c] * u[(size_t)(t - 30 + j) * D + c]; } y[idx] = s; }
__global__ void k_ln_silu(const float* y, const float* g, const float* b, float* o) {
    __shared__ float red[256];
    const int t = blockIdx.x; const float* yr = y + (size_t)t * D; float s = 0.f;
    for (int k = threadIdx.x; k < D; k += 256) s += yr[k];
    red[threadIdx.x] = s; __syncthreads();
    for (int q = 128; q > 0; q >>= 1) { if (threadIdx.x < q) red[threadIdx.x] += red[threadIdx.x + q]; __syncthreads(); }
    const float mean = red[0] / D; __syncthreads(); s = 0.f;
    for (int k = threadIdx.x; k < D; k += 256) { const float d = yr[k] - mean; s += d * d; }
    red[threadIdx.x] = s; __syncthreads();
    for (int q = 128; q > 0; q >>= 1) { if (threadIdx.x < q) red[threadIdx.x] += red[threadIdx.x + q]; __syncthreads(); }
    const float rstd = rsqrtf(red[0] / D + 1e-5f);
    for (int k = threadIdx.x; k < D; k += 256) { const float v = (yr[k] - mean) * rstd * g[k] + b[k]; o[(size_t)t * D + k] = v * sigmoidf_(v); }
}
__global__ void k_router(const float* h, const float* wr, const float* br, float* logits) { const int idx = blockIdx.x * blockDim.x + threadIdx.x; if (idx >= T * E) return; const int e = idx % E, t = idx / E; float s = 0.f; const float* hr = h + (size_t)t * D;
    for (int k = 0; k < D; ++k) s += hr[k] * wr[k * E + e]; logits[idx] = s + br[e]; }
__global__ void k_topk(const float* logits, int* cnt, int* list, int* tk_e, int* tk_pos, float* tk_gate) {
    const int t = blockIdx.x * blockDim.x + threadIdx.x; if (t >= T) return; const float* lg = logits + (size_t)t * E;
    int i0 = -1, i1 = -1, i2 = -1, i3 = -1; float v0 = 0, v1 = 0, v2 = 0, v3 = 0;
    for (int k = 0; k < 4; ++k) { int bi = -1; float bv = -3.0e38f;
        for (int e = 0; e < E; ++e) { if (e == i0 || e == i1 || e == i2 || e == i3) continue; const float v = lg[e]; if (v > bv) { bv = v; bi = e; } }
        if (k == 0) { i0 = bi; v0 = bv; } else if (k == 1) { i1 = bi; v1 = bv; } else if (k == 2) { i2 = bi; v2 = bv; } else { i3 = bi; v3 = bv; } }
    const float e0 = 1.0f, e1 = __expf(v1 - v0), e2 = __expf(v2 - v0), e3 = __expf(v3 - v0), inv = 1.0f / (e0 + e1 + e2 + e3);
    const int ids[4] = {i0, i1, i2, i3}; const float gs[4] = {e0 * inv, e1 * inv, e2 * inv, e3 * inv};
#pragma unroll
    for (int k = 0; k < 4; ++k) { const int pos = atomicAdd(&cnt[ids[k]], 1); list[(size_t)ids[k] * T + pos] = t * 4 + k; tk_e[t * 4 + k] = ids[k]; tk_pos[t * 4 + k] = pos; tk_gate[t * 4 + k] = gs[k]; }
}
__global__ void k_offsets(const int* cnt, int* offs) { if (threadIdx.x == 0 && blockIdx.x == 0) { int s = 0; for (int e = 0; e < E; ++e) { offs[e] = s; s += cnt[e]; } } }
__global__ void k_swiglu(const float* un, float* act, int nrows) { const size_t idx = (size_t)blockIdx.x * blockDim.x + threadIdx.x; if (idx >= (size_t)nrows * D) return; const size_t s = idx / D, j = idx % D;
    float glu = un[s * 2 * D + j], lin = un[s * 2 * D + D + j]; glu = fminf(glu, 7.0f); lin = fminf(fmaxf(lin, -7.0f), 7.0f); act[idx] = glu * sigmoidf_(1.702f * glu) * (lin + 1.0f); }
__global__ void k_combine(float* x, const float* yn, const int* offs, const int* tk_e, const int* tk_pos, const float* tk_gate, const float* gf, int gate_stride) {
    const size_t idx = (size_t)blockIdx.x * blockDim.x + threadIdx.x; if (idx >= (size_t)T * D) return; const int t = (int)(idx / D), n = (int)(idx % D), b = t / SEQ; float s = 0.f;
#pragma unroll
    for (int k = 0; k < 4; ++k) { const size_t row = (size_t)offs[tk_e[t * 4 + k]] + tk_pos[t * 4 + k]; s += tk_gate[t * 4 + k] * yn[row * D + n]; }
    x[idx] = x[idx] + gf[(size_t)b * gate_stride + n] * s;
}

struct WS { float *mod, *X, *H, *QKV, *AO, *U2, *U, *Yc, *Un, *ACT, *Yn, *logits, *tk_gate; int *cnt, *offs, *list, *tk_e, *tk_pos; };
inline WS carve(unsigned char* base) {
    WS w; size_t o = 0; auto take = [&](size_t bytes) { unsigned char* p = base + o; o += (bytes + 255) & ~(size_t)255; return p; };
    w.mod = (float*)take((size_t)4 * NB * 6 * D * 4); w.X = (float*)take((size_t)T * D * 4); w.H = (float*)take((size_t)T * D * 4); w.QKV = (float*)take((size_t)T * 1536 * 4);
    w.AO = (float*)take((size_t)T * D * 4); w.U2 = (float*)take((size_t)T * 2 * D * 4); w.U = (float*)take((size_t)T * D * 4); w.Yc = (float*)take((size_t)T * D * 4);
    w.Un = (float*)take((size_t)NSLOT * 2 * D * 4); w.ACT = (float*)take((size_t)NSLOT * D * 4); w.Yn = (float*)take((size_t)NSLOT * D * 4); w.logits = (float*)take((size_t)T * E * 4);
    w.tk_gate = (float*)take((size_t)NSLOT * 4); w.cnt = (int*)take(4 * 64 * 4); w.offs = (int*)take(4 * 64 * 4); w.list = (int*)take((size_t)E * T * 4); w.tk_e = (int*)take((size_t)NSLOT * 4); w.tk_pos = (int*)take((size_t)NSLOT * 4);
    return w;
}
constexpr size_t WS_BYTES = (size_t)1700 << 20;

struct In { const float *x, *c, *w_mod, *b_mod, *norm_mix_g, *norm_ffn_g, *attn_w_qkv, *attn_b_qkv, *attn_w_o, *attn_b_o, *attn_sinks, *rel_bias_table, *conv_w_in, *conv_b_in, *conv_w_dw, *conv_b_dw,
    *conv_ln_g, *conv_ln_b, *conv_w_out, *conv_b_out, *router_w, *router_b, *moe_w_in, *moe_b_in, *moe_w_out, *moe_b_out, *final_norm_g; };
inline void forward(const In& in, const WS& w, float* out, hipStream_t st, int depth = 4, float* const* snaps = nullptr) {
    const int MS = 6 * D;
    k_mod<<<(4 * NB * 6 * D + 255) / 256, 256, 0, st>>>(in.c, in.w_mod, in.b_mod, w.mod);
    hipMemcpyAsync(w.X, in.x, (size_t)T * D * 4, hipMemcpyDeviceToDevice, st);
    hipMemsetAsync(w.cnt, 0, 4 * 64 * 4, st);
    for (int i = 0; i < depth; ++i) {
        const float* mod = w.mod + (size_t)i * NB * MS; const int j = i / 2;
        const float *sh_m = mod, *sc_m = mod + D, *g_m = mod + 2 * D, *sh_f = mod + 3 * D, *sc_f = mod + 4 * D, *g_f = mod + 5 * D;
        k_norm<<<T, 256, 0, st>>>(w.X, in.norm_mix_g + i * D, sc_m, sh_m, MS, w.H);
        GemmP p{}; p.A = w.H; p.lda = D; p.K = D; p.M = T;
        if (i % 2 == 0) {
            p.W = in.attn_w_qkv + (size_t)j * D * 1536; p.bias = in.attn_b_qkv + j * 1536; p.C = w.QKV; p.ldc = 1536; p.N = 1536;
            k_gemm<<<dim3(1536 / 64, T / 64, 1), 256, 0, st>>>(p);
            k_attn<<<T * 16 / 64, 64, 0, st>>>(w.QKV, in.attn_sinks + j * 16, in.rel_bias_table, w.AO);
            GemmP q{}; q.A = w.AO; q.lda = D; q.K = D; q.M = T; q.W = in.attn_w_o + (size_t)j * D * D; q.bias = in.attn_b_o + j * D; q.C = w.X; q.ldc = D; q.N = D; q.mode = 1; q.Xin = w.X; q.gate = g_m; q.gate_stride = MS;
            k_gemm<<<dim3(D / 64, T / 64, 1), 256, 0, st>>>(q);
        } else {
            p.W = in.conv_w_in + (size_t)j * D * 2 * D; p.bias = in.conv_b_in + j * 2 * D; p.C = w.U2; p.ldc = 2 * D; p.N = 2 * D;
            k_gemm<<<dim3(2 * D / 64, T / 64, 1), 256, 0, st>>>(p);
            k_glu<<<T * D / 256, 256, 0, st>>>(w.U2, w.U);
            k_dwconv<<<T * D / 256, 256, 0, st>>>(w.U, in.conv_w_dw + (size_t)j * 31 * D, in.conv_b_dw + j * D, w.U2);
            k_ln_silu<<<T, 256, 0, st>>>(w.U2, in.conv_ln_g + j * D, in.conv_ln_b + j * D, w.Yc);
            GemmP q{}; q.A = w.Yc; q.lda = D; q.K = D; q.M = T; q.W = in.conv_w_out + (size_t)j * D * D; q.bias = in.conv_b_out + j * D; q.C = w.X; q.ldc = D; q.N = D; q.mode = 1; q.Xin = w.X; q.gate = g_m; q.gate_stride = MS;
            k_gemm<<<dim3(D / 64, T / 64, 1), 256, 0, st>>>(q);
        }
        if (snaps && snaps[2 * i]) hipMemcpyAsync(snaps[2 * i], w.X, (size_t)T * D * 4, hipMemcpyDeviceToDevice, st);
        k_norm<<<T, 256, 0, st>>>(w.X, in.norm_ffn_g + i * D, sc_f, sh_f, MS, w.H);
        k_router<<<T * E / 256, 256, 0, st>>>(w.H, in.router_w + (size_t)i * D * E, in.router_b + i * E, w.logits);
        int* cnt = w.cnt + i * 64; int* offs = w.offs + i * 64;
        k_topk<<<T / 256, 256, 0, st>>>(w.logits, cnt, w.list, w.tk_e, w.tk_pos, w.tk_gate);
        k_offsets<<<1, 64, 0, st>>>(cnt, offs);
        GemmP a{}; a.A = w.H; a.lda = D; a.rowlist = w.list; a.rowlist_stride = T; a.row_shift = 2; a.counts = cnt; a.offs = offs; a.W = in.moe_w_in + (size_t)i * E * D * 2 * D; a.w_stride = (size_t)D * 2 * D;
        a.bias = in.moe_b_in + (size_t)i * E * 2 * D; a.b_stride = 2 * D; a.C = w.Un; a.ldc = 2 * D; a.N = 2 * D; a.K = D;
        k_gemm<<<dim3(2 * D / 64, T / 64, E), 256, 0, st>>>(a);
        k_swiglu<<<(unsigned)(((size_t)NSLOT * D + 255) / 256), 256, 0, st>>>(w.Un, w.ACT, NSLOT);
        GemmP o{}; o.A = w.ACT; o.lda = D; o.counts = cnt; o.offs = offs; o.a_use_off = 1; o.W = in.moe_w_out + (size_t)i * E * D * D; o.w_stride = (size_t)D * D;
        o.bias = in.moe_b_out + (size_t)i * E * D; o.b_stride = D; o.C = w.Yn; o.ldc = D; o.N = D; o.K = D;
        k_gemm<<<dim3(D / 64, T / 64, E), 256, 0, st>>>(o);
        k_combine<<<T * D / 256, 256, 0, st>>>(w.X, w.Yn, offs, w.tk_e, w.tk_pos, w.tk_gate, g_f, MS);
        if (snaps && snaps[2 * i + 1]) hipMemcpyAsync(snaps[2 * i + 1], w.X, (size_t)T * D * 4, hipMemcpyDeviceToDevice, st);
    }
    k_norm<<<T, 256, 0, st>>>(w.X, in.final_norm_g, nullptr, nullptr, 0, out);
}
}
extern "C" void kernel_launch(void* const* d_in, const int* in_sizes, int n_in, void* d_out, int out_size, void* d_ws, size_t ws_size, hipStream_t stream) {
    if (n_in != 27 || out_size != nv::T * nv::D || ws_size < nv::WS_BYTES) { fprintf(stderr, "kernel_launch: unexpected shapes (n_in %d out %d ws %zu)\n", n_in, out_size, ws_size); return; }
    nv::In in; const float** f = (const float**)&in; for (int i = 0; i < 27; ++i) f[i] = (const float*)d_in[i];
    nv::WS w = nv::carve((unsigned char*)d_ws);
    nv::forward(in, w, (float*)d_out, stream);
}
```

```cpp
#include <hip/hip_runtime.h>
#include <cstdio>
#include <cstdint>
namespace fk {
#define LAS __attribute__((address_space(3)))
#define GAS __attribute__((address_space(1)))
typedef unsigned short bf16_t;
typedef short bf16x8 __attribute__((ext_vector_type(8)));
typedef short s16x4 __attribute__((ext_vector_type(4)));
typedef float f32x4 __attribute__((ext_vector_type(4)));
typedef float f32x2 __attribute__((ext_vector_type(2)));
typedef float f32x16 __attribute__((ext_vector_type(16)));
typedef unsigned u32x4 __attribute__((ext_vector_type(4)));
typedef unsigned u32x2 __attribute__((ext_vector_type(2)));
typedef __bf16 bf16x2_t __attribute__((ext_vector_type(2)));
typedef GAS unsigned gu32;
#define RLX_AGENT __ATOMIC_RELAXED, __HIP_MEMORY_SCOPE_AGENT
#define LDS_WAIT() asm volatile("s_waitcnt lgkmcnt(0)" ::: "memory")
#define VM_WAIT() asm volatile("s_waitcnt vmcnt(0)" ::: "memory")

constexpr int T = 16384, D = 1024, SEQ = 2048, NBATCH = 8, NE = 32, DEPTH = 4;
constexpr int NWAVES = 8, NTHR = 512;
constexpr int SLOTCAP = T * 4 + NE * 256;
constexpr float LOG2E = 1.4426950408889634f;

__device__ __forceinline__ unsigned cvt_pk(float lo, float hi) { f32x2 v = {lo, hi}; bf16x2_t b = __builtin_convertvector(v, bf16x2_t); return __builtin_bit_cast(unsigned, b); }
__device__ __forceinline__ float bf_lo(unsigned w) { return __uint_as_float(w << 16); }
__device__ __forceinline__ float bf_hi(unsigned w) { return __uint_as_float(w & 0xffff0000u); }
__device__ __forceinline__ float sigmoid_f(float v) { return __builtin_amdgcn_rcpf(1.0f + __builtin_amdgcn_exp2f(-LOG2E * v)); }

constexpr size_t MiB = (size_t)1 << 20;
constexpr size_t WS_CTL = 0, CTL_ZERO_BYTES = 1 * MiB;
constexpr size_t WS_MOD = 1 * MiB;
constexpr size_t WS_WQKV = 2 * MiB;
constexpr size_t WS_WO = 8 * MiB;
constexpr size_t WS_CWIN = 12 * MiB;
constexpr size_t WS_CWOUT = 20 * MiB;
constexpr size_t WS_MWIN = 24 * MiB;
constexpr size_t WS_MWOUT = WS_MWIN + 512 * MiB;
constexpr size_t WS_X = WS_MWOUT + 256 * MiB;
constexpr size_t WS_H = WS_X + 64 * MiB;
constexpr size_t WS_QKV = WS_H + 32 * MiB;
constexpr size_t WS_AO = WS_QKV + 48 * MiB;
constexpr size_t WS_U = WS_AO + 32 * MiB;
constexpr size_t WS_LIST = WS_U + 32 * MiB;
constexpr size_t WS_GLIST = WS_LIST + 2 * MiB;
constexpr size_t WS_TK = WS_GLIST + 2 * MiB;
constexpr size_t WS_ACT = WS_TK + 1 * MiB;
constexpr size_t WS_YS = WS_ACT + 144 * MiB;
constexpr size_t WS_END = WS_YS + 144 * MiB;
constexpr int CW_TMO = 0, CW_P0Q = 64, CW_BAR = 4096, CW_CNT = 16384;
#define XCD_BAR_WORDS 3456

constexpr int RING_BYTES = 131072;
constexpr int LDS_TOK = RING_BYTES;
constexpr int LDS_UT = LDS_TOK + 9216;
constexpr int LDS_EXP = LDS_UT + 256;
constexpr int LDS_MISC = LDS_EXP + 512;
constexpr int LDS_BYTES = 147456;
static_assert(LDS_MISC + 128 <= LDS_BYTES, "LDS map");

#define XB_TMO      128
#define XB_XCNT(j)  (256  + 64 * (j))
#define XB_XSUB(j)  (1280 + 64 * (j))
#define XB_XGEN(j)  (2304 + 64 * (j))
#define XB_TOP      3328
#define XB_TOPGEN   3392
#define XB_SPIN_CAP (1u << 18)
__device__ __forceinline__ unsigned xb_ld(unsigned* p)              { return __hip_atomic_load(p, __ATOMIC_RELAXED, __HIP_MEMORY_SCOPE_AGENT); }
__device__ __forceinline__ unsigned xb_add(unsigned* p, unsigned v) { return __hip_atomic_fetch_add(p, v, __ATOMIC_RELAXED, __HIP_MEMORY_SCOPE_AGENT); }
__device__ __forceinline__ unsigned xb_xcc_id() { return (unsigned)__builtin_amdgcn_s_getreg((3 << 11) | 20) & 0xFu; }
#define XB_SPIN(cond, bar) do { unsigned _sp = 0; while (cond) { __builtin_amdgcn_s_sleep(1); \
    if ((++_sp & 255u) == 0u) { if (xb_ld(&(bar)[XB_TMO])) break; if (_sp > XB_SPIN_CAP) { atomicAdd(&(bar)[XB_TMO], 1u); break; } } } } while (0)
struct XcdBarrier { unsigned* bar; unsigned x; volatile LAS unsigned* st; };
__device__ __forceinline__ XcdBarrier xcd_barrier_post(unsigned* bar, volatile LAS unsigned* st) {
    XcdBarrier b; b.bar = bar; b.x = xb_xcc_id(); b.st = st;
    if (threadIdx.x == 0) (void)xb_add(&bar[XB_XCNT(b.x)], 1u);
    return b;
}
__device__ __forceinline__ void xcd_barrier_complete(unsigned* bar, unsigned x, unsigned& nloc, unsigned& nx) {
    const unsigned G = gridDim.x * gridDim.y * gridDim.z;
    unsigned sum, cnt, mine, sp = 0u;
    for (;;) {
        sum = 0u; cnt = 0u; mine = 0u;
#pragma unroll
        for (unsigned j = 0; j < 16; ++j) { const unsigned c = xb_ld(&bar[XB_XCNT(j)]); sum += c; cnt += (c > 0u) ? 1u : 0u; mine = (j == x) ? c : mine; }
        if (sum == G) break;
        __builtin_amdgcn_s_sleep(1);
        if ((++sp & 255u) == 0u) { if (xb_ld(&bar[XB_TMO])) break; if (sp > XB_SPIN_CAP) { atomicAdd(&bar[XB_TMO], 1u); break; } }
    }
    nloc = mine > 0u ? mine : 1u; nx = cnt > 0u ? cnt : 1u;
}
__device__ __forceinline__ void xcd_barrier(const XcdBarrier& b) {
    asm volatile("s_waitcnt vmcnt(0)" ::: "memory");
    __syncthreads();
    if (threadIdx.x == 0) {
        unsigned* bar = b.bar;
        __builtin_amdgcn_s_waitcnt(0);
        unsigned nloc = b.st[0], nx = b.st[1];
        if (nloc == 0u) { xcd_barrier_complete(bar, b.x, nloc, nx); b.st[0] = nloc; b.st[1] = nx; }
        const unsigned old = xb_add(&bar[XB_XSUB(b.x)], 1u);
        const unsigned gen = old / nloc;
        if (old + 1u == (gen + 1u) * nloc) {
            __builtin_amdgcn_fence(__ATOMIC_RELEASE, "agent");
            asm volatile("s_waitcnt vmcnt(0)" ::: "memory");
            const unsigned og = xb_add(&bar[XB_TOP], 1u);
            const unsigned tg = og / nx;
            if (og + 1u == (tg + 1u) * nx) xb_add(&bar[XB_TOPGEN], 1u);
            else XB_SPIN(xb_ld(&bar[XB_TOPGEN]) == tg, bar);
            __builtin_amdgcn_fence(__ATOMIC_ACQUIRE, "agent");
            xb_add(&bar[XB_XGEN(b.x)], 1u);
            asm volatile("s_waitcnt vmcnt(0)" ::: "memory");
        } else {
            XB_SPIN(xb_ld(&bar[XB_XGEN(b.x)]) == gen, bar);
            __builtin_amdgcn_fence(__ATOMIC_ACQUIRE, "agent");
            asm volatile("s_waitcnt vmcnt(0)" ::: "memory");
        }
    }
    __syncthreads();
}

constexpr int BM = 256, BK = 64, HALF = 128, HTB = HALF * BK * 2, NXCD = 8, WGM = 8;
__host__ __device__ __forceinline__ int lds_byte(int r, int c) { const int st = (r >> 4) * 2 + (c >> 5), rr = r & 15, cc = c & 31, ob = rr * 64 + cc * 2; return st * 1024 + (ob ^ (((ob >> 9) & 1) << 5)); }
__host__ __device__ __forceinline__ void stage_rc(int b, int& R, int& C) { const int st = b / 1024, sb = b % 1024, swz = sb ^ (((sb >> 9) & 1) << 5); R = (st >> 1) * 16 + swz / 64; C = (st & 1) * 32 + (swz % 64) / 2; }
__host__ __device__ __forceinline__ int perm32(int rho) { const int n = rho >> 4, i = rho & 15; return 8 * (i >> 2) + 4 * n + (i & 3); }

struct Unit { int am, om, e, pn; };
struct Gemm { const bf16_t* A; const bf16_t* Bt; int K; size_t b_estride; };

struct DenseOrder {
    int nM, nN, nwg, G, c;
    __device__ void init(int N, int G_, int c_) { nM = T / BM; nN = N / BM; nwg = nM * nN; G = G_; c = c_; }
    __device__ __forceinline__ bool next(int i, Unit& u) const {
        const long L = (long)i * G + c; if (L >= nwg) return false;
        int wgid = (int)L; { const int q = nwg / NXCD, r = nwg % NXCD, xcd = wgid % NXCD, off = wgid / NXCD; wgid = (xcd < r ? xcd * (q + 1) : r * (q + 1) + (xcd - r) * q) + off; }
        const int nig = WGM * nN, gid = wgid / nig, fm = gid * WGM, gsz = (nM - fm) < WGM ? (nM - fm) : WGM;
        const int pm = fm + ((wgid % nig) % gsz); u.pn = (wgid % nig) / gsz; u.am = pm * BM; u.om = pm * BM; u.e = 0; return true;
    }
};
struct TableOrder {
    const LAS int* ut; int n;
    __device__ __forceinline__ bool next(int i, Unit& u) const {
        if (i >= n) return false;
        u.am = __builtin_amdgcn_readfirstlane(ut[4 * i]); u.om = __builtin_amdgcn_readfirstlane(ut[4 * i + 1]); u.e = __builtin_amdgcn_readfirstlane(ut[4 * i + 2]); u.pn = __builtin_amdgcn_readfirstlane(ut[4 * i + 3]); return true;
    }
};

template <class Epi, class Sched, bool GATHER>
__device__ __forceinline__ void gemm_phase(LAS unsigned char* lds, const Gemm g, const Sched& S, const Epi& E, const LAS int* toktab, const int tid) {
    const int wid = __builtin_amdgcn_readfirstlane(tid >> 6), lane = tid & 63, wr = wid >> 2, wc = wid & 3, fr = lane & 15, fq = lane >> 4;
    const int K = g.K, nt = K / BK;
    int Rr[2], Cc[2]; unsigned voffB[2];
#pragma unroll
    for (int i = 0; i < 2; ++i) { int R, C; stage_rc(tid * 16 + i * 8192, R, C); Rr[i] = R; Cc[i] = C; const int Rb = Epi::PERM ? ((R & ~31) + perm32(R & 31)) : R; voffB[i] = (unsigned)(Rb * K + C) * 2u; }
    const size_t kstep = (size_t)(BK * 2);
    const size_t hstep = (size_t)HALF * K * 2;
    const unsigned ldsw = (unsigned)wid * 1024u;
    const int aoff = lds_byte(wr * 64 + fr, fq * 8), boff = lds_byte(wc * 32 + fr, fq * 8);
#define PG8_SA(b, h) (((b) * 2 + (h)) * HTB)
#define PG8_SB(b, h) ((4 + (b) * 2 + (h)) * HTB)
#define PG8_STAGE(bufoff, gbase, voff) do { _Pragma("unroll") for (int _i = 0; _i < 2; ++_i) \
        __builtin_amdgcn_global_load_lds((const unsigned*)((const char*)(gbase) + (voff)[_i]), (LAS unsigned*)(lds + (bufoff) + ldsw + _i * 8192), 16, 0, 0); } while (0)
#define PG8_LDA(dst, b, h) do { _Pragma("unroll") for (int m = 0; m < 4; ++m) _Pragma("unroll") for (int k = 0; k < 2; ++k) dst[m][k] = *(const LAS bf16x8*)(lds + PG8_SA(b, h) + aoff + m * 2048 + k * 1024); } while (0)
#define PG8_LDB(dst, b, h) do { _Pragma("unroll") for (int n = 0; n < 2; ++n) _Pragma("unroll") for (int k = 0; k < 2; ++k) dst[n][k] = *(const LAS bf16x8*)(lds + PG8_SB(b, h) + boff + n * 2048 + k * 1024); } while (0)
#define PG8_MMA(ai, bj, At, Bt) do { __builtin_amdgcn_s_setprio(1); _Pragma("unroll") for (int m = 0; m < 4; ++m) _Pragma("unroll") for (int n = 0; n < 2; ++n) _Pragma("unroll") for (int k = 0; k < 2; ++k) \
        acc[ai][bj][m][n] = __builtin_amdgcn_mfma_f32_16x16x32_bf16(Bt[n][k], At[m][k], acc[ai][bj][m][n], 0, 0, 0); __builtin_amdgcn_s_setprio(0); } while (0)
#define PG8_WAIT_V(n) asm volatile("s_waitcnt vmcnt(" #n ")" ::: "memory")
#define PG8_WAIT_L(n) asm volatile("s_waitcnt lgkmcnt(" #n ")" ::: "memory")
#define PG8_BAR __builtin_amdgcn_s_barrier()
#define PG8_SCHED __builtin_amdgcn_sched_barrier(0)
#define A_OFFS(dst, u) do { _Pragma("unroll") for (int _h = 0; _h < 2; ++_h) _Pragma("unroll") for (int _i = 0; _i < 2; ++_i) { \
        const int _row = GATHER ? toktab[(u).am + _h * HALF + Rr[_i]] : ((u).am + _h * HALF + Rr[_i]); dst[_h][_i] = (unsigned)(_row * K + Cc[_i]) * 2u; } } while (0)
    Unit cur, nxt; int ui = 0;
    if (!S.next(0, cur)) return;
    f32x4 acc[2][2][4][2];
#pragma unroll
    for (int a = 0; a < 2; ++a)
#pragma unroll
        for (int b = 0; b < 2; ++b)
#pragma unroll
            for (int m = 0; m < 4; ++m)
#pragma unroll
                for (int n = 0; n < 2; ++n) acc[a][b][m][n] = (f32x4){0.f, 0.f, 0.f, 0.f};
    bf16x8 At[4][2], B0[2][2], B1[2][2];
    unsigned ao[2][2]; A_OFFS(ao, cur);
    const char* const Ab = (const char*)g.A;
    const char* cB = (const char*)g.Bt + ((size_t)cur.e * g.b_estride + (size_t)cur.pn * BM * K) * 2;
    PG8_STAGE(PG8_SB(0, 0), cB, voffB); PG8_STAGE(PG8_SB(0, 1), cB + hstep, voffB); PG8_STAGE(PG8_SA(0, 0), Ab, ao[0]); PG8_STAGE(PG8_SA(0, 1), Ab, ao[1]);
    if (wr == 1) PG8_BAR;
    PG8_WAIT_V(2); PG8_BAR;
    PG8_STAGE(PG8_SB(1, 0), cB + kstep, voffB); PG8_STAGE(PG8_SA(1, 0), Ab + kstep, ao[0]); PG8_STAGE(PG8_SB(1, 1), cB + hstep + kstep, voffB);
    PG8_WAIT_V(6); PG8_BAR;
    for (;;) {
        const bool has_next = S.next(ui + 1, nxt);
        const char* nB = has_next ? (const char*)g.Bt + ((size_t)nxt.e * g.b_estride + (size_t)nxt.pn * BM * K) * 2 : cB;
        for (int t = 0; t < nt; t += 2) {
            const bool last = (t == nt - 2);
            const char* a1 = Ab + (size_t)(t + 1) * kstep;
            const char* a2 = last ? Ab : Ab + (size_t)(t + 2) * kstep; const char* b2 = last ? nB : cB + (size_t)(t + 2) * kstep;
            const char* a3 = a2 + kstep; const char* b3 = b2 + kstep;
            unsigned a2o[2][2];
            if (last && has_next) { A_OFFS(a2o, nxt); }
            else {
#pragma unroll
                for (int _h = 0; _h < 2; ++_h)
#pragma unroll
                    for (int _i = 0; _i < 2; ++_i) a2o[_h][_i] = ao[_h][_i]; }
            PG8_LDB(B0, 0, 0); PG8_LDB(B1, 0, 1); PG8_SCHED; PG8_LDA(At, 0, 0); PG8_STAGE(PG8_SA(1, 1), a1, ao[1]);
            PG8_WAIT_V(8); PG8_WAIT_L(0); PG8_BAR; PG8_MMA(0, 0, At, B0); PG8_MMA(0, 1, At, B1); PG8_BAR; PG8_SCHED;
            PG8_LDA(At, 0, 1); PG8_STAGE(PG8_SB(0, 0), b2, voffB); PG8_STAGE(PG8_SB(0, 1), b2 + hstep, voffB); PG8_STAGE(PG8_SA(0, 0), a2, a2o[0]);
            PG8_WAIT_V(8); PG8_WAIT_L(0); PG8_BAR; PG8_MMA(1, 0, At, B0); PG8_MMA(1, 1, At, B1); PG8_BAR; PG8_SCHED;
            PG8_LDB(B0, 1, 0); PG8_LDB(B1, 1, 1); PG8_SCHED; PG8_LDA(At, 1, 0); PG8_STAGE(PG8_SA(0, 1), a2, a2o[1]);
            PG8_WAIT_V(8); PG8_WAIT_L(0); PG8_BAR; PG8_MMA(0, 0, At, B0); PG8_MMA(0, 1, At, B1); PG8_BAR; PG8_SCHED;
            PG8_LDA(At, 1, 1); PG8_STAGE(PG8_SB(1, 0), b3, voffB); PG8_STAGE(PG8_SB(1, 1), b3 + hstep, voffB); PG8_STAGE(PG8_SA(1, 0), a3, a2o[0]);
            PG8_WAIT_V(8); PG8_WAIT_L(0); PG8_BAR; PG8_MMA(1, 0, At, B0); PG8_MMA(1, 1, At, B1); PG8_BAR; PG8_SCHED;
            if (last) {
#pragma unroll
                for (int _h = 0; _h < 2; ++_h)
#pragma unroll
                    for (int _i = 0; _i < 2; ++_i) ao[_h][_i] = a2o[_h][_i]; }
        }
        if (wr == 0) PG8_BAR;
        E(acc, cur, wr, wc, fr, fq);
        if (!has_next) break;
#pragma unroll
        for (int a = 0; a < 2; ++a)
#pragma unroll
            for (int b = 0; b < 2; ++b)
#pragma unroll
                for (int m = 0; m < 4; ++m)
#pragma unroll
                    for (int n = 0; n < 2; ++n) acc[a][b][m][n] = (f32x4){0.f, 0.f, 0.f, 0.f};
        cur = nxt; cB = nB; ++ui;
        if (wr == 1) PG8_BAR;
    }
    PG8_WAIT_V(0);
    PG8_BAR;
#undef PG8_SA
#undef PG8_SB
#undef PG8_STAGE
#undef PG8_LDA
#undef PG8_LDB
#undef PG8_MMA
#undef PG8_WAIT_V
#undef PG8_WAIT_L
#undef PG8_BAR
#undef PG8_SCHED
#undef A_OFFS
}
struct EpiBias16 {
    static constexpr bool PERM = true;
    bf16_t* O; int ldc; const float* bias;
    __device__ __forceinline__ void operator()(const f32x4 (&acc)[2][2][4][2], const Unit& u, int wr, int wc, int fr, int fq) const {
        const int row0 = u.om + wr * 64 + fr, col0 = u.pn * BM + wc * 32 + 8 * fq;
        f32x4 bv[2][2];
#pragma unroll
        for (int bj = 0; bj < 2; ++bj)
#pragma unroll
            for (int n = 0; n < 2; ++n) bv[bj][n] = *(const f32x4*)(bias + col0 + bj * HALF + 4 * n);
#pragma unroll
        for (int ai = 0; ai < 2; ++ai)
#pragma unroll
            for (int m = 0; m < 4; ++m) { bf16_t* rowp = O + (size_t)(row0 + ai * HALF + m * 16) * ldc + col0;
#pragma unroll
                for (int bj = 0; bj < 2; ++bj) { const f32x4 v0 = acc[ai][bj][m][0] + bv[bj][0], v1 = acc[ai][bj][m][1] + bv[bj][1];
                    u32x4 w; w.x = cvt_pk(v0[0], v0[1]); w.y = cvt_pk(v0[2], v0[3]); w.z = cvt_pk(v1[0], v1[1]); w.w = cvt_pk(v1[2], v1[3]);
                    *(u32x4*)(rowp + bj * HALF) = w; } }
    }
};
struct EpiResid {
    static constexpr bool PERM = false;
    const float* Xin; float* X; const float* bias; const float* gate;
    __device__ __forceinline__ void operator()(const f32x4 (&acc)[2][2][4][2], const Unit& u, int wr, int wc, int fr, int fq) const {
        const int row0 = u.om + wr * 64 + fr, col0 = u.pn * BM + wc * 32 + 4 * fq; const float* gb = gate + (size_t)(u.om / SEQ) * (6 * D);
        f32x4 bv[2][2], gv[2][2];
#pragma unroll
        for (int bj = 0; bj < 2; ++bj)
#pragma unroll
            for (int n = 0; n < 2; ++n) { bv[bj][n] = *(const f32x4*)(bias + col0 + bj * HALF + n * 16); gv[bj][n] = *(const f32x4*)(gb + col0 + bj * HALF + n * 16); }
#pragma unroll
        for (int ai = 0; ai < 2; ++ai)
#pragma unroll
            for (int m = 0; m < 4; ++m) { const size_t off = (size_t)(row0 + ai * HALF + m * 16) * D + col0;
#pragma unroll
                for (int bj = 0; bj < 2; ++bj)
#pragma unroll
                    for (int n = 0; n < 2; ++n) { const f32x4 xi = *(const f32x4*)(Xin + off + bj * HALF + n * 16); *(f32x4*)(X + off + bj * HALF + n * 16) = xi + gv[bj][n] * (acc[ai][bj][m][n] + bv[bj][n]); }
                asm volatile("" ::: "memory"); }
    }
};
template <int MODE> struct EpiPair {
    static constexpr bool PERM = true;
    bf16_t* O; const float* bias; int b_estride;
    __device__ __forceinline__ void operator()(const f32x4 (&acc)[2][2][4][2], const Unit& u, int wr, int wc, int fr, int fq) const {
        const int row0 = u.om + wr * 64 + fr, col0 = u.pn * HALF + wc * 32 + 8 * fq; const float* bb = bias + (size_t)u.e * b_estride;
        f32x4 bv[2][2];
#pragma unroll
        for (int bj = 0; bj < 2; ++bj)
#pragma unroll
            for (int n = 0; n < 2; ++n) bv[bj][n] = *(const f32x4*)(bb + bj * D + col0 + 4 * n);
#pragma unroll
        for (int ai = 0; ai < 2; ++ai)
#pragma unroll
            for (int m = 0; m < 4; ++m) { bf16_t* rowp = O + (size_t)(row0 + ai * HALF + m * 16) * D + col0; float r[8];
#pragma unroll
                for (int n = 0; n < 2; ++n) { const f32x4 a = acc[ai][0][m][n] + bv[0][n], g = acc[ai][1][m][n] + bv[1][n];
#pragma unroll
                    for (int j = 0; j < 4; ++j) {
                        if (MODE == 0) r[4 * n + j] = a[j] * sigmoid_f(g[j]);
                        else { const float glu = fminf(a[j], 7.0f), lin = fminf(fmaxf(g[j], -7.0f), 7.0f); r[4 * n + j] = glu * sigmoid_f(1.702f * glu) * (lin + 1.0f); } } }
                u32x4 w; w.x = cvt_pk(r[0], r[1]); w.y = cvt_pk(r[2], r[3]); w.z = cvt_pk(r[4], r[5]); w.w = cvt_pk(r[6], r[7]);
                *(u32x4*)rowp = w; }
    }
};
struct EpiMoeOut {
    static constexpr bool PERM = true;
    bf16_t* O; const float* bias; const float* gl; const LAS int* exoff;
    __device__ __forceinline__ void operator()(const f32x4 (&acc)[2][2][4][2], const Unit& u, int wr, int wc, int fr, int fq) const {
        const int row0 = u.om + wr * 64 + fr, col0 = u.pn * BM + wc * 32 + 8 * fq; const float* bb = bias + (size_t)u.e * D;
        const float* gp = gl + (size_t)u.e * T + (u.om - exoff[u.e]) + wr * 64 + fr;
        f32x4 bv[2][2];
#pragma unroll
        for (int bj = 0; bj < 2; ++bj)
#pragma unroll
            for (int n = 0; n < 2; ++n) bv[bj][n] = *(const f32x4*)(bb + col0 + bj * HALF + 4 * n);
#pragma unroll
        for (int ai = 0; ai < 2; ++ai)
#pragma unroll
            for (int m = 0; m < 4; ++m) { bf16_t* rowp = O + (size_t)(row0 + ai * HALF + m * 16) * D + col0; const float gt = gp[ai * HALF + m * 16];
#pragma unroll
                for (int bj = 0; bj < 2; ++bj) { const f32x4 v0 = (acc[ai][bj][m][0] + bv[bj][0]) * gt, v1 = (acc[ai][bj][m][1] + bv[bj][1]) * gt;
                    u32x4 w; w.x = cvt_pk(v0[0], v0[1]); w.y = cvt_pk(v0[2], v0[3]); w.z = cvt_pk(v1[0], v1[1]); w.w = cvt_pk(v1[2], v1[3]);
                    *(u32x4*)(rowp + bj * HALF) = w; } }
    }
};

struct Frame {
    LAS unsigned char* lds; volatile LAS unsigned* MISC; gu32* ctl; unsigned char* ws;
    int tid, lane, wave, G, c;
    const float* const* in;
    float* out;
};
enum { I_X = 0, I_C, I_WMOD, I_BMOD, I_NMG, I_NFG, I_AWQKV, I_ABQKV, I_AWO, I_ABO, I_SINK, I_RELB, I_CWIN, I_CBIN, I_CWDW, I_CBDW, I_CLNG, I_CLNB, I_CWOUT, I_CBOUT, I_RW, I_RB, I_MWIN, I_MBIN, I_MWOUT, I_MBOUT, I_FNG };
#define WSP(type, off) ((type*)(F.ws + (off)))
__device__ __forceinline__ void wg_barrier() { __syncthreads(); }

__device__ __forceinline__ int build_exp_tables(Frame& F, int layer) {
    LAS int* EX = (LAS int*)(F.lds + LDS_EXP);
    if (F.tid < 64) {
        const int e = F.tid & 31; const int cnt = (int)__hip_atomic_load(F.ctl + CW_CNT + 64 * layer + e, RLX_AGENT); const int tiles = (cnt + 255) >> 8;
        int pre = tiles;
#pragma unroll
        for (int o = 1; o < 32; o <<= 1) { const int v = __shfl_up(pre, o, 32); if (e >= o) pre += v; }
        if (F.tid < 32) { EX[e] = cnt; EX[32 + e] = pre - tiles; EX[64 + e] = (pre - tiles) * 256; if (e == 31) EX[96] = pre; }
    }
    wg_barrier();
    return EX[96];
}
template <int MODE> __device__ __forceinline__ void row_phase(Frame& F, int layer) {
    constexpr bool COMB = (MODE & 1) != 0, ROUT = (MODE & 2) != 0, FIN = (MODE & 4) != 0;
    LAS float* red = (LAS float*)(F.lds); LAS float* part = (LAS float*)(F.lds + 1024); LAS float* lg = (LAS float*)(F.lds + 1024 + 16384);
    LAS int* hist = (LAS int*)(F.lds + 20480); LAS int* gbase = hist + 32; LAS int* pend = (LAS int*)(F.lds + 20480 + 256);
    const LAS int* EX = (const LAS int*)(F.lds + LDS_EXP);
    const int lane = F.lane, w = F.wave, row = lane & 15, kq = lane >> 4, kb = 128 * w + 8 * kq;
    const float* xin = (layer == 0 && !ROUT && !COMB && !FIN) ? F.in[I_X] : WSP(const float, WS_X);
    float* X = WSP(float, WS_X); bf16_t* H = WSP(bf16_t, WS_H);
    const float* mod = WSP(const float, WS_MOD);
    const float* gamma = FIN ? F.in[I_FNG] : (ROUT ? F.in[I_NFG] + layer * D : F.in[I_NMG] + layer * D);
    const int ngrp = T / 16, g0 = (int)((long)F.c * ngrp / F.G), g1 = (int)((long)(F.c + 1) * ngrp / F.G);
    if (COMB) build_exp_tables(F, layer - 1);
    if (ROUT) { if (F.tid < 32) hist[F.tid] = 0; }
    bf16x8 whi[2][4], wlo[2][4];
    if (ROUT) {
        const float* wrp = F.in[I_RW] + (size_t)layer * D * NE;
#pragma unroll
        for (int eh = 0; eh < 2; ++eh)
#pragma unroll
            for (int s = 0; s < 4; ++s) { float v[8];
#pragma unroll
                for (int j = 0; j < 8; ++j) v[j] = wrp[(size_t)(kb + 32 * s + j) * NE + 16 * eh + row];
                u32x4 hi, lo;
#pragma unroll
                for (int p = 0; p < 4; ++p) { const unsigned h2 = cvt_pk(v[2 * p], v[2 * p + 1]); hi[p] = h2; lo[p] = cvt_pk(v[2 * p] - bf_lo(h2), v[2 * p + 1] - bf_hi(h2)); }
                whi[eh][s] = __builtin_bit_cast(bf16x8, hi); wlo[eh][s] = __builtin_bit_cast(bf16x8, lo); }
    }
    LAS float* Gl = (LAS float*)(F.lds + 32768); LAS float* Sl = Gl + D; LAS float* Fl = Sl + D;
    int curb = -1;
    for (int grp = g0; grp < g1; ++grp) {
        const int t = grp * 16 + row, b = (grp * 16) / SEQ, par = (grp - g0) & 1;
        if (b != curb) { curb = b;
            const float* mb = mod + ((size_t)layer * NBATCH + b) * (6 * D);
            wg_barrier();
            for (int k = F.tid; k < D; k += NTHR) { const float gm = gamma[k];
                if (FIN) { Gl[k] = gm; Sl[k] = 0.f; }
                else { const float* shp = mb + (ROUT ? 3 * D : 0); const float* scp = mb + (ROUT ? 4 * D : D); Gl[k] = gm * (scp[k] + 1.0f); Sl[k] = shp[k]; }
                if (COMB) { const float* gf = mod + ((size_t)(layer - 1) * NBATCH + b) * (6 * D) + 5 * D; Fl[k] = gf[k]; } }
            wg_barrier();
        }
        f32x4 xv[4][2];
#pragma unroll
        for (int s = 0; s < 4; ++s)
#pragma unroll
            for (int q = 0; q < 2; ++q) xv[s][q] = *(const f32x4*)(xin + (size_t)t * D + kb + 32 * s + 4 * q);
        if (COMB) {
            const bf16_t* YS = WSP(const bf16_t, WS_YS); const int* TK = WSP(const int, WS_TK);
            size_t yoff[4];
#pragma unroll
            for (int kk = 0; kk < 4; ++kk) { const int tk = TK[t * 4 + kk]; yoff[kk] = (size_t)(EX[64 + (tk >> 16)] + (tk & 0xffff)) * D + kb; }
#pragma unroll
            for (int s = 0; s < 4; ++s) { f32x4 a0 = (f32x4){0.f, 0.f, 0.f, 0.f}, a1 = a0;
#pragma unroll
                for (int kk = 0; kk < 4; ++kk) { const u32x4 y = *(const u32x4*)(YS + yoff[kk] + 32 * s);
                    a0 += (f32x4){bf_lo(y.x), bf_hi(y.x), bf_lo(y.y), bf_hi(y.y)}; a1 += (f32x4){bf_lo(y.z), bf_hi(y.z), bf_lo(y.w), bf_hi(y.w)}; }
                xv[s][0] += *(const LAS f32x4*)(Fl + kb + 32 * s) * a0; xv[s][1] += *(const LAS f32x4*)(Fl + kb + 32 * s + 4) * a1;
                if (!FIN) { *(f32x4*)(X + (size_t)t * D + kb + 32 * s) = xv[s][0]; *(f32x4*)(X + (size_t)t * D + kb + 32 * s + 4) = xv[s][1]; } }
        }
        float ss = 0.f;
#pragma unroll
        for (int s = 0; s < 4; ++s)
#pragma unroll
            for (int q = 0; q < 2; ++q) { const f32x4 v = xv[s][q]; ss += (v[0] * v[0] + v[1] * v[1]) + (v[2] * v[2] + v[3] * v[3]); }
        ss += __shfl_xor(ss, 16); ss += __shfl_xor(ss, 32);
        if (kq == 0) red[par * 128 + w * 16 + row] = ss;
        wg_barrier();
        float tot = 0.f;
#pragma unroll
        for (int ww = 0; ww < 8; ++ww) tot += red[par * 128 + ww * 16 + row];
        const float rstd = rsqrtf(tot * (1.0f / D) + 1e-5f);
        f32x4 acc[2] = {(f32x4){0.f, 0.f, 0.f, 0.f}, (f32x4){0.f, 0.f, 0.f, 0.f}};
#pragma unroll
        for (int s = 0; s < 4; ++s) {
            const f32x4 h0 = xv[s][0] * rstd * *(const LAS f32x4*)(Gl + kb + 32 * s) + *(const LAS f32x4*)(Sl + kb + 32 * s), h1 = xv[s][1] * rstd * *(const LAS f32x4*)(Gl + kb + 32 * s + 4) + *(const LAS f32x4*)(Sl + kb + 32 * s + 4);
            if (FIN) { *(f32x4*)(F.out + (size_t)t * D + kb + 32 * s) = h0; *(f32x4*)(F.out + (size_t)t * D + kb + 32 * s + 4) = h1; }
            else {
                u32x4 hi; hi.x = cvt_pk(h0[0], h0[1]); hi.y = cvt_pk(h0[2], h0[3]); hi.z = cvt_pk(h1[0], h1[1]); hi.w = cvt_pk(h1[2], h1[3]);
                *(u32x4*)(H + (size_t)t * D + kb + 32 * s) = hi;
                if (ROUT) {
                    u32x4 lo; lo.x = cvt_pk(h0[0] - bf_lo(hi.x), h0[1] - bf_hi(hi.x)); lo.y = cvt_pk(h0[2] - bf_lo(hi.y), h0[3] - bf_hi(hi.y));
                    lo.z = cvt_pk(h1[0] - bf_lo(hi.z), h1[1] - bf_hi(hi.z)); lo.w = cvt_pk(h1[2] - bf_lo(hi.w), h1[3] - bf_hi(hi.w));
                    const bf16x8 ah = __builtin_bit_cast(bf16x8, hi), al = __builtin_bit_cast(bf16x8, lo);
#pragma unroll
                    for (int eh = 0; eh < 2; ++eh) {
                        acc[eh] = __builtin_amdgcn_mfma_f32_16x16x32_bf16(ah, whi[eh][s], acc[eh], 0, 0, 0);
                        acc[eh] = __builtin_amdgcn_mfma_f32_16x16x32_bf16(ah, wlo[eh][s], acc[eh], 0, 0, 0);
                        acc[eh] = __builtin_amdgcn_mfma_f32_16x16x32_bf16(al, whi[eh][s], acc[eh], 0, 0, 0); }
                }
            }
        }
        if (ROUT) {
#pragma unroll
            for (int eh = 0; eh < 2; ++eh)
#pragma unroll
                for (int i = 0; i < 4; ++i) part[(w * 16 + 4 * kq + i) * 32 + 16 * eh + row] = acc[eh][i];
            wg_barrier();
            { const int r = F.tid >> 5, e = F.tid & 31; float v = F.in[I_RB][layer * NE + e];
#pragma unroll
              for (int ww = 0; ww < 8; ++ww) v += part[(ww * 16 + r) * 32 + e];
              lg[r * 32 + e] = v; }
            wg_barrier();
            if (F.tid < 16) {
                const int r = F.tid; unsigned used = 0u; int ids[4]; float vals[4];
#pragma unroll
                for (int k = 0; k < 4; ++k) { int bi = 0; float bv = -3.0e38f;
                    for (int e = 0; e < 32; ++e) { const float v = lg[r * 32 + e]; if (!((used >> e) & 1u) && v > bv) { bv = v; bi = e; } }
                    used |= 1u << bi; ids[k] = bi; vals[k] = bv; }
                const float e1 = __expf(vals[1] - vals[0]), e2 = __expf(vals[2] - vals[0]), e3 = __expf(vals[3] - vals[0]), inv = 1.0f / (1.0f + e1 + e2 + e3);
                const float gs[4] = {inv, e1 * inv, e2 * inv, e3 * inv};
#pragma unroll
                for (int k = 0; k < 4; ++k) { const int lp = atomicAdd((int*)&hist[ids[k]], 1); const int idx = ((grp - g0) * 16 + r) * 4 + k; pend[2 * idx] = ids[k] | (lp << 8); pend[2 * idx + 1] = __float_as_int(gs[k]); }
            }
        }
    }
    if (ROUT) {
        wg_barrier();
        if (F.tid < 32) { const int n = hist[F.tid]; gbase[F.tid] = n > 0 ? (int)__hip_atomic_fetch_add(F.ctl + CW_CNT + 64 * layer + F.tid, (unsigned)n, RLX_AGENT) : 0; }
        wg_barrier();
        int* LIST = WSP(int, WS_LIST); float* GL = WSP(float, WS_GLIST); int* TK = WSP(int, WS_TK);
        const int nent = (g1 - g0) * 64;
        for (int idx = F.tid; idx < nent; idx += NTHR) { const int pw = pend[2 * idx], e = pw & 0xff, pos = gbase[e] + (pw >> 8), tok = g0 * 16 + (idx >> 2);
            LIST[(size_t)e * T + pos] = tok; GL[(size_t)e * T + pos] = __int_as_float(pend[2 * idx + 1]); TK[tok * 4 + (idx & 3)] = (e << 16) | pos; }
    }
    wg_barrier();
}
__device__ const unsigned char kBucket[128] = {0, 1, 2, 3, 4, 5, 6, 7, 8, 9, 10, 11, 12, 13, 14, 15, 16, 16, 16, 17, 17, 18, 18, 18, 19, 19, 19, 20, 20, 20, 20, 21, 21, 21, 21, 22, 22, 22, 22, 22, 23, 23, 23, 23, 23, 23, 24, 24, 24, 24, 24, 24, 25, 25, 25, 25, 25, 25, 25, 26, 26, 26, 26, 26, 26, 26, 26, 27, 27, 27, 27, 27, 27, 27, 27, 27, 27, 28, 28, 28, 28, 28, 28, 28, 28, 28, 28, 29, 29, 29, 29, 29, 29, 29, 29, 29, 29, 29, 29, 30, 30, 30, 30, 30, 30, 30, 30, 30, 30, 30, 30, 30, 30, 31, 31, 31, 31, 31, 31, 31, 31, 31, 31, 31, 31, 31, 31, 31};
constexpr int KP = 144, VP = 192;
constexpr int ATT_K = 0, ATT_V = 256 * KP, ATT_B = ATT_V + 256 * VP;
__device__ __forceinline__ int crow(int r, int hi) { return (r & 3) + 8 * (r >> 2) + 4 * hi; }
typedef short v4i16_t __attribute__((ext_vector_type(4)));
__device__ __forceinline__ s16x4 vtr(const LAS unsigned char* p) { return __builtin_bit_cast(s16x4, __builtin_amdgcn_ds_read_tr16_b64_v4i16((LAS v4i16_t*)p)); }

__device__ __forceinline__ void attn_phase(Frame& F, int j) {
    const bf16_t* QKV = WSP(const bf16_t, WS_QKV); bf16_t* AO = WSP(bf16_t, WS_AO);
    LAS unsigned char* Kl = F.lds + ATT_K; LAS unsigned char* Vl = F.lds + ATT_V; LAS float* Bl = (LAS float*)(F.lds + ATT_B);
    const int lane = F.lane, w = F.wave, r = lane & 31, hh = lane >> 5;
    const float c1 = 0.125f * LOG2E;
    for (int unit = F.c; unit < NBATCH * 16 * 4; unit += F.G) {
        const int kvh = unit & 3, n = (unit >> 2) & 15, b = unit >> 6;
        const int krow0 = b * SEQ + (n > 0 ? (n - 1) * 128 : 0);
#pragma unroll
        for (int it = 0; it < 4; ++it) { const int ch = F.tid + NTHR * it, s = ch >> 3, c8 = ch & 7;
            const int grow = (n > 0 || s >= 128) ? (b * SEQ + (n - 1) * 128 + s) : (krow0 + s);
            const u32x4 kv = *(const u32x4*)(QKV + (size_t)grow * 1536 + 1024 + kvh * 64 + 8 * c8); const u32x4 vv = *(const u32x4*)(QKV + (size_t)grow * 1536 + 1280 + kvh * 64 + 8 * c8);
            *(LAS u32x4*)(Kl + s * KP + 16 * c8) = kv; *(LAS u32x4*)(Vl + s * VP + 16 * c8) = vv; }
        { const int g = F.tid >> 7, dist = F.tid & 127; Bl[F.tid] = F.in[I_RELB][kBucket[dist] * 16 + kvh * 4 + g] * LOG2E; }
        wg_barrier();
        const int g = w >> 1, hq = kvh * 4 + g; const float sink2 = F.in[I_SINK][j * 16 + hq] * LOG2E;
#pragma unroll 1
        for (int grp = 0; grp < 2; ++grp) {
            const int a0 = (w & 1) * 64 + grp * 32, a = a0 + r; const size_t tok = (size_t)b * SEQ + n * 128 + a;
            bf16x8 qf[4];
#pragma unroll
            for (int d0 = 0; d0 < 4; ++d0) qf[d0] = *(const bf16x8*)(QKV + tok * 1536 + hq * 64 + 16 * d0 + 8 * hh);
            const int kt0 = a0 >> 5;
            f32x16 S[5];
#pragma unroll
            for (int t = 0; t < 5; ++t) {
#pragma unroll
                for (int i = 0; i < 16; ++i) S[t][i] = 0.f;
                const LAS unsigned char* kp = Kl + (32 * (kt0 + t) + r) * KP + 16 * hh;
#pragma unroll
                for (int d0 = 0; d0 < 4; ++d0) { const bf16x8 kf = *(const LAS bf16x8*)(kp + 32 * d0); S[t] = __builtin_amdgcn_mfma_f32_32x32x16_bf16(kf, qf[d0], S[t], 0, 0, 0); }
            }
            float m = sink2;
#pragma unroll
            for (int t = 0; t < 5; ++t)
#pragma unroll
                for (int i = 0; i < 16; ++i) { const int s = 32 * (kt0 + t) + crow(i, hh), dist = a + 128 - s; const bool ok = (dist >= 0) && (dist < 128) && (n > 0 || s >= 128);
                    const float v = ok ? S[t][i] * c1 + Bl[g * 128 + (dist & 127)] : -3.0e38f; S[t][i] = v; m = fmaxf(m, v); }
            m = fmaxf(m, __shfl_xor(m, 32));
            float l = 0.f;
#pragma unroll
            for (int t = 0; t < 5; ++t)
#pragma unroll
                for (int i = 0; i < 16; ++i) { const float p = __builtin_amdgcn_exp2f(S[t][i] - m); S[t][i] = p; l += p; }
            l += __shfl_xor(l, 32); l += __builtin_amdgcn_exp2f(sink2 - m);
            f32x16 O[2];
#pragma unroll
            for (int i = 0; i < 16; ++i) { O[0][i] = 0.f; O[1][i] = 0.f; }
            const int q4 = (lane >> 2) & 3, p4 = lane & 3, blk = (lane >> 4) & 1;
#pragma unroll
            for (int t = 0; t < 5; ++t)
#pragma unroll
                for (int s2 = 0; s2 < 2; ++s2) {
                    u32x4 pk; pk.x = cvt_pk(S[t][8 * s2 + 0], S[t][8 * s2 + 1]); pk.y = cvt_pk(S[t][8 * s2 + 2], S[t][8 * s2 + 3]); pk.z = cvt_pk(S[t][8 * s2 + 4], S[t][8 * s2 + 5]); pk.w = cvt_pk(S[t][8 * s2 + 6], S[t][8 * s2 + 7]);
                    const bf16x8 pb = __builtin_bit_cast(bf16x8, pk);
                    const LAS unsigned char* vp = Vl + (32 * (kt0 + t) + 16 * s2 + 4 * hh + q4) * VP + 32 * blk + 8 * p4;
#pragma unroll
                    for (int dh = 0; dh < 2; ++dh) { const s16x4 lo = vtr(vp + 64 * dh), hi = vtr(vp + 64 * dh + 8 * VP);
                        const bf16x8 va = (bf16x8){lo[0], lo[1], lo[2], lo[3], hi[0], hi[1], hi[2], hi[3]};
                        O[dh] = __builtin_amdgcn_mfma_f32_32x32x16_bf16(va, pb, O[dh], 0, 0, 0); }
                }
            const float inv = 1.0f / l;
#pragma unroll
            for (int dh = 0; dh < 2; ++dh)
#pragma unroll
                for (int g4 = 0; g4 < 4; ++g4) { u32x2 o2; o2.x = cvt_pk(O[dh][4 * g4] * inv, O[dh][4 * g4 + 1] * inv); o2.y = cvt_pk(O[dh][4 * g4 + 2] * inv, O[dh][4 * g4 + 3] * inv);
                    *(u32x2*)(AO + tok * D + hq * 64 + 32 * dh + 8 * g4 + 4 * hh) = o2; }
        }
        wg_barrier();
    }
}

__device__ __forceinline__ void dwconv_phase(Frame& F, int j) {
    const bf16_t* U = WSP(const bf16_t, WS_U); bf16_t* YC = WSP(bf16_t, WS_AO);
    LAS unsigned char* ut = F.lds; LAS float* st = (LAS float*)(F.lds + 62 * 2048); LAS float* fin = st + 8 * 64;
    const int tid = F.tid, lane = F.lane, w = F.wave;
    const float* wd = F.in[I_CWDW] + (size_t)j * 31 * D + 2 * tid;
    f32x2 wk[31];
#pragma unroll
    for (int q = 0; q < 31; ++q) wk[q] = *(const f32x2*)(wd + q * D);
    const f32x2 bdw = *(const f32x2*)(F.in[I_CBDW] + j * D + 2 * tid), lng = *(const f32x2*)(F.in[I_CLNG] + j * D + 2 * tid), lnb = *(const f32x2*)(F.in[I_CLNB] + j * D + 2 * tid);
    for (int tile = F.c; tile < T / 32; tile += F.G) {
        const int t0 = tile * 32, tin0 = t0 % SEQ;
        for (int ch = tid; ch < 62 * 128; ch += NTHR) { const int rr = ch >> 7, c16 = ch & 127; u32x4 v = (u32x4){0u, 0u, 0u, 0u};
            if (tin0 + rr - 30 >= 0) v = *(const u32x4*)(U + (size_t)(t0 + rr - 30) * D + 8 * c16);
            *(LAS u32x4*)(ut + rr * 2048 + 16 * c16) = v; }
        wg_barrier();
        f32x2 y[32];
#pragma unroll
        for (int blk = 0; blk < 8; ++blk) {
            f32x2 a[4] = {bdw, bdw, bdw, bdw};
#pragma unroll
            for (int rr = 0; rr < 34; ++rr) { const unsigned uw = *(const LAS unsigned*)(ut + (4 * blk + rr) * 2048 + 4 * tid); const f32x2 uv = (f32x2){bf_lo(uw), bf_hi(uw)};
#pragma unroll
                for (int o = 0; o < 4; ++o) { const int q = rr - o; if (q >= 0 && q < 31) a[o] += wk[q] * uv; } }
#pragma unroll
            for (int o = 0; o < 4; ++o) y[4 * blk + o] = a[o];
        }
#pragma unroll
        for (int tk = 0; tk < 32; ++tk) { float s1 = y[tk].x + y[tk].y, s2 = y[tk].x * y[tk].x + y[tk].y * y[tk].y;
#pragma unroll
            for (int o = 1; o < 64; o <<= 1) { s1 += __shfl_xor(s1, o); s2 += __shfl_xor(s2, o); }
            if (lane == 0) { st[(w * 32 + tk) * 2] = s1; st[(w * 32 + tk) * 2 + 1] = s2; } }
        wg_barrier();
        if (tid < 32) { float s1 = 0.f, s2 = 0.f;
#pragma unroll
            for (int ww = 0; ww < 8; ++ww) { s1 += st[(ww * 32 + tid) * 2]; s2 += st[(ww * 32 + tid) * 2 + 1]; }
            const float mean = s1 * (1.0f / D), var = fmaxf(s2 * (1.0f / D) - mean * mean, 0.f); fin[2 * tid] = mean; fin[2 * tid + 1] = rsqrtf(var + 1e-5f); }
        wg_barrier();
#pragma unroll
        for (int tk = 0; tk < 32; ++tk) { const float mean = fin[2 * tk], rstd = fin[2 * tk + 1];
            const float v0 = (y[tk].x - mean) * rstd * lng.x + lnb.x, v1 = (y[tk].y - mean) * rstd * lng.y + lnb.y;
            *(unsigned*)(YC + (size_t)(t0 + tk) * D + 2 * tid) = cvt_pk(v0 * sigmoid_f(v0), v1 * sigmoid_f(v1)); }
        wg_barrier();
    }
}
__device__ __forceinline__ void p0_mod_task(Frame& F, int task) {
    LAS float* cact = (LAS float*)F.lds; LAS float* part = (LAS float*)(F.lds + 32768);
    const int i = task / 24, n0 = (task % 24) * 256, tid = F.tid, lane = F.lane, w = F.wave;
    for (int q = tid; q < NBATCH * D; q += NTHR) { const float cv = F.in[I_C][q]; cact[q] = cv * sigmoid_f(cv); }
    wg_barrier();
    f32x4 acc[8];
#pragma unroll
    for (int b = 0; b < 8; ++b) acc[b] = (f32x4){0.f, 0.f, 0.f, 0.f};
    const float* Wp = F.in[I_WMOD] + ((size_t)i * D + 128 * w) * (6 * D) + n0 + 4 * lane;
#pragma unroll 4
    for (int k = 0; k < 128; ++k) { const f32x4 wv = *(const f32x4*)(Wp + (size_t)k * (6 * D));
#pragma unroll
        for (int b = 0; b < 8; ++b) acc[b] += wv * cact[b * D + 128 * w + k]; }
#pragma unroll
    for (int b = 0; b < 8; ++b) *(LAS f32x4*)(part + (w * 8 + b) * 256 + 4 * lane) = acc[b];
    wg_barrier();
    float* mod = WSP(float, WS_MOD);
#pragma unroll
    for (int q = 0; q < 4; ++q) { const int o = tid + NTHR * q, b = o >> 8, n = o & 255; float s = F.in[I_BMOD][i * 6 * D + n0 + n];
#pragma unroll
        for (int ww = 0; ww < 8; ++ww) s += part[(ww * 8 + b) * 256 + n];
        mod[((size_t)i * NBATCH + b) * (6 * D) + n0 + n] = s; }
    wg_barrier();
}
struct TItem { const float* W; bf16_t* Dst; int N, paired, kb, nb; };
__device__ __forceinline__ bool p0_item(Frame& F, int it, TItem& x) {
    const int NQ = 192, NO = 128, NCI = 256, NCO = 128, NMI = 16384;
    if (it < NQ) { const int j = it / 96, r = it % 96; x.W = F.in[I_AWQKV] + (size_t)j * D * 1536; x.Dst = WSP(bf16_t, WS_WQKV) + (size_t)j * 1536 * D; x.N = 1536; x.paired = 0; x.kb = r / 6; x.nb = r % 6; return true; } it -= NQ;
    if (it < NO) { const int j = it / 64, r = it % 64; x.W = F.in[I_AWO] + (size_t)j * D * D; x.Dst = WSP(bf16_t, WS_WO) + (size_t)j * D * D; x.N = 1024; x.paired = 0; x.kb = r / 4; x.nb = r % 4; return true; } it -= NO;
    if (it < NCI) { const int j = it / 128, r = it % 128; x.W = F.in[I_CWIN] + (size_t)j * D * 2048; x.Dst = WSP(bf16_t, WS_CWIN) + (size_t)j * 2048 * D; x.N = 2048; x.paired = 1; x.kb = r / 8; x.nb = r % 8; return true; } it -= NCI;
    if (it < NCO) { const int j = it / 64, r = it % 64; x.W = F.in[I_CWOUT] + (size_t)j * D * D; x.Dst = WSP(bf16_t, WS_CWOUT) + (size_t)j * D * D; x.N = 1024; x.paired = 0; x.kb = r / 4; x.nb = r % 4; return true; } it -= NCO;
    if (it < NMI) { const int m = it / 128, r = it % 128; x.W = F.in[I_MWIN] + (size_t)m * D * 2048; x.Dst = WSP(bf16_t, WS_MWIN) + (size_t)m * 2048 * D; x.N = 2048; x.paired = 1; x.kb = r / 8; x.nb = r % 8; return true; } it -= NMI;
    if (it < 8192) { const int m = it / 64, r = it % 64; x.W = F.in[I_MWOUT] + (size_t)m * D * D; x.Dst = WSP(bf16_t, WS_MWOUT) + (size_t)m * D * D; x.N = 1024; x.paired = 0; x.kb = r / 4; x.nb = r % 4; return true; }
    return false;
}
constexpr int P0_NITEMS = 192 + 128 + 256 + 128 + 16384 + 8192;
__device__ __forceinline__ void p0_phase(Frame& F) {
    for (int task = F.c; task < 96; task += F.G) p0_mod_task(F, task);
    LAS float* tile = (LAS float*)F.lds;
    volatile LAS int* qslot = (volatile LAS int*)(F.lds + 64 * 257 * 4 + 64);
    const int tid = F.tid, lane = F.lane, w = F.wave;
    if (tid == 0) qslot[0] = (int)__hip_atomic_fetch_add(F.ctl + CW_P0Q, 1u, RLX_AGENT);
    wg_barrier();
    int it = qslot[0]; TItem cur; bool valid = p0_item(F, it, cur);
    f32x4 rg[8];
    if (valid) {
#pragma unroll
        for (int q = 0; q < 8; ++q) rg[q] = *(const f32x4*)(cur.W + (size_t)(cur.kb * 64 + w * 8 + q) * cur.N + cur.nb * 256 + 4 * lane); }
    wg_barrier();
    while (valid) {
        if (tid == 0) qslot[0] = (int)__hip_atomic_fetch_add(F.ctl + CW_P0Q, 1u, RLX_AGENT);
#pragma unroll
        for (int q = 0; q < 8; ++q) { LAS float* tp = tile + (w * 8 + q) * 257 + 4 * lane; tp[0] = rg[q][0]; tp[1] = rg[q][1]; tp[2] = rg[q][2]; tp[3] = rg[q][3]; }
        wg_barrier();
        const int nit = qslot[0]; TItem nx; const bool nvalid = p0_item(F, nit, nx);
        if (nvalid) {
#pragma unroll
            for (int q = 0; q < 8; ++q) rg[q] = *(const f32x4*)(nx.W + (size_t)(nx.kb * 64 + w * 8 + q) * nx.N + nx.nb * 256 + 4 * lane); }
        const int kc = lane >> 3;
#pragma unroll
        for (int r4 = 0; r4 < 4; ++r4) { const int nl = 32 * w + 8 * r4 + (lane & 7), n = cur.nb * 256 + nl; const LAS float* sp = tile + (8 * kc) * 257 + nl;
            u32x4 o; o.x = cvt_pk(sp[0], sp[257]); o.y = cvt_pk(sp[2 * 257], sp[3 * 257]); o.z = cvt_pk(sp[4 * 257], sp[5 * 257]); o.w = cvt_pk(sp[6 * 257], sp[7 * 257]);
            int nd = n; if (cur.paired) { const int half = n >> 10, rem = n & 1023; nd = ((rem >> 7) << 8) + (half << 7) + (rem & 127); }
            *(u32x4*)(cur.Dst + (size_t)nd * D + cur.kb * 64 + 8 * kc) = o; }
        wg_barrier();
        cur = nx; valid = nvalid;
    }
}

template <bool GATHER> __device__ __forceinline__ int moe_build_units(Frame& F, int layer, int npn, int total_tiles, int ubase) {
    const LAS int* EX = (const LAS int*)(F.lds + LDS_EXP); LAS int* UT = (LAS int*)(F.lds + LDS_UT); LAS int* TOK = (LAS int*)(F.lds + LDS_TOK);
    const int U = total_tiles * npn; const int mine = F.c < U ? (U - F.c + F.G - 1) / F.G : 0; int n = mine - ubase; n = n < 0 ? 0 : (n > 9 ? 9 : n);
    if (F.tid < n) { const int L = F.c + (ubase + F.tid) * F.G, tau = L / npn, pn = L % npn; int e = 0;
        for (int q = 1; q < 32; ++q) if (tau >= EX[32 + q]) e = q;
        const int mt = tau - EX[32 + e], om = EX[64 + e] + 256 * mt;
        UT[4 * F.tid] = GATHER ? 256 * F.tid : om; UT[4 * F.tid + 1] = om; UT[4 * F.tid + 2] = e; UT[4 * F.tid + 3] = pn; UT[40 + F.tid] = mt; }
    wg_barrier();
    if (GATHER) { const int* LIST = WSP(const int, WS_LIST);
        for (int q = F.tid; q < n * 256; q += NTHR) { const int ui = q >> 8, rr = q & 255, e = UT[4 * ui + 2], pos = 256 * UT[40 + ui] + rr; TOK[q] = pos < EX[e] ? LIST[(size_t)e * T + pos] : 0; }
        wg_barrier(); }
    return n;
}

constexpr int N_PHASES = 30;
struct Args { const float* in[27]; float* out; unsigned char* ws; int ph_lo, ph_hi; };
__global__ void __launch_bounds__(NTHR, 2) mega(const Args args) {
    extern __shared__ __attribute__((aligned(16))) unsigned char lds_raw[];
    Frame F; F.lds = (LAS unsigned char*)lds_raw; F.MISC = (volatile LAS unsigned*)(F.lds + LDS_MISC); F.ws = args.ws; F.ctl = (gu32*)(args.ws + WS_CTL);
    F.tid = threadIdx.x; F.lane = F.tid & 63; F.wave = __builtin_amdgcn_readfirstlane(F.tid >> 6); F.G = gridDim.x; F.c = blockIdx.x; F.out = args.out;
    F.in = args.in;
    if (F.tid < 32) F.MISC[F.tid] = 0u;
    __syncthreads();
    const int lo = args.ph_lo, hi = args.ph_hi;
    XcdBarrier bar; bar.bar = (unsigned*)(F.ctl + CW_BAR); bar.x = 0; bar.st = F.MISC + 8;
    if (hi - lo > 1) bar = xcd_barrier_post((unsigned*)(F.ctl + CW_BAR), F.MISC + 8);
#ifndef PH_MASK
#define PH_MASK 0xFFFF
#endif
#define IN(k) (lo <= (k) && (k) < hi)
#define HAS(b) (((PH_MASK) >> (b)) & 1)
#define PHASE_ENTER() do { int _t = F.tid; asm volatile("" : "+v"(_t)); F.tid = _t; F.lane = _t & 63; F.wave = __builtin_amdgcn_readfirstlane(_t >> 6); unsigned char* _w = F.ws; asm volatile("" : "+s"(_w)); F.ws = _w; } while (0)
#define SEAM(k) do { if ((k) + 1 < hi) xcd_barrier(bar); } while (0)
    const LAS int* toktab = (const LAS int*)(F.lds + LDS_TOK);
    if (HAS(0) && IN(0)) { p0_phase(F); SEAM(0); }
    for (int i = 0; i < DEPTH; ++i) {
        const int pb = 1 + 7 * i, j = i >> 1; const bool conv = (i & 1) != 0;
        const float* modl = WSP(const float, WS_MOD) + (size_t)i * NBATCH * (6 * D);
        if (IN(pb)) { PHASE_ENTER(); if (i == 0) { if (HAS(1)) row_phase<0>(F, 0); } else { if (HAS(2)) row_phase<1>(F, i); } SEAM(pb); }
        if (IN(pb + 1)) { PHASE_ENTER();
            if (!conv) { if (HAS(3)) { Gemm g{WSP(const bf16_t, WS_H), WSP(const bf16_t, WS_WQKV) + (size_t)j * 1536 * D, D, 0}; DenseOrder S; S.init(1536, F.G, F.c);
                EpiBias16 E{WSP(bf16_t, WS_QKV), 1536, F.in[I_ABQKV] + j * 1536}; gemm_phase<EpiBias16, DenseOrder, false>(F.lds, g, S, E, toktab, F.tid); } }
            else if (HAS(4)) { Gemm g{WSP(const bf16_t, WS_H), WSP(const bf16_t, WS_CWIN) + (size_t)j * 2048 * D, D, 0}; DenseOrder S; S.init(2048, F.G, F.c);
                EpiPair<0> E{WSP(bf16_t, WS_U), F.in[I_CBIN] + j * 2048, 0}; gemm_phase<EpiPair<0>, DenseOrder, false>(F.lds, g, S, E, toktab, F.tid); }
            SEAM(pb + 1); }
        if (IN(pb + 2)) { PHASE_ENTER(); if (!conv) { if (HAS(5)) attn_phase(F, j); } else { if (HAS(6)) dwconv_phase(F, j); } SEAM(pb + 2); }
        if (IN(pb + 3)) { PHASE_ENTER(); if (HAS(7)) {
            Gemm g{WSP(const bf16_t, WS_AO), (conv ? WSP(const bf16_t, WS_CWOUT) : WSP(const bf16_t, WS_WO)) + (size_t)j * D * D, D, 0}; DenseOrder S; S.init(1024, F.G, F.c);
            EpiResid E{(i == 0) ? F.in[I_X] : WSP(const float, WS_X), WSP(float, WS_X), (conv ? F.in[I_CBOUT] : F.in[I_ABO]) + j * D, modl + 2 * D};
            gemm_phase<EpiResid, DenseOrder, false>(F.lds, g, S, E, toktab, F.tid); }
            SEAM(pb + 3); }
        if (IN(pb + 4)) { PHASE_ENTER(); if (HAS(8)) row_phase<2>(F, i); SEAM(pb + 4); }
        if (IN(pb + 5)) { PHASE_ENTER(); if (HAS(9)) {
            const int tt = build_exp_tables(F, i);
            Gemm g{WSP(const bf16_t, WS_H), WSP(const bf16_t, WS_MWIN) + (size_t)i * NE * 2048 * D, D, (size_t)2048 * D};
            EpiPair<1> E{WSP(bf16_t, WS_ACT), F.in[I_MBIN] + (size_t)i * NE * 2048, 2048};
            for (int ub = 0;; ub += 9) { const int n = moe_build_units<true>(F, i, 8, tt, ub); if (n == 0) break;
                TableOrder S{(const LAS int*)(F.lds + LDS_UT), n}; gemm_phase<EpiPair<1>, TableOrder, true>(F.lds, g, S, E, toktab, F.tid); wg_barrier(); if (n < 9) break; } }
            SEAM(pb + 5); }
        if (IN(pb + 6)) { PHASE_ENTER(); if (HAS(10)) {
            const int tt = build_exp_tables(F, i);
            Gemm g{WSP(const bf16_t, WS_ACT), WSP(const bf16_t, WS_MWOUT) + (size_t)i * NE * D * D, D, (size_t)D * D};
            EpiMoeOut E{WSP(bf16_t, WS_YS), F.in[I_MBOUT] + (size_t)i * NE * D, WSP(const float, WS_GLIST), (const LAS int*)(F.lds + LDS_EXP + 256)};
            for (int ub = 0;; ub += 9) { const int n = moe_build_units<false>(F, i, 4, tt, ub); if (n == 0) break;
                TableOrder S{(const LAS int*)(F.lds + LDS_UT), n}; gemm_phase<EpiMoeOut, TableOrder, false>(F.lds, g, S, E, toktab, F.tid); wg_barrier(); if (n < 9) break; } }
            SEAM(pb + 6); }
    }
    if (HAS(11) && IN(29)) { PHASE_ENTER(); row_phase<5>(F, DEPTH); }
#undef IN
#undef SEAM
}

inline void launch_range(void* const* d_in, void* d_out, void* d_ws, int grid, int lo, int hi, hipStream_t stream) {
    Args a{}; for (int i = 0; i < 27; ++i) a.in[i] = (const float*)d_in[i];
    a.out = (float*)d_out; a.ws = (unsigned char*)d_ws; a.ph_lo = lo; a.ph_hi = hi;
    hipLaunchKernelGGL(mega, dim3(grid), dim3(NTHR), LDS_BYTES, stream, a);
}
inline int setup_grid() {
    static int grid = 0;
    if (grid == 0) {
        int dev = 0, cus = 0;
        if (hipGetDevice(&dev) != hipSuccess || hipDeviceGetAttribute(&cus, hipDeviceAttributeMultiprocessorCount, dev) != hipSuccess) { grid = -1; return grid; }
        if (hipFuncSetAttribute((const void*)mega, hipFuncAttributeMaxDynamicSharedMemorySize, LDS_BYTES) != hipSuccess) { grid = -1; return grid; }
        int per_cu = 0; (void)hipOccupancyMaxActiveBlocksPerMultiprocessor(&per_cu, (const void*)mega, NTHR, LDS_BYTES); (void)hipGetLastError();
        if (per_cu < 1) fprintf(stderr, "kernel_launch: occupancy query reports %d blocks per CU\n", per_cu);
        grid = cus;
    }
    return grid;
}
}
#ifndef FAST_LAUNCH_MODE
#define FAST_LAUNCH_MODE 1
#endif
extern "C" void kernel_launch(void* const* d_in, const int* in_sizes, int n_in, void* d_out, int out_size, void* d_ws, size_t ws_size, hipStream_t stream) {
    if (n_in != 27 || out_size != fk::T * fk::D || ws_size < fk::WS_END) { fprintf(stderr, "kernel_launch: unexpected shapes (n_in %d out %d ws %zu)\n", n_in, out_size, ws_size); return; }
    const int grid = fk::setup_grid(); if (grid <= 0) return;
    (void)hipMemsetAsync((char*)d_ws + fk::WS_CTL, 0, fk::CTL_ZERO_BYTES, stream);
#if FAST_LAUNCH_MODE == 1
    fk::launch_range(d_in, d_out, d_ws, grid, 0, fk::N_PHASES, stream);
#else
    for (int k = 0; k < fk::N_PHASES; ++k) fk::launch_range(d_in, d_out, d_ws, grid, k, k + 1, stream);
#endif
}
```

```cpp
#include <hip/hip_runtime.h>
#include <cstdio>
#include <cstdint>
namespace fk {
#define LAS __attribute__((address_space(3)))
#define GAS __attribute__((address_space(1)))
typedef unsigned short bf16_t;
typedef short bf16x8 __attribute__((ext_vector_type(8)));
typedef short s16x4 __attribute__((ext_vector_type(4)));
typedef float f32x4 __attribute__((ext_vector_type(4)));
typedef float f32x2 __attribute__((ext_vector_type(2)));
typedef float f32x16 __attribute__((ext_vector_type(16)));
typedef float f32x8 __attribute__((ext_vector_type(8)));
typedef unsigned u32x4 __attribute__((ext_vector_type(4)));
typedef unsigned u32x2 __attribute__((ext_vector_type(2)));
typedef __bf16 bf16x2_t __attribute__((ext_vector_type(2)));
typedef int v4i __attribute__((ext_vector_type(4)));
typedef int v8i __attribute__((ext_vector_type(8)));
typedef GAS unsigned gu32;
#define RLX_AGENT __ATOMIC_RELAXED, __HIP_MEMORY_SCOPE_AGENT
#define LDS_WAIT() asm volatile("s_waitcnt lgkmcnt(0)" ::: "memory")
#define VM_WAIT() asm volatile("s_waitcnt vmcnt(0)" ::: "memory")

constexpr int T = 16384, D = 1024, SEQ = 2048, NBATCH = 8, NE = 32, DEPTH = 4;
constexpr int NWAVES = 8, NTHR = 512;
constexpr int SLOTCAP = T * 4 + NE * 256;
constexpr float LOG2E = 1.4426950408889634f;

__device__ __forceinline__ unsigned cvt_pk(float lo, float hi) { f32x2 v = {lo, hi}; bf16x2_t b = __builtin_convertvector(v, bf16x2_t); return __builtin_bit_cast(unsigned, b); }
__device__ __forceinline__ float bf_lo(unsigned w) { return __uint_as_float(w << 16); }
__device__ __forceinline__ float bf_hi(unsigned w) { return __uint_as_float(w & 0xffff0000u); }
__device__ __forceinline__ unsigned cvt_pk4_fp8(float a, float b, float c, float d) {
    a = __builtin_amdgcn_fmed3f(a, -448.f, 448.f); b = __builtin_amdgcn_fmed3f(b, -448.f, 448.f); c = __builtin_amdgcn_fmed3f(c, -448.f, 448.f); d = __builtin_amdgcn_fmed3f(d, -448.f, 448.f);
    int w = 0; w = __builtin_amdgcn_cvt_pk_fp8_f32(a, b, w, false); w = __builtin_amdgcn_cvt_pk_fp8_f32(c, d, w, true); return (unsigned)w; }
__device__ __forceinline__ unsigned cvt_pk4_fp8_nc(float a, float b, float c, float d) { int w = 0; w = __builtin_amdgcn_cvt_pk_fp8_f32(a, b, w, false); w = __builtin_amdgcn_cvt_pk_fp8_f32(c, d, w, true); return (unsigned)w; }
constexpr float F8_SH = 8.0f, F8_SW = 64.0f, F8_SACT = 4.0f, F8_SY = 16.0f;
__device__ __forceinline__ f32x4 fp8x4_to_f32(unsigned w) { const f32x2 lo = __builtin_amdgcn_cvt_pk_f32_fp8((int)w, false), hi = __builtin_amdgcn_cvt_pk_f32_fp8((int)w, true); return (f32x4){lo.x, lo.y, hi.x, hi.y}; }
__device__ __forceinline__ float sigmoid_f(float v) { return __builtin_amdgcn_rcpf(1.0f + __builtin_amdgcn_exp2f(-LOG2E * v)); }

constexpr size_t MiB = (size_t)1 << 20;
constexpr size_t WS_CTL = 0, CTL_ZERO_BYTES = 1 * MiB;
constexpr size_t WS_MOD = 1 * MiB;
constexpr size_t WS_WQKV = 2 * MiB;
constexpr size_t WS_WO = 8 * MiB;
constexpr size_t WS_CWIN = 12 * MiB;
constexpr size_t WS_CWOUT = 20 * MiB;
constexpr size_t WS_MWIN = 24 * MiB;
constexpr size_t WS_MWOUT = WS_MWIN + 512 * MiB;
constexpr size_t WS_X = WS_MWOUT + 256 * MiB;
constexpr size_t WS_H = WS_X + 64 * MiB;
constexpr size_t WS_QKV = WS_H + 32 * MiB;
constexpr size_t WS_AO = WS_QKV + 48 * MiB;
constexpr size_t WS_U = WS_AO + 32 * MiB;
constexpr size_t WS_LIST = WS_U + 32 * MiB;
constexpr size_t WS_GLIST = WS_LIST + 2 * MiB;
constexpr size_t WS_TK = WS_GLIST + 2 * MiB;
constexpr size_t WS_ACT = WS_TK + 1 * MiB;
constexpr size_t WS_YS = WS_ACT + 144 * MiB;
constexpr size_t WS_END = WS_YS + 144 * MiB;
constexpr int CW_TMO = 0, CW_P0Q = 64, CW_BAR = 4096, CW_CNT = 16384;
#define XCD_BAR_WORDS 3456

constexpr int RING_BYTES = 131072;
constexpr int LDS_TOK = RING_BYTES;
constexpr int LDS_UT = LDS_TOK + 9216;
constexpr int LDS_EXP = LDS_UT + 256;
constexpr int LDS_BYTES = 163840;
constexpr int LDS_MISC = LDS_BYTES - 128;
static_assert(LDS_EXP + 512 <= LDS_MISC, "LDS map");

#define XB_TMO      128
#define XB_XCNT(j)  (256  + 64 * (j))
#define XB_XSUB(j)  (1280 + 64 * (j))
#define XB_XGEN(j)  (2304 + 64 * (j))
#define XB_TOP      3328
#define XB_TOPGEN   3392
#define XB_SPIN_CAP (1u << 18)
__device__ __forceinline__ unsigned xb_ld(unsigned* p)              { return __hip_atomic_load(p, __ATOMIC_RELAXED, __HIP_MEMORY_SCOPE_AGENT); }
__device__ __forceinline__ unsigned xb_add(unsigned* p, unsigned v) { return __hip_atomic_fetch_add(p, v, __ATOMIC_RELAXED, __HIP_MEMORY_SCOPE_AGENT); }
__device__ __forceinline__ unsigned xb_xcc_id() { return (unsigned)__builtin_amdgcn_s_getreg((3 << 11) | 20) & 0xFu; }
#define XB_SPIN(cond, bar) do { unsigned _sp = 0; while (cond) { __builtin_amdgcn_s_sleep(1); \
    if ((++_sp & 255u) == 0u) { if (xb_ld(&(bar)[XB_TMO])) break; if (_sp > XB_SPIN_CAP) { atomicAdd(&(bar)[XB_TMO], 1u); break; } } } } while (0)
struct XcdBarrier { unsigned* bar; unsigned x; volatile LAS unsigned* st; };
__device__ __forceinline__ XcdBarrier xcd_barrier_post(unsigned* bar, volatile LAS unsigned* st) {
    XcdBarrier b; b.bar = bar; b.x = xb_xcc_id(); b.st = st;
    if (threadIdx.x == 0) (void)xb_add(&bar[XB_XCNT(b.x)], 1u);
    return b;
}
__device__ __forceinline__ void xcd_barrier_complete(unsigned* bar, unsigned x, unsigned& nloc, unsigned& nx) {
    const unsigned G = gridDim.x * gridDim.y * gridDim.z;
    unsigned sum, cnt, mine, sp = 0u;
    for (;;) {
        sum = 0u; cnt = 0u; mine = 0u;
#pragma unroll
        for (unsigned j = 0; j < 16; ++j) { const unsigned c = xb_ld(&bar[XB_XCNT(j)]); sum += c; cnt += (c > 0u) ? 1u : 0u; mine = (j == x) ? c : mine; }
        if (sum == G) break;
        __builtin_amdgcn_s_sleep(1);
        if ((++sp & 255u) == 0u) { if (xb_ld(&bar[XB_TMO])) break; if (sp > XB_SPIN_CAP) { atomicAdd(&bar[XB_TMO], 1u); break; } }
    }
    nloc = mine > 0u ? mine : 1u; nx = cnt > 0u ? cnt : 1u;
}
__device__ __forceinline__ void xcd_barrier(const XcdBarrier& b) {
    asm volatile("s_waitcnt vmcnt(0)" ::: "memory");
    __syncthreads();
    if (threadIdx.x == 0) {
        unsigned* bar = b.bar;
        __builtin_amdgcn_s_waitcnt(0);
        unsigned nloc = b.st[0], nx = b.st[1];
        if (nloc == 0u) { xcd_barrier_complete(bar, b.x, nloc, nx); b.st[0] = nloc; b.st[1] = nx; }
        const unsigned old = xb_add(&bar[XB_XSUB(b.x)], 1u);
        const unsigned gen = old / nloc;
        if (old + 1u == (gen + 1u) * nloc) {
            __builtin_amdgcn_fence(__ATOMIC_RELEASE, "agent");
            asm volatile("s_waitcnt vmcnt(0)" ::: "memory");
            const unsigned og = xb_add(&bar[XB_TOP], 1u);
            const unsigned tg = og / nx;
            if (og + 1u == (tg + 1u) * nx) xb_add(&bar[XB_TOPGEN], 1u);
            else XB_SPIN(xb_ld(&bar[XB_TOPGEN]) == tg, bar);
            __builtin_amdgcn_fence(__ATOMIC_ACQUIRE, "agent");
            xb_add(&bar[XB_XGEN(b.x)], 1u);
            asm volatile("s_waitcnt vmcnt(0)" ::: "memory");
        } else {
            XB_SPIN(xb_ld(&bar[XB_XGEN(b.x)]) == gen, bar);
            __builtin_amdgcn_fence(__ATOMIC_ACQUIRE, "agent");
            asm volatile("s_waitcnt vmcnt(0)" ::: "memory");
        }
    }
    __syncthreads();
}

constexpr int BM = 256, BK = 64, HALF = 128, HTB = HALF * BK * 2, NXCD = 8, WGM = 8;
__host__ __device__ __forceinline__ int lds_byte(int r, int c) { const int st = (r >> 4) * 2 + (c >> 5), rr = r & 15, cc = c & 31, ob = rr * 64 + cc * 2; return st * 1024 + (ob ^ (((ob >> 9) & 1) << 5)); }
__host__ __device__ __forceinline__ void stage_rc(int b, int& R, int& C) { const int st = b / 1024, sb = b % 1024, swz = sb ^ (((sb >> 9) & 1) << 5); R = (st >> 1) * 16 + swz / 64; C = (st & 1) * 32 + (swz % 64) / 2; }
__host__ __device__ __forceinline__ int perm32(int rho) { const int n = rho >> 4, i = rho & 15; return 8 * (i >> 2) + 4 * n + (i & 3); }

struct Unit { int am, om, e, pn; };
struct Gemm { const bf16_t* A; const bf16_t* Bt; int K; size_t b_estride; };

struct DenseOrder {
    int nM, nN, nwg, G, c;
    __device__ void init(int N, int G_, int c_) { nM = T / BM; nN = N / BM; nwg = nM * nN; G = G_; c = c_; }
    __device__ __forceinline__ bool next(int i, Unit& u) const {
        const long L = (long)i * G + c; if (L >= nwg) return false;
        int wgid = (int)L; { const int q = nwg / NXCD, r = nwg % NXCD, xcd = wgid % NXCD, off = wgid / NXCD; wgid = (xcd < r ? xcd * (q + 1) : r * (q + 1) + (xcd - r) * q) + off; }
        const int nig = WGM * nN, gid = wgid / nig, fm = gid * WGM, gsz = (nM - fm) < WGM ? (nM - fm) : WGM;
        const int pm = fm + ((wgid % nig) % gsz); u.pn = (wgid % nig) / gsz; u.am = pm * BM; u.om = pm * BM; u.e = 0; return true;
    }
};
struct TableOrder {
    const LAS int* ut; int n;
    __device__ __forceinline__ bool next(int i, Unit& u) const {
        if (i >= n) return false;
        u.am = __builtin_amdgcn_readfirstlane(ut[4 * i]); u.om = __builtin_amdgcn_readfirstlane(ut[4 * i + 1]); u.e = __builtin_amdgcn_readfirstlane(ut[4 * i + 2]); u.pn = __builtin_amdgcn_readfirstlane(ut[4 * i + 3]); return true;
    }
};

template <class Epi, class Sched, bool GATHER, bool F8 = false>
__device__ __forceinline__ void gemm_phase(LAS unsigned char* lds, const Gemm g, const Sched& S, const Epi& E, const LAS int* toktab, const int tid, const int tkb, unsigned long long& t_acc, unsigned long long& g_ticks, unsigned long long& g_cyc) {
    unsigned long long t_b = 0ull, c_b = 0ull; static_assert(true, "");
#ifndef TIME_KIND
#define TIME_KIND (-1)
#endif
#define GT_BEG(k) do { if (TIME_KIND >= 20 && TIME_KIND == tkb + (k)) t_b = __builtin_amdgcn_s_memrealtime(); if ((k) == 0 && TIME_KIND == tkb + 5) { t_b = __builtin_amdgcn_s_memrealtime(); c_b = __builtin_readcyclecounter(); } } while (0)
#define GT_END(k) do { if (TIME_KIND >= 20 && TIME_KIND == tkb + (k)) t_acc += __builtin_amdgcn_s_memrealtime() - t_b; if ((k) == 0 && TIME_KIND == tkb + 5) { g_ticks += __builtin_amdgcn_s_memrealtime() - t_b; g_cyc += __builtin_readcyclecounter() - c_b; } } while (0)
    const int wid = __builtin_amdgcn_readfirstlane(tid >> 6), lane = tid & 63, wr = wid >> 2, wc = wid & 3, fr = lane & 15, fq = lane >> 4;
    const int K = g.K, nt = K / BK;
    int Rr[2], Cc[2]; unsigned voffB[2];
#pragma unroll
    for (int i = 0; i < 2; ++i) { int R, C; stage_rc(tid * 16 + i * 8192, R, C); Rr[i] = R; Cc[i] = C; const int Rb = Epi::PERM ? ((R & ~31) + perm32(R & 31)) : R; voffB[i] = (unsigned)(Rb * K + C) * 2u; }
    const unsigned ldsw = (unsigned)wid * 1024u;
    const int aoff = lds_byte(wr * 64 + fr, fq * 8), boff = lds_byte(wc * 32 + fr, fq * 8);
#define PG8_SA(b, h) (((b) * 2 + (h)) * HTB)
#define PG8_SB(b, h) ((4 + (b) * 2 + (h)) * HTB)
#ifndef USE_BUFFER_LDS
#define USE_BUFFER_LDS 1
#endif
#if USE_BUFFER_LDS
#define PG8_STAGE(bufoff, rsrc, soff, voff) do { _Pragma("unroll") for (int _i = 0; _i < 2; ++_i) \
        __builtin_amdgcn_raw_ptr_buffer_load_lds(rsrc, (LAS unsigned*)(lds + (bufoff) + ldsw + _i * 8192), 16, (int)(voff)[_i], (int)(soff), 0, 0); } while (0)
#else
#define PG8_STAGE(bufoff, rsrc, soff, voff) do { _Pragma("unroll") for (int _i = 0; _i < 2; ++_i) \
        __builtin_amdgcn_global_load_lds((const unsigned*)((const char*)(rsrc##_base) + (size_t)(soff) + (voff)[_i]), (LAS unsigned*)(lds + (bufoff) + ldsw + _i * 8192), 16, 0, 0); } while (0)
#endif
#define CAT8(l, h) __builtin_shufflevector((l), (h), 0, 1, 2, 3, 4, 5, 6, 7)
#define LO4(x) __builtin_shufflevector((x), (x), 0, 1, 2, 3)
#define HI4(x) __builtin_shufflevector((x), (x), 4, 5, 6, 7)
#define PG8_LDA(dst, b, h) do { _Pragma("unroll") for (int m = 0; m < 4; ++m) dst[m] = CAT8(*(const LAS v4i*)(lds + PG8_SA(b, h) + aoff + m * 2048), *(const LAS v4i*)(lds + PG8_SA(b, h) + aoff + m * 2048 + 1024)); } while (0)
#define PG8_LDB(dst, b, h) do { _Pragma("unroll") for (int n = 0; n < 2; ++n) dst[n] = CAT8(*(const LAS v4i*)(lds + PG8_SB(b, h) + boff + n * 2048), *(const LAS v4i*)(lds + PG8_SB(b, h) + boff + n * 2048 + 1024)); } while (0)
#define PG8_MMA(ai, bj, At, Bt) do { __builtin_amdgcn_s_setprio(1); \
        if constexpr (F8) { _Pragma("unroll") for (int m = 0; m < 4; ++m) { f32x4 _l = LO4(acc8[ai][bj][m]), _h = HI4(acc8[ai][bj][m]); \
            _l = __builtin_amdgcn_mfma_scale_f32_16x16x128_f8f6f4(Bt[0], At[m], _l, 0, 0, 0, 0x7f7f7f7f, 0, 0x7f7f7f7f); \
            _h = __builtin_amdgcn_mfma_scale_f32_16x16x128_f8f6f4(Bt[1], At[m], _h, 0, 0, 0, 0x7f7f7f7f, 0, 0x7f7f7f7f); acc8[ai][bj][m] = CAT8(_l, _h); } \
              \
            asm volatile("" : "+v"(acc8[ai][bj][0]), "+v"(acc8[ai][bj][1]), "+v"(acc8[ai][bj][2]), "+v"(acc8[ai][bj][3])); } \
        else { _Pragma("unroll") for (int m = 0; m < 4; ++m) { f32x4 _l = LO4(acc8[ai][bj][m]), _h = HI4(acc8[ai][bj][m]); \
            _l = __builtin_amdgcn_mfma_f32_16x16x32_bf16(__builtin_bit_cast(bf16x8, LO4(Bt[0])), __builtin_bit_cast(bf16x8, LO4(At[m])), _l, 0, 0, 0); \
            _l = __builtin_amdgcn_mfma_f32_16x16x32_bf16(__builtin_bit_cast(bf16x8, HI4(Bt[0])), __builtin_bit_cast(bf16x8, HI4(At[m])), _l, 0, 0, 0); \
            _h = __builtin_amdgcn_mfma_f32_16x16x32_bf16(__builtin_bit_cast(bf16x8, LO4(Bt[1])), __builtin_bit_cast(bf16x8, LO4(At[m])), _h, 0, 0, 0); \
            _h = __builtin_amdgcn_mfma_f32_16x16x32_bf16(__builtin_bit_cast(bf16x8, HI4(Bt[1])), __builtin_bit_cast(bf16x8, HI4(At[m])), _h, 0, 0, 0); acc8[ai][bj][m] = CAT8(_l, _h); } } \
        __builtin_amdgcn_s_setprio(0); } while (0)
#define PG8_WAIT_V(n) asm volatile("s_waitcnt vmcnt(" #n ")" ::: "memory")
#define PG8_WAIT_L(n) asm volatile("s_waitcnt lgkmcnt(" #n ")" ::: "memory")
#define PG8_BAR __builtin_amdgcn_s_barrier()
#define PG8_SCHED __builtin_amdgcn_sched_barrier(0)
#define A_OFFS(dst, u) do { _Pragma("unroll") for (int _h = 0; _h < 2; ++_h) _Pragma("unroll") for (int _i = 0; _i < 2; ++_i) { \
        const int _row = GATHER ? toktab[(u).am + _h * HALF + Rr[_i]] : ((u).am + _h * HALF + Rr[_i]); dst[_h][_i] = (unsigned)(_row * K + Cc[_i]) * 2u; } } while (0)
    Unit cur, nxt; int ui = 0;
    if (!S.next(0, cur)) return;
    f32x8 acc8[2][2][4];
#pragma unroll
    for (int a = 0; a < 2; ++a)
#pragma unroll
        for (int b = 0; b < 2; ++b)
#pragma unroll
            for (int m = 0; m < 4; ++m) acc8[a][b][m] = (f32x8){0.f, 0.f, 0.f, 0.f, 0.f, 0.f, 0.f, 0.f};
    v8i At[4], B0[2], B1[2];
    unsigned ao[2][2]; A_OFFS(ao, cur);
    const __amdgpu_buffer_rsrc_t rA = __builtin_amdgcn_make_buffer_rsrc((void*)g.A, 0, 0x7fffffff, 0x00020000), rB = __builtin_amdgcn_make_buffer_rsrc((void*)g.Bt, 0, 0x7fffffff, 0x00020000);
    const char* const rA_base = (const char*)g.A; const char* const rB_base = (const char*)g.Bt; (void)rA_base; (void)rB_base;
    const unsigned kstep = (unsigned)(BK * 2), hstep = (unsigned)HALF * K * 2;
    unsigned cB = (unsigned)(((size_t)cur.e * g.b_estride + (size_t)cur.pn * BM * K) * 2);
    PG8_STAGE(PG8_SB(0, 0), rB, cB, voffB); PG8_STAGE(PG8_SB(0, 1), rB, cB + hstep, voffB); PG8_STAGE(PG8_SA(0, 0), rA, 0u, ao[0]); PG8_STAGE(PG8_SA(0, 1), rA, 0u, ao[1]);
    if (wr == 1) PG8_BAR;
    PG8_WAIT_V(2); PG8_BAR;
    PG8_STAGE(PG8_SB(1, 0), rB, cB + kstep, voffB); PG8_STAGE(PG8_SA(1, 0), rA, kstep, ao[0]); PG8_STAGE(PG8_SB(1, 1), rB, cB + hstep + kstep, voffB);
    PG8_WAIT_V(6); PG8_BAR;
    for (;;) {
        const bool has_next = S.next(ui + 1, nxt);
        const unsigned nB = has_next ? (unsigned)(((size_t)nxt.e * g.b_estride + (size_t)nxt.pn * BM * K) * 2) : cB;
        GT_BEG(0);
#pragma unroll 1
        for (int t = 0; t < nt; t += 2) {
            const bool last = (t == nt - 2);
            const unsigned a1 = (unsigned)(t + 1) * kstep;
            const unsigned a2 = last ? 0u : (unsigned)(t + 2) * kstep, b2 = last ? nB : cB + (unsigned)(t + 2) * kstep;
            const unsigned a3 = a2 + kstep, b3 = b2 + kstep;
            unsigned a2o[2][2];
            if (last && has_next) { A_OFFS(a2o, nxt); }
            else {
#pragma unroll
                for (int _h = 0; _h < 2; ++_h)
#pragma unroll
                    for (int _i = 0; _i < 2; ++_i) a2o[_h][_i] = ao[_h][_i]; }
            PG8_LDB(B0, 0, 0); PG8_LDB(B1, 0, 1); PG8_SCHED; PG8_LDA(At, 0, 0); PG8_STAGE(PG8_SA(1, 1), rA, a1, ao[1]);
            PG8_WAIT_V(8); PG8_WAIT_L(0); PG8_BAR; PG8_MMA(0, 0, At, B0); PG8_MMA(0, 1, At, B1); PG8_BAR; PG8_SCHED;
            PG8_LDA(At, 0, 1); PG8_STAGE(PG8_SB(0, 0), rB, b2, voffB); PG8_STAGE(PG8_SB(0, 1), rB, b2 + hstep, voffB); PG8_STAGE(PG8_SA(0, 0), rA, a2, a2o[0]);
            PG8_WAIT_V(8); PG8_WAIT_L(0); PG8_BAR; PG8_MMA(1, 0, At, B0); PG8_MMA(1, 1, At, B1); PG8_BAR; PG8_SCHED;
            PG8_LDB(B0, 1, 0); PG8_LDB(B1, 1, 1); PG8_SCHED; PG8_LDA(At, 1, 0); PG8_STAGE(PG8_SA(0, 1), rA, a2, a2o[1]);
            PG8_WAIT_V(8); PG8_WAIT_L(0); PG8_BAR; PG8_MMA(0, 0, At, B0); PG8_MMA(0, 1, At, B1); PG8_BAR; PG8_SCHED;
            PG8_LDA(At, 1, 1); PG8_STAGE(PG8_SB(1, 0), rB, b3, voffB); PG8_STAGE(PG8_SB(1, 1), rB, b3 + hstep, voffB); PG8_STAGE(PG8_SA(1, 0), rA, a3, a2o[0]);
            PG8_WAIT_V(8); PG8_WAIT_L(0); PG8_BAR; PG8_MMA(1, 0, At, B0); PG8_MMA(1, 1, At, B1); PG8_BAR; PG8_SCHED;
            if (last) {
#pragma unroll
                for (int _h = 0; _h < 2; ++_h)
#pragma unroll
                    for (int _i = 0; _i < 2; ++_i) ao[_h][_i] = a2o[_h][_i]; }
        }
        GT_END(0); GT_BEG(1);
        if (wr == 0) PG8_BAR;
        { f32x4 acc[2][2][4][2];
#pragma unroll
          for (int a = 0; a < 2; ++a)
#pragma unroll
              for (int b = 0; b < 2; ++b)
#pragma unroll
                  for (int m = 0; m < 4; ++m) { acc[a][b][m][0] = LO4(acc8[a][b][m]); acc[a][b][m][1] = HI4(acc8[a][b][m]); }
          E(acc, cur, wr, wc, fr, fq); }
        GT_END(1);
        if (!has_next) break;
#pragma unroll
        for (int a = 0; a < 2; ++a)
#pragma unroll
            for (int b = 0; b < 2; ++b)
#pragma unroll
                for (int m = 0; m < 4; ++m) acc8[a][b][m] = (f32x8){0.f, 0.f, 0.f, 0.f, 0.f, 0.f, 0.f, 0.f};
        cur = nxt; cB = nB; ++ui;
        if (wr == 1) PG8_BAR;
    }
    PG8_WAIT_V(0);
    PG8_BAR;
#undef PG8_SA
#undef PG8_SB
#undef PG8_STAGE
#undef PG8_LDA
#undef PG8_LDB
#undef PG8_MMA
#undef PG8_WAIT_V
#undef PG8_WAIT_L
#undef PG8_BAR
#undef PG8_SCHED
#undef A_OFFS
#undef GT_BEG
#undef GT_END
#undef CAT8
#undef LO4
#undef HI4
}
struct EpiBias16 {
    static constexpr bool PERM = true;
    bf16_t* O; int ldc; const float* bias;
    __device__ __forceinline__ void operator()(const f32x4 (&acc)[2][2][4][2], const Unit& u, int wr, int wc, int fr, int fq) const {
        const int row0 = u.om + wr * 64 + fr, col0 = u.pn * BM + wc * 32 + 8 * fq;
        f32x4 bv[2][2];
#pragma unroll
        for (int bj = 0; bj < 2; ++bj)
#pragma unroll
            for (int n = 0; n < 2; ++n) bv[bj][n] = *(const f32x4*)(bias + col0 + bj * HALF + 4 * n);
#pragma unroll
        for (int ai = 0; ai < 2; ++ai)
#pragma unroll
            for (int m = 0; m < 4; ++m) { bf16_t* rowp = O + (size_t)(row0 + ai * HALF + m * 16) * ldc + col0;
#pragma unroll
                for (int bj = 0; bj < 2; ++bj) { const f32x4 v0 = acc[ai][bj][m][0] + bv[bj][0], v1 = acc[ai][bj][m][1] + bv[bj][1];
                    u32x4 w; w.x = cvt_pk(v0[0], v0[1]); w.y = cvt_pk(v0[2], v0[3]); w.z = cvt_pk(v1[0], v1[1]); w.w = cvt_pk(v1[2], v1[3]);
                    *(u32x4*)(rowp + bj * HALF) = w; } }
    }
};
template <bool XF32> struct EpiResid {
    static constexpr bool PERM = true;
    const void* Xin; bf16_t* X; const float* bias; const float* gate;
    __device__ __forceinline__ void operator()(const f32x4 (&acc)[2][2][4][2], const Unit& u, int wr, int wc, int fr, int fq) const {
        const int row0 = u.om + wr * 64 + fr, col0 = u.pn * BM + wc * 32 + 8 * fq; const float* gb = gate + (size_t)(u.om / SEQ) * (6 * D);
        f32x4 bv[2][2], gv[2][2];
#pragma unroll
        for (int bj = 0; bj < 2; ++bj)
#pragma unroll
            for (int n = 0; n < 2; ++n) { bv[bj][n] = *(const f32x4*)(bias + col0 + bj * HALF + 4 * n); gv[bj][n] = *(const f32x4*)(gb + col0 + bj * HALF + 4 * n); }
#pragma unroll
        for (int ai = 0; ai < 2; ++ai)
#pragma unroll
            for (int m = 0; m < 4; ++m) { const size_t off = (size_t)(row0 + ai * HALF + m * 16) * D + col0;
#pragma unroll
                for (int bj = 0; bj < 2; ++bj) { f32x4 x0, x1;
                    if (XF32) { x0 = *(const f32x4*)((const float*)Xin + off + bj * HALF); x1 = *(const f32x4*)((const float*)Xin + off + bj * HALF + 4); }
                    else { const u32x4 xb = *(const u32x4*)((const bf16_t*)Xin + off + bj * HALF); x0 = (f32x4){bf_lo(xb.x), bf_hi(xb.x), bf_lo(xb.y), bf_hi(xb.y)}; x1 = (f32x4){bf_lo(xb.z), bf_hi(xb.z), bf_lo(xb.w), bf_hi(xb.w)}; }
                    const f32x4 v0 = x0 + gv[bj][0] * (acc[ai][bj][m][0] + bv[bj][0]), v1 = x1 + gv[bj][1] * (acc[ai][bj][m][1] + bv[bj][1]);
                    u32x4 w; w.x = cvt_pk(v0[0], v0[1]); w.y = cvt_pk(v0[2], v0[3]); w.z = cvt_pk(v1[0], v1[1]); w.w = cvt_pk(v1[2], v1[3]);
                    *(u32x4*)(X + off + bj * HALF) = w; }
                asm volatile("" ::: "memory"); }
    }
};
template <int MODE> struct EpiPair {
    static constexpr bool PERM = true;
    void* O; const float* bias; int b_estride;
    __device__ __forceinline__ void operator()(const f32x4 (&acc)[2][2][4][2], const Unit& u, int wr, int wc, int fr, int fq) const {
        const int row0 = u.om + wr * 64 + fr, col0 = u.pn * HALF + wc * 32 + 8 * fq; const float* bb = bias + (size_t)u.e * b_estride;
        constexpr float ASC = MODE == 1 ? 1.0f / (F8_SH * F8_SW) : 1.0f;
        f32x4 bv[2][2];
#pragma unroll
        for (int bj = 0; bj < 2; ++bj)
#pragma unroll
            for (int n = 0; n < 2; ++n) bv[bj][n] = *(const f32x4*)(bb + bj * D + col0 + 4 * n);
#pragma unroll
        for (int ai = 0; ai < 2; ++ai)
#pragma unroll
            for (int m = 0; m < 4; ++m) { float r[8];
#pragma unroll
                for (int n = 0; n < 2; ++n) { const f32x4 a = acc[ai][0][m][n] * ASC + bv[0][n], g = acc[ai][1][m][n] * ASC + bv[1][n];
#pragma unroll
                    for (int jp = 0; jp < 2; ++jp) {
                        f32x2 av = (f32x2){a[2 * jp], a[2 * jp + 1]}, gv = (f32x2){g[2 * jp], g[2 * jp + 1]}, o;
                        if (MODE == 0) { const f32x2 x = gv * (-LOG2E); f32x2 e; e.x = __builtin_amdgcn_exp2f(x.x); e.y = __builtin_amdgcn_exp2f(x.y); const f32x2 d = e + 1.0f;
                            f32x2 rc; rc.x = __builtin_amdgcn_rcpf(d.x); rc.y = __builtin_amdgcn_rcpf(d.y); o = av * rc; }
                        else { f32x2 glu, lin; glu.x = fminf(av.x, 7.0f); glu.y = fminf(av.y, 7.0f); lin.x = __builtin_amdgcn_fmed3f(gv.x, -7.0f, 7.0f); lin.y = __builtin_amdgcn_fmed3f(gv.y, -7.0f, 7.0f);
                            const f32x2 x = glu * (-1.702f * LOG2E); f32x2 e; e.x = __builtin_amdgcn_exp2f(x.x); e.y = __builtin_amdgcn_exp2f(x.y); const f32x2 d = e + 1.0f;
                            f32x2 rc; rc.x = __builtin_amdgcn_rcpf(d.x); rc.y = __builtin_amdgcn_rcpf(d.y); o = (glu * rc) * (lin * F8_SACT + F8_SACT); }
                        r[4 * n + 2 * jp] = o.x; r[4 * n + 2 * jp + 1] = o.y; } }
                if (MODE == 0) { bf16_t* rowp = (bf16_t*)O + (size_t)(row0 + ai * HALF + m * 16) * D + col0;
                    u32x4 w; w.x = cvt_pk(r[0], r[1]); w.y = cvt_pk(r[2], r[3]); w.z = cvt_pk(r[4], r[5]); w.w = cvt_pk(r[6], r[7]); *(u32x4*)rowp = w; }
                else { unsigned char* rowp = (unsigned char*)O + (size_t)(row0 + ai * HALF + m * 16) * D + col0;
                    u32x2 w; w.x = cvt_pk4_fp8_nc(r[0], r[1], r[2], r[3]); w.y = cvt_pk4_fp8_nc(r[4], r[5], r[6], r[7]); *(u32x2*)rowp = w; } }
    }
};
struct EpiMoeOut {
    static constexpr bool PERM = true;
    bf16_t* O; const float* bias; const float* gl; const LAS int* exoff;
    __device__ __forceinline__ void operator()(const f32x4 (&acc)[2][2][4][2], const Unit& u, int wr, int wc, int fr, int fq) const {
        const int row0 = u.om + wr * 64 + fr, col0 = u.pn * BM + wc * 32 + 8 * fq; const float* bb = bias + (size_t)u.e * D;
        const GAS float* gp = (const GAS float*)(gl + (size_t)u.e * T + (u.om - exoff[u.e]) + wr * 64 + fr);
        f32x4 bv[2][2]; float gt[2][4];
#pragma unroll
        for (int ai = 0; ai < 2; ++ai)
#pragma unroll
            for (int m = 0; m < 4; ++m) gt[ai][m] = gp[ai * HALF + m * 16];
#pragma unroll
        for (int bj = 0; bj < 2; ++bj)
#pragma unroll
            for (int n = 0; n < 2; ++n) bv[bj][n] = *(const GAS f32x4*)(bb + col0 + bj * HALF + 4 * n);
#pragma unroll
        for (int ai = 0; ai < 2; ++ai)
#pragma unroll
            for (int m = 0; m < 4; ++m) { GAS unsigned char* rowp = (GAS unsigned char*)O + (size_t)(row0 + ai * HALF + m * 16) * D + col0; const float g16 = gt[ai][m] * F8_SY;
#pragma unroll
                for (int bj = 0; bj < 2; ++bj) { const f32x4 v0 = (acc[ai][bj][m][0] * (1.0f / (F8_SACT * F8_SW)) + bv[bj][0]) * g16, v1 = (acc[ai][bj][m][1] * (1.0f / (F8_SACT * F8_SW)) + bv[bj][1]) * g16;
                    u32x2 w; w.x = cvt_pk4_fp8(v0[0], v0[1], v0[2], v0[3]); w.y = cvt_pk4_fp8(v1[0], v1[1], v1[2], v1[3]);
                    *(GAS u32x2*)(rowp + bj * HALF) = w; } }
    }
};

struct Frame {
    LAS unsigned char* lds; volatile LAS unsigned* MISC; gu32* ctl; unsigned char* ws;
    int tid, lane, wave, G, c;
    const float* const* in;
    float* out;
};
enum { I_X = 0, I_C, I_WMOD, I_BMOD, I_NMG, I_NFG, I_AWQKV, I_ABQKV, I_AWO, I_ABO, I_SINK, I_RELB, I_CWIN, I_CBIN, I_CWDW, I_CBDW, I_CLNG, I_CLNB, I_CWOUT, I_CBOUT, I_RW, I_RB, I_MWIN, I_MBIN, I_MWOUT, I_MBOUT, I_FNG };
#define WSP(type, off) ((type*)(F.ws + (off)))
__device__ __forceinline__ void wg_barrier() { __syncthreads(); }

__device__ __forceinline__ int build_exp_tables(Frame& F, int layer) {
    LAS int* EX = (LAS int*)(F.lds + LDS_EXP);
    if (F.tid < 64) {
        const int e = F.tid & 31; const int cnt = (int)__hip_atomic_load(F.ctl + CW_CNT + 64 * layer + e, RLX_AGENT); const int tiles = (cnt + 255) >> 8;
        int pre = tiles;
#pragma unroll
        for (int o = 1; o < 32; o <<= 1) { const int v = __shfl_up(pre, o, 32); if (e >= o) pre += v; }
        if (F.tid < 32) { EX[e] = cnt; EX[32 + e] = pre - tiles; EX[64 + e] = (pre - tiles) * 256; if (e == 31) EX[96] = pre; }
    }
    wg_barrier();
    return EX[96];
}
template <int MODE> __device__ __forceinline__ void row_phase(Frame& F, int layer) {
    constexpr bool COMB = (MODE & 1) != 0, ROUT = (MODE & 2) != 0, FIN = (MODE & 4) != 0;
    LAS float* red = (LAS float*)(F.lds); LAS float* part = (LAS float*)(F.lds + 49152); LAS float* lg = (LAS float*)(F.lds + 49152 + 65536);
    LAS int* hist = (LAS int*)(F.lds + 4608); LAS int* gbase = hist + 32; LAS int* pend = (LAS int*)(F.lds + 8192);
    const LAS int* EX = (const LAS int*)(F.lds + LDS_EXP);
    const int lane = F.lane, w = F.wave, row = lane & 15, kq = lane >> 4;
    constexpr int KS = (MODE & 2) ? 32 : 8;
    const int kb = (MODE & 2) ? 128 * w + 8 * kq : 128 * w + 32 * kq;
    constexpr bool XF32 = (MODE == 0);
    const float* xin = F.in[I_X]; bf16_t* X = WSP(bf16_t, WS_X); bf16_t* H = WSP(bf16_t, WS_H);
    const float* mod = WSP(const float, WS_MOD);
    const float* gamma = FIN ? F.in[I_FNG] : (ROUT ? F.in[I_NFG] + layer * D : F.in[I_NMG] + layer * D);
    const int ngrp = T / 16, g0 = (int)((long)F.c * ngrp / F.G), g1 = (int)((long)(F.c + 1) * ngrp / F.G);
    if (COMB) build_exp_tables(F, layer - 1);
    if (ROUT) { if (F.tid < 32) hist[F.tid] = 0; }
    bf16x8 whi[2][4], wlo[2][4];
    if (ROUT) {
        const float* wrp = F.in[I_RW] + (size_t)layer * D * NE;
#pragma unroll
        for (int eh = 0; eh < 2; ++eh)
#pragma unroll
            for (int s = 0; s < 4; ++s) { float v[8];
#pragma unroll
                for (int j = 0; j < 8; ++j) v[j] = wrp[(size_t)(kb + 32 * s + j) * NE + 16 * eh + row];
                u32x4 hi, lo;
#pragma unroll
                for (int p = 0; p < 4; ++p) { const unsigned h2 = cvt_pk(v[2 * p], v[2 * p + 1]); hi[p] = h2; lo[p] = cvt_pk(v[2 * p] - bf_lo(h2), v[2 * p + 1] - bf_hi(h2)); }
                whi[eh][s] = __builtin_bit_cast(bf16x8, hi); wlo[eh][s] = __builtin_bit_cast(bf16x8, lo); }
    }
    LAS float* Gl = (LAS float*)(F.lds + 32768); LAS float* Sl = Gl + D; LAS float* Fl = Sl + D;
    constexpr int GU = (XF32 || ROUT) ? 2 : 4;
#define UNPK0(v) ((f32x4){bf_lo((v).x), bf_hi((v).x), bf_lo((v).y), bf_hi((v).y)})
#define UNPK1(v) ((f32x4){bf_lo((v).z), bf_hi((v).z), bf_lo((v).w), bf_hi((v).w)})
    int curb = -1;
    for (int grp0 = g0; grp0 < g1; grp0 += GU) {
        const int b = (grp0 * 16) / SEQ, par = ((grp0 - g0) / GU) & 1;
        if (b != curb) { curb = b;
            const float* mb = mod + ((size_t)layer * NBATCH + b) * (6 * D);
            wg_barrier();
            for (int k = F.tid; k < D; k += NTHR) { const float gm = gamma[k];
                if (FIN) { Gl[k] = gm; Sl[k] = 0.f; }
                else { const float* shp = mb + (ROUT ? 3 * D : 0); const float* scp = mb + (ROUT ? 4 * D : D); Gl[k] = gm * (scp[k] + 1.0f); Sl[k] = shp[k]; }
                if (COMB) { const float* gf = mod + ((size_t)(layer - 1) * NBATCH + b) * (6 * D) + 5 * D; Fl[k] = gf[k]; } }
            wg_barrier();
        }
        u32x4 xb[GU][4]; int tks[GU][4];
#pragma unroll
        for (int u = 0; u < GU; ++u) { const int t = (grp0 + u < g1 ? grp0 + u : g1 - 1) * 16 + row;
            if (COMB) { const int* TK = WSP(const int, WS_TK);
#pragma unroll
                for (int kk = 0; kk < 4; ++kk) tks[u][kk] = TK[t * 4 + kk]; }
#pragma unroll
            for (int s = 0; s < 4; ++s) {
                if (XF32) { const f32x4 x0 = *(const f32x4*)(xin + (size_t)t * D + kb + KS * s), x1 = *(const f32x4*)(xin + (size_t)t * D + kb + KS * s + 4);
                    xb[u][s].x = cvt_pk(x0[0], x0[1]); xb[u][s].y = cvt_pk(x0[2], x0[3]); xb[u][s].z = cvt_pk(x1[0], x1[1]); xb[u][s].w = cvt_pk(x1[2], x1[3]); }
                else xb[u][s] = *(const u32x4*)(X + (size_t)t * D + kb + KS * s); } }
        if (COMB) {
            const unsigned char* YS = WSP(const unsigned char, WS_YS);
#pragma unroll
            for (int u = 0; u < GU; ++u) { const int t = (grp0 + u < g1 ? grp0 + u : g1 - 1) * 16 + row;
                size_t yoff[4];
#pragma unroll
                for (int kk = 0; kk < 4; ++kk) { const int tk = tks[u][kk]; yoff[kk] = (size_t)(EX[64 + (tk >> 16)] + (tk & 0xffff)) * D + kb; }
                u32x2 yv[4][4];
#pragma unroll
                for (int s = 0; s < 4; ++s)
#pragma unroll
                    for (int kk = 0; kk < 4; ++kk) yv[s][kk] = *(const u32x2*)(YS + yoff[kk] + KS * s);
#pragma unroll
                for (int s = 0; s < 4; ++s) { f32x4 a0 = (f32x4){0.f, 0.f, 0.f, 0.f}, a1 = a0;
#pragma unroll
                    for (int kk = 0; kk < 4; ++kk) { a0 += fp8x4_to_f32(yv[s][kk].x); a1 += fp8x4_to_f32(yv[s][kk].y); }
                    const f32x4 x0 = UNPK0(xb[u][s]) + *(const LAS f32x4*)(Fl + kb + KS * s) * a0 * (1.0f / F8_SY), x1 = UNPK1(xb[u][s]) + *(const LAS f32x4*)(Fl + kb + KS * s + 4) * a1 * (1.0f / F8_SY);
                    xb[u][s].x = cvt_pk(x0[0], x0[1]); xb[u][s].y = cvt_pk(x0[2], x0[3]); xb[u][s].z = cvt_pk(x1[0], x1[1]); xb[u][s].w = cvt_pk(x1[2], x1[3]);
                    if (!FIN && grp0 + u < g1) *(u32x4*)(X + (size_t)t * D + kb + KS * s) = xb[u][s]; } }
        }
#pragma unroll
        for (int u = 0; u < GU; ++u) { float ss = 0.f;
#pragma unroll
            for (int s = 0; s < 4; ++s) { const f32x4 v0 = UNPK0(xb[u][s]), v1 = UNPK1(xb[u][s]); ss += (v0[0] * v0[0] + v0[1] * v0[1]) + (v0[2] * v0[2] + v0[3] * v0[3]) + (v1[0] * v1[0] + v1[1] * v1[1]) + (v1[2] * v1[2] + v1[3] * v1[3]); }
            ss += __shfl_xor(ss, 16); ss += __shfl_xor(ss, 32);
            if (kq == 0) red[(par * GU + u) * 128 + w * 16 + row] = ss; }
        wg_barrier();
        f32x4 acc[GU][2];
#pragma unroll
        for (int u = 0; u < GU; ++u) { const int t = (grp0 + u < g1 ? grp0 + u : g1 - 1) * 16 + row; const bool live = grp0 + u < g1;
            float tot = 0.f;
#pragma unroll
            for (int ww = 0; ww < 8; ++ww) tot += red[(par * GU + u) * 128 + ww * 16 + row];
            const float rstd = rsqrtf(tot * (1.0f / D) + 1e-5f);
            acc[u][0] = (f32x4){0.f, 0.f, 0.f, 0.f}; acc[u][1] = acc[u][0];
#pragma unroll
            for (int s = 0; s < 4; ++s) {
                const f32x4 h0 = UNPK0(xb[u][s]) * rstd * *(const LAS f32x4*)(Gl + kb + KS * s) + *(const LAS f32x4*)(Sl + kb + KS * s), h1 = UNPK1(xb[u][s]) * rstd * *(const LAS f32x4*)(Gl + kb + KS * s + 4) + *(const LAS f32x4*)(Sl + kb + KS * s + 4);
                if (FIN) { if (live) { *(f32x4*)(F.out + (size_t)t * D + kb + KS * s) = h0; *(f32x4*)(F.out + (size_t)t * D + kb + KS * s + 4) = h1; } }
                else {
                    u32x4 hi; hi.x = cvt_pk(h0[0], h0[1]); hi.y = cvt_pk(h0[2], h0[3]); hi.z = cvt_pk(h1[0], h1[1]); hi.w = cvt_pk(h1[2], h1[3]);
                    if (!ROUT) { if (live) *(u32x4*)(H + (size_t)t * D + kb + KS * s) = hi; }
                    else { u32x2 q8; q8.x = cvt_pk4_fp8(h0[0] * F8_SH, h0[1] * F8_SH, h0[2] * F8_SH, h0[3] * F8_SH); q8.y = cvt_pk4_fp8(h1[0] * F8_SH, h1[1] * F8_SH, h1[2] * F8_SH, h1[3] * F8_SH);
                        if (live) *(u32x2*)((unsigned char*)H + (size_t)t * D + kb + KS * s) = q8; }
                    if (ROUT) {
                        u32x4 lo; lo.x = cvt_pk(h0[0] - bf_lo(hi.x), h0[1] - bf_hi(hi.x)); lo.y = cvt_pk(h0[2] - bf_lo(hi.y), h0[3] - bf_hi(hi.y));
                        lo.z = cvt_pk(h1[0] - bf_lo(hi.z), h1[1] - bf_hi(hi.z)); lo.w = cvt_pk(h1[2] - bf_lo(hi.w), h1[3] - bf_hi(hi.w));
                        const bf16x8 ah = __builtin_bit_cast(bf16x8, hi), al = __builtin_bit_cast(bf16x8, lo);
#pragma unroll
                        for (int eh = 0; eh < 2; ++eh) {
                            acc[u][eh] = __builtin_amdgcn_mfma_f32_16x16x32_bf16(ah, whi[eh][s], acc[u][eh], 0, 0, 0);
                            acc[u][eh] = __builtin_amdgcn_mfma_f32_16x16x32_bf16(ah, wlo[eh][s], acc[u][eh], 0, 0, 0);
                            acc[u][eh] = __builtin_amdgcn_mfma_f32_16x16x32_bf16(al, whi[eh][s], acc[u][eh], 0, 0, 0); }
                    }
                }
            }
        }
        if (ROUT) {
#pragma unroll
            for (int u = 0; u < GU; ++u)
#pragma unroll
                for (int eh = 0; eh < 2; ++eh)
#pragma unroll
                    for (int i = 0; i < 4; ++i) part[((u * 8 + w) * 16 + 4 * kq + i) * 32 + 16 * eh + row] = acc[u][eh][i];
            wg_barrier();
#pragma unroll
            for (int u = 0; u < GU; ++u) { const int r = F.tid >> 5, e = F.tid & 31; float v = F.in[I_RB][layer * NE + e];
#pragma unroll
                for (int ww = 0; ww < 8; ++ww) v += part[((u * 8 + ww) * 16 + r) * 32 + e];
                lg[(u * 16 + r) * 32 + e] = v; }
            wg_barrier();
            if (F.tid < 16 * GU && grp0 + (F.tid >> 4) < g1) {
                const int u = F.tid >> 4, r = F.tid & 15; unsigned used = 0u; int ids[4]; float vals[4];
#pragma unroll
                for (int k = 0; k < 4; ++k) { int bi = 0; float bv = -3.0e38f;
                    for (int e = 0; e < 32; ++e) { const float v = lg[(u * 16 + r) * 32 + e]; if (!((used >> e) & 1u) && v > bv) { bv = v; bi = e; } }
                    used |= 1u << bi; ids[k] = bi; vals[k] = bv; }
                const float e1 = __expf(vals[1] - vals[0]), e2 = __expf(vals[2] - vals[0]), e3 = __expf(vals[3] - vals[0]), inv = 1.0f / (1.0f + e1 + e2 + e3);
                const float gs[4] = {inv, e1 * inv, e2 * inv, e3 * inv};
#pragma unroll
                for (int k = 0; k < 4; ++k) { const int lp = atomicAdd((int*)&hist[ids[k]], 1); const int idx = ((grp0 + u - g0) * 16 + r) * 4 + k; pend[2 * idx] = ids[k] | (lp << 8); pend[2 * idx + 1] = __float_as_int(gs[k]); }
            }
        }
    }
#undef UNPK0
#undef UNPK1
    if (ROUT) {
        wg_barrier();
        if (F.tid < 32) { const int n = hist[F.tid]; gbase[F.tid] = n > 0 ? (int)__hip_atomic_fetch_add(F.ctl + CW_CNT + 64 * layer + F.tid, (unsigned)n, RLX_AGENT) : 0; }
        wg_barrier();
        int* LIST = WSP(int, WS_LIST); float* GL = WSP(float, WS_GLIST); int* TK = WSP(int, WS_TK);
        const int nent = (g1 - g0) * 64;
        for (int idx = F.tid; idx < nent; idx += NTHR) { const int pw = pend[2 * idx], e = pw & 0xff, pos = gbase[e] + (pw >> 8), tok = g0 * 16 + (idx >> 2);
            LIST[(size_t)e * T + pos] = tok; GL[(size_t)e * T + pos] = __int_as_float(pend[2 * idx + 1]); TK[tok * 4 + (idx & 3)] = (e << 16) | pos; }
    }
    wg_barrier();
}
__device__ const unsigned char kBucket[128] = {0, 1, 2, 3, 4, 5, 6, 7, 8, 9, 10, 11, 12, 13, 14, 15, 16, 16, 16, 17, 17, 18, 18, 18, 19, 19, 19, 20, 20, 20, 20, 21, 21, 21, 21, 22, 22, 22, 22, 22, 23, 23, 23, 23, 23, 23, 24, 24, 24, 24, 24, 24, 25, 25, 25, 25, 25, 25, 25, 26, 26, 26, 26, 26, 26, 26, 26, 27, 27, 27, 27, 27, 27, 27, 27, 27, 27, 28, 28, 28, 28, 28, 28, 28, 28, 28, 28, 29, 29, 29, 29, 29, 29, 29, 29, 29, 29, 29, 29, 30, 30, 30, 30, 30, 30, 30, 30, 30, 30, 30, 30, 30, 30, 31, 31, 31, 31, 31, 31, 31, 31, 31, 31, 31, 31, 31, 31, 31};
constexpr int KP = 144, VP = 192;
constexpr int ATT_K = 0, ATT_V = 256 * KP, ATT_B = ATT_V + 256 * VP;
__device__ __forceinline__ int crow(int r, int hi) { return (r & 3) + 8 * (r >> 2) + 4 * hi; }
typedef short v4i16_t __attribute__((ext_vector_type(4)));
__device__ __forceinline__ s16x4 vtr(const LAS unsigned char* p) { return __builtin_bit_cast(s16x4, __builtin_amdgcn_ds_read_tr16_b64_v4i16((LAS v4i16_t*)p)); }

__device__ __forceinline__ void attn_phase(Frame& F, int j) {
    const bf16_t* QKV = WSP(const bf16_t, WS_QKV); bf16_t* AO = WSP(bf16_t, WS_AO);
    LAS unsigned char* Kl = F.lds + ATT_K; LAS unsigned char* Vl = F.lds + ATT_V; LAS float* Bl = (LAS float*)(F.lds + ATT_B);
    const int lane = F.lane, w = F.wave, r = lane & 31, hh = lane >> 5;
    const float c1 = 0.125f * LOG2E;
    for (int unit = F.c; unit < NBATCH * 16 * 4; unit += F.G) {
        const int kvh = unit & 3, n = (unit >> 2) & 15, b = unit >> 6;
        const int krow0 = b * SEQ + (n > 0 ? (n - 1) * 128 : 0);
#pragma unroll
        for (int it = 0; it < 4; ++it) { const int ch = F.tid + NTHR * it, s = ch >> 3, c8 = ch & 7;
            const int grow = (n > 0 || s >= 128) ? (b * SEQ + (n - 1) * 128 + s) : (krow0 + s);
            const u32x4 kv = *(const u32x4*)(QKV + (size_t)grow * 1536 + 1024 + kvh * 64 + 8 * c8); const u32x4 vv = *(const u32x4*)(QKV + (size_t)grow * 1536 + 1280 + kvh * 64 + 8 * c8);
            *(LAS u32x4*)(Kl + s * KP + 16 * c8) = kv; *(LAS u32x4*)(Vl + s * VP + 16 * c8) = vv; }
        { const int g = F.tid >> 7, dist = F.tid & 127; Bl[F.tid] = F.in[I_RELB][kBucket[dist] * 16 + kvh * 4 + g] * LOG2E; }
        wg_barrier();
        const int g = w >> 1, hq = kvh * 4 + g; const float sink2 = F.in[I_SINK][j * 16 + hq] * LOG2E;
#pragma unroll 1
        for (int grp = 0; grp < 2; ++grp) {
            const int a0 = (w & 1) * 64 + grp * 32, a = a0 + r; const size_t tok = (size_t)b * SEQ + n * 128 + a;
            bf16x8 qf[4];
#pragma unroll
            for (int d0 = 0; d0 < 4; ++d0) qf[d0] = *(const bf16x8*)(QKV + tok * 1536 + hq * 64 + 16 * d0 + 8 * hh);
            const int kt0 = a0 >> 5;
            f32x16 S[5];
#pragma unroll
            for (int t = 0; t < 5; ++t) {
#pragma unroll
                for (int i = 0; i < 16; ++i) S[t][i] = 0.f;
                const LAS unsigned char* kp = Kl + (32 * (kt0 + t) + r) * KP + 16 * hh;
#pragma unroll
                for (int d0 = 0; d0 < 4; ++d0) { const bf16x8 kf = *(const LAS bf16x8*)(kp + 32 * d0); S[t] = __builtin_amdgcn_mfma_f32_32x32x16_bf16(kf, qf[d0], S[t], 0, 0, 0); }
            }
            float m = sink2;
#pragma unroll
            for (int t = 0; t < 5; ++t)
#pragma unroll
                for (int i = 0; i < 16; ++i) { const int s = 32 * (kt0 + t) + crow(i, hh), dist = a + 128 - s; const bool ok = (dist >= 0) && (dist < 128) && (n > 0 || s >= 128);
                    const float v = ok ? S[t][i] * c1 + Bl[g * 128 + (dist & 127)] : -3.0e38f; S[t][i] = v; m = fmaxf(m, v); }
            m = fmaxf(m, __shfl_xor(m, 32));
            float l = 0.f;
#pragma unroll
            for (int t = 0; t < 5; ++t)
#pragma unroll
                for (int i = 0; i < 16; ++i) { const float p = __builtin_amdgcn_exp2f(S[t][i] - m); S[t][i] = p; l += p; }
            l += __shfl_xor(l, 32); l += __builtin_amdgcn_exp2f(sink2 - m);
            f32x16 O[2];
#pragma unroll
            for (int i = 0; i < 16; ++i) { O[0][i] = 0.f; O[1][i] = 0.f; }
            const int q4 = (lane >> 2) & 3, p4 = lane & 3, blk = (lane >> 4) & 1;
#pragma unroll
            for (int t = 0; t < 5; ++t)
#pragma unroll
                for (int s2 = 0; s2 < 2; ++s2) {
                    u32x4 pk; pk.x = cvt_pk(S[t][8 * s2 + 0], S[t][8 * s2 + 1]); pk.y = cvt_pk(S[t][8 * s2 + 2], S[t][8 * s2 + 3]); pk.z = cvt_pk(S[t][8 * s2 + 4], S[t][8 * s2 + 5]); pk.w = cvt_pk(S[t][8 * s2 + 6], S[t][8 * s2 + 7]);
                    const bf16x8 pb = __builtin_bit_cast(bf16x8, pk);
                    const LAS unsigned char* vp = Vl + (32 * (kt0 + t) + 16 * s2 + 4 * hh + q4) * VP + 32 * blk + 8 * p4;
#pragma unroll
                    for (int dh = 0; dh < 2; ++dh) { const s16x4 lo = vtr(vp + 64 * dh), hi = vtr(vp + 64 * dh + 8 * VP);
                        const bf16x8 va = (bf16x8){lo[0], lo[1], lo[2], lo[3], hi[0], hi[1], hi[2], hi[3]};
                        O[dh] = __builtin_amdgcn_mfma_f32_32x32x16_bf16(va, pb, O[dh], 0, 0, 0); }
                }
            const float inv = 1.0f / l;
#pragma unroll
            for (int dh = 0; dh < 2; ++dh)
#pragma unroll
                for (int g4 = 0; g4 < 4; ++g4) { u32x2 o2; o2.x = cvt_pk(O[dh][4 * g4] * inv, O[dh][4 * g4 + 1] * inv); o2.y = cvt_pk(O[dh][4 * g4 + 2] * inv, O[dh][4 * g4 + 3] * inv);
                    *(u32x2*)(AO + tok * D + hq * 64 + 32 * dh + 8 * g4 + 4 * hh) = o2; }
        }
        wg_barrier();
    }
}

__device__ __forceinline__ float wave_sum63(float v) {
    v += __builtin_bit_cast(float, __builtin_amdgcn_update_dpp(0, __builtin_bit_cast(int, v), 0x111, 0xf, 0xf, true));
    v += __builtin_bit_cast(float, __builtin_amdgcn_update_dpp(0, __builtin_bit_cast(int, v), 0x112, 0xf, 0xf, true));
    v += __builtin_bit_cast(float, __builtin_amdgcn_update_dpp(0, __builtin_bit_cast(int, v), 0x114, 0xf, 0xf, true));
    v += __builtin_bit_cast(float, __builtin_amdgcn_update_dpp(0, __builtin_bit_cast(int, v), 0x118, 0xf, 0xf, true));
    v += __builtin_bit_cast(float, __builtin_amdgcn_update_dpp(0, __builtin_bit_cast(int, v), 0x142, 0xa, 0xf, true));
    v += __builtin_bit_cast(float, __builtin_amdgcn_update_dpp(0, __builtin_bit_cast(int, v), 0x143, 0xc, 0xf, true));
    return v;
}
__device__ __forceinline__ void dwconv_phase(Frame& F, int j, unsigned long long& t_acc) {
#ifndef TIME_KIND
#define TIME_KIND (-1)
#endif
    unsigned long long t_b = 0ull;
#define DT_BEG(k) do { if (TIME_KIND == (k)) t_b = __builtin_amdgcn_s_memrealtime(); } while (0)
#define DT_END(k) do { if (TIME_KIND == (k)) t_acc += __builtin_amdgcn_s_memrealtime() - t_b; } while (0)
    constexpr int PP = 520;
    DT_BEG(16);
    const bf16_t* U = WSP(const bf16_t, WS_U); bf16_t* YC = WSP(bf16_t, WS_AO);
    LAS unsigned char* ut = F.lds; LAS float* P = (LAS float*)F.lds; LAS float* fin = (LAS float*)(F.lds + 64 * PP * 4);
    const int tid = F.tid, lane = F.lane, w = F.wave;
    const float* wd = F.in[I_CWDW] + (size_t)j * 31 * D + 2 * tid;
    f32x2 wk[31];
#pragma unroll
    for (int q = 0; q < 31; ++q) wk[q] = *(const f32x2*)(wd + q * D);
    const f32x2 bdw = *(const f32x2*)(F.in[I_CBDW] + j * D + 2 * tid), lng = *(const f32x2*)(F.in[I_CLNG] + j * D + 2 * tid), lnb = *(const f32x2*)(F.in[I_CLNB] + j * D + 2 * tid);
    const __amdgpu_buffer_rsrc_t rU = __builtin_amdgcn_make_buffer_rsrc((void*)U, 0, 0x7fffffff, 0x00020000);
    asm volatile("s_waitcnt vmcnt(0)" ::: "memory"); DT_END(16);
    for (int tile = F.c; tile < T / 32; tile += F.G) {
        const int t0 = tile * 32, tin0 = t0 % SEQ, rlo = tin0 >= 30 ? 0 : 30 - tin0;
        DT_BEG(12);
        for (int pc = w; pc < 124; pc += NWAVES) { const int rr = pc >> 1;
            if (rr >= rlo) __builtin_amdgcn_raw_ptr_buffer_load_lds(rU, (LAS unsigned*)(ut + pc * 1024), 16, lane * 16, (int)(((size_t)(t0 + rr - 30) * D + (pc & 1) * 512) * 2), 0, 0);
            else *(LAS u32x4*)(ut + pc * 1024 + lane * 16) = (u32x4){0u, 0u, 0u, 0u}; }
        asm volatile("s_waitcnt vmcnt(0)" ::: "memory");
        wg_barrier();
        DT_END(12); DT_BEG(13);
        f32x2 y[32];
#pragma unroll
        for (int blk = 0; blk < 4; ++blk) {
            f32x2 a[8] = {bdw, bdw, bdw, bdw, bdw, bdw, bdw, bdw};
#pragma unroll
            for (int rr = 0; rr < 38; ++rr) { const unsigned uw = *(const LAS unsigned*)(ut + (8 * blk + rr) * 2048 + 4 * tid); const f32x2 uv = (f32x2){bf_lo(uw), bf_hi(uw)};
#pragma unroll
                for (int o = 0; o < 8; ++o) { const int q = rr - o; if (q >= 0 && q < 31) a[o] += wk[q] * uv; } }
#pragma unroll
            for (int o = 0; o < 8; ++o) y[8 * blk + o] = a[o];
        }
        DT_END(13); DT_BEG(14);
        wg_barrier();
#pragma unroll
        for (int tk = 0; tk < 32; ++tk) { P[(2 * tk) * PP + tid] = y[tk].x + y[tk].y; P[(2 * tk + 1) * PP + tid] = y[tk].x * y[tk].x + y[tk].y * y[tk].y; }
        wg_barrier();
        { const int qn = tid >> 3, l8 = tid & 7; float v = 0.f;
#pragma unroll 16
          for (int i2 = 0; i2 < 64; ++i2) v += P[qn * PP + l8 + 8 * i2];
          v += __shfl_xor(v, 1); v += __shfl_xor(v, 2); v += __shfl_xor(v, 4);
          if (l8 == 0) fin[qn] = v; }
        wg_barrier();
        DT_END(14); DT_BEG(15);
#pragma unroll
        for (int tk = 0; tk < 32; ++tk) { const float mean = fin[2 * tk] * (1.0f / D), var = fmaxf(fin[2 * tk + 1] * (1.0f / D) - mean * mean, 0.f), rstd = rsqrtf(var + 1e-5f);
            const float v0 = (y[tk].x - mean) * rstd * lng.x + lnb.x, v1 = (y[tk].y - mean) * rstd * lng.y + lnb.y;
            *(unsigned*)(YC + (size_t)(t0 + tk) * D + 2 * tid) = cvt_pk(v0 * sigmoid_f(v0), v1 * sigmoid_f(v1)); }
        asm volatile("s_waitcnt vmcnt(0)" ::: "memory");
        wg_barrier();
        DT_END(15);
    }
#undef DT_BEG
#undef DT_END
}
__device__ __forceinline__ void p0_mod_task(Frame& F, int task) {
    LAS float* cact = (LAS float*)F.lds; LAS float* part = (LAS float*)(F.lds + 32768);
    const int i = task / 24, n0 = (task % 24) * 256, tid = F.tid, lane = F.lane, w = F.wave;
    for (int q = tid; q < NBATCH * D; q += NTHR) { const float cv = F.in[I_C][q]; cact[q] = cv * sigmoid_f(cv); }
    wg_barrier();
    f32x4 acc[8];
#pragma unroll
    for (int b = 0; b < 8; ++b) acc[b] = (f32x4){0.f, 0.f, 0.f, 0.f};
    const float* Wp = F.in[I_WMOD] + ((size_t)i * D + 128 * w) * (6 * D) + n0 + 4 * lane;
#pragma unroll 4
    for (int k = 0; k < 128; ++k) { const f32x4 wv = *(const f32x4*)(Wp + (size_t)k * (6 * D));
#pragma unroll
        for (int b = 0; b < 8; ++b) acc[b] += wv * cact[b * D + 128 * w + k]; }
#pragma unroll
    for (int b = 0; b < 8; ++b) *(LAS f32x4*)(part + (w * 8 + b) * 256 + 4 * lane) = acc[b];
    wg_barrier();
    float* mod = WSP(float, WS_MOD);
#pragma unroll
    for (int q = 0; q < 4; ++q) { const int o = tid + NTHR * q, b = o >> 8, n = o & 255; float s = F.in[I_BMOD][i * 6 * D + n0 + n];
#pragma unroll
        for (int ww = 0; ww < 8; ++ww) s += part[(ww * 8 + b) * 256 + n];
        mod[((size_t)i * NBATCH + b) * (6 * D) + n0 + n] = s; }
    wg_barrier();
}
struct TItem { const float* W; bf16_t* Dst; int N, paired, kb, nb, f8; };
constexpr int CV_DENSE = 352, CV_MOE = 3072;
__device__ __forceinline__ bool cv_item(Frame& F, int q, int it, TItem& x) {
    if (it < 0) return false;
    if (q == 0) {
        const int NQ = 96, NO = 64, NCI = 128, NCO = 64;
        if (it < NQ) { const int j = it / 48, r = it % 48; x.W = F.in[I_AWQKV] + (size_t)j * D * 1536; x.Dst = WSP(bf16_t, WS_WQKV) + (size_t)j * 1536 * D; x.N = 1536; x.paired = 0; x.f8 = 0; x.kb = r / 6; x.nb = r % 6; return true; } it -= NQ;
        if (it < NO) { const int j = it / 32, r = it % 32; x.W = F.in[I_AWO] + (size_t)j * D * D; x.Dst = WSP(bf16_t, WS_WO) + (size_t)j * D * D; x.N = 1024; x.paired = 0; x.f8 = 0; x.kb = r / 4; x.nb = r % 4; return true; } it -= NO;
        if (it < NCI) { const int j = it / 64, r = it % 64; x.W = F.in[I_CWIN] + (size_t)j * D * 2048; x.Dst = WSP(bf16_t, WS_CWIN) + (size_t)j * 2048 * D; x.N = 2048; x.paired = 1; x.f8 = 0; x.kb = r / 8; x.nb = r % 8; return true; } it -= NCI;
        if (it < NCO) { const int j = it / 32, r = it % 32; x.W = F.in[I_CWOUT] + (size_t)j * D * D; x.Dst = WSP(bf16_t, WS_CWOUT) + (size_t)j * D * D; x.N = 1024; x.paired = 0; x.f8 = 0; x.kb = r / 4; x.nb = r % 4; return true; } it -= NCO;
    }
    if (it < 2048) { const int m = q * NE + it / 64, r = it % 64; x.W = F.in[I_MWIN] + (size_t)m * D * 2048; x.Dst = (bf16_t*)(WSP(unsigned char, WS_MWIN) + (size_t)m * 2048 * D); x.N = 2048; x.paired = 1; x.f8 = 1; x.kb = r / 8; x.nb = r % 8; return true; } it -= 2048;
    if (it < 1024) { const int m = q * NE + it / 32, r = it % 32; x.W = F.in[I_MWOUT] + (size_t)m * D * D; x.Dst = (bf16_t*)(WSP(unsigned char, WS_MWOUT) + (size_t)m * D * D); x.N = 1024; x.paired = 0; x.f8 = 1; x.kb = r / 4; x.nb = r % 4; return true; }
    return false;
}
__device__ __forceinline__ void cv_run(Frame& F, int q, int max_items) {
    if (q > 3 || max_items <= 0) return;
    LAS float* tile = (LAS float*)F.lds;
    volatile LAS int* qslot = (volatile LAS int*)(F.lds + 128 * 257 * 4 + 64);
    const int tid = F.tid, lane = F.lane, w = F.wave; gu32* qc = F.ctl + CW_P0Q + 64 * q;
    int claimed = 1;
    wg_barrier();
    if (tid == 0) qslot[0] = (int)__hip_atomic_fetch_add(qc, 1u, RLX_AGENT);
    wg_barrier();
    int it = qslot[0]; TItem cur; bool valid = cv_item(F, q, it, cur);
    f32x4 rg[16];
    if (valid) {
#pragma unroll
        for (int qq = 0; qq < 16; ++qq) rg[qq] = *(const f32x4*)(cur.W + (size_t)(cur.kb * 128 + w * 16 + qq) * cur.N + cur.nb * 256 + 4 * lane); }
    wg_barrier();
    while (valid) {
        const bool more = claimed < max_items;
        if (tid == 0) qslot[0] = more ? (int)__hip_atomic_fetch_add(qc, 1u, RLX_AGENT) : -1;
        ++claimed;
#pragma unroll
        for (int qq = 0; qq < 16; ++qq) { LAS float* tp = tile + (w * 16 + qq) * 257 + 4 * lane; tp[0] = rg[qq][0]; tp[1] = rg[qq][1]; tp[2] = rg[qq][2]; tp[3] = rg[qq][3]; }
        wg_barrier();
        const int nit = qslot[0]; TItem nx; const bool nvalid = cv_item(F, q, nit, nx);
        if (nvalid) {
#pragma unroll
            for (int qq = 0; qq < 16; ++qq) rg[qq] = *(const f32x4*)(nx.W + (size_t)(nx.kb * 128 + w * 16 + qq) * nx.N + nx.nb * 256 + 4 * lane); }
        const int kc = lane >> 3;
#pragma unroll
        for (int r4 = 0; r4 < 4; ++r4) { const int nl = 32 * w + 8 * r4 + (lane & 7), n = cur.nb * 256 + nl; const LAS float* sp = tile + (16 * kc) * 257 + nl;
            float v[16];
#pragma unroll
            for (int jj = 0; jj < 16; ++jj) v[jj] = sp[jj * 257];
            int nd = n; if (cur.paired) { const int half = n >> 10, rem = n & 1023; nd = ((rem >> 7) << 8) + (half << 7) + (rem & 127); }
            if (cur.f8) { u32x4 o; o.x = cvt_pk4_fp8(v[0] * F8_SW, v[1] * F8_SW, v[2] * F8_SW, v[3] * F8_SW); o.y = cvt_pk4_fp8(v[4] * F8_SW, v[5] * F8_SW, v[6] * F8_SW, v[7] * F8_SW);
                o.z = cvt_pk4_fp8(v[8] * F8_SW, v[9] * F8_SW, v[10] * F8_SW, v[11] * F8_SW); o.w = cvt_pk4_fp8(v[12] * F8_SW, v[13] * F8_SW, v[14] * F8_SW, v[15] * F8_SW);
                *(u32x4*)((unsigned char*)cur.Dst + (size_t)nd * D + cur.kb * 128 + 16 * kc) = o; }
            else { u32x4 o0, o1; o0.x = cvt_pk(v[0], v[1]); o0.y = cvt_pk(v[2], v[3]); o0.z = cvt_pk(v[4], v[5]); o0.w = cvt_pk(v[6], v[7]); o1.x = cvt_pk(v[8], v[9]); o1.y = cvt_pk(v[10], v[11]); o1.z = cvt_pk(v[12], v[13]); o1.w = cvt_pk(v[14], v[15]);
                bf16_t* dp = cur.Dst + (size_t)nd * D + cur.kb * 128 + 16 * kc; *(u32x4*)dp = o0; *(u32x4*)(dp + 8) = o1; } }
        wg_barrier();
        cur = nx; valid = nvalid;
    }
}
#ifndef CV_OVERLAP
#define CV_OVERLAP 1
#endif
__device__ __forceinline__ void p0_phase(Frame& F) {
    for (int task = F.c; task < 96; task += F.G) p0_mod_task(F, task);
    cv_run(F, 0, 1 << 30);
    if (!CV_OVERLAP) { cv_run(F, 1, 1 << 30); cv_run(F, 2, 1 << 30); cv_run(F, 3, 1 << 30); }
}

template <bool GATHER> __device__ __forceinline__ int moe_build_units(Frame& F, int layer, int npn, int total_tiles, int ubase) {
    const LAS int* EX = (const LAS int*)(F.lds + LDS_EXP); LAS int* UT = (LAS int*)(F.lds + LDS_UT); LAS int* TOK = (LAS int*)(F.lds + LDS_TOK);
    const int tps = 32 / npn, nsb = (total_tiles + tps - 1) / tps;
    const bool xcd_ok = (F.G % 256) == 0 || F.G == 256;
    int n = 0;
    if (xcd_ok && F.G == 256) {
        const int x = F.c & 7, jx = F.c >> 3;
        const int mine = x < nsb ? (nsb - x + 7) / 8 : 0; n = mine - ubase; n = n < 0 ? 0 : (n > 9 ? 9 : n);
        if (F.tid < n) { const int q = (ubase + F.tid) * 8 + x, tau = q * tps + (jx % tps), pn = jx / tps; int e = 0;
            if (tau < total_tiles) { for (int qq = 1; qq < 32; ++qq) if (tau >= EX[32 + qq]) e = qq; } else e = -1;
            const int mt = e >= 0 ? tau - EX[32 + e] : 0, om = e >= 0 ? EX[64 + e] + 256 * mt : 0;
            UT[4 * F.tid] = GATHER ? 256 * F.tid : om; UT[4 * F.tid + 1] = om; UT[4 * F.tid + 2] = e; UT[4 * F.tid + 3] = pn; UT[40 + F.tid] = mt; }
    } else {
        const int U = total_tiles * npn; const int mine = F.c < U ? (U - F.c + F.G - 1) / F.G : 0; n = mine - ubase; n = n < 0 ? 0 : (n > 9 ? 9 : n);
        if (F.tid < n) { const int L = F.c + (ubase + F.tid) * F.G, tau = L / npn, pn = L % npn; int e = 0;
            for (int qq = 1; qq < 32; ++qq) if (tau >= EX[32 + qq]) e = qq;
            const int mt = tau - EX[32 + e], om = EX[64 + e] + 256 * mt;
            UT[4 * F.tid] = GATHER ? 256 * F.tid : om; UT[4 * F.tid + 1] = om; UT[4 * F.tid + 2] = e; UT[4 * F.tid + 3] = pn; UT[40 + F.tid] = mt; }
    }
    wg_barrier();
    if (F.tid == 0) { int w = 0; for (int r = 0; r < n; ++r) { if (UT[4 * r + 2] >= 0) { if (w != r) { UT[4 * w] = GATHER ? 256 * w : UT[4 * r]; UT[4 * w + 1] = UT[4 * r + 1]; UT[4 * w + 2] = UT[4 * r + 2]; UT[4 * w + 3] = UT[4 * r + 3]; UT[40 + w] = UT[40 + r]; } ++w; } } UT[60] = w; UT[61] = n; }
    wg_barrier();
    const int nv = UT[60];
    if (GATHER) { const int* LIST = WSP(const int, WS_LIST);
        for (int q = F.tid; q < nv * 256; q += NTHR) { const int ui = q >> 8, rr = q & 255, e = UT[4 * ui + 2], pos = 256 * UT[40 + ui] + rr; TOK[q] = pos < EX[e] ? LIST[(size_t)e * T + pos] : 0; }
        wg_barrier(); }
    return nv | (n << 8);
}

constexpr int N_PHASES = 30;
struct Args { const float* in[27]; float* out; unsigned char* ws; int ph_lo, ph_hi; };
__global__ void __launch_bounds__(NTHR, 2) mega(const Args args) {
    extern __shared__ __attribute__((aligned(16))) unsigned char lds_raw[];
    Frame F; F.lds = (LAS unsigned char*)lds_raw; F.MISC = (volatile LAS unsigned*)(F.lds + LDS_MISC); F.ws = args.ws; F.ctl = (gu32*)(args.ws + WS_CTL);
    F.tid = threadIdx.x; F.lane = F.tid & 63; F.wave = __builtin_amdgcn_readfirstlane(F.tid >> 6); F.G = gridDim.x; F.c = blockIdx.x; F.out = args.out;
    F.in = args.in;
    if (F.tid < 32) F.MISC[F.tid] = 0u;
    __syncthreads();
    const int lo = args.ph_lo, hi = args.ph_hi;
    XcdBarrier bar; bar.bar = (unsigned*)(F.ctl + CW_BAR); bar.x = 0; bar.st = F.MISC + 8;
    if (hi - lo > 1) bar = xcd_barrier_post((unsigned*)(F.ctl + CW_BAR), F.MISC + 8);
#ifndef CVQ_QKV
#define CVQ_QKV 4
#endif
#ifndef CVQ_MOE
#define CVQ_MOE 2
#endif
#ifndef PH_MASK
#define PH_MASK 0xFFFF
#endif
#define IN(k) (lo <= (k) && (k) < hi)
#define HAS(b) (((PH_MASK) >> (b)) & 1)
#define PHASE_ENTER() do { int _t = F.tid; asm volatile("" : "+v"(_t)); F.tid = _t; F.lane = _t & 63; F.wave = __builtin_amdgcn_readfirstlane(_t >> 6); unsigned char* _w = F.ws; asm volatile("" : "+s"(_w)); F.ws = _w; int _g = F.G; asm volatile("" : "+s"(_g)); F.G = _g; } while (0)
    unsigned long long t_acc = 0ull, t_beg = 0ull, g_ticks = 0ull, g_cyc = 0ull;
#define TBEG(kind) do { if (TIME_KIND == (kind)) t_beg = __builtin_amdgcn_s_memrealtime(); } while (0)
#define TEND(kind) do { if (TIME_KIND == (kind)) t_acc += __builtin_amdgcn_s_memrealtime() - t_beg; } while (0)
#define SEAM(k) do { if ((k) + 1 < hi) xcd_barrier(bar); } while (0)
    const LAS int* toktab = (const LAS int*)(F.lds + LDS_TOK);
    if (HAS(0) && IN(0)) { TBEG(0); p0_phase(F); SEAM(0); TEND(0); }
    for (int i = 0; i < DEPTH; ++i) {
        const int pb = 1 + 7 * i, j = i >> 1; const bool conv = (i & 1) != 0;
        const float* modl = WSP(const float, WS_MOD) + (size_t)i * NBATCH * (6 * D);
        if (IN(pb)) { PHASE_ENTER(); TBEG(1); if (i == 0) { if (HAS(1)) row_phase<0>(F, 0); } else { TBEG(7); if (HAS(2)) row_phase<1>(F, i); TEND(7); } SEAM(pb); TEND(1); }
        if (IN(pb + 1)) { PHASE_ENTER(); TBEG(2);
            if (!conv) { if (HAS(3)) { Gemm g{WSP(const bf16_t, WS_H), WSP(const bf16_t, WS_WQKV) + (size_t)j * 1536 * D, D, 0}; DenseOrder S; S.init(1536, F.G, F.c);
                EpiBias16 E{WSP(bf16_t, WS_QKV), 1536, F.in[I_ABQKV] + j * 1536}; gemm_phase<EpiBias16, DenseOrder, false>(F.lds, g, S, E, toktab, F.tid, 40, t_acc, g_ticks, g_cyc);
                if (CV_OVERLAP && (long)F.c + F.G >= 384) cv_run(F, i + 1, CVQ_QKV); } }
            else if (HAS(4)) { Gemm g{WSP(const bf16_t, WS_H), WSP(const bf16_t, WS_CWIN) + (size_t)j * 2048 * D, D, 0}; DenseOrder S; S.init(2048, F.G, F.c);
                EpiPair<0> E{WSP(void, WS_U), F.in[I_CBIN] + j * 2048, 0}; gemm_phase<EpiPair<0>, DenseOrder, false>(F.lds, g, S, E, toktab, F.tid, 50, t_acc, g_ticks, g_cyc); }
            SEAM(pb + 1); TEND(2); }
        if (IN(pb + 2)) { PHASE_ENTER(); TBEG(3); if (!conv) { TBEG(6); if (HAS(5)) attn_phase(F, j); TEND(6); } else { if (HAS(6)) dwconv_phase(F, j, t_acc); TBEG(17); } SEAM(pb + 2); if (conv) TEND(17); TEND(3); }
        if (IN(pb + 3)) { PHASE_ENTER(); TBEG(2); if (HAS(7)) {
            Gemm g{WSP(const bf16_t, WS_AO), (conv ? WSP(const bf16_t, WS_CWOUT) : WSP(const bf16_t, WS_WO)) + (size_t)j * D * D, D, 0}; DenseOrder S; S.init(1024, F.G, F.c);
            const float* bias2 = (conv ? F.in[I_CBOUT] : F.in[I_ABO]) + j * D;
            if (i == 0) { EpiResid<true> E{F.in[I_X], WSP(bf16_t, WS_X), bias2, modl + 2 * D}; gemm_phase<EpiResid<true>, DenseOrder, false>(F.lds, g, S, E, toktab, F.tid, 60, t_acc, g_ticks, g_cyc); }
            else { EpiResid<false> E{WSP(const bf16_t, WS_X), WSP(bf16_t, WS_X), bias2, modl + 2 * D}; gemm_phase<EpiResid<false>, DenseOrder, false>(F.lds, g, S, E, toktab, F.tid, 60, t_acc, g_ticks, g_cyc); } }
            SEAM(pb + 3); TEND(2); }
        if (IN(pb + 4)) { PHASE_ENTER(); TBEG(1); if (CV_OVERLAP && i > 0) cv_run(F, i, 1 << 30); TBEG(8); if (HAS(8)) row_phase<2>(F, i); TEND(8); SEAM(pb + 4); TEND(1); }
        if (IN(pb + 5)) { PHASE_ENTER(); TBEG(4); if (HAS(9)) {
            const int tt = build_exp_tables(F, i);
            Gemm g{WSP(const bf16_t, WS_H), (const bf16_t*)(WSP(const unsigned char, WS_MWIN) + (size_t)i * NE * 2048 * D), D / 2, (size_t)2048 * D / 2};
            EpiPair<1> E{WSP(void, WS_ACT), F.in[I_MBIN] + (size_t)i * NE * 2048, 2048};
            for (int ub = 0;; ub += 9) { const int nn = moe_build_units<true>(F, i, 8, tt, ub); const int n = nn >> 8, nv = nn & 255; if (n == 0) break;
                TableOrder S{(const LAS int*)(F.lds + LDS_UT), nv}; gemm_phase<EpiPair<1>, TableOrder, true, true>(F.lds, g, S, E, toktab, F.tid, 20, t_acc, g_ticks, g_cyc); wg_barrier();
                if (n < 9) { if (CV_OVERLAP && ub + nv < (((tt + 3) / 4) + 7) / 8) cv_run(F, i + 1, CVQ_MOE); break; } } }
            SEAM(pb + 5); TEND(4); }
        if (IN(pb + 6)) { PHASE_ENTER(); TBEG(5); if (HAS(10)) {
            const int tt = build_exp_tables(F, i);
            Gemm g{WSP(const bf16_t, WS_ACT), (const bf16_t*)(WSP(const unsigned char, WS_MWOUT) + (size_t)i * NE * D * D), D / 2, (size_t)D * D / 2};
            EpiMoeOut E{WSP(bf16_t, WS_YS), F.in[I_MBOUT] + (size_t)i * NE * D, WSP(const float, WS_GLIST), (const LAS int*)(F.lds + LDS_EXP + 256)};
            for (int ub = 0;; ub += 9) { const int nn = moe_build_units<false>(F, i, 4, tt, ub); const int n = nn >> 8, nv = nn & 255; if (n == 0) break;
                TableOrder S{(const LAS int*)(F.lds + LDS_UT), nv}; gemm_phase<EpiMoeOut, TableOrder, false, true>(F.lds, g, S, E, toktab, F.tid, 30, t_acc, g_ticks, g_cyc); wg_barrier();
                if (n < 9) { if (CV_OVERLAP && ub + nv < (((tt + 7) / 8) + 7) / 8) cv_run(F, i + 1, CVQ_MOE); break; } } }
            SEAM(pb + 6); TEND(5); }
    }
    if (HAS(11) && IN(29)) { PHASE_ENTER(); TBEG(1); row_phase<5>(F, DEPTH); TEND(1); }
    if (TIME_KIND >= 20 && (TIME_KIND % 10) == 5 && g_ticks > 0) t_acc = (g_cyc * 1000ull) / g_ticks;
    if (TIME_KIND >= 0 && blockIdx.x == 0) { const unsigned long long t0 = __builtin_amdgcn_s_memrealtime(); while (__builtin_amdgcn_s_memrealtime() - t0 < t_acc) __builtin_amdgcn_s_sleep(8); }
#undef IN
#undef SEAM
}

inline void launch_range(void* const* d_in, void* d_out, void* d_ws, int grid, int lo, int hi, hipStream_t stream) {
    Args a{}; for (int i = 0; i < 27; ++i) a.in[i] = (const float*)d_in[i];
    a.out = (float*)d_out; a.ws = (unsigned char*)d_ws; a.ph_lo = lo; a.ph_hi = hi;
    hipLaunchKernelGGL(mega, dim3(grid), dim3(NTHR), LDS_BYTES, stream, a);
}
inline int setup_grid() {
    static int grid = 0;
    if (grid == 0) {
        int dev = 0, cus = 0;
        if (hipGetDevice(&dev) != hipSuccess || hipDeviceGetAttribute(&cus, hipDeviceAttributeMultiprocessorCount, dev) != hipSuccess) { grid = -1; return grid; }
        if (hipFuncSetAttribute((const void*)mega, hipFuncAttributeMaxDynamicSharedMemorySize, LDS_BYTES) != hipSuccess) { grid = -1; return grid; }
        int per_cu = 0; (void)hipOccupancyMaxActiveBlocksPerMultiprocessor(&per_cu, (const void*)mega, NTHR, LDS_BYTES); (void)hipGetLastError();
        if (per_cu < 1) fprintf(stderr, "kernel_launch: occupancy query reports %d blocks per CU\n", per_cu);
        grid = cus;
    }
    return grid;
}
}
#ifndef FAST_LAUNCH_MODE
#define FAST_LAUNCH_MODE 1
#endif
extern "C" void kernel_launch(void* const* d_in, const int* in_sizes, int n_in, void* d_out, int out_size, void* d_ws, size_t ws_size, hipStream_t stream) {
    if (n_in != 27 || out_size != fk::T * fk::D || ws_size < fk::WS_END) { fprintf(stderr, "kernel_launch: unexpected shapes (n_in %d out %d ws %zu)\n", n_in, out_size, ws_size); return; }
    const int grid = fk::setup_grid(); if (grid <= 0) return;
    (void)hipMemsetAsync((char*)d_ws + fk::WS_CTL, 0, fk::CTL_ZERO_BYTES, stream);
#if FAST_LAUNCH_MODE == 1
    fk::launch_range(d_in, d_out, d_ws, grid, 0, fk::N_PHASES, stream);
#else
    for (int k = 0; k < fk::N_PHASES; ++k) fk::launch_range(d_in, d_out, d_ws, grid, k, k + 1, stream);
#endif
}
```

```cpp
#include <hip/hip_runtime.h>
#include <cstdio>
#include <cstdint>
namespace fk {
#define LAS __attribute__((address_space(3)))
#define GAS __attribute__((address_space(1)))
typedef unsigned short bf16_t;
typedef short bf16x8 __attribute__((ext_vector_type(8)));
typedef short s16x4 __attribute__((ext_vector_type(4)));
typedef float f32x4 __attribute__((ext_vector_type(4)));
typedef float f32x2 __attribute__((ext_vector_type(2)));
typedef float f32x16 __attribute__((ext_vector_type(16)));
typedef float f32x8 __attribute__((ext_vector_type(8)));
typedef unsigned u32x4 __attribute__((ext_vector_type(4)));
typedef unsigned u32x2 __attribute__((ext_vector_type(2)));
typedef __bf16 bf16x2_t __attribute__((ext_vector_type(2)));
typedef int v4i __attribute__((ext_vector_type(4)));
typedef int v8i __attribute__((ext_vector_type(8)));
typedef GAS unsigned gu32;
#define RLX_AGENT __ATOMIC_RELAXED, __HIP_MEMORY_SCOPE_AGENT
#define LDS_WAIT() asm volatile("s_waitcnt lgkmcnt(0)" ::: "memory")
#define VM_WAIT() asm volatile("s_waitcnt vmcnt(0)" ::: "memory")

constexpr int T = 16384, D = 1024, SEQ = 2048, NBATCH = 8, NE = 32, DEPTH = 4;
constexpr int NWAVES = 8, NTHR = 512;
constexpr int SLOTCAP = T * 4 + NE * 256;
constexpr float LOG2E = 1.4426950408889634f;

__device__ __forceinline__ unsigned cvt_pk(float lo, float hi) { f32x2 v = {lo, hi}; bf16x2_t b = __builtin_convertvector(v, bf16x2_t); return __builtin_bit_cast(unsigned, b); }
__device__ __forceinline__ float bf_lo(unsigned w) { return __uint_as_float(w << 16); }
__device__ __forceinline__ float bf_hi(unsigned w) { return __uint_as_float(w & 0xffff0000u); }
__device__ __forceinline__ unsigned cvt_pk4_fp8(float a, float b, float c, float d) {
    a = __builtin_amdgcn_fmed3f(a, -448.f, 448.f); b = __builtin_amdgcn_fmed3f(b, -448.f, 448.f); c = __builtin_amdgcn_fmed3f(c, -448.f, 448.f); d = __builtin_amdgcn_fmed3f(d, -448.f, 448.f);
    int w = 0; w = __builtin_amdgcn_cvt_pk_fp8_f32(a, b, w, false); w = __builtin_amdgcn_cvt_pk_fp8_f32(c, d, w, true); return (unsigned)w; }
__device__ __forceinline__ unsigned cvt_pk4_fp8_nc(float a, float b, float c, float d) { int w = 0; w = __builtin_amdgcn_cvt_pk_fp8_f32(a, b, w, false); w = __builtin_amdgcn_cvt_pk_fp8_f32(c, d, w, true); return (unsigned)w; }
constexpr float F8_SH = 8.0f, F8_SW = 64.0f, F8_SACT = 4.0f, F8_SY = 16.0f;
__device__ __forceinline__ f32x4 fp8x4_to_f32(unsigned w) { const f32x2 lo = __builtin_amdgcn_cvt_pk_f32_fp8((int)w, false), hi = __builtin_amdgcn_cvt_pk_f32_fp8((int)w, true); return (f32x4){lo.x, lo.y, hi.x, hi.y}; }
__device__ __forceinline__ float sigmoid_f(float v) { return __builtin_amdgcn_rcpf(1.0f + __builtin_amdgcn_exp2f(-LOG2E * v)); }

constexpr size_t MiB = (size_t)1 << 20;
constexpr size_t WS_CTL = 0, CTL_ZERO_BYTES = 1 * MiB;
constexpr size_t WS_MOD = 1 * MiB;
constexpr size_t WS_WQKV = 2 * MiB;
constexpr size_t WS_WO = 8 * MiB;
constexpr size_t WS_CWIN = 12 * MiB;
constexpr size_t WS_CWOUT = 20 * MiB;
constexpr size_t WS_MWIN = 24 * MiB;
constexpr size_t WS_MWOUT = WS_MWIN + 512 * MiB;
constexpr size_t WS_X = WS_MWOUT + 256 * MiB;
constexpr size_t WS_H = WS_X + 64 * MiB;
constexpr size_t WS_QKV = WS_H + 32 * MiB;
constexpr size_t WS_AO = WS_QKV + 48 * MiB;
constexpr size_t WS_U = WS_AO + 32 * MiB;
constexpr size_t WS_LIST = WS_U + 32 * MiB;
constexpr size_t WS_GLIST = WS_LIST + 2 * MiB;
constexpr size_t WS_TK = WS_GLIST + 2 * MiB;
constexpr size_t WS_ACT = WS_TK + 1 * MiB;
constexpr size_t WS_YS = WS_ACT + 144 * MiB;
constexpr size_t WS_END = WS_YS + 144 * MiB;
constexpr int CW_TMO = 0, CW_P0Q = 64, CW_BAR = 4096, CW_CNT = 16384;
#define XCD_BAR_WORDS 3456

constexpr int RING_BYTES = 131072;
constexpr int LDS_TOK = RING_BYTES;
constexpr int LDS_UT = LDS_TOK + 9216;
constexpr int LDS_EXP = LDS_UT + 256;
constexpr int LDS_BYTES = 163840;
constexpr int LDS_MISC = LDS_BYTES - 128;
static_assert(LDS_EXP + 512 <= LDS_MISC, "LDS map");

#define XB_TMO      128
#define XB_XCNT(j)  (256  + 64 * (j))
#define XB_XSUB(j)  (1280 + 64 * (j))
#define XB_XGEN(j)  (2304 + 64 * (j))
#define XB_TOP      3328
#define XB_TOPGEN   3392
#define XB_SPIN_CAP (1u << 18)
__device__ __forceinline__ unsigned xb_ld(unsigned* p)              { return __hip_atomic_load(p, __ATOMIC_RELAXED, __HIP_MEMORY_SCOPE_AGENT); }
__device__ __forceinline__ unsigned xb_add(unsigned* p, unsigned v) { return __hip_atomic_fetch_add(p, v, __ATOMIC_RELAXED, __HIP_MEMORY_SCOPE_AGENT); }
__device__ __forceinline__ unsigned xb_xcc_id() { return (unsigned)__builtin_amdgcn_s_getreg((3 << 11) | 20) & 0xFu; }
#define XB_SPIN(cond, bar) do { unsigned _sp = 0; while (cond) { __builtin_amdgcn_s_sleep(1); \
    if ((++_sp & 255u) == 0u) { if (xb_ld(&(bar)[XB_TMO])) break; if (_sp > XB_SPIN_CAP) { atomicAdd(&(bar)[XB_TMO], 1u); break; } } } } while (0)
struct XcdBarrier { unsigned* bar; unsigned x; volatile LAS unsigned* st; };
__device__ __forceinline__ XcdBarrier xcd_barrier_post(unsigned* bar, volatile LAS unsigned* st) {
    XcdBarrier b; b.bar = bar; b.x = xb_xcc_id(); b.st = st;
    if (threadIdx.x == 0) (void)xb_add(&bar[XB_XCNT(b.x)], 1u);
    return b;
}
__device__ __forceinline__ void xcd_barrier_complete(unsigned* bar, unsigned x, unsigned& nloc, unsigned& nx) {
    const unsigned G = gridDim.x * gridDim.y * gridDim.z;
    unsigned sum, cnt, mine, sp = 0u;
    for (;;) {
        sum = 0u; cnt = 0u; mine = 0u;
#pragma unroll
        for (unsigned j = 0; j < 16; ++j) { const unsigned c = xb_ld(&bar[XB_XCNT(j)]); sum += c; cnt += (c > 0u) ? 1u : 0u; mine = (j == x) ? c : mine; }
        if (sum == G) break;
        __builtin_amdgcn_s_sleep(1);
        if ((++sp & 255u) == 0u) { if (xb_ld(&bar[XB_TMO])) break; if (sp > XB_SPIN_CAP) { atomicAdd(&bar[XB_TMO], 1u); break; } }
    }
    nloc = mine > 0u ? mine : 1u; nx = cnt > 0u ? cnt : 1u;
}
__device__ __forceinline__ void xcd_barrier(const XcdBarrier& b) {
    asm volatile("s_waitcnt vmcnt(0)" ::: "memory");
    __syncthreads();
    if (threadIdx.x == 0) {
        unsigned* bar = b.bar;
        __builtin_amdgcn_s_waitcnt(0);
        unsigned nloc = b.st[0], nx = b.st[1];
        if (nloc == 0u) { xcd_barrier_complete(bar, b.x, nloc, nx); b.st[0] = nloc; b.st[1] = nx; }
        const unsigned old = xb_add(&bar[XB_XSUB(b.x)], 1u);
        const unsigned gen = old / nloc;
        if (old + 1u == (gen + 1u) * nloc) {
            __builtin_amdgcn_fence(__ATOMIC_RELEASE, "agent");
            asm volatile("s_waitcnt vmcnt(0)" ::: "memory");
            const unsigned og = xb_add(&bar[XB_TOP], 1u);
            const unsigned tg = og / nx;
            if (og + 1u == (tg + 1u) * nx) xb_add(&bar[XB_TOPGEN], 1u);
            else XB_SPIN(xb_ld(&bar[XB_TOPGEN]) == tg, bar);
            __builtin_amdgcn_fence(__ATOMIC_ACQUIRE, "agent");
            xb_add(&bar[XB_XGEN(b.x)], 1u);
            asm volatile("s_waitcnt vmcnt(0)" ::: "memory");
        } else {
            XB_SPIN(xb_ld(&bar[XB_XGEN(b.x)]) == gen, bar);
            __builtin_amdgcn_fence(__ATOMIC_ACQUIRE, "agent");
            asm volatile("s_waitcnt vmcnt(0)" ::: "memory");
        }
    }
    __syncthreads();
}

constexpr int BM = 256, BK = 64, HALF = 128, HTB = HALF * BK * 2, NXCD = 8, WGM = 8;
__host__ __device__ __forceinline__ int lds_byte(int r, int c) { const int st = (r >> 4) * 2 + (c >> 5), rr = r & 15, cc = c & 31, ob = rr * 64 + cc * 2; return st * 1024 + (ob ^ (((ob >> 9) & 1) << 5)); }
__host__ __device__ __forceinline__ void stage_rc(int b, int& R, int& C) { const int st = b / 1024, sb = b % 1024, swz = sb ^ (((sb >> 9) & 1) << 5); R = (st >> 1) * 16 + swz / 64; C = (st & 1) * 32 + (swz % 64) / 2; }
__host__ __device__ __forceinline__ int perm32(int rho) { const int n = rho >> 4, i = rho & 15; return 8 * (i >> 2) + 4 * n + (i & 3); }

struct Unit { int am, om, e, pn; };
struct Gemm { const bf16_t* A; const bf16_t* Bt; int K; size_t b_estride; };

struct DenseOrder {
    int nM, nN, nwg, G, c;
    __device__ void init(int N, int G_, int c_) { nM = T / BM; nN = N / BM; nwg = nM * nN; G = G_; c = c_; }
    __device__ __forceinline__ bool next(int i, Unit& u) const {
        const long L = (long)i * G + c; if (L >= nwg) return false;
        int wgid = (int)L; { const int q = nwg / NXCD, r = nwg % NXCD, xcd = wgid % NXCD, off = wgid / NXCD; wgid = (xcd < r ? xcd * (q + 1) : r * (q + 1) + (xcd - r) * q) + off; }
        const int nig = WGM * nN, gid = wgid / nig, fm = gid * WGM, gsz = (nM - fm) < WGM ? (nM - fm) : WGM;
        const int pm = fm + ((wgid % nig) % gsz); u.pn = (wgid % nig) / gsz; u.am = pm * BM; u.om = pm * BM; u.e = 0; return true;
    }
};
struct TableOrder {
    const LAS int* ut; int n;
    __device__ __forceinline__ bool next(int i, Unit& u) const {
        if (i >= n) return false;
        u.am = __builtin_amdgcn_readfirstlane(ut[4 * i]); u.om = __builtin_amdgcn_readfirstlane(ut[4 * i + 1]); u.e = __builtin_amdgcn_readfirstlane(ut[4 * i + 2]); u.pn = __builtin_amdgcn_readfirstlane(ut[4 * i + 3]); return true;
    }
};

template <class Epi, class Sched, bool GATHER, bool F8 = false>
__device__ __forceinline__ void gemm_phase(LAS unsigned char* lds, const Gemm g, const Sched& S, const Epi& E, const LAS int* toktab, const int tid, const int tkb, unsigned long long& t_acc, unsigned long long& g_ticks, unsigned long long& g_cyc) {
    unsigned long long t_b = 0ull, c_b = 0ull; static_assert(true, "");
#ifndef TIME_KIND
#define TIME_KIND (-1)
#endif
#define GT_BEG(k) do { if (TIME_KIND >= 20 && TIME_KIND == tkb + (k)) t_b = __builtin_amdgcn_s_memrealtime(); if ((k) == 0 && TIME_KIND == tkb + 5) { t_b = __builtin_amdgcn_s_memrealtime(); c_b = __builtin_readcyclecounter(); } } while (0)
#define GT_END(k) do { if (TIME_KIND >= 20 && TIME_KIND == tkb + (k)) t_acc += __builtin_amdgcn_s_memrealtime() - t_b; if ((k) == 0 && TIME_KIND == tkb + 5) { g_ticks += __builtin_amdgcn_s_memrealtime() - t_b; g_cyc += __builtin_readcyclecounter() - c_b; } } while (0)
    const int wid = __builtin_amdgcn_readfirstlane(tid >> 6), lane = tid & 63, wr = wid >> 2, wc = wid & 3, fr = lane & 15, fq = lane >> 4;
    const int K = g.K, nt = K / BK;
    int Rr[2], Cc[2]; unsigned voffB[2];
#pragma unroll
    for (int i = 0; i < 2; ++i) { int R, C; stage_rc(tid * 16 + i * 8192, R, C); Rr[i] = R; Cc[i] = C; const int Rb = Epi::PERM ? ((R & ~31) + perm32(R & 31)) : R; voffB[i] = (unsigned)(Rb * K + C) * 2u; }
    const unsigned ldsw = (unsigned)wid * 1024u;
    const int aoff = lds_byte(wr * 64 + fr, fq * 8), boff = lds_byte(wc * 32 + fr, fq * 8);
#define PG8_SA(b, h) (((b) * 2 + (h)) * HTB)
#define PG8_SB(b, h) ((4 + (b) * 2 + (h)) * HTB)
#ifndef USE_BUFFER_LDS
#define USE_BUFFER_LDS 1
#endif
#if USE_BUFFER_LDS
#define PG8_STAGE(bufoff, rsrc, soff, voff) do { _Pragma("unroll") for (int _i = 0; _i < 2; ++_i) \
        __builtin_amdgcn_raw_ptr_buffer_load_lds(rsrc, (LAS unsigned*)(lds + (bufoff) + ldsw + _i * 8192), 16, (int)(voff)[_i], (int)(soff), 0, 0); } while (0)
#else
#define PG8_STAGE(bufoff, rsrc, soff, voff) do { _Pragma("unroll") for (int _i = 0; _i < 2; ++_i) \
        __builtin_amdgcn_global_load_lds((const unsigned*)((const char*)(rsrc##_base) + (size_t)(soff) + (voff)[_i]), (LAS unsigned*)(lds + (bufoff) + ldsw + _i * 8192), 16, 0, 0); } while (0)
#endif
#define CAT8(l, h) __builtin_shufflevector((l), (h), 0, 1, 2, 3, 4, 5, 6, 7)
#define LO4(x) __builtin_shufflevector((x), (x), 0, 1, 2, 3)
#define HI4(x) __builtin_shufflevector((x), (x), 4, 5, 6, 7)
#define PG8_LDA(dst, b, h) do { _Pragma("unroll") for (int m = 0; m < 4; ++m) dst[m] = CAT8(*(const LAS v4i*)(lds + PG8_SA(b, h) + aoff + m * 2048), *(const LAS v4i*)(lds + PG8_SA(b, h) + aoff + m * 2048 + 1024)); } while (0)
#define PG8_LDB(dst, b, h) do { _Pragma("unroll") for (int n = 0; n < 2; ++n) dst[n] = CAT8(*(const LAS v4i*)(lds + PG8_SB(b, h) + boff + n * 2048), *(const LAS v4i*)(lds + PG8_SB(b, h) + boff + n * 2048 + 1024)); } while (0)
#define PG8_MMA(ai, bj, At, Bt) do { __builtin_amdgcn_s_setprio(1); \
        if constexpr (F8) { _Pragma("unroll") for (int m = 0; m < 4; ++m) { f32x4 _l = LO4(acc8[ai][bj][m]), _h = HI4(acc8[ai][bj][m]); \
            _l = __builtin_amdgcn_mfma_scale_f32_16x16x128_f8f6f4(Bt[0], At[m], _l, 0, 0, 0, 0x7f7f7f7f, 0, 0x7f7f7f7f); \
            _h = __builtin_amdgcn_mfma_scale_f32_16x16x128_f8f6f4(Bt[1], At[m], _h, 0, 0, 0, 0x7f7f7f7f, 0, 0x7f7f7f7f); acc8[ai][bj][m] = CAT8(_l, _h); } \
              \
            asm volatile("" : "+v"(acc8[ai][bj][0]), "+v"(acc8[ai][bj][1]), "+v"(acc8[ai][bj][2]), "+v"(acc8[ai][bj][3])); } \
        else { _Pragma("unroll") for (int m = 0; m < 4; ++m) { f32x4 _l = LO4(acc8[ai][bj][m]), _h = HI4(acc8[ai][bj][m]); \
            _l = __builtin_amdgcn_mfma_f32_16x16x32_bf16(__builtin_bit_cast(bf16x8, LO4(Bt[0])), __builtin_bit_cast(bf16x8, LO4(At[m])), _l, 0, 0, 0); \
            _l = __builtin_amdgcn_mfma_f32_16x16x32_bf16(__builtin_bit_cast(bf16x8, HI4(Bt[0])), __builtin_bit_cast(bf16x8, HI4(At[m])), _l, 0, 0, 0); \
            _h = __builtin_amdgcn_mfma_f32_16x16x32_bf16(__builtin_bit_cast(bf16x8, LO4(Bt[1])), __builtin_bit_cast(bf16x8, LO4(At[m])), _h, 0, 0, 0); \
            _h = __builtin_amdgcn_mfma_f32_16x16x32_bf16(__builtin_bit_cast(bf16x8, HI4(Bt[1])), __builtin_bit_cast(bf16x8, HI4(At[m])), _h, 0, 0, 0); acc8[ai][bj][m] = CAT8(_l, _h); } } \
        __builtin_amdgcn_s_setprio(0); } while (0)
#define PG8_WAIT_V(n) asm volatile("s_waitcnt vmcnt(" #n ")" ::: "memory")
#define PG8_WAIT_L(n) asm volatile("s_waitcnt lgkmcnt(" #n ")" ::: "memory")
#define PG8_BAR __builtin_amdgcn_s_barrier()
#define PG8_SCHED __builtin_amdgcn_sched_barrier(0)
#define A_OFFS(dst, u) do { _Pragma("unroll") for (int _h = 0; _h < 2; ++_h) _Pragma("unroll") for (int _i = 0; _i < 2; ++_i) { \
        const int _row = GATHER ? toktab[(u).am + _h * HALF + Rr[_i]] : ((u).am + _h * HALF + Rr[_i]); dst[_h][_i] = (unsigned)(_row * K + Cc[_i]) * 2u; } } while (0)
    Unit cur, nxt; int ui = 0;
    if (!S.next(0, cur)) return;
    f32x8 acc8[2][2][4];
#pragma unroll
    for (int a = 0; a < 2; ++a)
#pragma unroll
        for (int b = 0; b < 2; ++b)
#pragma unroll
            for (int m = 0; m < 4; ++m) acc8[a][b][m] = (f32x8){0.f, 0.f, 0.f, 0.f, 0.f, 0.f, 0.f, 0.f};
    v8i At[4], B0[2], B1[2];
    unsigned ao[2][2]; A_OFFS(ao, cur);
    const __amdgpu_buffer_rsrc_t rA = __builtin_amdgcn_make_buffer_rsrc((void*)g.A, 0, 0x7fffffff, 0x00020000), rB = __builtin_amdgcn_make_buffer_rsrc((void*)g.Bt, 0, 0x7fffffff, 0x00020000);
    const char* const rA_base = (const char*)g.A; const char* const rB_base = (const char*)g.Bt; (void)rA_base; (void)rB_base;
    const unsigned kstep = (unsigned)(BK * 2), hstep = (unsigned)HALF * K * 2;
    unsigned cB = (unsigned)(((size_t)cur.e * g.b_estride + (size_t)cur.pn * BM * K) * 2);
    PG8_STAGE(PG8_SB(0, 0), rB, cB, voffB); PG8_STAGE(PG8_SB(0, 1), rB, cB + hstep, voffB); PG8_STAGE(PG8_SA(0, 0), rA, 0u, ao[0]); PG8_STAGE(PG8_SA(0, 1), rA, 0u, ao[1]);
    if (wr == 1) PG8_BAR;
    PG8_WAIT_V(2); PG8_BAR;
    PG8_STAGE(PG8_SB(1, 0), rB, cB + kstep, voffB); PG8_STAGE(PG8_SA(1, 0), rA, kstep, ao[0]); PG8_STAGE(PG8_SB(1, 1), rB, cB + hstep + kstep, voffB);
    PG8_WAIT_V(6); PG8_BAR;
    for (;;) {
        const bool has_next = S.next(ui + 1, nxt);
        const unsigned nB = has_next ? (unsigned)(((size_t)nxt.e * g.b_estride + (size_t)nxt.pn * BM * K) * 2) : cB;
        GT_BEG(0);
#pragma unroll 1
        for (int t = 0; t < nt; t += 2) {
            const bool last = (t == nt - 2);
            const unsigned a1 = (unsigned)(t + 1) * kstep;
            const unsigned a2 = last ? 0u : (unsigned)(t + 2) * kstep, b2 = last ? nB : cB + (unsigned)(t + 2) * kstep;
            const unsigned a3 = a2 + kstep, b3 = b2 + kstep;
            unsigned a2o[2][2];
            if (last && has_next) { A_OFFS(a2o, nxt); }
            else {
#pragma unroll
                for (int _h = 0; _h < 2; ++_h)
#pragma unroll
                    for (int _i = 0; _i < 2; ++_i) a2o[_h][_i] = ao[_h][_i]; }
            PG8_LDB(B0, 0, 0); PG8_LDB(B1, 0, 1); PG8_SCHED; PG8_LDA(At, 0, 0); PG8_STAGE(PG8_SA(1, 1), rA, a1, ao[1]);
            PG8_WAIT_V(8); PG8_WAIT_L(0); PG8_BAR; PG8_MMA(0, 0, At, B0); PG8_MMA(0, 1, At, B1); PG8_BAR; PG8_SCHED;
            PG8_LDA(At, 0, 1); PG8_STAGE(PG8_SB(0, 0), rB, b2, voffB); PG8_STAGE(PG8_SB(0, 1), rB, b2 + hstep, voffB); PG8_STAGE(PG8_SA(0, 0), rA, a2, a2o[0]);
            PG8_WAIT_V(8); PG8_WAIT_L(0); PG8_BAR; PG8_MMA(1, 0, At, B0); PG8_MMA(1, 1, At, B1); PG8_BAR; PG8_SCHED;
            PG8_LDB(B0, 1, 0); PG8_LDB(B1, 1, 1); PG8_SCHED; PG8_LDA(At, 1, 0); PG8_STAGE(PG8_SA(0, 1), rA, a2, a2o[1]);
            PG8_WAIT_V(8); PG8_WAIT_L(0); PG8_BAR; PG8_MMA(0, 0, At, B0); PG8_MMA(0, 1, At, B1); PG8_BAR; PG8_SCHED;
            PG8_LDA(At, 1, 1); PG8_STAGE(PG8_SB(1, 0), rB, b3, voffB); PG8_STAGE(PG8_SB(1, 1), rB, b3 + hstep, voffB); PG8_STAGE(PG8_SA(1, 0), rA, a3, a2o[0]);
            PG8_WAIT_V(8); PG8_WAIT_L(0); PG8_BAR; PG8_MMA(1, 0, At, B0); PG8_MMA(1, 1, At, B1); PG8_BAR; PG8_SCHED;
            if (last) {
#pragma unroll
                for (int _h = 0; _h < 2; ++_h)
#pragma unroll
                    for (int _i = 0; _i < 2; ++_i) ao[_h][_i] = a2o[_h][_i]; }
        }
        GT_END(0); GT_BEG(1);
        if (wr == 0) PG8_BAR;
        { f32x4 acc[2][2][4][2];
#pragma unroll
          for (int a = 0; a < 2; ++a)
#pragma unroll
              for (int b = 0; b < 2; ++b)
#pragma unroll
                  for (int m = 0; m < 4; ++m) { acc[a][b][m][0] = LO4(acc8[a][b][m]); acc[a][b][m][1] = HI4(acc8[a][b][m]); }
          E(acc, cur, wr, wc, fr, fq); }
        GT_END(1);
        if (!has_next) break;
#pragma unroll
        for (int a = 0; a < 2; ++a)
#pragma unroll
            for (int b = 0; b < 2; ++b)
#pragma unroll
                for (int m = 0; m < 4; ++m) acc8[a][b][m] = (f32x8){0.f, 0.f, 0.f, 0.f, 0.f, 0.f, 0.f, 0.f};
        cur = nxt; cB = nB; ++ui;
        if (wr == 1) PG8_BAR;
    }
    PG8_WAIT_V(0);
    PG8_BAR;
#undef PG8_SA
#undef PG8_SB
#undef PG8_STAGE
#undef PG8_LDA
#undef PG8_LDB
#undef PG8_MMA
#undef PG8_WAIT_V
#undef PG8_WAIT_L
#undef PG8_BAR
#undef PG8_SCHED
#undef A_OFFS
#undef GT_BEG
#undef GT_END
#undef CAT8
#undef LO4
#undef HI4
}
struct EpiBias16 {
    static constexpr bool PERM = true;
    bf16_t* O; int ldc; const float* bias;
    __device__ __forceinline__ void operator()(const f32x4 (&acc)[2][2][4][2], const Unit& u, int wr, int wc, int fr, int fq) const {
        const int row0 = u.om + wr * 64 + fr, col0 = u.pn * BM + wc * 32 + 8 * fq;
        f32x4 bv[2][2];
#pragma unroll
        for (int bj = 0; bj < 2; ++bj)
#pragma unroll
            for (int n = 0; n < 2; ++n) bv[bj][n] = *(const f32x4*)(bias + col0 + bj * HALF + 4 * n);
#pragma unroll
        for (int ai = 0; ai < 2; ++ai)
#pragma unroll
            for (int m = 0; m < 4; ++m) { bf16_t* rowp = O + (size_t)(row0 + ai * HALF + m * 16) * ldc + col0;
#pragma unroll
                for (int bj = 0; bj < 2; ++bj) { const f32x4 v0 = acc[ai][bj][m][0] + bv[bj][0], v1 = acc[ai][bj][m][1] + bv[bj][1];
                    u32x4 w; w.x = cvt_pk(v0[0], v0[1]); w.y = cvt_pk(v0[2], v0[3]); w.z = cvt_pk(v1[0], v1[1]); w.w = cvt_pk(v1[2], v1[3]);
                    *(u32x4*)(rowp + bj * HALF) = w; } }
    }
};
template <bool XF32> struct EpiResid {
    static constexpr bool PERM = true;
    const void* Xin; bf16_t* X; const float* bias; const float* gate;
    __device__ __forceinline__ void operator()(const f32x4 (&acc)[2][2][4][2], const Unit& u, int wr, int wc, int fr, int fq) const {
        const int row0 = u.om + wr * 64 + fr, col0 = u.pn * BM + wc * 32 + 8 * fq; const float* gb = gate + (size_t)(u.om / SEQ) * (6 * D);
        f32x4 bv[2][2], gv[2][2];
#pragma unroll
        for (int bj = 0; bj < 2; ++bj)
#pragma unroll
            for (int n = 0; n < 2; ++n) { bv[bj][n] = *(const f32x4*)(bias + col0 + bj * HALF + 4 * n); gv[bj][n] = *(const f32x4*)(gb + col0 + bj * HALF + 4 * n); }
#pragma unroll
        for (int ai = 0; ai < 2; ++ai)
#pragma unroll
            for (int m = 0; m < 4; ++m) { const size_t off = (size_t)(row0 + ai * HALF + m * 16) * D + col0;
#pragma unroll
                for (int bj = 0; bj < 2; ++bj) { f32x4 x0, x1;
                    if (XF32) { x0 = *(const f32x4*)((const float*)Xin + off + bj * HALF); x1 = *(const f32x4*)((const float*)Xin + off + bj * HALF + 4); }
                    else { const u32x4 xb = *(const u32x4*)((const bf16_t*)Xin + off + bj * HALF); x0 = (f32x4){bf_lo(xb.x), bf_hi(xb.x), bf_lo(xb.y), bf_hi(xb.y)}; x1 = (f32x4){bf_lo(xb.z), bf_hi(xb.z), bf_lo(xb.w), bf_hi(xb.w)}; }
                    const f32x4 v0 = x0 + gv[bj][0] * (acc[ai][bj][m][0] + bv[bj][0]), v1 = x1 + gv[bj][1] * (acc[ai][bj][m][1] + bv[bj][1]);
                    u32x4 w; w.x = cvt_pk(v0[0], v0[1]); w.y = cvt_pk(v0[2], v0[3]); w.z = cvt_pk(v1[0], v1[1]); w.w = cvt_pk(v1[2], v1[3]);
                    *(u32x4*)(X + off + bj * HALF) = w; }
                asm volatile("" ::: "memory"); }
    }
};
template <int MODE> struct EpiPair {
    static constexpr bool PERM = true;
    void* O; const float* bias; int b_estride;
    __device__ __forceinline__ void operator()(const f32x4 (&acc)[2][2][4][2], const Unit& u, int wr, int wc, int fr, int fq) const {
        const int row0 = u.om + wr * 64 + fr, col0 = u.pn * HALF + wc * 32 + 8 * fq; const float* bb = bias + (size_t)u.e * b_estride;
        constexpr float ASC = MODE == 1 ? 1.0f / (F8_SH * F8_SW) : 1.0f;
        f32x4 bv[2][2];
#pragma unroll
        for (int bj = 0; bj < 2; ++bj)
#pragma unroll
            for (int n = 0; n < 2; ++n) bv[bj][n] = *(const f32x4*)(bb + bj * D + col0 + 4 * n);
#pragma unroll
        for (int ai = 0; ai < 2; ++ai)
#pragma unroll
            for (int m = 0; m < 4; ++m) { float r[8];
#pragma unroll
                for (int n = 0; n < 2; ++n) { const f32x4 a = acc[ai][0][m][n] * ASC + bv[0][n], g = acc[ai][1][m][n] * ASC + bv[1][n];
#pragma unroll
                    for (int jp = 0; jp < 2; ++jp) {
                        f32x2 av = (f32x2){a[2 * jp], a[2 * jp + 1]}, gv = (f32x2){g[2 * jp], g[2 * jp + 1]}, o;
                        if (MODE == 0) { const f32x2 x = gv * (-LOG2E); f32x2 e; e.x = __builtin_amdgcn_exp2f(x.x); e.y = __builtin_amdgcn_exp2f(x.y); const f32x2 d = e + 1.0f;
                            f32x2 rc; rc.x = __builtin_amdgcn_rcpf(d.x); rc.y = __builtin_amdgcn_rcpf(d.y); o = av * rc; }
                        else { f32x2 glu, lin; glu.x = fminf(av.x, 7.0f); glu.y = fminf(av.y, 7.0f); lin.x = __builtin_amdgcn_fmed3f(gv.x, -7.0f, 7.0f); lin.y = __builtin_amdgcn_fmed3f(gv.y, -7.0f, 7.0f);
                            const f32x2 x = glu * (-1.702f * LOG2E); f32x2 e; e.x = __builtin_amdgcn_exp2f(x.x); e.y = __builtin_amdgcn_exp2f(x.y); const f32x2 d = e + 1.0f;
                            f32x2 rc; rc.x = __builtin_amdgcn_rcpf(d.x); rc.y = __builtin_amdgcn_rcpf(d.y); o = (glu * rc) * (lin * F8_SACT + F8_SACT); }
                        r[4 * n + 2 * jp] = o.x; r[4 * n + 2 * jp + 1] = o.y; } }
                if (MODE == 0) { bf16_t* rowp = (bf16_t*)O + (size_t)(row0 + ai * HALF + m * 16) * D + col0;
                    u32x4 w; w.x = cvt_pk(r[0], r[1]); w.y = cvt_pk(r[2], r[3]); w.z = cvt_pk(r[4], r[5]); w.w = cvt_pk(r[6], r[7]); *(u32x4*)rowp = w; }
                else { unsigned char* rowp = (unsigned char*)O + (size_t)(row0 + ai * HALF + m * 16) * D + col0;
                    u32x2 w; w.x = cvt_pk4_fp8_nc(r[0], r[1], r[2], r[3]); w.y = cvt_pk4_fp8_nc(r[4], r[5], r[6], r[7]); *(u32x2*)rowp = w; } }
    }
};
struct EpiMoeOut {
    static constexpr bool PERM = true;
    bf16_t* O; const float* bias; const float* gl; const LAS int* exoff;
    __device__ __forceinline__ void operator()(const f32x4 (&acc)[2][2][4][2], const Unit& u, int wr, int wc, int fr, int fq) const {
        const int row0 = u.om + wr * 64 + fr, col0 = u.pn * BM + wc * 32 + 8 * fq; const float* bb = bias + (size_t)u.e * D;
        const GAS float* gp = (const GAS float*)(gl + (size_t)u.e * T + (u.om - exoff[u.e]) + wr * 64 + fr);
        f32x4 bv[2][2]; float gt[2][4];
#pragma unroll
        for (int ai = 0; ai < 2; ++ai)
#pragma unroll
            for (int m = 0; m < 4; ++m) gt[ai][m] = gp[ai * HALF + m * 16];
#pragma unroll
        for (int bj = 0; bj < 2; ++bj)
#pragma unroll
            for (int n = 0; n < 2; ++n) bv[bj][n] = *(const GAS f32x4*)(bb + col0 + bj * HALF + 4 * n);
#pragma unroll
        for (int ai = 0; ai < 2; ++ai)
#pragma unroll
            for (int m = 0; m < 4; ++m) { GAS unsigned char* rowp = (GAS unsigned char*)O + (size_t)(row0 + ai * HALF + m * 16) * D + col0; const float g16 = gt[ai][m] * F8_SY;
#pragma unroll
                for (int bj = 0; bj < 2; ++bj) { const f32x4 v0 = (acc[ai][bj][m][0] * (1.0f / (F8_SACT * F8_SW)) + bv[bj][0]) * g16, v1 = (acc[ai][bj][m][1] * (1.0f / (F8_SACT * F8_SW)) + bv[bj][1]) * g16;
                    u32x2 w; w.x = cvt_pk4_fp8(v0[0], v0[1], v0[2], v0[3]); w.y = cvt_pk4_fp8(v1[0], v1[1], v1[2], v1[3]);
                    *(GAS u32x2*)(rowp + bj * HALF) = w; } }
    }
};

struct Frame {
    LAS unsigned char* lds; volatile LAS unsigned* MISC; gu32* ctl; unsigned char* ws;
    int tid, lane, wave, G, c;
    const float* const* in;
    float* out;
};
enum { I_X = 0, I_C, I_WMOD, I_BMOD, I_NMG, I_NFG, I_AWQKV, I_ABQKV, I_AWO, I_ABO, I_SINK, I_RELB, I_CWIN, I_CBIN, I_CWDW, I_CBDW, I_CLNG, I_CLNB, I_CWOUT, I_CBOUT, I_RW, I_RB, I_MWIN, I_MBIN, I_MWOUT, I_MBOUT, I_FNG };
#define WSP(type, off) ((type*)(F.ws + (off)))
__device__ __forceinline__ void wg_barrier() { __syncthreads(); }

__device__ __forceinline__ int build_exp_tables(Frame& F, int layer) {
    LAS int* EX = (LAS int*)(F.lds + LDS_EXP);
    if (F.tid < 64) {
        const int e = F.tid & 31; const int cnt = (int)__hip_atomic_load(F.ctl + CW_CNT + 64 * layer + e, RLX_AGENT); const int tiles = (cnt + 255) >> 8;
        int pre = tiles;
#pragma unroll
        for (int o = 1; o < 32; o <<= 1) { const int v = __shfl_up(pre, o, 32); if (e >= o) pre += v; }
        if (F.tid < 32) { EX[e] = cnt; EX[32 + e] = pre - tiles; EX[64 + e] = (pre - tiles) * 256; if (e == 31) EX[96] = pre; }
    }
    wg_barrier();
    return EX[96];
}
template <int MODE> __device__ __forceinline__ void row_phase(Frame& F, int layer) {
    constexpr bool COMB = (MODE & 1) != 0, ROUT = (MODE & 2) != 0, FIN = (MODE & 4) != 0;
    LAS float* red = (LAS float*)(F.lds); LAS float* part = (LAS float*)(F.lds + 49152); LAS float* lg = (LAS float*)(F.lds + 49152 + 65536);
    LAS int* hist = (LAS int*)(F.lds + 4608); LAS int* gbase = hist + 32; LAS int* pend = (LAS int*)(F.lds + 8192);
    const LAS int* EX = (const LAS int*)(F.lds + LDS_EXP);
    const int lane = F.lane, w = F.wave, row = lane & 15, kq = lane >> 4;
    constexpr int KS = (MODE & 2) ? 32 : 8;
    const int kb = (MODE & 2) ? 128 * w + 8 * kq : 128 * w + 32 * kq;
    constexpr bool XF32 = (MODE == 0);
    const float* xin = F.in[I_X]; bf16_t* X = WSP(bf16_t, WS_X); bf16_t* H = WSP(bf16_t, WS_H);
    const float* mod = WSP(const float, WS_MOD);
    const float* gamma = FIN ? F.in[I_FNG] : (ROUT ? F.in[I_NFG] + layer * D : F.in[I_NMG] + layer * D);
    const int ngrp = T / 16, g0 = (int)((long)F.c * ngrp / F.G), g1 = (int)((long)(F.c + 1) * ngrp / F.G);
    if (COMB) build_exp_tables(F, layer - 1);
    if (ROUT) { if (F.tid < 32) hist[F.tid] = 0; }
    bf16x8 whi[2][4], wlo[2][4];
    if (ROUT) {
        const float* wrp = F.in[I_RW] + (size_t)layer * D * NE;
#pragma unroll
        for (int eh = 0; eh < 2; ++eh)
#pragma unroll
            for (int s = 0; s < 4; ++s) { float v[8];
#pragma unroll
                for (int j = 0; j < 8; ++j) v[j] = wrp[(size_t)(kb + 32 * s + j) * NE + 16 * eh + row];
                u32x4 hi, lo;
#pragma unroll
                for (int p = 0; p < 4; ++p) { const unsigned h2 = cvt_pk(v[2 * p], v[2 * p + 1]); hi[p] = h2; lo[p] = cvt_pk(v[2 * p] - bf_lo(h2), v[2 * p + 1] - bf_hi(h2)); }
                whi[eh][s] = __builtin_bit_cast(bf16x8, hi); wlo[eh][s] = __builtin_bit_cast(bf16x8, lo); }
    }
    LAS float* Gl = (LAS float*)(F.lds + 32768); LAS float* Sl = Gl + D; LAS float* Fl = Sl + D;
    constexpr int GU = (XF32 || ROUT) ? 2 : 4;
#define UNPK0(v) ((f32x4){bf_lo((v).x), bf_hi((v).x), bf_lo((v).y), bf_hi((v).y)})
#define UNPK1(v) ((f32x4){bf_lo((v).z), bf_hi((v).z), bf_lo((v).w), bf_hi((v).w)})
    int curb = -1;
    for (int grp0 = g0; grp0 < g1; grp0 += GU) {
        const int b = (grp0 * 16) / SEQ, par = ((grp0 - g0) / GU) & 1;
        if (b != curb) { curb = b;
            const float* mb = mod + ((size_t)layer * NBATCH + b) * (6 * D);
            wg_barrier();
            for (int k = F.tid; k < D; k += NTHR) { const float gm = gamma[k];
                if (FIN) { Gl[k] = gm; Sl[k] = 0.f; }
                else { const float* shp = mb + (ROUT ? 3 * D : 0); const float* scp = mb + (ROUT ? 4 * D : D); Gl[k] = gm * (scp[k] + 1.0f); Sl[k] = shp[k]; }
                if (COMB) { const float* gf = mod + ((size_t)(layer - 1) * NBATCH + b) * (6 * D) + 5 * D; Fl[k] = gf[k]; } }
            wg_barrier();
        }
        u32x4 xb[GU][4]; int tks[GU][4];
#pragma unroll
        for (int u = 0; u < GU; ++u) { const int t = (grp0 + u < g1 ? grp0 + u : g1 - 1) * 16 + row;
            if (COMB) { const int* TK = WSP(const int, WS_TK);
#pragma unroll
                for (int kk = 0; kk < 4; ++kk) tks[u][kk] = TK[t * 4 + kk]; }
#pragma unroll
            for (int s = 0; s < 4; ++s) {
                if (XF32) { const f32x4 x0 = *(const f32x4*)(xin + (size_t)t * D + kb + KS * s), x1 = *(const f32x4*)(xin + (size_t)t * D + kb + KS * s + 4);
                    xb[u][s].x = cvt_pk(x0[0], x0[1]); xb[u][s].y = cvt_pk(x0[2], x0[3]); xb[u][s].z = cvt_pk(x1[0], x1[1]); xb[u][s].w = cvt_pk(x1[2], x1[3]); }
                else xb[u][s] = *(const u32x4*)(X + (size_t)t * D + kb + KS * s); } }
        if (COMB) {
            const unsigned char* YS = WSP(const unsigned char, WS_YS);
#pragma unroll
            for (int u = 0; u < GU; ++u) { const int t = (grp0 + u < g1 ? grp0 + u : g1 - 1) * 16 + row;
                size_t yoff[4];
#pragma unroll
                for (int kk = 0; kk < 4; ++kk) { const int tk = tks[u][kk]; yoff[kk] = (size_t)(EX[64 + (tk >> 16)] + (tk & 0xffff)) * D + kb; }
                u32x2 yv[4][4];
#pragma unroll
                for (int s = 0; s < 4; ++s)
#pragma unroll
                    for (int kk = 0; kk < 4; ++kk) yv[s][kk] = *(const u32x2*)(YS + yoff[kk] + KS * s);
#pragma unroll
                for (int s = 0; s < 4; ++s) { f32x4 a0 = (f32x4){0.f, 0.f, 0.f, 0.f}, a1 = a0;
#pragma unroll
                    for (int kk = 0; kk < 4; ++kk) { a0 += fp8x4_to_f32(yv[s][kk].x); a1 += fp8x4_to_f32(yv[s][kk].y); }
                    const f32x4 x0 = UNPK0(xb[u][s]) + *(const LAS f32x4*)(Fl + kb + KS * s) * a0 * (1.0f / F8_SY), x1 = UNPK1(xb[u][s]) + *(const LAS f32x4*)(Fl + kb + KS * s + 4) * a1 * (1.0f / F8_SY);
                    xb[u][s].x = cvt_pk(x0[0], x0[1]); xb[u][s].y = cvt_pk(x0[2], x0[3]); xb[u][s].z = cvt_pk(x1[0], x1[1]); xb[u][s].w = cvt_pk(x1[2], x1[3]);
                    if (!FIN && grp0 + u < g1) *(u32x4*)(X + (size_t)t * D + kb + KS * s) = xb[u][s]; } }
        }
#pragma unroll
        for (int u = 0; u < GU; ++u) { float ss = 0.f;
#pragma unroll
            for (int s = 0; s < 4; ++s) { const f32x4 v0 = UNPK0(xb[u][s]), v1 = UNPK1(xb[u][s]); ss += (v0[0] * v0[0] + v0[1] * v0[1]) + (v0[2] * v0[2] + v0[3] * v0[3]) + (v1[0] * v1[0] + v1[1] * v1[1]) + (v1[2] * v1[2] + v1[3] * v1[3]); }
            ss += __shfl_xor(ss, 16); ss += __shfl_xor(ss, 32);
            if (kq == 0) red[(par * GU + u) * 128 + w * 16 + row] = ss; }
        wg_barrier();
        f32x4 acc[GU][2];
#pragma unroll
        for (int u = 0; u < GU; ++u) { const int t = (grp0 + u < g1 ? grp0 + u : g1 - 1) * 16 + row; const bool live = grp0 + u < g1;
            float tot = 0.f;
#pragma unroll
            for (int ww = 0; ww < 8; ++ww) tot += red[(par * GU + u) * 128 + ww * 16 + row];
            const float rstd = rsqrtf(tot * (1.0f / D) + 1e-5f);
            acc[u][0] = (f32x4){0.f, 0.f, 0.f, 0.f}; acc[u][1] = acc[u][0];
#pragma unroll
            for (int s = 0; s < 4; ++s) {
                const f32x4 h0 = UNPK0(xb[u][s]) * rstd * *(const LAS f32x4*)(Gl + kb + KS * s) + *(const LAS f32x4*)(Sl + kb + KS * s), h1 = UNPK1(xb[u][s]) * rstd * *(const LAS f32x4*)(Gl + kb + KS * s + 4) + *(const LAS f32x4*)(Sl + kb + KS * s + 4);
                if (FIN) { if (live) { *(f32x4*)(F.out + (size_t)t * D + kb + KS * s) = h0; *(f32x4*)(F.out + (size_t)t * D + kb + KS * s + 4) = h1; } }
                else {
                    u32x4 hi; hi.x = cvt_pk(h0[0], h0[1]); hi.y = cvt_pk(h0[2], h0[3]); hi.z = cvt_pk(h1[0], h1[1]); hi.w = cvt_pk(h1[2], h1[3]);
                    if (!ROUT) { if (live) *(u32x4*)(H + (size_t)t * D + kb + KS * s) = hi; }
                    else { u32x2 q8; q8.x = cvt_pk4_fp8(h0[0] * F8_SH, h0[1] * F8_SH, h0[2] * F8_SH, h0[3] * F8_SH); q8.y = cvt_pk4_fp8(h1[0] * F8_SH, h1[1] * F8_SH, h1[2] * F8_SH, h1[3] * F8_SH);
                        if (live) *(u32x2*)((unsigned char*)H + (size_t)t * D + kb + KS * s) = q8; }
                    if (ROUT) {
                        u32x4 lo; lo.x = cvt_pk(h0[0] - bf_lo(hi.x), h0[1] - bf_hi(hi.x)); lo.y = cvt_pk(h0[2] - bf_lo(hi.y), h0[3] - bf_hi(hi.y));
                        lo.z = cvt_pk(h1[0] - bf_lo(hi.z), h1[1] - bf_hi(hi.z)); lo.w = cvt_pk(h1[2] - bf_lo(hi.w), h1[3] - bf_hi(hi.w));
                        const bf16x8 ah = __builtin_bit_cast(bf16x8, hi), al = __builtin_bit_cast(bf16x8, lo);
#pragma unroll
                        for (int eh = 0; eh < 2; ++eh) {
                            acc[u][eh] = __builtin_amdgcn_mfma_f32_16x16x32_bf16(ah, whi[eh][s], acc[u][eh], 0, 0, 0);
                            acc[u][eh] = __builtin_amdgcn_mfma_f32_16x16x32_bf16(ah, wlo[eh][s], acc[u][eh], 0, 0, 0);
                            acc[u][eh] = __builtin_amdgcn_mfma_f32_16x16x32_bf16(al, whi[eh][s], acc[u][eh], 0, 0, 0); }
                    }
                }
            }
        }
        if (ROUT) {
#pragma unroll
            for (int u = 0; u < GU; ++u)
#pragma unroll
                for (int eh = 0; eh < 2; ++eh)
#pragma unroll
                    for (int i = 0; i < 4; ++i) part[((u * 8 + w) * 16 + 4 * kq + i) * 32 + 16 * eh + row] = acc[u][eh][i];
            wg_barrier();
#pragma unroll
            for (int u = 0; u < GU; ++u) { const int r = F.tid >> 5, e = F.tid & 31; float v = F.in[I_RB][layer * NE + e];
#pragma unroll
                for (int ww = 0; ww < 8; ++ww) v += part[((u * 8 + ww) * 16 + r) * 32 + e];
                lg[(u * 16 + r) * 32 + e] = v; }
            wg_barrier();
            if (F.tid < 16 * GU && grp0 + (F.tid >> 4) < g1) {
                const int u = F.tid >> 4, r = F.tid & 15; unsigned used = 0u; int ids[4]; float vals[4];
#pragma unroll
                for (int k = 0; k < 4; ++k) { int bi = 0; float bv = -3.0e38f;
                    for (int e = 0; e < 32; ++e) { const float v = lg[(u * 16 + r) * 32 + e]; if (!((used >> e) & 1u) && v > bv) { bv = v; bi = e; } }
                    used |= 1u << bi; ids[k] = bi; vals[k] = bv; }
                const float e1 = __expf(vals[1] - vals[0]), e2 = __expf(vals[2] - vals[0]), e3 = __expf(vals[3] - vals[0]), inv = 1.0f / (1.0f + e1 + e2 + e3);
                const float gs[4] = {inv, e1 * inv, e2 * inv, e3 * inv};
#pragma unroll
                for (int k = 0; k < 4; ++k) { const int lp = atomicAdd((int*)&hist[ids[k]], 1); const int idx = ((grp0 + u - g0) * 16 + r) * 4 + k; pend[2 * idx] = ids[k] | (lp << 8); pend[2 * idx + 1] = __float_as_int(gs[k]); }
            }
        }
    }
#undef UNPK0
#undef UNPK1
    if (ROUT) {
        wg_barrier();
        if (F.tid < 32) { const int n = hist[F.tid]; gbase[F.tid] = n > 0 ? (int)__hip_atomic_fetch_add(F.ctl + CW_CNT + 64 * layer + F.tid, (unsigned)n, RLX_AGENT) : 0; }
        wg_barrier();
        int* LIST = WSP(int, WS_LIST); float* GL = WSP(float, WS_GLIST); int* TK = WSP(int, WS_TK);
        const int nent = (g1 - g0) * 64;
        for (int idx = F.tid; idx < nent; idx += NTHR) { const int pw = pend[2 * idx], e = pw & 0xff, pos = gbase[e] + (pw >> 8), tok = g0 * 16 + (idx >> 2);
            LIST[(size_t)e * T + pos] = tok; GL[(size_t)e * T + pos] = __int_as_float(pend[2 * idx + 1]); TK[tok * 4 + (idx & 3)] = (e << 16) | pos; }
    }
    wg_barrier();
}
__device__ const unsigned char kBucket[128] = {0, 1, 2, 3, 4, 5, 6, 7, 8, 9, 10, 11, 12, 13, 14, 15, 16, 16, 16, 17, 17, 18, 18, 18, 19, 19, 19, 20, 20, 20, 20, 21, 21, 21, 21, 22, 22, 22, 22, 22, 23, 23, 23, 23, 23, 23, 24, 24, 24, 24, 24, 24, 25, 25, 25, 25, 25, 25, 25, 26, 26, 26, 26, 26, 26, 26, 26, 27, 27, 27, 27, 27, 27, 27, 27, 27, 27, 28, 28, 28, 28, 28, 28, 28, 28, 28, 28, 29, 29, 29, 29, 29, 29, 29, 29, 29, 29, 29, 29, 30, 30, 30, 30, 30, 30, 30, 30, 30, 30, 30, 30, 30, 30, 31, 31, 31, 31, 31, 31, 31, 31, 31, 31, 31, 31, 31, 31, 31};
constexpr int KP = 144, VP = 192;
constexpr int ATT_K = 0, ATT_V = 256 * KP, ATT_B = ATT_V + 256 * VP;
__device__ __forceinline__ int crow(int r, int hi) { return (r & 3) + 8 * (r >> 2) + 4 * hi; }
typedef short v4i16_t __attribute__((ext_vector_type(4)));
__device__ __forceinline__ s16x4 vtr(const LAS unsigned char* p) { return __builtin_bit_cast(s16x4, __builtin_amdgcn_ds_read_tr16_b64_v4i16((LAS v4i16_t*)p)); }

__device__ __forceinline__ void attn_phase(Frame& F, int j) {
    const bf16_t* QKV = WSP(const bf16_t, WS_QKV); bf16_t* AO = WSP(bf16_t, WS_AO);
    LAS unsigned char* Kl = F.lds + ATT_K; LAS unsigned char* Vl = F.lds + ATT_V; LAS float* Bl = (LAS float*)(F.lds + ATT_B);
    const int lane = F.lane, w = F.wave, r = lane & 31, hh = lane >> 5;
    const float c1 = 0.125f * LOG2E;
    for (int unit = F.c; unit < NBATCH * 16 * 4; unit += F.G) {
        const int kvh = unit & 3, n = (unit >> 2) & 15, b = unit >> 6;
        const int krow0 = b * SEQ + (n > 0 ? (n - 1) * 128 : 0);
#pragma unroll
        for (int it = 0; it < 4; ++it) { const int ch = F.tid + NTHR * it, s = ch >> 3, c8 = ch & 7;
            const int grow = (n > 0 || s >= 128) ? (b * SEQ + (n - 1) * 128 + s) : (krow0 + s);
            const u32x4 kv = *(const u32x4*)(QKV + (size_t)grow * 1536 + 1024 + kvh * 64 + 8 * c8); const u32x4 vv = *(const u32x4*)(QKV + (size_t)grow * 1536 + 1280 + kvh * 64 + 8 * c8);
            *(LAS u32x4*)(Kl + s * KP + 16 * c8) = kv; *(LAS u32x4*)(Vl + s * VP + 16 * c8) = vv; }
        { const int g = F.tid >> 7, dist = F.tid & 127; Bl[F.tid] = F.in[I_RELB][kBucket[dist] * 16 + kvh * 4 + g] * LOG2E; }
        wg_barrier();
        const int g = w >> 1, hq = kvh * 4 + g; const float sink2 = F.in[I_SINK][j * 16 + hq] * LOG2E;
#pragma unroll 1
        for (int grp = 0; grp < 2; ++grp) {
            const int a0 = (w & 1) * 64 + grp * 32, a = a0 + r; const size_t tok = (size_t)b * SEQ + n * 128 + a;
            bf16x8 qf[4];
#pragma unroll
            for (int d0 = 0; d0 < 4; ++d0) qf[d0] = *(const bf16x8*)(QKV + tok * 1536 + hq * 64 + 16 * d0 + 8 * hh);
            const int kt0 = a0 >> 5;
            f32x16 S[5];
#pragma unroll
            for (int t = 0; t < 5; ++t) {
#pragma unroll
                for (int i = 0; i < 16; ++i) S[t][i] = 0.f;
                const LAS unsigned char* kp = Kl + (32 * (kt0 + t) + r) * KP + 16 * hh;
#pragma unroll
                for (int d0 = 0; d0 < 4; ++d0) { const bf16x8 kf = *(const LAS bf16x8*)(kp + 32 * d0); S[t] = __builtin_amdgcn_mfma_f32_32x32x16_bf16(kf, qf[d0], S[t], 0, 0, 0); }
            }
            float m = sink2;
#pragma unroll
            for (int t = 0; t < 5; ++t)
#pragma unroll
                for (int i = 0; i < 16; ++i) { const int s = 32 * (kt0 + t) + crow(i, hh), dist = a + 128 - s; const bool ok = (dist >= 0) && (dist < 128) && (n > 0 || s >= 128);
                    const float v = ok ? S[t][i] * c1 + Bl[g * 128 + (dist & 127)] : -3.0e38f; S[t][i] = v; m = fmaxf(m, v); }
            m = fmaxf(m, __shfl_xor(m, 32));
            float l = 0.f;
#pragma unroll
            for (int t = 0; t < 5; ++t)
#pragma unroll
                for (int i = 0; i < 16; ++i) { const float p = __builtin_amdgcn_exp2f(S[t][i] - m); S[t][i] = p; l += p; }
            l += __shfl_xor(l, 32); l += __builtin_amdgcn_exp2f(sink2 - m);
            f32x16 O[2];
#pragma unroll
            for (int i = 0; i < 16; ++i) { O[0][i] = 0.f; O[1][i] = 0.f; }
            const int q4 = (lane >> 2) & 3, p4 = lane & 3, blk = (lane >> 4) & 1;
#pragma unroll
            for (int t = 0; t < 5; ++t)
#pragma unroll
                for (int s2 = 0; s2 < 2; ++s2) {
                    u32x4 pk; pk.x = cvt_pk(S[t][8 * s2 + 0], S[t][8 * s2 + 1]); pk.y = cvt_pk(S[t][8 * s2 + 2], S[t][8 * s2 + 3]); pk.z = cvt_pk(S[t][8 * s2 + 4], S[t][8 * s2 + 5]); pk.w = cvt_pk(S[t][8 * s2 + 6], S[t][8 * s2 + 7]);
                    const bf16x8 pb = __builtin_bit_cast(bf16x8, pk);
                    const LAS unsigned char* vp = Vl + (32 * (kt0 + t) + 16 * s2 + 4 * hh + q4) * VP + 32 * blk + 8 * p4;
#pragma unroll
                    for (int dh = 0; dh < 2; ++dh) { const s16x4 lo = vtr(vp + 64 * dh), hi = vtr(vp + 64 * dh + 8 * VP);
                        const bf16x8 va = (bf16x8){lo[0], lo[1], lo[2], lo[3], hi[0], hi[1], hi[2], hi[3]};
                        O[dh] = __builtin_amdgcn_mfma_f32_32x32x16_bf16(va, pb, O[dh], 0, 0, 0); }
                }
            const float inv = 1.0f / l;
#pragma unroll
            for (int dh = 0; dh < 2; ++dh)
#pragma unroll
                for (int g4 = 0; g4 < 4; ++g4) { u32x2 o2; o2.x = cvt_pk(O[dh][4 * g4] * inv, O[dh][4 * g4 + 1] * inv); o2.y = cvt_pk(O[dh][4 * g4 + 2] * inv, O[dh][4 * g4 + 3] * inv);
                    *(u32x2*)(AO + tok * D + hq * 64 + 32 * dh + 8 * g4 + 4 * hh) = o2; }
        }
        wg_barrier();
    }
}

__device__ __forceinline__ float wave_sum63(float v) {
    v += __builtin_bit_cast(float, __builtin_amdgcn_update_dpp(0, __builtin_bit_cast(int, v), 0x111, 0xf, 0xf, true));
    v += __builtin_bit_cast(float, __builtin_amdgcn_update_dpp(0, __builtin_bit_cast(int, v), 0x112, 0xf, 0xf, true));
    v += __builtin_bit_cast(float, __builtin_amdgcn_update_dpp(0, __builtin_bit_cast(int, v), 0x114, 0xf, 0xf, true));
    v += __builtin_bit_cast(float, __builtin_amdgcn_update_dpp(0, __builtin_bit_cast(int, v), 0x118, 0xf, 0xf, true));
    v += __builtin_bit_cast(float, __builtin_amdgcn_update_dpp(0, __builtin_bit_cast(int, v), 0x142, 0xa, 0xf, true));
    v += __builtin_bit_cast(float, __builtin_amdgcn_update_dpp(0, __builtin_bit_cast(int, v), 0x143, 0xc, 0xf, true));
    return v;
}
__device__ __forceinline__ void dwconv_phase(Frame& F, int j, unsigned long long& t_acc) {
#ifndef TIME_KIND
#define TIME_KIND (-1)
#endif
    unsigned long long t_b = 0ull;
#define DT_BEG(k) do { if (TIME_KIND == (k)) t_b = __builtin_amdgcn_s_memrealtime(); } while (0)
#define DT_END(k) do { if (TIME_KIND == (k)) t_acc += __builtin_amdgcn_s_memrealtime() - t_b; } while (0)
    constexpr int PP = 520;
    DT_BEG(16);
    const bf16_t* U = WSP(const bf16_t, WS_U); bf16_t* YC = WSP(bf16_t, WS_AO);
    LAS unsigned char* ut = F.lds; LAS float* P = (LAS float*)F.lds; LAS float* fin = (LAS float*)(F.lds + 64 * PP * 4);
    const int tid = F.tid, lane = F.lane, w = F.wave;
    const float* wd = F.in[I_CWDW] + (size_t)j * 31 * D + 2 * tid;
    f32x2 wk[31];
#pragma unroll
    for (int q = 0; q < 31; ++q) wk[q] = *(const f32x2*)(wd + q * D);
    const f32x2 bdw = *(const f32x2*)(F.in[I_CBDW] + j * D + 2 * tid), lng = *(const f32x2*)(F.in[I_CLNG] + j * D + 2 * tid), lnb = *(const f32x2*)(F.in[I_CLNB] + j * D + 2 * tid);
    const __amdgpu_buffer_rsrc_t rU = __builtin_amdgcn_make_buffer_rsrc((void*)U, 0, 0x7fffffff, 0x00020000);
    asm volatile("s_waitcnt vmcnt(0)" ::: "memory"); DT_END(16);
    for (int tile = F.c; tile < T / 32; tile += F.G) {
        const int t0 = tile * 32, tin0 = t0 % SEQ, rlo = tin0 >= 30 ? 0 : 30 - tin0;
        DT_BEG(12);
        for (int pc = w; pc < 124; pc += NWAVES) { const int rr = pc >> 1;
            if (rr >= rlo) __builtin_amdgcn_raw_ptr_buffer_load_lds(rU, (LAS unsigned*)(ut + pc * 1024), 16, lane * 16, (int)(((size_t)(t0 + rr - 30) * D + (pc & 1) * 512) * 2), 0, 0);
            else *(LAS u32x4*)(ut + pc * 1024 + lane * 16) = (u32x4){0u, 0u, 0u, 0u}; }
        asm volatile("s_waitcnt vmcnt(0)" ::: "memory");
        wg_barrier();
        DT_END(12); DT_BEG(13);
        f32x2 y[32];
#pragma unroll
        for (int blk = 0; blk < 4; ++blk) {
            f32x2 a[8] = {bdw, bdw, bdw, bdw, bdw, bdw, bdw, bdw};
#pragma unroll
            for (int rr = 0; rr < 38; ++rr) { const unsigned uw = *(const LAS unsigned*)(ut + (8 * blk + rr) * 2048 + 4 * tid); const f32x2 uv = (f32x2){bf_lo(uw), bf_hi(uw)};
#pragma unroll
                for (int o = 0; o < 8; ++o) { const int q = rr - o; if (q >= 0 && q < 31) a[o] += wk[q] * uv; } }
#pragma unroll
            for (int o = 0; o < 8; ++o) y[8 * blk + o] = a[o];
        }
        DT_END(13); DT_BEG(14);
        wg_barrier();
#pragma unroll
        for (int tk = 0; tk < 32; ++tk) { P[(2 * tk) * PP + tid] = y[tk].x + y[tk].y; P[(2 * tk + 1) * PP + tid] = y[tk].x * y[tk].x + y[tk].y * y[tk].y; }
        wg_barrier();
        { const int qn = tid >> 3, l8 = tid & 7; float v = 0.f;
#pragma unroll 16
          for (int i2 = 0; i2 < 64; ++i2) v += P[qn * PP + l8 + 8 * i2];
          v += __shfl_xor(v, 1); v += __shfl_xor(v, 2); v += __shfl_xor(v, 4);
          if (l8 == 0) fin[qn] = v; }
        wg_barrier();
        DT_END(14); DT_BEG(15);
#pragma unroll
        for (int tk = 0; tk < 32; ++tk) { const float mean = fin[2 * tk] * (1.0f / D), var = fmaxf(fin[2 * tk + 1] * (1.0f / D) - mean * mean, 0.f), rstd = rsqrtf(var + 1e-5f);
            const float v0 = (y[tk].x - mean) * rstd * lng.x + lnb.x, v1 = (y[tk].y - mean) * rstd * lng.y + lnb.y;
            *(unsigned*)(YC + (size_t)(t0 + tk) * D + 2 * tid) = cvt_pk(v0 * sigmoid_f(v0), v1 * sigmoid_f(v1)); }
        asm volatile("s_waitcnt vmcnt(0)" ::: "memory");
        wg_barrier();
        DT_END(15);
    }
#undef DT_BEG
#undef DT_END
}
__device__ __forceinline__ void p0_mod_task(Frame& F, int task) {
    LAS float* cact = (LAS float*)F.lds; LAS float* part = (LAS float*)(F.lds + 32768);
    const int i = task / 24, n0 = (task % 24) * 256, tid = F.tid, lane = F.lane, w = F.wave;
    for (int q = tid; q < NBATCH * D; q += NTHR) { const float cv = F.in[I_C][q]; cact[q] = cv * sigmoid_f(cv); }
    wg_barrier();
    f32x4 acc[8];
#pragma unroll
    for (int b = 0; b < 8; ++b) acc[b] = (f32x4){0.f, 0.f, 0.f, 0.f};
    const float* Wp = F.in[I_WMOD] + ((size_t)i * D + 128 * w) * (6 * D) + n0 + 4 * lane;
#pragma unroll 4
    for (int k = 0; k < 128; ++k) { const f32x4 wv = *(const f32x4*)(Wp + (size_t)k * (6 * D));
#pragma unroll
        for (int b = 0; b < 8; ++b) acc[b] += wv * cact[b * D + 128 * w + k]; }
#pragma unroll
    for (int b = 0; b < 8; ++b) *(LAS f32x4*)(part + (w * 8 + b) * 256 + 4 * lane) = acc[b];
    wg_barrier();
    float* mod = WSP(float, WS_MOD);
#pragma unroll
    for (int q = 0; q < 4; ++q) { const int o = tid + NTHR * q, b = o >> 8, n = o & 255; float s = F.in[I_BMOD][i * 6 * D + n0 + n];
#pragma unroll
        for (int ww = 0; ww < 8; ++ww) s += part[(ww * 8 + b) * 256 + n];
        mod[((size_t)i * NBATCH + b) * (6 * D) + n0 + n] = s; }
    wg_barrier();
}
struct TItem { const float* W; bf16_t* Dst; int N, paired, kb, nb, f8; };
constexpr int CV_DENSE = 352, CV_MOE = 3072;
__device__ __forceinline__ bool cv_item(Frame& F, int q, int it, TItem& x) {
    if (it < 0) return false;
    if (q == 0) {
        const int NQ = 96, NO = 64, NCI = 128, NCO = 64;
        if (it < NQ) { const int j = it / 48, r = it % 48; x.W = F.in[I_AWQKV] + (size_t)j * D * 1536; x.Dst = WSP(bf16_t, WS_WQKV) + (size_t)j * 1536 * D; x.N = 1536; x.paired = 0; x.f8 = 0; x.kb = r / 6; x.nb = r % 6; return true; } it -= NQ;
        if (it < NO) { const int j = it / 32, r = it % 32; x.W = F.in[I_AWO] + (size_t)j * D * D; x.Dst = WSP(bf16_t, WS_WO) + (size_t)j * D * D; x.N = 1024; x.paired = 0; x.f8 = 0; x.kb = r / 4; x.nb = r % 4; return true; } it -= NO;
        if (it < NCI) { const int j = it / 64, r = it % 64; x.W = F.in[I_CWIN] + (size_t)j * D * 2048; x.Dst = WSP(bf16_t, WS_CWIN) + (size_t)j * 2048 * D; x.N = 2048; x.paired = 1; x.f8 = 0; x.kb = r / 8; x.nb = r % 8; return true; } it -= NCI;
        if (it < NCO) { const int j = it / 32, r = it % 32; x.W = F.in[I_CWOUT] + (size_t)j * D * D; x.Dst = WSP(bf16_t, WS_CWOUT) + (size_t)j * D * D; x.N = 1024; x.paired = 0; x.f8 = 0; x.kb = r / 4; x.nb = r % 4; return true; } it -= NCO;
    }
    if (it < 2048) { const int m = q * NE + it / 64, r = it % 64; x.W = F.in[I_MWIN] + (size_t)m * D * 2048; x.Dst = (bf16_t*)(WSP(unsigned char, WS_MWIN) + (size_t)m * 2048 * D); x.N = 2048; x.paired = 1; x.f8 = 1; x.kb = r / 8; x.nb = r % 8; return true; } it -= 2048;
    if (it < 1024) { const int m = q * NE + it / 32, r = it % 32; x.W = F.in[I_MWOUT] + (size_t)m * D * D; x.Dst = (bf16_t*)(WSP(unsigned char, WS_MWOUT) + (size_t)m * D * D); x.N = 1024; x.paired = 0; x.f8 = 1; x.kb = r / 4; x.nb = r % 4; return true; }
    return false;
}
__device__ __forceinline__ void cv_run(Frame& F, int q, int max_items) {
    if (q > 3 || max_items <= 0) return;
    LAS float* tile = (LAS float*)F.lds;
    volatile LAS int* qslot = (volatile LAS int*)(F.lds + 128 * 257 * 4 + 64);
    const int tid = F.tid, lane = F.lane, w = F.wave; gu32* qc = F.ctl + CW_P0Q + 64 * q;
    int claimed = 1;
    wg_barrier();
    if (tid == 0) qslot[0] = (int)__hip_atomic_fetch_add(qc, 1u, RLX_AGENT);
    wg_barrier();
    int it = qslot[0]; TItem cur; bool valid = cv_item(F, q, it, cur);
    f32x4 rg[16];
    if (valid) {
#pragma unroll
        for (int qq = 0; qq < 16; ++qq) rg[qq] = __builtin_nontemporal_load((const f32x4*)(cur.W + (size_t)(cur.kb * 128 + w * 16 + qq) * cur.N + cur.nb * 256 + 4 * lane)); }
    wg_barrier();
    while (valid) {
        const bool more = claimed < max_items;
        if (tid == 0) qslot[0] = more ? (int)__hip_atomic_fetch_add(qc, 1u, RLX_AGENT) : -1;
        ++claimed;
#pragma unroll
        for (int qq = 0; qq < 16; ++qq) { LAS float* tp = tile + (w * 16 + qq) * 257 + 4 * lane; tp[0] = rg[qq][0]; tp[1] = rg[qq][1]; tp[2] = rg[qq][2]; tp[3] = rg[qq][3]; }
        wg_barrier();
        const int nit = qslot[0]; TItem nx; const bool nvalid = cv_item(F, q, nit, nx);
        if (nvalid) {
#pragma unroll
            for (int qq = 0; qq < 16; ++qq) rg[qq] = __builtin_nontemporal_load((const f32x4*)(nx.W + (size_t)(nx.kb * 128 + w * 16 + qq) * nx.N + nx.nb * 256 + 4 * lane)); }
        const int kc = lane >> 3;
#pragma unroll
        for (int r4 = 0; r4 < 4; ++r4) { const int nl = 32 * w + 8 * r4 + (lane & 7), n = cur.nb * 256 + nl; const LAS float* sp = tile + (16 * kc) * 257 + nl;
            float v[16];
#pragma unroll
            for (int jj = 0; jj < 16; ++jj) v[jj] = sp[jj * 257];
            int nd = n; if (cur.paired) { const int half = n >> 10, rem = n & 1023; nd = ((rem >> 7) << 8) + (half << 7) + (rem & 127); }
            if (cur.f8) { u32x4 o; o.x = cvt_pk4_fp8(v[0] * F8_SW, v[1] * F8_SW, v[2] * F8_SW, v[3] * F8_SW); o.y = cvt_pk4_fp8(v[4] * F8_SW, v[5] * F8_SW, v[6] * F8_SW, v[7] * F8_SW);
                o.z = cvt_pk4_fp8(v[8] * F8_SW, v[9] * F8_SW, v[10] * F8_SW, v[11] * F8_SW); o.w = cvt_pk4_fp8(v[12] * F8_SW, v[13] * F8_SW, v[14] * F8_SW, v[15] * F8_SW);
                *(u32x4*)((unsigned char*)cur.Dst + (size_t)nd * D + cur.kb * 128 + 16 * kc) = o; }
            else { u32x4 o0, o1; o0.x = cvt_pk(v[0], v[1]); o0.y = cvt_pk(v[2], v[3]); o0.z = cvt_pk(v[4], v[5]); o0.w = cvt_pk(v[6], v[7]); o1.x = cvt_pk(v[8], v[9]); o1.y = cvt_pk(v[10], v[11]); o1.z = cvt_pk(v[12], v[13]); o1.w = cvt_pk(v[14], v[15]);
                bf16_t* dp = cur.Dst + (size_t)nd * D + cur.kb * 128 + 16 * kc; *(u32x4*)dp = o0; *(u32x4*)(dp + 8) = o1; } }
        wg_barrier();
        cur = nx; valid = nvalid;
    }
}
#ifndef CV_OVERLAP
#define CV_OVERLAP 1
#endif
__device__ __forceinline__ void p0_phase(Frame& F) {
    for (int task = F.c; task < 96; task += F.G) p0_mod_task(F, task);
    cv_run(F, 0, 1 << 30);
    if (!CV_OVERLAP) { cv_run(F, 1, 1 << 30); cv_run(F, 2, 1 << 30); cv_run(F, 3, 1 << 30); }
}

template <bool GATHER> __device__ __forceinline__ int moe_build_units(Frame& F, int layer, int npn, int total_tiles, int ubase) {
    const LAS int* EX = (const LAS int*)(F.lds + LDS_EXP); LAS int* UT = (LAS int*)(F.lds + LDS_UT); LAS int* TOK = (LAS int*)(F.lds + LDS_TOK);
    const int tps = 32 / npn, nsb = (total_tiles + tps - 1) / tps;
    const bool xcd_ok = (F.G % 256) == 0 || F.G == 256;
    int n = 0;
    if (xcd_ok && F.G == 256) {
        const int x = F.c & 7, jx = F.c >> 3;
        const int mine = x < nsb ? (nsb - x + 7) / 8 : 0; n = mine - ubase; n = n < 0 ? 0 : (n > 9 ? 9 : n);
        if (F.tid < n) { const int q = (ubase + F.tid) * 8 + x, tau = q * tps + (jx % tps), pn = jx / tps; int e = 0;
            if (tau < total_tiles) { for (int qq = 1; qq < 32; ++qq) if (tau >= EX[32 + qq]) e = qq; } else e = -1;
            const int mt = e >= 0 ? tau - EX[32 + e] : 0, om = e >= 0 ? EX[64 + e] + 256 * mt : 0;
            UT[4 * F.tid] = GATHER ? 256 * F.tid : om; UT[4 * F.tid + 1] = om; UT[4 * F.tid + 2] = e; UT[4 * F.tid + 3] = pn; UT[40 + F.tid] = mt; }
    } else {
        const int U = total_tiles * npn; const int mine = F.c < U ? (U - F.c + F.G - 1) / F.G : 0; n = mine - ubase; n = n < 0 ? 0 : (n > 9 ? 9 : n);
        if (F.tid < n) { const int L = F.c + (ubase + F.tid) * F.G, tau = L / npn, pn = L % npn; int e = 0;
            for (int qq = 1; qq < 32; ++qq) if (tau >= EX[32 + qq]) e = qq;
            const int mt = tau - EX[32 + e], om = EX[64 + e] + 256 * mt;
            UT[4 * F.tid] = GATHER ? 256 * F.tid : om; UT[4 * F.tid + 1] = om; UT[4 * F.tid + 2] = e; UT[4 * F.tid + 3] = pn; UT[40 + F.tid] = mt; }
    }
    wg_barrier();
    if (F.tid == 0) { int w = 0; for (int r = 0; r < n; ++r) { if (UT[4 * r + 2] >= 0) { if (w != r) { UT[4 * w] = GATHER ? 256 * w : UT[4 * r]; UT[4 * w + 1] = UT[4 * r + 1]; UT[4 * w + 2] = UT[4 * r + 2]; UT[4 * w + 3] = UT[4 * r + 3]; UT[40 + w] = UT[40 + r]; } ++w; } } UT[60] = w; UT[61] = n; }
    wg_barrier();
    const int nv = UT[60];
    if (GATHER) { const int* LIST = WSP(const int, WS_LIST);
        for (int q = F.tid; q < nv * 256; q += NTHR) { const int ui = q >> 8, rr = q & 255, e = UT[4 * ui + 2], pos = 256 * UT[40 + ui] + rr; TOK[q] = pos < EX[e] ? LIST[(size_t)e * T + pos] : 0; }
        wg_barrier(); }
    return nv | (n << 8);
}

constexpr int N_PHASES = 30;
struct Args { const float* in[27]; float* out; unsigned char* ws; int ph_lo, ph_hi; };
__global__ void __launch_bounds__(NTHR, 2) mega(const Args args) {
    extern __shared__ __attribute__((aligned(16))) unsigned char lds_raw[];
    Frame F; F.lds = (LAS unsigned char*)lds_raw; F.MISC = (volatile LAS unsigned*)(F.lds + LDS_MISC); F.ws = args.ws; F.ctl = (gu32*)(args.ws + WS_CTL);
    F.tid = threadIdx.x; F.lane = F.tid & 63; F.wave = __builtin_amdgcn_readfirstlane(F.tid >> 6); F.G = gridDim.x; F.c = blockIdx.x; F.out = args.out;
    F.in = args.in;
    if (F.tid < 32) F.MISC[F.tid] = 0u;
    __syncthreads();
    const int lo = args.ph_lo, hi = args.ph_hi;
    XcdBarrier bar; bar.bar = (unsigned*)(F.ctl + CW_BAR); bar.x = 0; bar.st = F.MISC + 8;
    if (hi - lo > 1) bar = xcd_barrier_post((unsigned*)(F.ctl + CW_BAR), F.MISC + 8);
#ifndef CVQ_QKV
#define CVQ_QKV 4
#endif
#ifndef CVQ_MOE
#define CVQ_MOE 2
#endif
#ifndef PH_MASK
#define PH_MASK 0xFFFF
#endif
#define IN(k) (lo <= (k) && (k) < hi)
#define HAS(b) (((PH_MASK) >> (b)) & 1)
#define PHASE_ENTER() do { int _t = F.tid; asm volatile("" : "+v"(_t)); F.tid = _t; F.lane = _t & 63; F.wave = __builtin_amdgcn_readfirstlane(_t >> 6); unsigned char* _w = F.ws; asm volatile("" : "+s"(_w)); F.ws = _w; int _g = F.G; asm volatile("" : "+s"(_g)); F.G = _g; } while (0)
    unsigned long long t_acc = 0ull, t_beg = 0ull, g_ticks = 0ull, g_cyc = 0ull;
#define TBEG(kind) do { if (TIME_KIND == (kind)) t_beg = __builtin_amdgcn_s_memrealtime(); } while (0)
#define TEND(kind) do { if (TIME_KIND == (kind)) t_acc += __builtin_amdgcn_s_memrealtime() - t_beg; } while (0)
#define SEAM(k) do { if ((k) + 1 < hi) xcd_barrier(bar); } while (0)
    const LAS int* toktab = (const LAS int*)(F.lds + LDS_TOK);
    if (HAS(0) && IN(0)) { TBEG(0); p0_phase(F); SEAM(0); TEND(0); }
    for (int i = 0; i < DEPTH; ++i) {
        const int pb = 1 + 7 * i, j = i >> 1; const bool conv = (i & 1) != 0;
        const float* modl = WSP(const float, WS_MOD) + (size_t)i * NBATCH * (6 * D);
        if (IN(pb)) { PHASE_ENTER(); TBEG(1); if (i == 0) { if (HAS(1)) row_phase<0>(F, 0); } else { TBEG(7); if (HAS(2)) row_phase<1>(F, i); TEND(7); } SEAM(pb); TEND(1); }
        if (IN(pb + 1)) { PHASE_ENTER(); TBEG(2);
            if (!conv) { if (HAS(3)) { Gemm g{WSP(const bf16_t, WS_H), WSP(const bf16_t, WS_WQKV) + (size_t)j * 1536 * D, D, 0}; DenseOrder S; S.init(1536, F.G, F.c);
                EpiBias16 E{WSP(bf16_t, WS_QKV), 1536, F.in[I_ABQKV] + j * 1536}; gemm_phase<EpiBias16, DenseOrder, false>(F.lds, g, S, E, toktab, F.tid, 40, t_acc, g_ticks, g_cyc);
                if (CV_OVERLAP && (long)F.c + F.G >= 384) cv_run(F, i + 1, CVQ_QKV); } }
            else if (HAS(4)) { Gemm g{WSP(const bf16_t, WS_H), WSP(const bf16_t, WS_CWIN) + (size_t)j * 2048 * D, D, 0}; DenseOrder S; S.init(2048, F.G, F.c);
                EpiPair<0> E{WSP(void, WS_U), F.in[I_CBIN] + j * 2048, 0}; gemm_phase<EpiPair<0>, DenseOrder, false>(F.lds, g, S, E, toktab, F.tid, 50, t_acc, g_ticks, g_cyc); }
            SEAM(pb + 1); TEND(2); }
        if (IN(pb + 2)) { PHASE_ENTER(); TBEG(3); if (!conv) { TBEG(6); if (HAS(5)) attn_phase(F, j); TEND(6); } else { if (HAS(6)) dwconv_phase(F, j, t_acc); TBEG(17); } SEAM(pb + 2); if (conv) TEND(17); TEND(3); }
        if (IN(pb + 3)) { PHASE_ENTER(); TBEG(2); if (HAS(7)) {
            Gemm g{WSP(const bf16_t, WS_AO), (conv ? WSP(const bf16_t, WS_CWOUT) : WSP(const bf16_t, WS_WO)) + (size_t)j * D * D, D, 0}; DenseOrder S; S.init(1024, F.G, F.c);
            const float* bias2 = (conv ? F.in[I_CBOUT] : F.in[I_ABO]) + j * D;
            if (i == 0) { EpiResid<true> E{F.in[I_X], WSP(bf16_t, WS_X), bias2, modl + 2 * D}; gemm_phase<EpiResid<true>, DenseOrder, false>(F.lds, g, S, E, toktab, F.tid, 60, t_acc, g_ticks, g_cyc); }
            else { EpiResid<false> E{WSP(const bf16_t, WS_X), WSP(bf16_t, WS_X), bias2, modl + 2 * D}; gemm_phase<EpiResid<false>, DenseOrder, false>(F.lds, g, S, E, toktab, F.tid, 60, t_acc, g_ticks, g_cyc); } }
            SEAM(pb + 3); TEND(2); }
        if (IN(pb + 4)) { PHASE_ENTER(); TBEG(1); if (CV_OVERLAP && i > 0) cv_run(F, i, 1 << 30); TBEG(8); if (HAS(8)) row_phase<2>(F, i); TEND(8); SEAM(pb + 4); TEND(1); }
        if (IN(pb + 5)) { PHASE_ENTER(); TBEG(4); if (HAS(9)) {
            const int tt = build_exp_tables(F, i);
            Gemm g{WSP(const bf16_t, WS_H), (const bf16_t*)(WSP(const unsigned char, WS_MWIN) + (size_t)i * NE * 2048 * D), D / 2, (size_t)2048 * D / 2};
            EpiPair<1> E{WSP(void, WS_ACT), F.in[I_MBIN] + (size_t)i * NE * 2048, 2048};
            for (int ub = 0;; ub += 9) { const int nn = moe_build_units<true>(F, i, 8, tt, ub); const int n = nn >> 8, nv = nn & 255; if (n == 0) break;
                TableOrder S{(const LAS int*)(F.lds + LDS_UT), nv}; gemm_phase<EpiPair<1>, TableOrder, true, true>(F.lds, g, S, E, toktab, F.tid, 20, t_acc, g_ticks, g_cyc); wg_barrier();
                if (n < 9) { if (CV_OVERLAP && ub + nv < (((tt + 3) / 4) + 7) / 8) cv_run(F, i + 1, CVQ_MOE); break; } } }
            SEAM(pb + 5); TEND(4); }
        if (IN(pb + 6)) { PHASE_ENTER(); TBEG(5); if (HAS(10)) {
            const int tt = build_exp_tables(F, i);
            Gemm g{WSP(const bf16_t, WS_ACT), (const bf16_t*)(WSP(const unsigned char, WS_MWOUT) + (size_t)i * NE * D * D), D / 2, (size_t)D * D / 2};
            EpiMoeOut E{WSP(bf16_t, WS_YS), F.in[I_MBOUT] + (size_t)i * NE * D, WSP(const float, WS_GLIST), (const LAS int*)(F.lds + LDS_EXP + 256)};
            for (int ub = 0;; ub += 9) { const int nn = moe_build_units<false>(F, i, 4, tt, ub); const int n = nn >> 8, nv = nn & 255; if (n == 0) break;
                TableOrder S{(const LAS int*)(F.lds + LDS_UT), nv}; gemm_phase<EpiMoeOut, TableOrder, false, true>(F.lds, g, S, E, toktab, F.tid, 30, t_acc, g_ticks, g_cyc); wg_barrier();
                if (n < 9) { if (CV_OVERLAP && ub + nv < (((tt + 7) / 8) + 7) / 8) cv_run(F, i + 1, CVQ_MOE); break; } } }
            SEAM(pb + 6); TEND(5); }
    }
    if (HAS(11) && IN(29)) { PHASE_ENTER(); TBEG(1); row_phase<5>(F, DEPTH); TEND(1); }
    if (TIME_KIND >= 20 && (TIME_KIND % 10) == 5 && g_ticks > 0) t_acc = (g_cyc * 1000ull) / g_ticks;
    if (TIME_KIND >= 0 && blockIdx.x == 0) { const unsigned long long t0 = __builtin_amdgcn_s_memrealtime(); while (__builtin_amdgcn_s_memrealtime() - t0 < t_acc) __builtin_amdgcn_s_sleep(8); }
#undef IN
#undef SEAM
}

inline void launch_range(void* const* d_in, void* d_out, void* d_ws, int grid, int lo, int hi, hipStream_t stream) {
    Args a{}; for (int i = 0; i < 27; ++i) a.in[i] = (const float*)d_in[i];
    a.out = (float*)d_out; a.ws = (unsigned char*)d_ws; a.ph_lo = lo; a.ph_hi = hi;
    hipLaunchKernelGGL(mega, dim3(grid), dim3(NTHR), LDS_BYTES, stream, a);
}
inline int setup_grid() {
    static int grid = 0;
    if (grid == 0) {
        int dev = 0, cus = 0;
        if (hipGetDevice(&dev) != hipSuccess || hipDeviceGetAttribute(&cus, hipDeviceAttributeMultiprocessorCount, dev) != hipSuccess) { grid = -1; return grid; }
        if (hipFuncSetAttribute((const void*)mega, hipFuncAttributeMaxDynamicSharedMemorySize, LDS_BYTES) != hipSuccess) { grid = -1; return grid; }
        int per_cu = 0; (void)hipOccupancyMaxActiveBlocksPerMultiprocessor(&per_cu, (const void*)mega, NTHR, LDS_BYTES); (void)hipGetLastError();
        if (per_cu < 1) fprintf(stderr, "kernel_launch: occupancy query reports %d blocks per CU\n", per_cu);
        grid = cus;
    }
    return grid;
}
}
#ifndef FAST_LAUNCH_MODE
#define FAST_LAUNCH_MODE 1
#endif
extern "C" void kernel_launch(void* const* d_in, const int* in_sizes, int n_in, void* d_out, int out_size, void* d_ws, size_t ws_size, hipStream_t stream) {
    if (n_in != 27 || out_size != fk::T * fk::D || ws_size < fk::WS_END) { fprintf(stderr, "kernel_launch: unexpected shapes (n_in %d out %d ws %zu)\n", n_in, out_size, ws_size); return; }
    const int grid = fk::setup_grid(); if (grid <= 0) return;
    (void)hipMemsetAsync((char*)d_ws + fk::WS_CTL, 0, fk::CTL_ZERO_BYTES, stream);
#if FAST_LAUNCH_MODE == 1
    fk::launch_range(d_in, d_out, d_ws, grid, 0, fk::N_PHASES, stream);
#else
    for (int k = 0; k < fk::N_PHASES; ++k) fk::launch_range(d_in, d_out, d_ws, grid, k, k + 1, stream);
#endif
}
```

```cpp
#include <hip/hip_runtime.h>
#include <cstdio>
#include <cstdint>
namespace fk {
#define LAS __attribute__((address_space(3)))
#define GAS __attribute__((address_space(1)))
typedef unsigned short bf16_t;
typedef short bf16x8 __attribute__((ext_vector_type(8)));
typedef short s16x4 __attribute__((ext_vector_type(4)));
typedef float f32x4 __attribute__((ext_vector_type(4)));
typedef float f32x2 __attribute__((ext_vector_type(2)));
typedef float f32x16 __attribute__((ext_vector_type(16)));
typedef float f32x8 __attribute__((ext_vector_type(8)));
typedef unsigned u32x4 __attribute__((ext_vector_type(4)));
typedef unsigned u32x2 __attribute__((ext_vector_type(2)));
typedef __bf16 bf16x2_t __attribute__((ext_vector_type(2)));
typedef int v4i __attribute__((ext_vector_type(4)));
typedef int v8i __attribute__((ext_vector_type(8)));
typedef GAS unsigned gu32;
#define RLX_AGENT __ATOMIC_RELAXED, __HIP_MEMORY_SCOPE_AGENT
#define LDS_WAIT() asm volatile("s_waitcnt lgkmcnt(0)" ::: "memory")
#define VM_WAIT() asm volatile("s_waitcnt vmcnt(0)" ::: "memory")

constexpr int T = 16384, D = 1024, SEQ = 2048, NBATCH = 8, NE = 32, DEPTH = 4;
constexpr int NWAVES = 8, NTHR = 512;
constexpr int SLOTCAP = T * 4 + NE * 256;
constexpr float LOG2E = 1.4426950408889634f;

__device__ __forceinline__ unsigned cvt_pk(float lo, float hi) { f32x2 v = {lo, hi}; bf16x2_t b = __builtin_convertvector(v, bf16x2_t); return __builtin_bit_cast(unsigned, b); }
__device__ __forceinline__ float bf_lo(unsigned w) { return __uint_as_float(w << 16); }
__device__ __forceinline__ float bf_hi(unsigned w) { return __uint_as_float(w & 0xffff0000u); }
__device__ __forceinline__ unsigned cvt_pk4_fp8(float a, float b, float c, float d) {
    a = __builtin_amdgcn_fmed3f(a, -448.f, 448.f); b = __builtin_amdgcn_fmed3f(b, -448.f, 448.f); c = __builtin_amdgcn_fmed3f(c, -448.f, 448.f); d = __builtin_amdgcn_fmed3f(d, -448.f, 448.f);
    int w = 0; w = __builtin_amdgcn_cvt_pk_fp8_f32(a, b, w, false); w = __builtin_amdgcn_cvt_pk_fp8_f32(c, d, w, true); return (unsigned)w; }
__device__ __forceinline__ unsigned cvt_pk4_fp8_nc(float a, float b, float c, float d) { int w = 0; w = __builtin_amdgcn_cvt_pk_fp8_f32(a, b, w, false); w = __builtin_amdgcn_cvt_pk_fp8_f32(c, d, w, true); return (unsigned)w; }
constexpr float F8_SH = 8.0f, F8_SW = 64.0f, F8_SACT = 4.0f, F8_SY = 16.0f;
__device__ __forceinline__ f32x4 fp8x4_to_f32(unsigned w) { const f32x2 lo = __builtin_amdgcn_cvt_pk_f32_fp8((int)w, false), hi = __builtin_amdgcn_cvt_pk_f32_fp8((int)w, true); return (f32x4){lo.x, lo.y, hi.x, hi.y}; }
__device__ __forceinline__ float sigmoid_f(float v) { return __builtin_amdgcn_rcpf(1.0f + __builtin_amdgcn_exp2f(-LOG2E * v)); }

constexpr size_t MiB = (size_t)1 << 20;
constexpr size_t WS_CTL = 0, CTL_ZERO_BYTES = 1 * MiB;
constexpr size_t WS_MOD = 1 * MiB;
constexpr size_t WS_WQKV = 2 * MiB;
constexpr size_t WS_WO = 8 * MiB;
constexpr size_t WS_CWIN = 12 * MiB;
constexpr size_t WS_CWOUT = 20 * MiB;
constexpr size_t WS_MWIN = 24 * MiB;
constexpr size_t WS_MWOUT = WS_MWIN + 512 * MiB;
constexpr size_t WS_X = WS_MWOUT + 256 * MiB;
constexpr size_t WS_H = WS_X + 64 * MiB;
constexpr size_t WS_QKV = WS_H + 32 * MiB;
constexpr size_t WS_AO = WS_QKV + 48 * MiB;
constexpr size_t WS_U = WS_AO + 32 * MiB;
constexpr size_t WS_LIST = WS_U + 32 * MiB;
constexpr size_t WS_GLIST = WS_LIST + 2 * MiB;
constexpr size_t WS_TK = WS_GLIST + 2 * MiB;
constexpr size_t WS_ACT = WS_TK + 1 * MiB;
constexpr size_t WS_YS = WS_ACT + 144 * MiB;
constexpr size_t WS_END = WS_YS + 144 * MiB;
constexpr int CW_TMO = 0, CW_P0Q = 64, CW_BAR = 4096, CW_CNT = 16384;
#define XCD_BAR_WORDS 3456

constexpr int RING_BYTES = 131072;
constexpr int LDS_TOK = RING_BYTES;
constexpr int LDS_UT = LDS_TOK + 9216;
constexpr int LDS_EXP = LDS_UT + 256;
constexpr int LDS_BYTES = 163840;
constexpr int LDS_MISC = LDS_BYTES - 128;
static_assert(LDS_EXP + 512 <= LDS_MISC, "LDS map");

#define XB_TMO      128
#define XB_XCNT(j)  (256  + 64 * (j))
#define XB_XSUB(j)  (1280 + 64 * (j))
#define XB_XGEN(j)  (2304 + 64 * (j))
#define XB_TOP      3328
#define XB_TOPGEN   3392
#define XB_SPIN_CAP (1u << 18)
__device__ __forceinline__ unsigned xb_ld(unsigned* p)              { return __hip_atomic_load(p, __ATOMIC_RELAXED, __HIP_MEMORY_SCOPE_AGENT); }
__device__ __forceinline__ unsigned xb_add(unsigned* p, unsigned v) { return __hip_atomic_fetch_add(p, v, __ATOMIC_RELAXED, __HIP_MEMORY_SCOPE_AGENT); }
__device__ __forceinline__ unsigned xb_xcc_id() { return (unsigned)__builtin_amdgcn_s_getreg((3 << 11) | 20) & 0xFu; }
#define XB_SPIN(cond, bar) do { unsigned _sp = 0; while (cond) { __builtin_amdgcn_s_sleep(1); \
    if ((++_sp & 255u) == 0u) { if (xb_ld(&(bar)[XB_TMO])) break; if (_sp > XB_SPIN_CAP) { atomicAdd(&(bar)[XB_TMO], 1u); break; } } } } while (0)
struct XcdBarrier { unsigned* bar; unsigned x; volatile LAS unsigned* st; };
__device__ __forceinline__ XcdBarrier xcd_barrier_post(unsigned* bar, volatile LAS unsigned* st) {
    XcdBarrier b; b.bar = bar; b.x = xb_xcc_id(); b.st = st;
    if (threadIdx.x == 0) (void)xb_add(&bar[XB_XCNT(b.x)], 1u);
    return b;
}
__device__ __forceinline__ void xcd_barrier_complete(unsigned* bar, unsigned x, unsigned& nloc, unsigned& nx) {
    const unsigned G = gridDim.x * gridDim.y * gridDim.z;
    unsigned sum, cnt, mine, sp = 0u;
    for (;;) {
        sum = 0u; cnt = 0u; mine = 0u;
#pragma unroll
        for (unsigned j = 0; j < 16; ++j) { const unsigned c = xb_ld(&bar[XB_XCNT(j)]); sum += c; cnt += (c > 0u) ? 1u : 0u; mine = (j == x) ? c : mine; }
        if (sum == G) break;
        __builtin_amdgcn_s_sleep(1);
        if ((++sp & 255u) == 0u) { if (xb_ld(&bar[XB_TMO])) break; if (sp > XB_SPIN_CAP) { atomicAdd(&bar[XB_TMO], 1u); break; } }
    }
    nloc = mine > 0u ? mine : 1u; nx = cnt > 0u ? cnt : 1u;
}
__device__ __forceinline__ void xcd_barrier(const XcdBarrier& b) {
    asm volatile("s_waitcnt vmcnt(0)" ::: "memory");
    __syncthreads();
    if (threadIdx.x == 0) {
        unsigned* bar = b.bar;
        __builtin_amdgcn_s_waitcnt(0);
        unsigned nloc = b.st[0], nx = b.st[1];
        if (nloc == 0u) { xcd_barrier_complete(bar, b.x, nloc, nx); b.st[0] = nloc; b.st[1] = nx; }
        const unsigned old = xb_add(&bar[XB_XSUB(b.x)], 1u);
        const unsigned gen = old / nloc;
        if (old + 1u == (gen + 1u) * nloc) {
            __builtin_amdgcn_fence(__ATOMIC_RELEASE, "agent");
            asm volatile("s_waitcnt vmcnt(0)" ::: "memory");
            const unsigned og = xb_add(&bar[XB_TOP], 1u);
            const unsigned tg = og / nx;
            if (og + 1u == (tg + 1u) * nx) xb_add(&bar[XB_TOPGEN], 1u);
            else XB_SPIN(xb_ld(&bar[XB_TOPGEN]) == tg, bar);
            __builtin_amdgcn_fence(__ATOMIC_ACQUIRE, "agent");
            xb_add(&bar[XB_XGEN(b.x)], 1u);
            asm volatile("s_waitcnt vmcnt(0)" ::: "memory");
        } else {
            XB_SPIN(xb_ld(&bar[XB_XGEN(b.x)]) == gen, bar);
            __builtin_amdgcn_fence(__ATOMIC_ACQUIRE, "agent");
            asm volatile("s_waitcnt vmcnt(0)" ::: "memory");
        }
    }
    __syncthreads();
}

constexpr int BM = 256, BK = 64, HALF = 128, HTB = HALF * BK * 2, NXCD = 8, WGM = 8;
__host__ __device__ __forceinline__ int lds_byte(int r, int c) { const int st = (r >> 4) * 2 + (c >> 5), rr = r & 15, cc = c & 31, ob = rr * 64 + cc * 2; return st * 1024 + (ob ^ (((ob >> 9) & 1) << 5)); }
__host__ __device__ __forceinline__ void stage_rc(int b, int& R, int& C) { const int st = b / 1024, sb = b % 1024, swz = sb ^ (((sb >> 9) & 1) << 5); R = (st >> 1) * 16 + swz / 64; C = (st & 1) * 32 + (swz % 64) / 2; }
__host__ __device__ __forceinline__ int perm32(int rho) { const int n = rho >> 4, i = rho & 15; return 8 * (i >> 2) + 4 * n + (i & 3); }

struct Unit { int am, om, e, pn; };
struct Gemm { const bf16_t* A; const bf16_t* Bt; int K; size_t b_estride; };

struct DenseOrder {
    int nM, nN, nwg, G, c;
    __device__ void init(int N, int G_, int c_) { nM = T / BM; nN = N / BM; nwg = nM * nN; G = G_; c = c_; }
    __device__ __forceinline__ bool next(int i, Unit& u) const {
        const long L = (long)i * G + c; if (L >= nwg) return false;
        int wgid = (int)L; { const int q = nwg / NXCD, r = nwg % NXCD, xcd = wgid % NXCD, off = wgid / NXCD; wgid = (xcd < r ? xcd * (q + 1) : r * (q + 1) + (xcd - r) * q) + off; }
        const int nig = WGM * nN, gid = wgid / nig, fm = gid * WGM, gsz = (nM - fm) < WGM ? (nM - fm) : WGM;
        const int pm = fm + ((wgid % nig) % gsz); u.pn = (wgid % nig) / gsz; u.am = pm * BM; u.om = pm * BM; u.e = 0; return true;
    }
};
struct TableOrder {
    const LAS int* ut; int n;
    __device__ __forceinline__ bool next(int i, Unit& u) const {
        if (i >= n) return false;
        u.am = __builtin_amdgcn_readfirstlane(ut[4 * i]); u.om = __builtin_amdgcn_readfirstlane(ut[4 * i + 1]); u.e = __builtin_amdgcn_readfirstlane(ut[4 * i + 2]); u.pn = __builtin_amdgcn_readfirstlane(ut[4 * i + 3]); return true;
    }
};

template <class Epi, class Sched, bool GATHER, bool F8 = false>
__device__ __forceinline__ void gemm_phase(LAS unsigned char* lds, const Gemm g, const Sched& S, const Epi& E, const LAS int* toktab, const int tid, const int tkb, unsigned long long& t_acc, unsigned long long& g_ticks, unsigned long long& g_cyc) {
    unsigned long long t_b = 0ull, c_b = 0ull; static_assert(true, "");
#ifndef TIME_KIND
#define TIME_KIND (-1)
#endif
#define GT_BEG(k) do { if (TIME_KIND >= 20 && TIME_KIND == tkb + (k)) t_b = __builtin_amdgcn_s_memrealtime(); if ((k) == 0 && TIME_KIND == tkb + 5) { t_b = __builtin_amdgcn_s_memrealtime(); c_b = __builtin_readcyclecounter(); } } while (0)
#define GT_END(k) do { if (TIME_KIND >= 20 && TIME_KIND == tkb + (k)) t_acc += __builtin_amdgcn_s_memrealtime() - t_b; if ((k) == 0 && TIME_KIND == tkb + 5) { g_ticks += __builtin_amdgcn_s_memrealtime() - t_b; g_cyc += __builtin_readcyclecounter() - c_b; } } while (0)
    const int wid = __builtin_amdgcn_readfirstlane(tid >> 6), lane = tid & 63, wr = wid >> 2, wc = wid & 3, fr = lane & 15, fq = lane >> 4;
    const int K = g.K, nt = K / BK;
    int Rr[2], Cc[2]; unsigned voffB[2];
#pragma unroll
    for (int i = 0; i < 2; ++i) { int R, C; stage_rc(tid * 16 + i * 8192, R, C); Rr[i] = R; Cc[i] = C; const int Rb = Epi::PERM ? ((R & ~31) + perm32(R & 31)) : R; voffB[i] = (unsigned)(Rb * K + C) * 2u; }
    const unsigned ldsw = (unsigned)wid * 1024u;
    const int aoff = lds_byte(wr * 64 + fr, fq * 8), boff = lds_byte(wc * 32 + fr, fq * 8);
#define PG8_SA(b, h) (((b) * 2 + (h)) * HTB)
#define PG8_SB(b, h) ((4 + (b) * 2 + (h)) * HTB)
#ifndef USE_BUFFER_LDS
#define USE_BUFFER_LDS 1
#endif
#if USE_BUFFER_LDS
#define PG8_STAGE(bufoff, rsrc, soff, voff) do { _Pragma("unroll") for (int _i = 0; _i < 2; ++_i) \
        __builtin_amdgcn_raw_ptr_buffer_load_lds(rsrc, (LAS unsigned*)(lds + (bufoff) + ldsw + _i * 8192), 16, (int)(voff)[_i], (int)(soff), 0, 0); } while (0)
#else
#define PG8_STAGE(bufoff, rsrc, soff, voff) do { _Pragma("unroll") for (int _i = 0; _i < 2; ++_i) \
        __builtin_amdgcn_global_load_lds((const unsigned*)((const char*)(rsrc##_base) + (size_t)(soff) + (voff)[_i]), (LAS unsigned*)(lds + (bufoff) + ldsw + _i * 8192), 16, 0, 0); } while (0)
#endif
#define CAT8(l, h) __builtin_shufflevector((l), (h), 0, 1, 2, 3, 4, 5, 6, 7)
#define LO4(x) __builtin_shufflevector((x), (x), 0, 1, 2, 3)
#define HI4(x) __builtin_shufflevector((x), (x), 4, 5, 6, 7)
#define PG8_LDA(dst, b, h) do { _Pragma("unroll") for (int m = 0; m < 4; ++m) dst[m] = CAT8(*(const LAS v4i*)(lds + PG8_SA(b, h) + aoff + m * 2048), *(const LAS v4i*)(lds + PG8_SA(b, h) + aoff + m * 2048 + 1024)); } while (0)
#define PG8_LDB(dst, b, h) do { _Pragma("unroll") for (int n = 0; n < 2; ++n) dst[n] = CAT8(*(const LAS v4i*)(lds + PG8_SB(b, h) + boff + n * 2048), *(const LAS v4i*)(lds + PG8_SB(b, h) + boff + n * 2048 + 1024)); } while (0)
#define PG8_MMA(ai, bj, At, Bt) do { __builtin_amdgcn_s_setprio(1); \
        if constexpr (F8) { _Pragma("unroll") for (int m = 0; m < 4; ++m) { f32x4 _l = LO4(acc8[ai][bj][m]), _h = HI4(acc8[ai][bj][m]); \
            _l = __builtin_amdgcn_mfma_scale_f32_16x16x128_f8f6f4(Bt[0], At[m], _l, 0, 0, 0, 0x7f7f7f7f, 0, 0x7f7f7f7f); \
            _h = __builtin_amdgcn_mfma_scale_f32_16x16x128_f8f6f4(Bt[1], At[m], _h, 0, 0, 0, 0x7f7f7f7f, 0, 0x7f7f7f7f); acc8[ai][bj][m] = CAT8(_l, _h); } \
              \
            asm volatile("" : "+v"(acc8[ai][bj][0]), "+v"(acc8[ai][bj][1]), "+v"(acc8[ai][bj][2]), "+v"(acc8[ai][bj][3])); } \
        else { _Pragma("unroll") for (int m = 0; m < 4; ++m) { f32x4 _l = LO4(acc8[ai][bj][m]), _h = HI4(acc8[ai][bj][m]); \
            _l = __builtin_amdgcn_mfma_f32_16x16x32_bf16(__builtin_bit_cast(bf16x8, LO4(Bt[0])), __builtin_bit_cast(bf16x8, LO4(At[m])), _l, 0, 0, 0); \
            _l = __builtin_amdgcn_mfma_f32_16x16x32_bf16(__builtin_bit_cast(bf16x8, HI4(Bt[0])), __builtin_bit_cast(bf16x8, HI4(At[m])), _l, 0, 0, 0); \
            _h = __builtin_amdgcn_mfma_f32_16x16x32_bf16(__builtin_bit_cast(bf16x8, LO4(Bt[1])), __builtin_bit_cast(bf16x8, LO4(At[m])), _h, 0, 0, 0); \
            _h = __builtin_amdgcn_mfma_f32_16x16x32_bf16(__builtin_bit_cast(bf16x8, HI4(Bt[1])), __builtin_bit_cast(bf16x8, HI4(At[m])), _h, 0, 0, 0); acc8[ai][bj][m] = CAT8(_l, _h); } } \
        __builtin_amdgcn_s_setprio(0); } while (0)
#define PG8_WAIT_V(n) asm volatile("s_waitcnt vmcnt(" #n ")" ::: "memory")
#define PG8_WAIT_L(n) asm volatile("s_waitcnt lgkmcnt(" #n ")" ::: "memory")
#define PG8_BAR __builtin_amdgcn_s_barrier()
#define PG8_SCHED __builtin_amdgcn_sched_barrier(0)
#define A_OFFS(dst, u) do { _Pragma("unroll") for (int _h = 0; _h < 2; ++_h) _Pragma("unroll") for (int _i = 0; _i < 2; ++_i) { \
        const int _row = GATHER ? toktab[(u).am + _h * HALF + Rr[_i]] : ((u).am + _h * HALF + Rr[_i]); dst[_h][_i] = (unsigned)(_row * K + Cc[_i]) * 2u; } } while (0)
    Unit cur, nxt; int ui = 0;
    if (!S.next(0, cur)) return;
    f32x8 acc8[2][2][4];
#pragma unroll
    for (int a = 0; a < 2; ++a)
#pragma unroll
        for (int b = 0; b < 2; ++b)
#pragma unroll
            for (int m = 0; m < 4; ++m) acc8[a][b][m] = (f32x8){0.f, 0.f, 0.f, 0.f, 0.f, 0.f, 0.f, 0.f};
    v8i At[4], B0[2], B1[2];
    unsigned ao[2][2]; A_OFFS(ao, cur);
    const __amdgpu_buffer_rsrc_t rA = __builtin_amdgcn_make_buffer_rsrc((void*)g.A, 0, 0x7fffffff, 0x00020000), rB = __builtin_amdgcn_make_buffer_rsrc((void*)g.Bt, 0, 0x7fffffff, 0x00020000);
    const char* const rA_base = (const char*)g.A; const char* const rB_base = (const char*)g.Bt; (void)rA_base; (void)rB_base;
    const unsigned kstep = (unsigned)(BK * 2), hstep = (unsigned)HALF * K * 2;
    unsigned cB = (unsigned)(((size_t)cur.e * g.b_estride + (size_t)cur.pn * BM * K) * 2);
    PG8_STAGE(PG8_SB(0, 0), rB, cB, voffB); PG8_STAGE(PG8_SB(0, 1), rB, cB + hstep, voffB); PG8_STAGE(PG8_SA(0, 0), rA, 0u, ao[0]); PG8_STAGE(PG8_SA(0, 1), rA, 0u, ao[1]);
    if (wr == 1) PG8_BAR;
    PG8_WAIT_V(2); PG8_BAR;
    PG8_STAGE(PG8_SB(1, 0), rB, cB + kstep, voffB); PG8_STAGE(PG8_SA(1, 0), rA, kstep, ao[0]); PG8_STAGE(PG8_SB(1, 1), rB, cB + hstep + kstep, voffB);
    PG8_WAIT_V(6); PG8_BAR;
    for (;;) {
        const bool has_next = S.next(ui + 1, nxt);
        const unsigned nB = has_next ? (unsigned)(((size_t)nxt.e * g.b_estride + (size_t)nxt.pn * BM * K) * 2) : cB;
        GT_BEG(0);
#pragma unroll 1
        for (int t = 0; t < nt; t += 2) {
            const bool last = (t == nt - 2);
            const unsigned a1 = (unsigned)(t + 1) * kstep;
            const unsigned a2 = last ? 0u : (unsigned)(t + 2) * kstep, b2 = last ? nB : cB + (unsigned)(t + 2) * kstep;
            const unsigned a3 = a2 + kstep, b3 = b2 + kstep;
            unsigned a2o[2][2];
            if (last && has_next) { A_OFFS(a2o, nxt); }
            else {
#pragma unroll
                for (int _h = 0; _h < 2; ++_h)
#pragma unroll
                    for (int _i = 0; _i < 2; ++_i) a2o[_h][_i] = ao[_h][_i]; }
            PG8_LDB(B0, 0, 0); PG8_LDB(B1, 0, 1); PG8_SCHED; PG8_LDA(At, 0, 0); PG8_STAGE(PG8_SA(1, 1), rA, a1, ao[1]);
            PG8_WAIT_V(8); PG8_WAIT_L(0); PG8_BAR; PG8_MMA(0, 0, At, B0); PG8_MMA(0, 1, At, B1); PG8_BAR; PG8_SCHED;
            PG8_LDA(At, 0, 1); PG8_STAGE(PG8_SB(0, 0), rB, b2, voffB); PG8_STAGE(PG8_SB(0, 1), rB, b2 + hstep, voffB); PG8_STAGE(PG8_SA(0, 0), rA, a2, a2o[0]);
            PG8_WAIT_V(8); PG8_WAIT_L(0); PG8_BAR; PG8_MMA(1, 0, At, B0); PG8_MMA(1, 1, At, B1); PG8_BAR; PG8_SCHED;
            PG8_LDB(B0, 1, 0); PG8_LDB(B1, 1, 1); PG8_SCHED; PG8_LDA(At, 1, 0); PG8_STAGE(PG8_SA(0, 1), rA, a2, a2o[1]);
            PG8_WAIT_V(8); PG8_WAIT_L(0); PG8_BAR; PG8_MMA(0, 0, At, B0); PG8_MMA(0, 1, At, B1); PG8_BAR; PG8_SCHED;
            PG8_LDA(At, 1, 1); PG8_STAGE(PG8_SB(1, 0), rB, b3, voffB); PG8_STAGE(PG8_SB(1, 1), rB, b3 + hstep, voffB); PG8_STAGE(PG8_SA(1, 0), rA, a3, a2o[0]);
            PG8_WAIT_V(8); PG8_WAIT_L(0); PG8_BAR; PG8_MMA(1, 0, At, B0); PG8_MMA(1, 1, At, B1); PG8_BAR; PG8_SCHED;
            if (last) {
#pragma unroll
                for (int _h = 0; _h < 2; ++_h)
#pragma unroll
                    for (int _i = 0; _i < 2; ++_i) ao[_h][_i] = a2o[_h][_i]; }
        }
        GT_END(0); GT_BEG(1);
        if (wr == 0) PG8_BAR;
        { f32x4 acc[2][2][4][2];
#pragma unroll
          for (int a = 0; a < 2; ++a)
#pragma unroll
              for (int b = 0; b < 2; ++b)
#pragma unroll
                  for (int m = 0; m < 4; ++m) { acc[a][b][m][0] = LO4(acc8[a][b][m]); acc[a][b][m][1] = HI4(acc8[a][b][m]); }
          E(acc, cur, wr, wc, fr, fq); }
        GT_END(1);
        if (!has_next) break;
#pragma unroll
        for (int a = 0; a < 2; ++a)
#pragma unroll
            for (int b = 0; b < 2; ++b)
#pragma unroll
                for (int m = 0; m < 4; ++m) acc8[a][b][m] = (f32x8){0.f, 0.f, 0.f, 0.f, 0.f, 0.f, 0.f, 0.f};
        cur = nxt; cB = nB; ++ui;
        if (wr == 1) PG8_BAR;
    }
    PG8_WAIT_V(0);
    PG8_BAR;
#undef PG8_SA
#undef PG8_SB
#undef PG8_STAGE
#undef PG8_LDA
#undef PG8_LDB
#undef PG8_MMA
#undef PG8_WAIT_V
#undef PG8_WAIT_L
#undef PG8_BAR
#undef PG8_SCHED
#undef A_OFFS
#undef GT_BEG
#undef GT_END
#undef CAT8
#undef LO4
#undef HI4
}
struct EpiBias16 {
    static constexpr bool PERM = true;
    bf16_t* O; int ldc; const float* bias;
    __device__ __forceinline__ void operator()(const f32x4 (&acc)[2][2][4][2], const Unit& u, int wr, int wc, int fr, int fq) const {
        const int row0 = u.om + wr * 64 + fr, col0 = u.pn * BM + wc * 32 + 8 * fq;
        f32x4 bv[2][2];
#pragma unroll
        for (int bj = 0; bj < 2; ++bj)
#pragma unroll
            for (int n = 0; n < 2; ++n) bv[bj][n] = *(const f32x4*)(bias + col0 + bj * HALF + 4 * n);
#pragma unroll
        for (int ai = 0; ai < 2; ++ai)
#pragma unroll
            for (int m = 0; m < 4; ++m) { bf16_t* rowp = O + (size_t)(row0 + ai * HALF + m * 16) * ldc + col0;
#pragma unroll
                for (int bj = 0; bj < 2; ++bj) { const f32x4 v0 = acc[ai][bj][m][0] + bv[bj][0], v1 = acc[ai][bj][m][1] + bv[bj][1];
                    u32x4 w; w.x = cvt_pk(v0[0], v0[1]); w.y = cvt_pk(v0[2], v0[3]); w.z = cvt_pk(v1[0], v1[1]); w.w = cvt_pk(v1[2], v1[3]);
                    *(u32x4*)(rowp + bj * HALF) = w; } }
    }
};
template <bool XF32> struct EpiResid {
    static constexpr bool PERM = true;
    const void* Xin; bf16_t* X; const float* bias; const float* gate;
    __device__ __forceinline__ void operator()(const f32x4 (&acc)[2][2][4][2], const Unit& u, int wr, int wc, int fr, int fq) const {
        const int row0 = u.om + wr * 64 + fr, col0 = u.pn * BM + wc * 32 + 8 * fq; const float* gb = gate + (size_t)(u.om / SEQ) * (6 * D);
        f32x4 bv[2][2], gv[2][2];
#pragma unroll
        for (int bj = 0; bj < 2; ++bj)
#pragma unroll
            for (int n = 0; n < 2; ++n) { bv[bj][n] = *(const f32x4*)(bias + col0 + bj * HALF + 4 * n); gv[bj][n] = *(const f32x4*)(gb + col0 + bj * HALF + 4 * n); }
#pragma unroll
        for (int ai = 0; ai < 2; ++ai)
#pragma unroll
            for (int m = 0; m < 4; ++m) { const size_t off = (size_t)(row0 + ai * HALF + m * 16) * D + col0;
#pragma unroll
                for (int bj = 0; bj < 2; ++bj) { f32x4 x0, x1;
                    if (XF32) { x0 = *(const f32x4*)((const float*)Xin + off + bj * HALF); x1 = *(const f32x4*)((const float*)Xin + off + bj * HALF + 4); }
                    else { const u32x4 xb = *(const u32x4*)((const bf16_t*)Xin + off + bj * HALF); x0 = (f32x4){bf_lo(xb.x), bf_hi(xb.x), bf_lo(xb.y), bf_hi(xb.y)}; x1 = (f32x4){bf_lo(xb.z), bf_hi(xb.z), bf_lo(xb.w), bf_hi(xb.w)}; }
                    const f32x4 v0 = x0 + gv[bj][0] * (acc[ai][bj][m][0] + bv[bj][0]), v1 = x1 + gv[bj][1] * (acc[ai][bj][m][1] + bv[bj][1]);
                    u32x4 w; w.x = cvt_pk(v0[0], v0[1]); w.y = cvt_pk(v0[2], v0[3]); w.z = cvt_pk(v1[0], v1[1]); w.w = cvt_pk(v1[2], v1[3]);
                    *(u32x4*)(X + off + bj * HALF) = w; }
                asm volatile("" ::: "memory"); }
    }
};
template <int MODE> struct EpiPair {
    static constexpr bool PERM = true;
    void* O; const float* bias; int b_estride;
    __device__ __forceinline__ void operator()(const f32x4 (&acc)[2][2][4][2], const Unit& u, int wr, int wc, int fr, int fq) const {
        const int row0 = u.om + wr * 64 + fr, col0 = u.pn * HALF + wc * 32 + 8 * fq; const float* bb = bias + (size_t)u.e * b_estride;
        constexpr float ASC = MODE == 1 ? 1.0f / (F8_SH * F8_SW) : 1.0f;
        f32x4 bv[2][2];
#pragma unroll
        for (int bj = 0; bj < 2; ++bj)
#pragma unroll
            for (int n = 0; n < 2; ++n) bv[bj][n] = *(const f32x4*)(bb + bj * D + col0 + 4 * n);
#pragma unroll
        for (int ai = 0; ai < 2; ++ai)
#pragma unroll
            for (int m = 0; m < 4; ++m) { float r[8];
#pragma unroll
                for (int n = 0; n < 2; ++n) { const f32x4 a = acc[ai][0][m][n] * ASC + bv[0][n], g = acc[ai][1][m][n] * ASC + bv[1][n];
#pragma unroll
                    for (int jp = 0; jp < 2; ++jp) {
                        f32x2 av = (f32x2){a[2 * jp], a[2 * jp + 1]}, gv = (f32x2){g[2 * jp], g[2 * jp + 1]}, o;
                        if (MODE == 0) { const f32x2 x = gv * (-LOG2E); f32x2 e; e.x = __builtin_amdgcn_exp2f(x.x); e.y = __builtin_amdgcn_exp2f(x.y); const f32x2 d = e + 1.0f;
                            f32x2 rc; rc.x = __builtin_amdgcn_rcpf(d.x); rc.y = __builtin_amdgcn_rcpf(d.y); o = av * rc; }
                        else { f32x2 glu, lin; glu.x = fminf(av.x, 7.0f); glu.y = fminf(av.y, 7.0f); lin.x = __builtin_amdgcn_fmed3f(gv.x, -7.0f, 7.0f); lin.y = __builtin_amdgcn_fmed3f(gv.y, -7.0f, 7.0f);
                            const f32x2 x = glu * (-1.702f * LOG2E); f32x2 e; e.x = __builtin_amdgcn_exp2f(x.x); e.y = __builtin_amdgcn_exp2f(x.y); const f32x2 d = e + 1.0f;
                            f32x2 rc; rc.x = __builtin_amdgcn_rcpf(d.x); rc.y = __builtin_amdgcn_rcpf(d.y); o = (glu * rc) * (lin * F8_SACT + F8_SACT); }
                        r[4 * n + 2 * jp] = o.x; r[4 * n + 2 * jp + 1] = o.y; } }
                if (MODE == 0) { bf16_t* rowp = (bf16_t*)O + (size_t)(row0 + ai * HALF + m * 16) * D + col0;
                    u32x4 w; w.x = cvt_pk(r[0], r[1]); w.y = cvt_pk(r[2], r[3]); w.z = cvt_pk(r[4], r[5]); w.w = cvt_pk(r[6], r[7]); *(u32x4*)rowp = w; }
                else { unsigned char* rowp = (unsigned char*)O + (size_t)(row0 + ai * HALF + m * 16) * D + col0;
                    u32x2 w; w.x = cvt_pk4_fp8_nc(r[0], r[1], r[2], r[3]); w.y = cvt_pk4_fp8_nc(r[4], r[5], r[6], r[7]); *(u32x2*)rowp = w; } }
    }
};
struct EpiMoeOut {
    static constexpr bool PERM = true;
    bf16_t* O; const float* bias; const float* gl; const LAS int* exoff;
    __device__ __forceinline__ void operator()(const f32x4 (&acc)[2][2][4][2], const Unit& u, int wr, int wc, int fr, int fq) const {
        const int row0 = u.om + wr * 64 + fr, col0 = u.pn * BM + wc * 32 + 8 * fq; const float* bb = bias + (size_t)u.e * D;
        const GAS float* gp = (const GAS float*)(gl + (size_t)u.e * T + (u.om - exoff[u.e]) + wr * 64 + fr);
        f32x4 bv[2][2]; float gt[2][4];
#pragma unroll
        for (int ai = 0; ai < 2; ++ai)
#pragma unroll
            for (int m = 0; m < 4; ++m) gt[ai][m] = gp[ai * HALF + m * 16];
#pragma unroll
        for (int bj = 0; bj < 2; ++bj)
#pragma unroll
            for (int n = 0; n < 2; ++n) bv[bj][n] = *(const GAS f32x4*)(bb + col0 + bj * HALF + 4 * n);
#pragma unroll
        for (int ai = 0; ai < 2; ++ai)
#pragma unroll
            for (int m = 0; m < 4; ++m) { GAS unsigned char* rowp = (GAS unsigned char*)O + (size_t)(row0 + ai * HALF + m * 16) * D + col0; const float g16 = gt[ai][m] * F8_SY;
#pragma unroll
                for (int bj = 0; bj < 2; ++bj) { const f32x4 v0 = (acc[ai][bj][m][0] * (1.0f / (F8_SACT * F8_SW)) + bv[bj][0]) * g16, v1 = (acc[ai][bj][m][1] * (1.0f / (F8_SACT * F8_SW)) + bv[bj][1]) * g16;
                    u32x2 w; w.x = cvt_pk4_fp8(v0[0], v0[1], v0[2], v0[3]); w.y = cvt_pk4_fp8(v1[0], v1[1], v1[2], v1[3]);
                    *(GAS u32x2*)(rowp + bj * HALF) = w; } }
    }
};

struct Frame {
    LAS unsigned char* lds; volatile LAS unsigned* MISC; gu32* ctl; unsigned char* ws;
    int tid, lane, wave, G, c;
    const float* const* in;
    float* out;
};
enum { I_X = 0, I_C, I_WMOD, I_BMOD, I_NMG, I_NFG, I_AWQKV, I_ABQKV, I_AWO, I_ABO, I_SINK, I_RELB, I_CWIN, I_CBIN, I_CWDW, I_CBDW, I_CLNG, I_CLNB, I_CWOUT, I_CBOUT, I_RW, I_RB, I_MWIN, I_MBIN, I_MWOUT, I_MBOUT, I_FNG };
#define WSP(type, off) ((type*)(F.ws + (off)))
__device__ __forceinline__ void wg_barrier() { __syncthreads(); }

__device__ __forceinline__ int build_exp_tables(Frame& F, int layer) {
    LAS int* EX = (LAS int*)(F.lds + LDS_EXP);
    if (F.tid < 64) {
        const int e = F.tid & 31; const int cnt = (int)__hip_atomic_load(F.ctl + CW_CNT + 64 * layer + e, RLX_AGENT); const int tiles = (cnt + 255) >> 8;
        int pre = tiles;
#pragma unroll
        for (int o = 1; o < 32; o <<= 1) { const int v = __shfl_up(pre, o, 32); if (e >= o) pre += v; }
        if (F.tid < 32) { EX[e] = cnt; EX[32 + e] = pre - tiles; EX[64 + e] = (pre - tiles) * 256; if (e == 31) EX[96] = pre; }
    }
    wg_barrier();
    return EX[96];
}
template <int MODE> __device__ __forceinline__ void row_phase(Frame& F, int layer) {
    constexpr bool COMB = (MODE & 1) != 0, ROUT = (MODE & 2) != 0, FIN = (MODE & 4) != 0;
    LAS float* red = (LAS float*)(F.lds); LAS float* part = (LAS float*)(F.lds + 49152); LAS float* lg = (LAS float*)(F.lds + 49152 + 65536);
    LAS int* hist = (LAS int*)(F.lds + 4608); LAS int* gbase = hist + 32; LAS int* pend = (LAS int*)(F.lds + 8192);
    const LAS int* EX = (const LAS int*)(F.lds + LDS_EXP);
    const int lane = F.lane, w = F.wave, row = lane & 15, kq = lane >> 4;
    constexpr int KS = (MODE & 2) ? 32 : 8;
    const int kb = (MODE & 2) ? 128 * w + 8 * kq : 128 * w + 32 * kq;
    constexpr bool XF32 = (MODE == 0);
    const float* xin = F.in[I_X]; bf16_t* X = WSP(bf16_t, WS_X); bf16_t* H = WSP(bf16_t, WS_H);
    const float* mod = WSP(const float, WS_MOD);
    const float* gamma = FIN ? F.in[I_FNG] : (ROUT ? F.in[I_NFG] + layer * D : F.in[I_NMG] + layer * D);
    const int ngrp = T / 16, g0 = (int)((long)F.c * ngrp / F.G), g1 = (int)((long)(F.c + 1) * ngrp / F.G);
    if (COMB) build_exp_tables(F, layer - 1);
    if (ROUT) { if (F.tid < 32) hist[F.tid] = 0; }
    bf16x8 whi[2][4], wlo[2][4];
    if (ROUT) {
        const float* wrp = F.in[I_RW] + (size_t)layer * D * NE;
#pragma unroll
        for (int eh = 0; eh < 2; ++eh)
#pragma unroll
            for (int s = 0; s < 4; ++s) { float v[8];
#pragma unroll
                for (int j = 0; j < 8; ++j) v[j] = wrp[(size_t)(kb + 32 * s + j) * NE + 16 * eh + row];
                u32x4 hi, lo;
#pragma unroll
                for (int p = 0; p < 4; ++p) { const unsigned h2 = cvt_pk(v[2 * p], v[2 * p + 1]); hi[p] = h2; lo[p] = cvt_pk(v[2 * p] - bf_lo(h2), v[2 * p + 1] - bf_hi(h2)); }
                whi[eh][s] = __builtin_bit_cast(bf16x8, hi); wlo[eh][s] = __builtin_bit_cast(bf16x8, lo); }
    }
    LAS float* Gl = (LAS float*)(F.lds + 32768); LAS float* Sl = Gl + D; LAS float* Fl = Sl + D;
    constexpr int GU = (XF32 || ROUT) ? 2 : 4;
#define UNPK0(v) ((f32x4){bf_lo((v).x), bf_hi((v).x), bf_lo((v).y), bf_hi((v).y)})
#define UNPK1(v) ((f32x4){bf_lo((v).z), bf_hi((v).z), bf_lo((v).w), bf_hi((v).w)})
    int curb = -1;
    for (int grp0 = g0; grp0 < g1; grp0 += GU) {
        const int b = (grp0 * 16) / SEQ, par = ((grp0 - g0) / GU) & 1;
        if (b != curb) { curb = b;
            const float* mb = mod + ((size_t)layer * NBATCH + b) * (6 * D);
            wg_barrier();
            for (int k = F.tid; k < D; k += NTHR) { const float gm = gamma[k];
                if (FIN) { Gl[k] = gm; Sl[k] = 0.f; }
                else { const float* shp = mb + (ROUT ? 3 * D : 0); const float* scp = mb + (ROUT ? 4 * D : D); Gl[k] = gm * (scp[k] + 1.0f); Sl[k] = shp[k]; }
                if (COMB) { const float* gf = mod + ((size_t)(layer - 1) * NBATCH + b) * (6 * D) + 5 * D; Fl[k] = gf[k]; } }
            wg_barrier();
        }
        u32x4 xb[GU][4]; int tks[GU][4];
#pragma unroll
        for (int u = 0; u < GU; ++u) { const int t = (grp0 + u < g1 ? grp0 + u : g1 - 1) * 16 + row;
            if (COMB) { const int* TK = WSP(const int, WS_TK);
#pragma unroll
                for (int kk = 0; kk < 4; ++kk) tks[u][kk] = TK[t * 4 + kk]; }
#pragma unroll
            for (int s = 0; s < 4; ++s) {
                if (XF32) { const f32x4 x0 = *(const f32x4*)(xin + (size_t)t * D + kb + KS * s), x1 = *(const f32x4*)(xin + (size_t)t * D + kb + KS * s + 4);
                    xb[u][s].x = cvt_pk(x0[0], x0[1]); xb[u][s].y = cvt_pk(x0[2], x0[3]); xb[u][s].z = cvt_pk(x1[0], x1[1]); xb[u][s].w = cvt_pk(x1[2], x1[3]); }
                else xb[u][s] = *(const u32x4*)(X + (size_t)t * D + kb + KS * s); } }
        if (COMB) {
            const unsigned char* YS = WSP(const unsigned char, WS_YS);
#pragma unroll
            for (int u = 0; u < GU; ++u) { const int t = (grp0 + u < g1 ? grp0 + u : g1 - 1) * 16 + row;
                size_t yoff[4];
#pragma unroll
                for (int kk = 0; kk < 4; ++kk) { const int tk = tks[u][kk]; yoff[kk] = (size_t)(EX[64 + (tk >> 16)] + (tk & 0xffff)) * D + kb; }
                u32x2 yv[4][4];
#pragma unroll
                for (int s = 0; s < 4; ++s)
#pragma unroll
                    for (int kk = 0; kk < 4; ++kk) yv[s][kk] = *(const u32x2*)(YS + yoff[kk] + KS * s);
#pragma unroll
                for (int s = 0; s < 4; ++s) { f32x4 a0 = (f32x4){0.f, 0.f, 0.f, 0.f}, a1 = a0;
#pragma unroll
                    for (int kk = 0; kk < 4; ++kk) { a0 += fp8x4_to_f32(yv[s][kk].x); a1 += fp8x4_to_f32(yv[s][kk].y); }
                    const f32x4 x0 = UNPK0(xb[u][s]) + *(const LAS f32x4*)(Fl + kb + KS * s) * a0 * (1.0f / F8_SY), x1 = UNPK1(xb[u][s]) + *(const LAS f32x4*)(Fl + kb + KS * s + 4) * a1 * (1.0f / F8_SY);
                    xb[u][s].x = cvt_pk(x0[0], x0[1]); xb[u][s].y = cvt_pk(x0[2], x0[3]); xb[u][s].z = cvt_pk(x1[0], x1[1]); xb[u][s].w = cvt_pk(x1[2], x1[3]);
                    if (!FIN && grp0 + u < g1) *(u32x4*)(X + (size_t)t * D + kb + KS * s) = xb[u][s]; } }
        }
#pragma unroll
        for (int u = 0; u < GU; ++u) { float ss = 0.f;
#pragma unroll
            for (int s = 0; s < 4; ++s) { const f32x4 v0 = UNPK0(xb[u][s]), v1 = UNPK1(xb[u][s]); ss += (v0[0] * v0[0] + v0[1] * v0[1]) + (v0[2] * v0[2] + v0[3] * v0[3]) + (v1[0] * v1[0] + v1[1] * v1[1]) + (v1[2] * v1[2] + v1[3] * v1[3]); }
            ss += __shfl_xor(ss, 16); ss += __shfl_xor(ss, 32);
            if (kq == 0) red[(par * GU + u) * 128 + w * 16 + row] = ss; }
        wg_barrier();
        f32x4 acc[GU][2];
#pragma unroll
        for (int u = 0; u < GU; ++u) { const int t = (grp0 + u < g1 ? grp0 + u : g1 - 1) * 16 + row; const bool live = grp0 + u < g1;
            float tot = 0.f;
#pragma unroll
            for (int ww = 0; ww < 8; ++ww) tot += red[(par * GU + u) * 128 + ww * 16 + row];
            const float rstd = rsqrtf(tot * (1.0f / D) + 1e-5f);
            acc[u][0] = (f32x4){0.f, 0.f, 0.f, 0.f}; acc[u][1] = acc[u][0];
#pragma unroll
            for (int s = 0; s < 4; ++s) {
                const f32x4 h0 = UNPK0(xb[u][s]) * rstd * *(const LAS f32x4*)(Gl + kb + KS * s) + *(const LAS f32x4*)(Sl + kb + KS * s), h1 = UNPK1(xb[u][s]) * rstd * *(const LAS f32x4*)(Gl + kb + KS * s + 4) + *(const LAS f32x4*)(Sl + kb + KS * s + 4);
                if (FIN) { if (live) { *(f32x4*)(F.out + (size_t)t * D + kb + KS * s) = h0; *(f32x4*)(F.out + (size_t)t * D + kb + KS * s + 4) = h1; } }
                else {
                    u32x4 hi; hi.x = cvt_pk(h0[0], h0[1]); hi.y = cvt_pk(h0[2], h0[3]); hi.z = cvt_pk(h1[0], h1[1]); hi.w = cvt_pk(h1[2], h1[3]);
                    if (!ROUT) { if (live) *(u32x4*)(H + (size_t)t * D + kb + KS * s) = hi; }
                    else { u32x2 q8; q8.x = cvt_pk4_fp8(h0[0] * F8_SH, h0[1] * F8_SH, h0[2] * F8_SH, h0[3] * F8_SH); q8.y = cvt_pk4_fp8(h1[0] * F8_SH, h1[1] * F8_SH, h1[2] * F8_SH, h1[3] * F8_SH);
                        if (live) *(u32x2*)((unsigned char*)H + (size_t)t * D + kb + KS * s) = q8; }
                    if (ROUT) {
                        u32x4 lo; lo.x = cvt_pk(h0[0] - bf_lo(hi.x), h0[1] - bf_hi(hi.x)); lo.y = cvt_pk(h0[2] - bf_lo(hi.y), h0[3] - bf_hi(hi.y));
                        lo.z = cvt_pk(h1[0] - bf_lo(hi.z), h1[1] - bf_hi(hi.z)); lo.w = cvt_pk(h1[2] - bf_lo(hi.w), h1[3] - bf_hi(hi.w));
                        const bf16x8 ah = __builtin_bit_cast(bf16x8, hi), al = __builtin_bit_cast(bf16x8, lo);
#pragma unroll
                        for (int eh = 0; eh < 2; ++eh) {
                            acc[u][eh] = __builtin_amdgcn_mfma_f32_16x16x32_bf16(ah, whi[eh][s], acc[u][eh], 0, 0, 0);
                            acc[u][eh] = __builtin_amdgcn_mfma_f32_16x16x32_bf16(ah, wlo[eh][s], acc[u][eh], 0, 0, 0);
                            acc[u][eh] = __builtin_amdgcn_mfma_f32_16x16x32_bf16(al, whi[eh][s], acc[u][eh], 0, 0, 0); }
                    }
                }
            }
        }
        if (ROUT) {
#pragma unroll
            for (int u = 0; u < GU; ++u)
#pragma unroll
                for (int eh = 0; eh < 2; ++eh)
#pragma unroll
                    for (int i = 0; i < 4; ++i) part[((u * 8 + w) * 16 + 4 * kq + i) * 32 + 16 * eh + row] = acc[u][eh][i];
            wg_barrier();
#pragma unroll
            for (int u = 0; u < GU; ++u) { const int r = F.tid >> 5, e = F.tid & 31; float v = F.in[I_RB][layer * NE + e];
#pragma unroll
                for (int ww = 0; ww < 8; ++ww) v += part[((u * 8 + ww) * 16 + r) * 32 + e];
                lg[(u * 16 + r) * 32 + e] = v; }
            wg_barrier();
            if (F.tid < 16 * GU && grp0 + (F.tid >> 4) < g1) {
                const int u = F.tid >> 4, r = F.tid & 15; unsigned used = 0u; int ids[4]; float vals[4];
#pragma unroll
                for (int k = 0; k < 4; ++k) { int bi = 0; float bv = -3.0e38f;
                    for (int e = 0; e < 32; ++e) { const float v = lg[(u * 16 + r) * 32 + e]; if (!((used >> e) & 1u) && v > bv) { bv = v; bi = e; } }
                    used |= 1u << bi; ids[k] = bi; vals[k] = bv; }
                const float e1 = __expf(vals[1] - vals[0]), e2 = __expf(vals[2] - vals[0]), e3 = __expf(vals[3] - vals[0]), inv = 1.0f / (1.0f + e1 + e2 + e3);
                const float gs[4] = {inv, e1 * inv, e2 * inv, e3 * inv};
#pragma unroll
                for (int k = 0; k < 4; ++k) { const int lp = atomicAdd((int*)&hist[ids[k]], 1); const int idx = ((grp0 + u - g0) * 16 + r) * 4 + k; pend[2 * idx] = ids[k] | (lp << 8); pend[2 * idx + 1] = __float_as_int(gs[k]); }
            }
        }
    }
#undef UNPK0
#undef UNPK1
    if (ROUT) {
        wg_barrier();
        if (F.tid < 32) { const int n = hist[F.tid]; gbase[F.tid] = n > 0 ? (int)__hip_atomic_fetch_add(F.ctl + CW_CNT + 64 * layer + F.tid, (unsigned)n, RLX_AGENT) : 0; }
        wg_barrier();
        int* LIST = WSP(int, WS_LIST); float* GL = WSP(float, WS_GLIST); int* TK = WSP(int, WS_TK);
        const int nent = (g1 - g0) * 64;
        for (int idx = F.tid; idx < nent; idx += NTHR) { const int pw = pend[2 * idx], e = pw & 0xff, pos = gbase[e] + (pw >> 8), tok = g0 * 16 + (idx >> 2);
            LIST[(size_t)e * T + pos] = tok; GL[(size_t)e * T + pos] = __int_as_float(pend[2 * idx + 1]); TK[tok * 4 + (idx & 3)] = (e << 16) | pos; }
    }
    wg_barrier();
}
__device__ const unsigned char kBucket[128] = {0, 1, 2, 3, 4, 5, 6, 7, 8, 9, 10, 11, 12, 13, 14, 15, 16, 16, 16, 17, 17, 18, 18, 18, 19, 19, 19, 20, 20, 20, 20, 21, 21, 21, 21, 22, 22, 22, 22, 22, 23, 23, 23, 23, 23, 23, 24, 24, 24, 24, 24, 24, 25, 25, 25, 25, 25, 25, 25, 26, 26, 26, 26, 26, 26, 26, 26, 27, 27, 27, 27, 27, 27, 27, 27, 27, 27, 28, 28, 28, 28, 28, 28, 28, 28, 28, 28, 29, 29, 29, 29, 29, 29, 29, 29, 29, 29, 29, 29, 30, 30, 30, 30, 30, 30, 30, 30, 30, 30, 30, 30, 30, 30, 31, 31, 31, 31, 31, 31, 31, 31, 31, 31, 31, 31, 31, 31, 31};
constexpr int KP = 144, VP = 192;
constexpr int ATT_K = 0, ATT_V = 256 * KP, ATT_B = ATT_V + 256 * VP;
__device__ __forceinline__ int crow(int r, int hi) { return (r & 3) + 8 * (r >> 2) + 4 * hi; }
typedef short v4i16_t __attribute__((ext_vector_type(4)));
__device__ __forceinline__ s16x4 vtr(const LAS unsigned char* p) { return __builtin_bit_cast(s16x4, __builtin_amdgcn_ds_read_tr16_b64_v4i16((LAS v4i16_t*)p)); }

__device__ __forceinline__ void attn_phase(Frame& F, int j) {
    const bf16_t* QKV = WSP(const bf16_t, WS_QKV); bf16_t* AO = WSP(bf16_t, WS_AO);
    LAS unsigned char* Kl = F.lds + ATT_K; LAS unsigned char* Vl = F.lds + ATT_V; LAS float* Bl = (LAS float*)(F.lds + ATT_B);
    const int lane = F.lane, w = F.wave, r = lane & 31, hh = lane >> 5;
    const float c1 = 0.125f * LOG2E;
    for (int unit = F.c; unit < NBATCH * 16 * 4; unit += F.G) {
        const int kvh = unit & 3, n = (unit >> 2) & 15, b = unit >> 6;
        const int krow0 = b * SEQ + (n > 0 ? (n - 1) * 128 : 0);
#pragma unroll
        for (int it = 0; it < 4; ++it) { const int ch = F.tid + NTHR * it, s = ch >> 3, c8 = ch & 7;
            const int grow = (n > 0 || s >= 128) ? (b * SEQ + (n - 1) * 128 + s) : (krow0 + s);
            const u32x4 kv = *(const u32x4*)(QKV + (size_t)grow * 1536 + 1024 + kvh * 64 + 8 * c8); const u32x4 vv = *(const u32x4*)(QKV + (size_t)grow * 1536 + 1280 + kvh * 64 + 8 * c8);
            *(LAS u32x4*)(Kl + s * KP + 16 * c8) = kv; *(LAS u32x4*)(Vl + s * VP + 16 * c8) = vv; }
        { const int g = F.tid >> 7, dist = F.tid & 127; Bl[F.tid] = F.in[I_RELB][kBucket[dist] * 16 + kvh * 4 + g] * LOG2E; }
        wg_barrier();
        const int g = w >> 1, hq = kvh * 4 + g; const float sink2 = F.in[I_SINK][j * 16 + hq] * LOG2E;
#pragma unroll 1
        for (int grp = 0; grp < 2; ++grp) {
            const int a0 = (w & 1) * 64 + grp * 32, a = a0 + r; const size_t tok = (size_t)b * SEQ + n * 128 + a;
            bf16x8 qf[4];
#pragma unroll
            for (int d0 = 0; d0 < 4; ++d0) qf[d0] = *(const bf16x8*)(QKV + tok * 1536 + hq * 64 + 16 * d0 + 8 * hh);
            const int kt0 = a0 >> 5;
            f32x16 S[5];
#pragma unroll
            for (int t = 0; t < 5; ++t) {
#pragma unroll
                for (int i = 0; i < 16; ++i) S[t][i] = 0.f;
                const LAS unsigned char* kp = Kl + (32 * (kt0 + t) + r) * KP + 16 * hh;
#pragma unroll
                for (int d0 = 0; d0 < 4; ++d0) { const bf16x8 kf = *(const LAS bf16x8*)(kp + 32 * d0); S[t] = __builtin_amdgcn_mfma_f32_32x32x16_bf16(kf, qf[d0], S[t], 0, 0, 0); }
            }
            float m = sink2;
#pragma unroll
            for (int t = 0; t < 5; ++t)
#pragma unroll
                for (int i = 0; i < 16; ++i) { const int s = 32 * (kt0 + t) + crow(i, hh), dist = a + 128 - s; const bool ok = (dist >= 0) && (dist < 128) && (n > 0 || s >= 128);
                    const float v = ok ? S[t][i] * c1 + Bl[g * 128 + (dist & 127)] : -3.0e38f; S[t][i] = v; m = fmaxf(m, v); }
            m = fmaxf(m, __shfl_xor(m, 32));
            float l = 0.f;
#pragma unroll
            for (int t = 0; t < 5; ++t)
#pragma unroll
                for (int i = 0; i < 16; ++i) { const float p = __builtin_amdgcn_exp2f(S[t][i] - m); S[t][i] = p; l += p; }
            l += __shfl_xor(l, 32); l += __builtin_amdgcn_exp2f(sink2 - m);
            f32x16 O[2];
#pragma unroll
            for (int i = 0; i < 16; ++i) { O[0][i] = 0.f; O[1][i] = 0.f; }
            const int q4 = (lane >> 2) & 3, p4 = lane & 3, blk = (lane >> 4) & 1;
#pragma unroll
            for (int t = 0; t < 5; ++t)
#pragma unroll
                for (int s2 = 0; s2 < 2; ++s2) {
                    u32x4 pk; pk.x = cvt_pk(S[t][8 * s2 + 0], S[t][8 * s2 + 1]); pk.y = cvt_pk(S[t][8 * s2 + 2], S[t][8 * s2 + 3]); pk.z = cvt_pk(S[t][8 * s2 + 4], S[t][8 * s2 + 5]); pk.w = cvt_pk(S[t][8 * s2 + 6], S[t][8 * s2 + 7]);
                    const bf16x8 pb = __builtin_bit_cast(bf16x8, pk);
                    const LAS unsigned char* vp = Vl + (32 * (kt0 + t) + 16 * s2 + 4 * hh + q4) * VP + 32 * blk + 8 * p4;
#pragma unroll
                    for (int dh = 0; dh < 2; ++dh) { const s16x4 lo = vtr(vp + 64 * dh), hi = vtr(vp + 64 * dh + 8 * VP);
                        const bf16x8 va = (bf16x8){lo[0], lo[1], lo[2], lo[3], hi[0], hi[1], hi[2], hi[3]};
                        O[dh] = __builtin_amdgcn_mfma_f32_32x32x16_bf16(va, pb, O[dh], 0, 0, 0); }
                }
            const float inv = 1.0f / l;
#pragma unroll
            for (int dh = 0; dh < 2; ++dh)
#pragma unroll
                for (int g4 = 0; g4 < 4; ++g4) { u32x2 o2; o2.x = cvt_pk(O[dh][4 * g4] * inv, O[dh][4 * g4 + 1] * inv); o2.y = cvt_pk(O[dh][4 * g4 + 2] * inv, O[dh][4 * g4 + 3] * inv);
                    *(u32x2*)(AO + tok * D + hq * 64 + 32 * dh + 8 * g4 + 4 * hh) = o2; }
        }
        wg_barrier();
    }
}

__device__ __forceinline__ float wave_sum63(float v) {
    v += __builtin_bit_cast(float, __builtin_amdgcn_update_dpp(0, __builtin_bit_cast(int, v), 0x111, 0xf, 0xf, true));
    v += __builtin_bit_cast(float, __builtin_amdgcn_update_dpp(0, __builtin_bit_cast(int, v), 0x112, 0xf, 0xf, true));
    v += __builtin_bit_cast(float, __builtin_amdgcn_update_dpp(0, __builtin_bit_cast(int, v), 0x114, 0xf, 0xf, true));
    v += __builtin_bit_cast(float, __builtin_amdgcn_update_dpp(0, __builtin_bit_cast(int, v), 0x118, 0xf, 0xf, true));
    v += __builtin_bit_cast(float, __builtin_amdgcn_update_dpp(0, __builtin_bit_cast(int, v), 0x142, 0xa, 0xf, true));
    v += __builtin_bit_cast(float, __builtin_amdgcn_update_dpp(0, __builtin_bit_cast(int, v), 0x143, 0xc, 0xf, true));
    return v;
}
__device__ __forceinline__ void dwconv_phase(Frame& F, int j, unsigned long long& t_acc) {
#ifndef TIME_KIND
#define TIME_KIND (-1)
#endif
    unsigned long long t_b = 0ull;
#define DT_BEG(k) do { if (TIME_KIND == (k)) t_b = __builtin_amdgcn_s_memrealtime(); } while (0)
#define DT_END(k) do { if (TIME_KIND == (k)) t_acc += __builtin_amdgcn_s_memrealtime() - t_b; } while (0)
    constexpr int PP = 520;
    DT_BEG(16);
    const bf16_t* U = WSP(const bf16_t, WS_U); bf16_t* YC = WSP(bf16_t, WS_AO);
    LAS unsigned char* ut = F.lds; LAS float* P = (LAS float*)F.lds; LAS float* fin = (LAS float*)(F.lds + 64 * PP * 4);
    const int tid = F.tid, lane = F.lane, w = F.wave;
    const float* wd = F.in[I_CWDW] + (size_t)j * 31 * D + 2 * tid;
    f32x2 wk[31];
#pragma unroll
    for (int q = 0; q < 31; ++q) wk[q] = *(const f32x2*)(wd + q * D);
    const f32x2 bdw = *(const f32x2*)(F.in[I_CBDW] + j * D + 2 * tid), lng = *(const f32x2*)(F.in[I_CLNG] + j * D + 2 * tid), lnb = *(const f32x2*)(F.in[I_CLNB] + j * D + 2 * tid);
    const __amdgpu_buffer_rsrc_t rU = __builtin_amdgcn_make_buffer_rsrc((void*)U, 0, 0x7fffffff, 0x00020000);
    asm volatile("s_waitcnt vmcnt(0)" ::: "memory"); DT_END(16);
    for (int tile = F.c; tile < T / 32; tile += F.G) {
        const int t0 = tile * 32, tin0 = t0 % SEQ, rlo = tin0 >= 30 ? 0 : 30 - tin0;
        DT_BEG(12);
        for (int pc = w; pc < 124; pc += NWAVES) { const int rr = pc >> 1;
            if (rr >= rlo) __builtin_amdgcn_raw_ptr_buffer_load_lds(rU, (LAS unsigned*)(ut + pc * 1024), 16, lane * 16, (int)(((size_t)(t0 + rr - 30) * D + (pc & 1) * 512) * 2), 0, 0);
            else *(LAS u32x4*)(ut + pc * 1024 + lane * 16) = (u32x4){0u, 0u, 0u, 0u}; }
        asm volatile("s_waitcnt vmcnt(0)" ::: "memory");
        wg_barrier();
        DT_END(12); DT_BEG(13);
        f32x2 y[32];
#pragma unroll
        for (int blk = 0; blk < 4; ++blk) {
            f32x2 a[8] = {bdw, bdw, bdw, bdw, bdw, bdw, bdw, bdw};
#pragma unroll
            for (int rr = 0; rr < 38; ++rr) { const unsigned uw = *(const LAS unsigned*)(ut + (8 * blk + rr) * 2048 + 4 * tid); const f32x2 uv = (f32x2){bf_lo(uw), bf_hi(uw)};
#pragma unroll
                for (int o = 0; o < 8; ++o) { const int q = rr - o; if (q >= 0 && q < 31) a[o] += wk[q] * uv; } }
#pragma unroll
            for (int o = 0; o < 8; ++o) y[8 * blk + o] = a[o];
        }
        DT_END(13); DT_BEG(14);
        wg_barrier();
#pragma unroll
        for (int tk = 0; tk < 32; ++tk) { P[(2 * tk) * PP + tid] = y[tk].x + y[tk].y; P[(2 * tk + 1) * PP + tid] = y[tk].x * y[tk].x + y[tk].y * y[tk].y; }
        wg_barrier();
        { const int qn = tid >> 3, l8 = tid & 7; float v = 0.f;
#pragma unroll 16
          for (int i2 = 0; i2 < 64; ++i2) v += P[qn * PP + l8 + 8 * i2];
          v += __shfl_xor(v, 1); v += __shfl_xor(v, 2); v += __shfl_xor(v, 4);
          if (l8 == 0) fin[qn] = v; }
        wg_barrier();
        DT_END(14); DT_BEG(15);
#pragma unroll
        for (int tk = 0; tk < 32; ++tk) { const float mean = fin[2 * tk] * (1.0f / D), var = fmaxf(fin[2 * tk + 1] * (1.0f / D) - mean * mean, 0.f), rstd = rsqrtf(var + 1e-5f);
            const float v0 = (y[tk].x - mean) * rstd * lng.x + lnb.x, v1 = (y[tk].y - mean) * rstd * lng.y + lnb.y;
            *(unsigned*)(YC + (size_t)(t0 + tk) * D + 2 * tid) = cvt_pk(v0 * sigmoid_f(v0), v1 * sigmoid_f(v1)); }
        asm volatile("s_waitcnt vmcnt(0)" ::: "memory");
        wg_barrier();
        DT_END(15);
    }
#undef DT_BEG
#undef DT_END
}
__device__ __forceinline__ void p0_mod_task(Frame& F, int task) {
    LAS float* cact = (LAS float*)F.lds; LAS float* part = (LAS float*)(F.lds + 32768);
    const int i = task / 24, n0 = (task % 24) * 256, tid = F.tid, lane = F.lane, w = F.wave;
    for (int q = tid; q < NBATCH * D; q += NTHR) { const float cv = F.in[I_C][q]; cact[q] = cv * sigmoid_f(cv); }
    wg_barrier();
    f32x4 acc[8];
#pragma unroll
    for (int b = 0; b < 8; ++b) acc[b] = (f32x4){0.f, 0.f, 0.f, 0.f};
    const float* Wp = F.in[I_WMOD] + ((size_t)i * D + 128 * w) * (6 * D) + n0 + 4 * lane;
#pragma unroll 4
    for (int k = 0; k < 128; ++k) { const f32x4 wv = __builtin_nontemporal_load((const f32x4*)(Wp + (size_t)k * (6 * D)));
#pragma unroll
        for (int b = 0; b < 8; ++b) acc[b] += wv * cact[b * D + 128 * w + k]; }
#pragma unroll
    for (int b = 0; b < 8; ++b) *(LAS f32x4*)(part + (w * 8 + b) * 256 + 4 * lane) = acc[b];
    wg_barrier();
    float* mod = WSP(float, WS_MOD);
#pragma unroll
    for (int q = 0; q < 4; ++q) { const int o = tid + NTHR * q, b = o >> 8, n = o & 255; float s = F.in[I_BMOD][i * 6 * D + n0 + n];
#pragma unroll
        for (int ww = 0; ww < 8; ++ww) s += part[(ww * 8 + b) * 256 + n];
        mod[((size_t)i * NBATCH + b) * (6 * D) + n0 + n] = s; }
    wg_barrier();
}
struct TItem { const float* W; bf16_t* Dst; int N, paired, kb, nb, f8; };
constexpr int CV_DENSE = 352, CV_MOE = 3072;
__device__ __forceinline__ bool cv_item(Frame& F, int q, int it, TItem& x) {
    if (it < 0) return false;
    if (q == 0) {
        const int NQ = 96, NO = 64, NCI = 128, NCO = 64;
        if (it < NQ) { const int j = it / 48, r = it % 48; x.W = F.in[I_AWQKV] + (size_t)j * D * 1536; x.Dst = WSP(bf16_t, WS_WQKV) + (size_t)j * 1536 * D; x.N = 1536; x.paired = 0; x.f8 = 0; x.kb = r / 6; x.nb = r % 6; return true; } it -= NQ;
        if (it < NO) { const int j = it / 32, r = it % 32; x.W = F.in[I_AWO] + (size_t)j * D * D; x.Dst = WSP(bf16_t, WS_WO) + (size_t)j * D * D; x.N = 1024; x.paired = 0; x.f8 = 0; x.kb = r / 4; x.nb = r % 4; return true; } it -= NO;
        if (it < NCI) { const int j = it / 64, r = it % 64; x.W = F.in[I_CWIN] + (size_t)j * D * 2048; x.Dst = WSP(bf16_t, WS_CWIN) + (size_t)j * 2048 * D; x.N = 2048; x.paired = 1; x.f8 = 0; x.kb = r / 8; x.nb = r % 8; return true; } it -= NCI;
        if (it < NCO) { const int j = it / 32, r = it % 32; x.W = F.in[I_CWOUT] + (size_t)j * D * D; x.Dst = WSP(bf16_t, WS_CWOUT) + (size_t)j * D * D; x.N = 1024; x.paired = 0; x.f8 = 0; x.kb = r / 4; x.nb = r % 4; return true; } it -= NCO;
    }
    if (it < 2048) { const int m = q * NE + it / 64, r = it % 64; x.W = F.in[I_MWIN] + (size_t)m * D * 2048; x.Dst = (bf16_t*)(WSP(unsigned char, WS_MWIN) + (size_t)m * 2048 * D); x.N = 2048; x.paired = 1; x.f8 = 1; x.kb = r / 8; x.nb = r % 8; return true; } it -= 2048;
    if (it < 1024) { const int m = q * NE + it / 32, r = it % 32; x.W = F.in[I_MWOUT] + (size_t)m * D * D; x.Dst = (bf16_t*)(WSP(unsigned char, WS_MWOUT) + (size_t)m * D * D); x.N = 1024; x.paired = 0; x.f8 = 1; x.kb = r / 4; x.nb = r % 4; return true; }
    return false;
}
__device__ __forceinline__ void cv_run(Frame& F, int q, int max_items) {
    if (q > 3 || max_items <= 0) return;
    LAS float* tile = (LAS float*)F.lds;
    volatile LAS int* qslot = (volatile LAS int*)(F.lds + 128 * 257 * 4 + 64);
    const int tid = F.tid, lane = F.lane, w = F.wave; gu32* qc = F.ctl + CW_P0Q + 64 * q;
    int claimed = 1;
    wg_barrier();
    if (tid == 0) qslot[0] = (int)__hip_atomic_fetch_add(qc, 1u, RLX_AGENT);
    wg_barrier();
    int it = qslot[0]; TItem cur; bool valid = cv_item(F, q, it, cur);
    f32x4 rg[16];
    if (valid) {
#pragma unroll
        for (int qq = 0; qq < 16; ++qq) rg[qq] = __builtin_nontemporal_load((const f32x4*)(cur.W + (size_t)(cur.kb * 128 + w * 16 + qq) * cur.N + cur.nb * 256 + 4 * lane)); }
    wg_barrier();
    while (valid) {
        const bool more = claimed < max_items;
        if (tid == 0) qslot[0] = more ? (int)__hip_atomic_fetch_add(qc, 1u, RLX_AGENT) : -1;
        ++claimed;
#pragma unroll
        for (int qq = 0; qq < 16; ++qq) { LAS float* tp = tile + (w * 16 + qq) * 257 + 4 * lane; tp[0] = rg[qq][0]; tp[1] = rg[qq][1]; tp[2] = rg[qq][2]; tp[3] = rg[qq][3]; }
        wg_barrier();
        const int nit = qslot[0]; TItem nx; const bool nvalid = cv_item(F, q, nit, nx);
        if (nvalid) {
#pragma unroll
            for (int qq = 0; qq < 16; ++qq) rg[qq] = __builtin_nontemporal_load((const f32x4*)(nx.W + (size_t)(nx.kb * 128 + w * 16 + qq) * nx.N + nx.nb * 256 + 4 * lane)); }
        const int kc = lane >> 3;
#pragma unroll
        for (int r4 = 0; r4 < 4; ++r4) { const int nl = 32 * w + 8 * r4 + (lane & 7), n = cur.nb * 256 + nl; const LAS float* sp = tile + (16 * kc) * 257 + nl;
            float v[16];
#pragma unroll
            for (int jj = 0; jj < 16; ++jj) v[jj] = sp[jj * 257];
            int nd = n; if (cur.paired) { const int half = n >> 10, rem = n & 1023; nd = ((rem >> 7) << 8) + (half << 7) + (rem & 127); }
            if (cur.f8) { u32x4 o; o.x = cvt_pk4_fp8(v[0] * F8_SW, v[1] * F8_SW, v[2] * F8_SW, v[3] * F8_SW); o.y = cvt_pk4_fp8(v[4] * F8_SW, v[5] * F8_SW, v[6] * F8_SW, v[7] * F8_SW);
                o.z = cvt_pk4_fp8(v[8] * F8_SW, v[9] * F8_SW, v[10] * F8_SW, v[11] * F8_SW); o.w = cvt_pk4_fp8(v[12] * F8_SW, v[13] * F8_SW, v[14] * F8_SW, v[15] * F8_SW);
                __builtin_nontemporal_store(o, (u32x4*)((unsigned char*)cur.Dst + (size_t)nd * D + cur.kb * 128 + 16 * kc)); }
            else { u32x4 o0, o1; o0.x = cvt_pk(v[0], v[1]); o0.y = cvt_pk(v[2], v[3]); o0.z = cvt_pk(v[4], v[5]); o0.w = cvt_pk(v[6], v[7]); o1.x = cvt_pk(v[8], v[9]); o1.y = cvt_pk(v[10], v[11]); o1.z = cvt_pk(v[12], v[13]); o1.w = cvt_pk(v[14], v[15]);
                bf16_t* dp = cur.Dst + (size_t)nd * D + cur.kb * 128 + 16 * kc; __builtin_nontemporal_store(o0, (u32x4*)dp); __builtin_nontemporal_store(o1, (u32x4*)(dp + 8)); } }
        wg_barrier();
        cur = nx; valid = nvalid;
    }
}
#ifndef CV_OVERLAP
#define CV_OVERLAP 1
#endif
__device__ __forceinline__ void p0_phase(Frame& F) {
    for (int task = F.c; task < 96; task += F.G) p0_mod_task(F, task);
    cv_run(F, 0, 1 << 30);
    if (!CV_OVERLAP) { cv_run(F, 1, 1 << 30); cv_run(F, 2, 1 << 30); cv_run(F, 3, 1 << 30); }
}

template <bool GATHER> __device__ __forceinline__ int moe_build_units(Frame& F, int layer, int npn, int total_tiles, int ubase) {
    const LAS int* EX = (const LAS int*)(F.lds + LDS_EXP); LAS int* UT = (LAS int*)(F.lds + LDS_UT); LAS int* TOK = (LAS int*)(F.lds + LDS_TOK);
    const int tps = 32 / npn, nsb = (total_tiles + tps - 1) / tps;
    const bool xcd_ok = (F.G % 256) == 0 || F.G == 256;
    int n = 0;
    if (xcd_ok && F.G == 256) {
        const int x = F.c & 7, jx = F.c >> 3;
        const int mine = x < nsb ? (nsb - x + 7) / 8 : 0; n = mine - ubase; n = n < 0 ? 0 : (n > 9 ? 9 : n);
        if (F.tid < n) { const int q = (ubase + F.tid) * 8 + x, tau = q * tps + (jx % tps), pn = jx / tps; int e = 0;
            if (tau < total_tiles) { for (int qq = 1; qq < 32; ++qq) if (tau >= EX[32 + qq]) e = qq; } else e = -1;
            const int mt = e >= 0 ? tau - EX[32 + e] : 0, om = e >= 0 ? EX[64 + e] + 256 * mt : 0;
            UT[4 * F.tid] = GATHER ? 256 * F.tid : om; UT[4 * F.tid + 1] = om; UT[4 * F.tid + 2] = e; UT[4 * F.tid + 3] = pn; UT[40 + F.tid] = mt; }
    } else {
        const int U = total_tiles * npn; const int mine = F.c < U ? (U - F.c + F.G - 1) / F.G : 0; n = mine - ubase; n = n < 0 ? 0 : (n > 9 ? 9 : n);
        if (F.tid < n) { const int L = F.c + (ubase + F.tid) * F.G, tau = L / npn, pn = L % npn; int e = 0;
            for (int qq = 1; qq < 32; ++qq) if (tau >= EX[32 + qq]) e = qq;
            const int mt = tau - EX[32 + e], om = EX[64 + e] + 256 * mt;
            UT[4 * F.tid] = GATHER ? 256 * F.tid : om; UT[4 * F.tid + 1] = om; UT[4 * F.tid + 2] = e; UT[4 * F.tid + 3] = pn; UT[40 + F.tid] = mt; }
    }
    wg_barrier();
    if (F.tid == 0) { int w = 0; for (int r = 0; r < n; ++r) { if (UT[4 * r + 2] >= 0) { if (w != r) { UT[4 * w] = GATHER ? 256 * w : UT[4 * r]; UT[4 * w + 1] = UT[4 * r + 1]; UT[4 * w + 2] = UT[4 * r + 2]; UT[4 * w + 3] = UT[4 * r + 3]; UT[40 + w] = UT[40 + r]; } ++w; } } UT[60] = w; UT[61] = n; }
    wg_barrier();
    const int nv = UT[60];
    if (GATHER) { const int* LIST = WSP(const int, WS_LIST);
        for (int q = F.tid; q < nv * 256; q += NTHR) { const int ui = q >> 8, rr = q & 255, e = UT[4 * ui + 2], pos = 256 * UT[40 + ui] + rr; TOK[q] = pos < EX[e] ? LIST[(size_t)e * T + pos] : 0; }
        wg_barrier(); }
    return nv | (n << 8);
}

constexpr int N_PHASES = 30;
struct Args { const float* in[27]; float* out; unsigned char* ws; int ph_lo, ph_hi; };
__global__ void __launch_bounds__(NTHR, 2) mega(const Args args) {
    extern __shared__ __attribute__((aligned(16))) unsigned char lds_raw[];
    Frame F; F.lds = (LAS unsigned char*)lds_raw; F.MISC = (volatile LAS unsigned*)(F.lds + LDS_MISC); F.ws = args.ws; F.ctl = (gu32*)(args.ws + WS_CTL);
    F.tid = threadIdx.x; F.lane = F.tid & 63; F.wave = __builtin_amdgcn_readfirstlane(F.tid >> 6); F.G = gridDim.x; F.c = blockIdx.x; F.out = args.out;
    F.in = args.in;
    if (F.tid < 32) F.MISC[F.tid] = 0u;
    __syncthreads();
    const int lo = args.ph_lo, hi = args.ph_hi;
    XcdBarrier bar; bar.bar = (unsigned*)(F.ctl + CW_BAR); bar.x = 0; bar.st = F.MISC + 8;
    if (hi - lo > 1) bar = xcd_barrier_post((unsigned*)(F.ctl + CW_BAR), F.MISC + 8);
#ifndef CVQ_QKV
#define CVQ_QKV 4
#endif
#ifndef CVQ_MOE
#define CVQ_MOE 2
#endif
#ifndef PH_MASK
#define PH_MASK 0xFFFF
#endif
#define IN(k) (lo <= (k) && (k) < hi)
#define HAS(b) (((PH_MASK) >> (b)) & 1)
#define PHASE_ENTER() do { int _t = F.tid; asm volatile("" : "+v"(_t)); F.tid = _t; F.lane = _t & 63; F.wave = __builtin_amdgcn_readfirstlane(_t >> 6); unsigned char* _w = F.ws; asm volatile("" : "+s"(_w)); F.ws = _w; int _g = F.G; asm volatile("" : "+s"(_g)); F.G = _g; } while (0)
    unsigned long long t_acc = 0ull, t_beg = 0ull, g_ticks = 0ull, g_cyc = 0ull;
#define TBEG(kind) do { if (TIME_KIND == (kind)) t_beg = __builtin_amdgcn_s_memrealtime(); } while (0)
#define TEND(kind) do { if (TIME_KIND == (kind)) t_acc += __builtin_amdgcn_s_memrealtime() - t_beg; } while (0)
#define SEAM(k) do { if ((k) + 1 < hi) xcd_barrier(bar); } while (0)
    const LAS int* toktab = (const LAS int*)(F.lds + LDS_TOK);
    if (HAS(0) && IN(0)) { TBEG(0); p0_phase(F); SEAM(0); TEND(0); }
    for (int i = 0; i < DEPTH; ++i) {
        const int pb = 1 + 7 * i, j = i >> 1; const bool conv = (i & 1) != 0;
        const float* modl = WSP(const float, WS_MOD) + (size_t)i * NBATCH * (6 * D);
        if (IN(pb)) { PHASE_ENTER(); TBEG(1); if (i == 0) { if (HAS(1)) row_phase<0>(F, 0); } else { TBEG(7); if (HAS(2)) row_phase<1>(F, i); TEND(7); } SEAM(pb); TEND(1); }
        if (IN(pb + 1)) { PHASE_ENTER(); TBEG(2);
            if (!conv) { if (HAS(3)) { Gemm g{WSP(const bf16_t, WS_H), WSP(const bf16_t, WS_WQKV) + (size_t)j * 1536 * D, D, 0}; DenseOrder S; S.init(1536, F.G, F.c);
                EpiBias16 E{WSP(bf16_t, WS_QKV), 1536, F.in[I_ABQKV] + j * 1536}; gemm_phase<EpiBias16, DenseOrder, false>(F.lds, g, S, E, toktab, F.tid, 40, t_acc, g_ticks, g_cyc);
                if (CV_OVERLAP && (long)F.c + F.G >= 384) cv_run(F, i + 1, CVQ_QKV); } }
            else if (HAS(4)) { Gemm g{WSP(const bf16_t, WS_H), WSP(const bf16_t, WS_CWIN) + (size_t)j * 2048 * D, D, 0}; DenseOrder S; S.init(2048, F.G, F.c);
                EpiPair<0> E{WSP(void, WS_U), F.in[I_CBIN] + j * 2048, 0}; gemm_phase<EpiPair<0>, DenseOrder, false>(F.lds, g, S, E, toktab, F.tid, 50, t_acc, g_ticks, g_cyc); }
            SEAM(pb + 1); TEND(2); }
        if (IN(pb + 2)) { PHASE_ENTER(); TBEG(3); if (!conv) { TBEG(6); if (HAS(5)) attn_phase(F, j); TEND(6); } else { if (HAS(6)) dwconv_phase(F, j, t_acc); TBEG(17); } SEAM(pb + 2); if (conv) TEND(17); TEND(3); }
        if (IN(pb + 3)) { PHASE_ENTER(); TBEG(2); if (HAS(7)) {
            Gemm g{WSP(const bf16_t, WS_AO), (conv ? WSP(const bf16_t, WS_CWOUT) : WSP(const bf16_t, WS_WO)) + (size_t)j * D * D, D, 0}; DenseOrder S; S.init(1024, F.G, F.c);
            const float* bias2 = (conv ? F.in[I_CBOUT] : F.in[I_ABO]) + j * D;
            if (i == 0) { EpiResid<true> E{F.in[I_X], WSP(bf16_t, WS_X), bias2, modl + 2 * D}; gemm_phase<EpiResid<true>, DenseOrder, false>(F.lds, g, S, E, toktab, F.tid, 60, t_acc, g_ticks, g_cyc); }
            else { EpiResid<false> E{WSP(const bf16_t, WS_X), WSP(bf16_t, WS_X), bias2, modl + 2 * D}; gemm_phase<EpiResid<false>, DenseOrder, false>(F.lds, g, S, E, toktab, F.tid, 60, t_acc, g_ticks, g_cyc); } }
            SEAM(pb + 3); TEND(2); }
        if (IN(pb + 4)) { PHASE_ENTER(); TBEG(1); if (CV_OVERLAP && i > 0) cv_run(F, i, 1 << 30); TBEG(8); if (HAS(8)) row_phase<2>(F, i); TEND(8); SEAM(pb + 4); TEND(1); }
        if (IN(pb + 5)) { PHASE_ENTER(); TBEG(4); if (HAS(9)) {
            const int tt = build_exp_tables(F, i);
            Gemm g{WSP(const bf16_t, WS_H), (const bf16_t*)(WSP(const unsigned char, WS_MWIN) + (size_t)i * NE * 2048 * D), D / 2, (size_t)2048 * D / 2};
            EpiPair<1> E{WSP(void, WS_ACT), F.in[I_MBIN] + (size_t)i * NE * 2048, 2048};
            for (int ub = 0;; ub += 9) { const int nn = moe_build_units<true>(F, i, 8, tt, ub); const int n = nn >> 8, nv = nn & 255; if (n == 0) break;
                TableOrder S{(const LAS int*)(F.lds + LDS_UT), nv}; gemm_phase<EpiPair<1>, TableOrder, true, true>(F.lds, g, S, E, toktab, F.tid, 20, t_acc, g_ticks, g_cyc); wg_barrier();
                if (n < 9) { if (CV_OVERLAP && ub + nv < (((tt + 3) / 4) + 7) / 8) cv_run(F, i + 1, CVQ_MOE); break; } } }
            SEAM(pb + 5); TEND(4); }
        if (IN(pb + 6)) { PHASE_ENTER(); TBEG(5); if (HAS(10)) {
            const int tt = build_exp_tables(F, i);
            Gemm g{WSP(const bf16_t, WS_ACT), (const bf16_t*)(WSP(const unsigned char, WS_MWOUT) + (size_t)i * NE * D * D), D / 2, (size_t)D * D / 2};
            EpiMoeOut E{WSP(bf16_t, WS_YS), F.in[I_MBOUT] + (size_t)i * NE * D, WSP(const float, WS_GLIST), (const LAS int*)(F.lds + LDS_EXP + 256)};
            for (int ub = 0;; ub += 9) { const int nn = moe_build_units<false>(F, i, 4, tt, ub); const int n = nn >> 8, nv = nn & 255; if (n == 0) break;
                TableOrder S{(const LAS int*)(F.lds + LDS_UT), nv}; gemm_phase<EpiMoeOut, TableOrder, false, true>(F.lds, g, S, E, toktab, F.tid, 30, t_acc, g_ticks, g_cyc); wg_barrier();
                if (n < 9) { if (CV_OVERLAP && ub + nv < (((tt + 7) / 8) + 7) / 8) cv_run(F, i + 1, CVQ_MOE); break; } } }
            SEAM(pb + 6); TEND(5); }
    }
    if (HAS(11) && IN(29)) { PHASE_ENTER(); TBEG(1); row_phase<5>(F, DEPTH); TEND(1); }
    if (TIME_KIND >= 20 && (TIME_KIND % 10) == 5 && g_ticks > 0) t_acc = (g_cyc * 1000ull) / g_ticks;
    if (TIME_KIND >= 0 && blockIdx.x == 0) { const unsigned long long t0 = __builtin_amdgcn_s_memrealtime(); while (__builtin_amdgcn_s_memrealtime() - t0 < t_acc) __builtin_amdgcn_s_sleep(8); }
#undef IN
#undef SEAM
}

inline void launch_range(void* const* d_in, void* d_out, void* d_ws, int grid, int lo, int hi, hipStream_t stream) {
    Args a{}; for (int i = 0; i < 27; ++i) a.in[i] = (const float*)d_in[i];
    a.out = (float*)d_out; a.ws = (unsigned char*)d_ws; a.ph_lo = lo; a.ph_hi = hi;
    hipLaunchKernelGGL(mega, dim3(grid), dim3(NTHR), LDS_BYTES, stream, a);
}
inline int setup_grid() {
    static int grid = 0;
    if (grid == 0) {
        int dev = 0, cus = 0;
        if (hipGetDevice(&dev) != hipSuccess || hipDeviceGetAttribute(&cus, hipDeviceAttributeMultiprocessorCount, dev) != hipSuccess) { grid = -1; return grid; }
        if (hipFuncSetAttribute((const void*)mega, hipFuncAttributeMaxDynamicSharedMemorySize, LDS_BYTES) != hipSuccess) { grid = -1; return grid; }
        int per_cu = 0; (void)hipOccupancyMaxActiveBlocksPerMultiprocessor(&per_cu, (const void*)mega, NTHR, LDS_BYTES); (void)hipGetLastError();
        if (per_cu < 1) fprintf(stderr, "kernel_launch: occupancy query reports %d blocks per CU\n", per_cu);
        grid = cus;
    }
    return grid;
}
}
#ifndef FAST_LAUNCH_MODE
#define FAST_LAUNCH_MODE 1
#endif
extern "C" void kernel_launch(void* const* d_in, const int* in_sizes, int n_in, void* d_out, int out_size, void* d_ws, size_t ws_size, hipStream_t stream) {
    if (n_in != 27 || out_size != fk::T * fk::D || ws_size < fk::WS_END) { fprintf(stderr, "kernel_launch: unexpected shapes (n_in %d out %d ws %zu)\n", n_in, out_size, ws_size); return; }
    const int grid = fk::setup_grid(); if (grid <= 0) return;
    (void)hipMemsetAsync((char*)d_ws + fk::WS_CTL, 0, fk::CTL_ZERO_BYTES, stream);
#if FAST_LAUNCH_MODE == 1
    fk::launch_range(d_in, d_out, d_ws, grid, 0, fk::N_PHASES, stream);
#else
    for (int k = 0; k < fk::N_PHASES; ++k) fk::launch_range(d_in, d_out, d_ws, grid, k, k + 1, stream);
#endif
}
```

```cpp
#include <hip/hip_runtime.h>
#include <cstdio>
#include <cstdint>
namespace fk {
#define LAS __attribute__((address_space(3)))
#define GAS __attribute__((address_space(1)))
typedef unsigned short bf16_t;
typedef short bf16x8 __attribute__((ext_vector_type(8)));
typedef short s16x4 __attribute__((ext_vector_type(4)));
typedef float f32x4 __attribute__((ext_vector_type(4)));
typedef float f32x2 __attribute__((ext_vector_type(2)));
typedef float f32x16 __attribute__((ext_vector_type(16)));
typedef float f32x8 __attribute__((ext_vector_type(8)));
typedef unsigned u32x4 __attribute__((ext_vector_type(4)));
typedef unsigned u32x2 __attribute__((ext_vector_type(2)));
typedef __bf16 bf16x2_t __attribute__((ext_vector_type(2)));
typedef int v4i __attribute__((ext_vector_type(4)));
typedef int v8i __attribute__((ext_vector_type(8)));
typedef GAS unsigned gu32;
#define RLX_AGENT __ATOMIC_RELAXED, __HIP_MEMORY_SCOPE_AGENT
#define LDS_WAIT() asm volatile("s_waitcnt lgkmcnt(0)" ::: "memory")
#define VM_WAIT() asm volatile("s_waitcnt vmcnt(0)" ::: "memory")

constexpr int T = 16384, D = 1024, SEQ = 2048, NBATCH = 8, NE = 32, DEPTH = 4;
constexpr int NWAVES = 8, NTHR = 512;
constexpr int SLOTCAP = T * 4 + NE * 256;
constexpr float LOG2E = 1.4426950408889634f;

__device__ __forceinline__ unsigned cvt_pk(float lo, float hi) { f32x2 v = {lo, hi}; bf16x2_t b = __builtin_convertvector(v, bf16x2_t); return __builtin_bit_cast(unsigned, b); }
__device__ __forceinline__ float bf_lo(unsigned w) { return __uint_as_float(w << 16); }
__device__ __forceinline__ float bf_hi(unsigned w) { return __uint_as_float(w & 0xffff0000u); }
__device__ __forceinline__ unsigned cvt_pk4_fp8(float a, float b, float c, float d) {
    a = __builtin_amdgcn_fmed3f(a, -448.f, 448.f); b = __builtin_amdgcn_fmed3f(b, -448.f, 448.f); c = __builtin_amdgcn_fmed3f(c, -448.f, 448.f); d = __builtin_amdgcn_fmed3f(d, -448.f, 448.f);
    int w = 0; w = __builtin_amdgcn_cvt_pk_fp8_f32(a, b, w, false); w = __builtin_amdgcn_cvt_pk_fp8_f32(c, d, w, true); return (unsigned)w; }
__device__ __forceinline__ unsigned cvt_pk4_fp8_nc(float a, float b, float c, float d) { int w = 0; w = __builtin_amdgcn_cvt_pk_fp8_f32(a, b, w, false); w = __builtin_amdgcn_cvt_pk_fp8_f32(c, d, w, true); return (unsigned)w; }
constexpr float F8_SH = 8.0f, F8_SW = 64.0f, F8_SACT = 4.0f, F8_SY = 16.0f;
__device__ __forceinline__ f32x4 fp8x4_to_f32(unsigned w) { const f32x2 lo = __builtin_amdgcn_cvt_pk_f32_fp8((int)w, false), hi = __builtin_amdgcn_cvt_pk_f32_fp8((int)w, true); return (f32x4){lo.x, lo.y, hi.x, hi.y}; }
__device__ __forceinline__ float sigmoid_f(float v) { return __builtin_amdgcn_rcpf(1.0f + __builtin_amdgcn_exp2f(-LOG2E * v)); }

constexpr size_t MiB = (size_t)1 << 20;
constexpr size_t WS_CTL = 0, CTL_ZERO_BYTES = 1 * MiB;
constexpr size_t WS_MOD = 1 * MiB;
constexpr size_t WS_WQKV = 2 * MiB;
constexpr size_t WS_WO = 8 * MiB;
constexpr size_t WS_CWIN = 12 * MiB;
constexpr size_t WS_CWOUT = 20 * MiB;
constexpr size_t WS_MWIN = 24 * MiB;
constexpr size_t WS_MWOUT = WS_MWIN + 512 * MiB;
constexpr size_t WS_X = WS_MWOUT + 256 * MiB;
constexpr size_t WS_H = WS_X + 64 * MiB;
constexpr size_t WS_QKV = WS_H + 32 * MiB;
constexpr size_t WS_AO = WS_QKV + 48 * MiB;
constexpr size_t WS_U = WS_AO + 32 * MiB;
constexpr size_t WS_LIST = WS_U + 32 * MiB;
constexpr size_t WS_GLIST = WS_LIST + 2 * MiB;
constexpr size_t WS_TK = WS_GLIST + 2 * MiB;
constexpr size_t WS_ACT = WS_TK + 1 * MiB;
constexpr size_t WS_YS = WS_ACT + 144 * MiB;
constexpr size_t WS_END = WS_YS + 144 * MiB;
constexpr int CW_TMO = 0, CW_P0Q = 64, CW_XC = 1024, CW_LB = 2048, CW_BAR = 4096, CW_CNT = 16384;
#define XCD_BAR_WORDS 3456

constexpr int RING_BYTES = 131072;
constexpr int LDS_TOK = RING_BYTES;
constexpr int LDS_UT = LDS_TOK + 9216;
constexpr int LDS_EXP = LDS_UT + 256;
constexpr int LDS_BYTES = 163840;
constexpr int LDS_MISC = LDS_BYTES - 128;
static_assert(LDS_EXP + 512 <= LDS_MISC, "LDS map");

#define XB_TMO      128
#define XB_XCNT(j)  (256  + 64 * (j))
#define XB_XSUB(j)  (1280 + 64 * (j))
#define XB_XGEN(j)  (2304 + 64 * (j))
#define XB_TOP      3328
#define XB_TOPGEN   3392
#define XB_SPIN_CAP (1u << 18)
__device__ __forceinline__ unsigned xb_ld(unsigned* p)              { return __hip_atomic_load(p, __ATOMIC_RELAXED, __HIP_MEMORY_SCOPE_AGENT); }
__device__ __forceinline__ unsigned xb_add(unsigned* p, unsigned v) { return __hip_atomic_fetch_add(p, v, __ATOMIC_RELAXED, __HIP_MEMORY_SCOPE_AGENT); }
__device__ __forceinline__ unsigned xb_xcc_id() { return (unsigned)__builtin_amdgcn_s_getreg((3 << 11) | 20) & 0xFu; }
#define XB_SPIN(cond, bar) do { unsigned _sp = 0; while (cond) { __builtin_amdgcn_s_sleep(1); \
    if ((++_sp & 255u) == 0u) { if (xb_ld(&(bar)[XB_TMO])) break; if (_sp > XB_SPIN_CAP) { atomicAdd(&(bar)[XB_TMO], 1u); break; } } } } while (0)
struct XcdBarrier { unsigned* bar; unsigned x; volatile LAS unsigned* st; };
__device__ __forceinline__ XcdBarrier xcd_barrier_post(unsigned* bar, volatile LAS unsigned* st) {
    XcdBarrier b; b.bar = bar; b.x = xb_xcc_id(); b.st = st;
    if (threadIdx.x == 0) (void)xb_add(&bar[XB_XCNT(b.x)], 1u);
    return b;
}
__device__ __forceinline__ void xcd_barrier_complete(unsigned* bar, unsigned x, unsigned& nloc, unsigned& nx) {
    const unsigned G = gridDim.x * gridDim.y * gridDim.z;
    unsigned sum, cnt, mine, sp = 0u;
    for (;;) {
        sum = 0u; cnt = 0u; mine = 0u;
#pragma unroll
        for (unsigned j = 0; j < 16; ++j) { const unsigned c = xb_ld(&bar[XB_XCNT(j)]); sum += c; cnt += (c > 0u) ? 1u : 0u; mine = (j == x) ? c : mine; }
        if (sum == G) break;
        __builtin_amdgcn_s_sleep(1);
        if ((++sp & 255u) == 0u) { if (xb_ld(&bar[XB_TMO])) break; if (sp > XB_SPIN_CAP) { atomicAdd(&bar[XB_TMO], 1u); break; } }
    }
    nloc = mine > 0u ? mine : 1u; nx = cnt > 0u ? cnt : 1u;
}
__device__ __forceinline__ void xcd_barrier(const XcdBarrier& b) {
    asm volatile("s_waitcnt vmcnt(0)" ::: "memory");
    __syncthreads();
    if (threadIdx.x == 0) {
        unsigned* bar = b.bar;
        __builtin_amdgcn_s_waitcnt(0);
        unsigned nloc = b.st[0], nx = b.st[1];
        if (nloc == 0u) { xcd_barrier_complete(bar, b.x, nloc, nx); b.st[0] = nloc; b.st[1] = nx; }
        const unsigned old = xb_add(&bar[XB_XSUB(b.x)], 1u);
        const unsigned gen = old / nloc;
        if (old + 1u == (gen + 1u) * nloc) {
            __builtin_amdgcn_fence(__ATOMIC_RELEASE, "agent");
            asm volatile("s_waitcnt vmcnt(0)" ::: "memory");
            const unsigned og = xb_add(&bar[XB_TOP], 1u);
            const unsigned tg = og / nx;
            if (og + 1u == (tg + 1u) * nx) xb_add(&bar[XB_TOPGEN], 1u);
            else XB_SPIN(xb_ld(&bar[XB_TOPGEN]) == tg, bar);
            __builtin_amdgcn_fence(__ATOMIC_ACQUIRE, "agent");
            xb_add(&bar[XB_XGEN(b.x)], 1u);
            asm volatile("s_waitcnt vmcnt(0)" ::: "memory");
        } else {
            XB_SPIN(xb_ld(&bar[XB_XGEN(b.x)]) == gen, bar);
            __builtin_amdgcn_fence(__ATOMIC_ACQUIRE, "agent");
            asm volatile("s_waitcnt vmcnt(0)" ::: "memory");
        }
    }
    __syncthreads();
}

__device__ __forceinline__ void xcc_local_barrier(unsigned* cnt, unsigned nloc, unsigned* tmo) {
    asm volatile("s_waitcnt vmcnt(0)" ::: "memory");
    __syncthreads();
    if (threadIdx.x == 0) {
        const unsigned old = __hip_atomic_fetch_add(cnt, 1u, __ATOMIC_RELAXED, __HIP_MEMORY_SCOPE_AGENT), target = (old / nloc + 1u) * nloc; unsigned sp = 0u;
        while (__hip_atomic_load(cnt, __ATOMIC_RELAXED, __HIP_MEMORY_SCOPE_AGENT) < target) { __builtin_amdgcn_s_sleep(1);
            if ((++sp & 255u) == 0u) { if (__hip_atomic_load(tmo, __ATOMIC_RELAXED, __HIP_MEMORY_SCOPE_AGENT)) break; if (sp > XB_SPIN_CAP) { atomicAdd(tmo, 1u); break; } } }
        __builtin_amdgcn_fence(__ATOMIC_ACQUIRE, "agent");
        asm volatile("s_waitcnt vmcnt(0)" ::: "memory");
    }
    __syncthreads();
}

constexpr int BM = 256, BK = 64, HALF = 128, HTB = HALF * BK * 2, NXCD = 8, WGM = 8;
__host__ __device__ __forceinline__ int lds_byte(int r, int c) { const int st = (r >> 4) * 2 + (c >> 5), rr = r & 15, cc = c & 31, ob = rr * 64 + cc * 2; return st * 1024 + (ob ^ (((ob >> 9) & 1) << 5)); }
__host__ __device__ __forceinline__ void stage_rc(int b, int& R, int& C) { const int st = b / 1024, sb = b % 1024, swz = sb ^ (((sb >> 9) & 1) << 5); R = (st >> 1) * 16 + swz / 64; C = (st & 1) * 32 + (swz % 64) / 2; }
__host__ __device__ __forceinline__ int perm32(int rho) { const int n = rho >> 4, i = rho & 15; return 8 * (i >> 2) + 4 * n + (i & 3); }

struct Unit { int am, om, e, pn; };
struct Gemm { const bf16_t* A; const bf16_t* Bt; int K; size_t b_estride; };

struct DenseOrder {
    int nM, nN, nwg, G, c;
    __device__ void init(int N, int G_, int c_) { nM = T / BM; nN = N / BM; nwg = nM * nN; G = G_; c = c_; }
    __device__ __forceinline__ bool next(int i, Unit& u) const {
        const long L = (long)i * G + c; if (L >= nwg) return false;
        int wgid = (int)L; { const int q = nwg / NXCD, r = nwg % NXCD, xcd = wgid % NXCD, off = wgid / NXCD; wgid = (xcd < r ? xcd * (q + 1) : r * (q + 1) + (xcd - r) * q) + off; }
        const int nig = WGM * nN, gid = wgid / nig, fm = gid * WGM, gsz = (nM - fm) < WGM ? (nM - fm) : WGM;
        const int pm = fm + ((wgid % nig) % gsz); u.pn = (wgid % nig) / gsz; u.am = pm * BM; u.om = pm * BM; u.e = 0; return true;
    }
};
struct TableOrder {
    const LAS int* ut; int n;
    __device__ __forceinline__ bool next(int i, Unit& u) const {
        if (i >= n) return false;
        u.am = __builtin_amdgcn_readfirstlane(ut[4 * i]); u.om = __builtin_amdgcn_readfirstlane(ut[4 * i + 1]); u.e = __builtin_amdgcn_readfirstlane(ut[4 * i + 2]); u.pn = __builtin_amdgcn_readfirstlane(ut[4 * i + 3]); return true;
    }
};

template <class Epi, class Sched, bool GATHER, bool F8 = false>
__device__ __forceinline__ void gemm_phase(LAS unsigned char* lds, const Gemm g, const Sched& S, const Epi& E, const LAS int* toktab, const int tid, const int tkb, unsigned long long& t_acc, unsigned long long& g_ticks, unsigned long long& g_cyc) {
    unsigned long long t_b = 0ull, c_b = 0ull; static_assert(true, "");
#ifndef TIME_KIND
#define TIME_KIND (-1)
#endif
#define GT_BEG(k) do { if (TIME_KIND >= 20 && TIME_KIND == tkb + (k)) t_b = __builtin_amdgcn_s_memrealtime(); if ((k) == 0 && TIME_KIND == tkb + 5) { t_b = __builtin_amdgcn_s_memrealtime(); c_b = __builtin_readcyclecounter(); } } while (0)
#define GT_END(k) do { if (TIME_KIND >= 20 && TIME_KIND == tkb + (k)) t_acc += __builtin_amdgcn_s_memrealtime() - t_b; if ((k) == 0 && TIME_KIND == tkb + 5) { g_ticks += __builtin_amdgcn_s_memrealtime() - t_b; g_cyc += __builtin_readcyclecounter() - c_b; } } while (0)
    const int wid = __builtin_amdgcn_readfirstlane(tid >> 6), lane = tid & 63, wr = wid >> 2, wc = wid & 3, fr = lane & 15, fq = lane >> 4;
    const int K = g.K, nt = K / BK;
    int Rr[2], Cc[2]; unsigned voffB[2];
#pragma unroll
    for (int i = 0; i < 2; ++i) { int R, C; stage_rc(tid * 16 + i * 8192, R, C); Rr[i] = R; Cc[i] = C; const int Rb = Epi::PERM ? ((R & ~31) + perm32(R & 31)) : R; voffB[i] = (unsigned)(Rb * K + C) * 2u; }
    const unsigned ldsw = (unsigned)wid * 1024u;
    const int aoff = lds_byte(wr * 64 + fr, fq * 8), boff = lds_byte(wc * 32 + fr, fq * 8);
#define PG8_SA(b, h) (((b) * 2 + (h)) * HTB)
#define PG8_SB(b, h) ((4 + (b) * 2 + (h)) * HTB)
#ifndef USE_BUFFER_LDS
#define USE_BUFFER_LDS 1
#endif
#if USE_BUFFER_LDS
#define PG8_STAGE(bufoff, rsrc, soff, voff) do { _Pragma("unroll") for (int _i = 0; _i < 2; ++_i) \
        __builtin_amdgcn_raw_ptr_buffer_load_lds(rsrc, (LAS unsigned*)(lds + (bufoff) + ldsw + _i * 8192), 16, (int)(voff)[_i], (int)(soff), 0, 0); } while (0)
#else
#define PG8_STAGE(bufoff, rsrc, soff, voff) do { _Pragma("unroll") for (int _i = 0; _i < 2; ++_i) \
        __builtin_amdgcn_global_load_lds((const unsigned*)((const char*)(rsrc##_base) + (size_t)(soff) + (voff)[_i]), (LAS unsigned*)(lds + (bufoff) + ldsw + _i * 8192), 16, 0, 0); } while (0)
#endif
#define CAT8(l, h) __builtin_shufflevector((l), (h), 0, 1, 2, 3, 4, 5, 6, 7)
#define LO4(x) __builtin_shufflevector((x), (x), 0, 1, 2, 3)
#define HI4(x) __builtin_shufflevector((x), (x), 4, 5, 6, 7)
#define PG8_LDA(dst, b, h) do { _Pragma("unroll") for (int m = 0; m < 4; ++m) dst[m] = CAT8(*(const LAS v4i*)(lds + PG8_SA(b, h) + aoff + m * 2048), *(const LAS v4i*)(lds + PG8_SA(b, h) + aoff + m * 2048 + 1024)); } while (0)
#define PG8_LDB(dst, b, h) do { _Pragma("unroll") for (int n = 0; n < 2; ++n) dst[n] = CAT8(*(const LAS v4i*)(lds + PG8_SB(b, h) + boff + n * 2048), *(const LAS v4i*)(lds + PG8_SB(b, h) + boff + n * 2048 + 1024)); } while (0)
#define PG8_MMA(ai, bj, At, Bt) do { __builtin_amdgcn_s_setprio(1); \
        if constexpr (F8) { _Pragma("unroll") for (int m = 0; m < 4; ++m) { f32x4 _l = LO4(acc8[ai][bj][m]), _h = HI4(acc8[ai][bj][m]); \
            _l = __builtin_amdgcn_mfma_scale_f32_16x16x128_f8f6f4(Bt[0], At[m], _l, 0, 0, 0, 0x7f7f7f7f, 0, 0x7f7f7f7f); \
            _h = __builtin_amdgcn_mfma_scale_f32_16x16x128_f8f6f4(Bt[1], At[m], _h, 0, 0, 0, 0x7f7f7f7f, 0, 0x7f7f7f7f); acc8[ai][bj][m] = CAT8(_l, _h); } \
              \
            asm volatile("" : "+v"(acc8[ai][bj][0]), "+v"(acc8[ai][bj][1]), "+v"(acc8[ai][bj][2]), "+v"(acc8[ai][bj][3])); } \
        else { _Pragma("unroll") for (int m = 0; m < 4; ++m) { f32x4 _l = LO4(acc8[ai][bj][m]), _h = HI4(acc8[ai][bj][m]); \
            _l = __builtin_amdgcn_mfma_f32_16x16x32_bf16(__builtin_bit_cast(bf16x8, LO4(Bt[0])), __builtin_bit_cast(bf16x8, LO4(At[m])), _l, 0, 0, 0); \
            _l = __builtin_amdgcn_mfma_f32_16x16x32_bf16(__builtin_bit_cast(bf16x8, HI4(Bt[0])), __builtin_bit_cast(bf16x8, HI4(At[m])), _l, 0, 0, 0); \
            _h = __builtin_amdgcn_mfma_f32_16x16x32_bf16(__builtin_bit_cast(bf16x8, LO4(Bt[1])), __builtin_bit_cast(bf16x8, LO4(At[m])), _h, 0, 0, 0); \
            _h = __builtin_amdgcn_mfma_f32_16x16x32_bf16(__builtin_bit_cast(bf16x8, HI4(Bt[1])), __builtin_bit_cast(bf16x8, HI4(At[m])), _h, 0, 0, 0); acc8[ai][bj][m] = CAT8(_l, _h); } } \
        __builtin_amdgcn_s_setprio(0); } while (0)
#define PG8_WAIT_V(n) asm volatile("s_waitcnt vmcnt(" #n ")" ::: "memory")
#define PG8_WAIT_L(n) asm volatile("s_waitcnt lgkmcnt(" #n ")" ::: "memory")
#define PG8_BAR __builtin_amdgcn_s_barrier()
#define PG8_SCHED __builtin_amdgcn_sched_barrier(0)
#define A_OFFS(dst, u) do { _Pragma("unroll") for (int _h = 0; _h < 2; ++_h) _Pragma("unroll") for (int _i = 0; _i < 2; ++_i) { \
        const int _row = GATHER ? toktab[(u).am + _h * HALF + Rr[_i]] : ((u).am + _h * HALF + Rr[_i]); dst[_h][_i] = (unsigned)(_row * K + Cc[_i]) * 2u; } } while (0)
    Unit cur, nxt; int ui = 0;
    if (!S.next(0, cur)) return;
    f32x8 acc8[2][2][4];
#pragma unroll
    for (int a = 0; a < 2; ++a)
#pragma unroll
        for (int b = 0; b < 2; ++b)
#pragma unroll
            for (int m = 0; m < 4; ++m) acc8[a][b][m] = (f32x8){0.f, 0.f, 0.f, 0.f, 0.f, 0.f, 0.f, 0.f};
    v8i At[4], B0[2], B1[2];
    unsigned ao[2][2]; A_OFFS(ao, cur);
    const __amdgpu_buffer_rsrc_t rA = __builtin_amdgcn_make_buffer_rsrc((void*)g.A, 0, 0x7fffffff, 0x00020000), rB = __builtin_amdgcn_make_buffer_rsrc((void*)g.Bt, 0, 0x7fffffff, 0x00020000);
    const char* const rA_base = (const char*)g.A; const char* const rB_base = (const char*)g.Bt; (void)rA_base; (void)rB_base;
    const unsigned kstep = (unsigned)(BK * 2), hstep = (unsigned)HALF * K * 2;
    unsigned cB = (unsigned)(((size_t)cur.e * g.b_estride + (size_t)cur.pn * BM * K) * 2);
    PG8_STAGE(PG8_SB(0, 0), rB, cB, voffB); PG8_STAGE(PG8_SB(0, 1), rB, cB + hstep, voffB); PG8_STAGE(PG8_SA(0, 0), rA, 0u, ao[0]); PG8_STAGE(PG8_SA(0, 1), rA, 0u, ao[1]);
    if (wr == 1) PG8_BAR;
    PG8_WAIT_V(2); PG8_BAR;
    PG8_STAGE(PG8_SB(1, 0), rB, cB + kstep, voffB); PG8_STAGE(PG8_SA(1, 0), rA, kstep, ao[0]); PG8_STAGE(PG8_SB(1, 1), rB, cB + hstep + kstep, voffB);
    PG8_WAIT_V(6); PG8_BAR;
    for (;;) {
        const bool has_next = S.next(ui + 1, nxt);
        const unsigned nB = has_next ? (unsigned)(((size_t)nxt.e * g.b_estride + (size_t)nxt.pn * BM * K) * 2) : cB;
        GT_BEG(0);
#pragma unroll 1
        for (int t = 0; t < nt; t += 2) {
            const bool last = (t == nt - 2);
            const unsigned a1 = (unsigned)(t + 1) * kstep;
            const unsigned a2 = last ? 0u : (unsigned)(t + 2) * kstep, b2 = last ? nB : cB + (unsigned)(t + 2) * kstep;
            const unsigned a3 = a2 + kstep, b3 = b2 + kstep;
            unsigned a2o[2][2];
            if (last && has_next) { A_OFFS(a2o, nxt); }
            else {
#pragma unroll
                for (int _h = 0; _h < 2; ++_h)
#pragma unroll
                    for (int _i = 0; _i < 2; ++_i) a2o[_h][_i] = ao[_h][_i]; }
            PG8_LDB(B0, 0, 0); PG8_LDB(B1, 0, 1); PG8_SCHED; PG8_LDA(At, 0, 0); PG8_STAGE(PG8_SA(1, 1), rA, a1, ao[1]);
            PG8_WAIT_V(8); PG8_WAIT_L(0); PG8_BAR; PG8_MMA(0, 0, At, B0); PG8_MMA(0, 1, At, B1); PG8_BAR; PG8_SCHED;
            PG8_LDA(At, 0, 1); PG8_STAGE(PG8_SB(0, 0), rB, b2, voffB); PG8_STAGE(PG8_SB(0, 1), rB, b2 + hstep, voffB); PG8_STAGE(PG8_SA(0, 0), rA, a2, a2o[0]);
            PG8_WAIT_V(8); PG8_WAIT_L(0); PG8_BAR; PG8_MMA(1, 0, At, B0); PG8_MMA(1, 1, At, B1); PG8_BAR; PG8_SCHED;
            PG8_LDB(B0, 1, 0); PG8_LDB(B1, 1, 1); PG8_SCHED; PG8_LDA(At, 1, 0); PG8_STAGE(PG8_SA(0, 1), rA, a2, a2o[1]);
            PG8_WAIT_V(8); PG8_WAIT_L(0); PG8_BAR; PG8_MMA(0, 0, At, B0); PG8_MMA(0, 1, At, B1); PG8_BAR; PG8_SCHED;
            PG8_LDA(At, 1, 1); PG8_STAGE(PG8_SB(1, 0), rB, b3, voffB); PG8_STAGE(PG8_SB(1, 1), rB, b3 + hstep, voffB); PG8_STAGE(PG8_SA(1, 0), rA, a3, a2o[0]);
            PG8_WAIT_V(8); PG8_WAIT_L(0); PG8_BAR; PG8_MMA(1, 0, At, B0); PG8_MMA(1, 1, At, B1); PG8_BAR; PG8_SCHED;
            if (last) {
#pragma unroll
                for (int _h = 0; _h < 2; ++_h)
#pragma unroll
                    for (int _i = 0; _i < 2; ++_i) ao[_h][_i] = a2o[_h][_i]; }
        }
        GT_END(0); GT_BEG(1);
        if (wr == 0) PG8_BAR;
        { f32x4 acc[2][2][4][2];
#pragma unroll
          for (int a = 0; a < 2; ++a)
#pragma unroll
              for (int b = 0; b < 2; ++b)
#pragma unroll
                  for (int m = 0; m < 4; ++m) { acc[a][b][m][0] = LO4(acc8[a][b][m]); acc[a][b][m][1] = HI4(acc8[a][b][m]); }
          E(acc, cur, wr, wc, fr, fq); }
        GT_END(1);
        if (!has_next) break;
#pragma unroll
        for (int a = 0; a < 2; ++a)
#pragma unroll
            for (int b = 0; b < 2; ++b)
#pragma unroll
                for (int m = 0; m < 4; ++m) acc8[a][b][m] = (f32x8){0.f, 0.f, 0.f, 0.f, 0.f, 0.f, 0.f, 0.f};
        cur = nxt; cB = nB; ++ui;
        if (wr == 1) PG8_BAR;
    }
    PG8_WAIT_V(0);
    PG8_BAR;
#undef PG8_SA
#undef PG8_SB
#undef PG8_STAGE
#undef PG8_LDA
#undef PG8_LDB
#undef PG8_MMA
#undef PG8_WAIT_V
#undef PG8_WAIT_L
#undef PG8_BAR
#undef PG8_SCHED
#undef A_OFFS
#undef GT_BEG
#undef GT_END
#undef CAT8
#undef LO4
#undef HI4
}
struct EpiBias16 {
    static constexpr bool PERM = true;
    bf16_t* O; int ldc; const float* bias;
    __device__ __forceinline__ void operator()(const f32x4 (&acc)[2][2][4][2], const Unit& u, int wr, int wc, int fr, int fq) const {
        const int row0 = u.om + wr * 64 + fr, col0 = u.pn * BM + wc * 32 + 8 * fq;
        f32x4 bv[2][2];
#pragma unroll
        for (int bj = 0; bj < 2; ++bj)
#pragma unroll
            for (int n = 0; n < 2; ++n) bv[bj][n] = *(const f32x4*)(bias + col0 + bj * HALF + 4 * n);
#pragma unroll
        for (int ai = 0; ai < 2; ++ai)
#pragma unroll
            for (int m = 0; m < 4; ++m) { bf16_t* rowp = O + (size_t)(row0 + ai * HALF + m * 16) * ldc + col0;
#pragma unroll
                for (int bj = 0; bj < 2; ++bj) { const f32x4 v0 = acc[ai][bj][m][0] + bv[bj][0], v1 = acc[ai][bj][m][1] + bv[bj][1];
                    u32x4 w; w.x = cvt_pk(v0[0], v0[1]); w.y = cvt_pk(v0[2], v0[3]); w.z = cvt_pk(v1[0], v1[1]); w.w = cvt_pk(v1[2], v1[3]);
                    *(u32x4*)(rowp + bj * HALF) = w; } }
    }
};
template <bool XF32> struct EpiResid {
    static constexpr bool PERM = true;
    const void* Xin; bf16_t* X; const float* bias; const float* gate;
    __device__ __forceinline__ void operator()(const f32x4 (&acc)[2][2][4][2], const Unit& u, int wr, int wc, int fr, int fq) const {
        const int row0 = u.om + wr * 64 + fr, col0 = u.pn * BM + wc * 32 + 8 * fq; const float* gb = gate + (size_t)(u.om / SEQ) * (6 * D);
        f32x4 bv[2][2], gv[2][2];
#pragma unroll
        for (int bj = 0; bj < 2; ++bj)
#pragma unroll
            for (int n = 0; n < 2; ++n) { bv[bj][n] = *(const f32x4*)(bias + col0 + bj * HALF + 4 * n); gv[bj][n] = *(const f32x4*)(gb + col0 + bj * HALF + 4 * n); }
#pragma unroll
        for (int ai = 0; ai < 2; ++ai)
#pragma unroll
            for (int m = 0; m < 4; ++m) { const size_t off = (size_t)(row0 + ai * HALF + m * 16) * D + col0;
#pragma unroll
                for (int bj = 0; bj < 2; ++bj) { f32x4 x0, x1;
                    if (XF32) { x0 = *(const f32x4*)((const float*)Xin + off + bj * HALF); x1 = *(const f32x4*)((const float*)Xin + off + bj * HALF + 4); }
                    else { const u32x4 xb = *(const u32x4*)((const bf16_t*)Xin + off + bj * HALF); x0 = (f32x4){bf_lo(xb.x), bf_hi(xb.x), bf_lo(xb.y), bf_hi(xb.y)}; x1 = (f32x4){bf_lo(xb.z), bf_hi(xb.z), bf_lo(xb.w), bf_hi(xb.w)}; }
                    const f32x4 v0 = x0 + gv[bj][0] * (acc[ai][bj][m][0] + bv[bj][0]), v1 = x1 + gv[bj][1] * (acc[ai][bj][m][1] + bv[bj][1]);
                    u32x4 w; w.x = cvt_pk(v0[0], v0[1]); w.y = cvt_pk(v0[2], v0[3]); w.z = cvt_pk(v1[0], v1[1]); w.w = cvt_pk(v1[2], v1[3]);
                    *(u32x4*)(X + off + bj * HALF) = w; }
                asm volatile("" ::: "memory"); }
    }
};
template <int MODE> struct EpiPair {
    static constexpr bool PERM = true;
    void* O; const float* bias; int b_estride;
    __device__ __forceinline__ void operator()(const f32x4 (&acc)[2][2][4][2], const Unit& u, int wr, int wc, int fr, int fq) const {
        const int row0 = u.om + wr * 64 + fr, col0 = u.pn * HALF + wc * 32 + 8 * fq; const float* bb = bias + (size_t)u.e * b_estride;
        constexpr float ASC = MODE == 1 ? 1.0f / (F8_SH * F8_SW) : 1.0f;
        f32x4 bv[2][2];
#pragma unroll
        for (int bj = 0; bj < 2; ++bj)
#pragma unroll
            for (int n = 0; n < 2; ++n) bv[bj][n] = *(const f32x4*)(bb + bj * D + col0 + 4 * n);
#pragma unroll
        for (int ai = 0; ai < 2; ++ai)
#pragma unroll
            for (int m = 0; m < 4; ++m) { float r[8];
#pragma unroll
                for (int n = 0; n < 2; ++n) { const f32x4 a = acc[ai][0][m][n] * ASC + bv[0][n], g = acc[ai][1][m][n] * ASC + bv[1][n];
#pragma unroll
                    for (int jp = 0; jp < 2; ++jp) {
                        f32x2 av = (f32x2){a[2 * jp], a[2 * jp + 1]}, gv = (f32x2){g[2 * jp], g[2 * jp + 1]}, o;
                        if (MODE == 0) { const f32x2 x = gv * (-LOG2E); f32x2 e; e.x = __builtin_amdgcn_exp2f(x.x); e.y = __builtin_amdgcn_exp2f(x.y); const f32x2 d = e + 1.0f;
                            f32x2 rc; rc.x = __builtin_amdgcn_rcpf(d.x); rc.y = __builtin_amdgcn_rcpf(d.y); o = av * rc; }
                        else { f32x2 glu, lin; glu.x = fminf(av.x, 7.0f); glu.y = fminf(av.y, 7.0f); lin.x = __builtin_amdgcn_fmed3f(gv.x, -7.0f, 7.0f); lin.y = __builtin_amdgcn_fmed3f(gv.y, -7.0f, 7.0f);
                            const f32x2 x = glu * (-1.702f * LOG2E); f32x2 e; e.x = __builtin_amdgcn_exp2f(x.x); e.y = __builtin_amdgcn_exp2f(x.y); const f32x2 d = e + 1.0f;
                            f32x2 rc; rc.x = __builtin_amdgcn_rcpf(d.x); rc.y = __builtin_amdgcn_rcpf(d.y); o = (glu * rc) * (lin * F8_SACT + F8_SACT); }
                        r[4 * n + 2 * jp] = o.x; r[4 * n + 2 * jp + 1] = o.y; } }
                if (MODE == 0) { bf16_t* rowp = (bf16_t*)O + (size_t)(row0 + ai * HALF + m * 16) * D + col0;
                    u32x4 w; w.x = cvt_pk(r[0], r[1]); w.y = cvt_pk(r[2], r[3]); w.z = cvt_pk(r[4], r[5]); w.w = cvt_pk(r[6], r[7]); *(u32x4*)rowp = w; }
                else { unsigned char* rowp = (unsigned char*)O + (size_t)(row0 + ai * HALF + m * 16) * D + col0;
                    u32x2 w; w.x = cvt_pk4_fp8_nc(r[0], r[1], r[2], r[3]); w.y = cvt_pk4_fp8_nc(r[4], r[5], r[6], r[7]); *(u32x2*)rowp = w; } }
    }
};
struct EpiMoeOut {
    static constexpr bool PERM = true;
    bf16_t* O; const float* bias; const float* gl; const LAS int* exoff;
    __device__ __forceinline__ void operator()(const f32x4 (&acc)[2][2][4][2], const Unit& u, int wr, int wc, int fr, int fq) const {
        const int row0 = u.om + wr * 64 + fr, col0 = u.pn * BM + wc * 32 + 8 * fq; const float* bb = bias + (size_t)u.e * D;
        const GAS float* gp = (const GAS float*)(gl + (size_t)u.e * T + (u.om - exoff[u.e]) + wr * 64 + fr);
        f32x4 bv[2][2]; float gt[2][4];
#pragma unroll
        for (int ai = 0; ai < 2; ++ai)
#pragma unroll
            for (int m = 0; m < 4; ++m) gt[ai][m] = gp[ai * HALF + m * 16];
#pragma unroll
        for (int bj = 0; bj < 2; ++bj)
#pragma unroll
            for (int n = 0; n < 2; ++n) bv[bj][n] = *(const GAS f32x4*)(bb + col0 + bj * HALF + 4 * n);
#pragma unroll
        for (int ai = 0; ai < 2; ++ai)
#pragma unroll
            for (int m = 0; m < 4; ++m) { GAS unsigned char* rowp = (GAS unsigned char*)O + (size_t)(row0 + ai * HALF + m * 16) * D + col0; const float g16 = gt[ai][m] * F8_SY;
#pragma unroll
                for (int bj = 0; bj < 2; ++bj) { const f32x4 v0 = (acc[ai][bj][m][0] * (1.0f / (F8_SACT * F8_SW)) + bv[bj][0]) * g16, v1 = (acc[ai][bj][m][1] * (1.0f / (F8_SACT * F8_SW)) + bv[bj][1]) * g16;
                    u32x2 w; w.x = cvt_pk4_fp8(v0[0], v0[1], v0[2], v0[3]); w.y = cvt_pk4_fp8(v1[0], v1[1], v1[2], v1[3]);
                    *(GAS u32x2*)(rowp + bj * HALF) = w; } }
    }
};

struct Frame {
    LAS unsigned char* lds; volatile LAS unsigned* MISC; gu32* ctl; unsigned char* ws;
    int tid, lane, wave, G, c;
    int xcc, rank, loc;
    const float* const* in;
    float* out;
};
enum { I_X = 0, I_C, I_WMOD, I_BMOD, I_NMG, I_NFG, I_AWQKV, I_ABQKV, I_AWO, I_ABO, I_SINK, I_RELB, I_CWIN, I_CBIN, I_CWDW, I_CBDW, I_CLNG, I_CLNB, I_CWOUT, I_CBOUT, I_RW, I_RB, I_MWIN, I_MBIN, I_MWOUT, I_MBOUT, I_FNG };
#define WSP(type, off) ((type*)(F.ws + (off)))
__device__ __forceinline__ void wg_barrier() { __syncthreads(); }

__device__ __forceinline__ int build_exp_tables(Frame& F, int layer) {
    LAS int* EX = (LAS int*)(F.lds + LDS_EXP);
    if (F.tid < 64) {
        const int e = F.tid & 31; const int cnt = (int)__hip_atomic_load(F.ctl + CW_CNT + 64 * layer + e, RLX_AGENT); const int tiles = (cnt + 255) >> 8;
        int pre = tiles;
#pragma unroll
        for (int o = 1; o < 32; o <<= 1) { const int v = __shfl_up(pre, o, 32); if (e >= o) pre += v; }
        if (F.tid < 32) { EX[e] = cnt; EX[32 + e] = pre - tiles; EX[64 + e] = (pre - tiles) * 256; if (e == 31) EX[96] = pre; }
    }
    wg_barrier();
    return EX[96];
}
template <int MODE> __device__ __forceinline__ void row_phase(Frame& F, int layer) {
    constexpr bool COMB = (MODE & 1) != 0, ROUT = (MODE & 2) != 0, FIN = (MODE & 4) != 0;
    LAS float* red = (LAS float*)(F.lds); LAS float* part = (LAS float*)(F.lds + 49152); LAS float* lg = (LAS float*)(F.lds + 49152 + 65536);
    LAS int* hist = (LAS int*)(F.lds + 4608); LAS int* gbase = hist + 32; LAS int* pend = (LAS int*)(F.lds + 8192);
    const LAS int* EX = (const LAS int*)(F.lds + LDS_EXP);
    const int lane = F.lane, w = F.wave, row = lane & 15, kq = lane >> 4;
    constexpr int KS = (MODE & 2) ? 32 : 8;
    const int kb = (MODE & 2) ? 128 * w + 8 * kq : 128 * w + 32 * kq;
    constexpr bool XF32 = (MODE == 0);
    const float* xin = F.in[I_X]; bf16_t* X = WSP(bf16_t, WS_X); bf16_t* H = WSP(bf16_t, WS_H);
    const float* mod = WSP(const float, WS_MOD);
    const float* gamma = FIN ? F.in[I_FNG] : (ROUT ? F.in[I_NFG] + layer * D : F.in[I_NMG] + layer * D);
    const int ngrp = T / 16; int g0 = (int)((long)F.c * ngrp / F.G), g1 = (int)((long)(F.c + 1) * ngrp / F.G);
    if (F.loc) { g0 = F.xcc * (SEQ / 16) + 4 * F.rank; g1 = g0 + 4; }
    if (COMB) build_exp_tables(F, layer - 1);
    if (ROUT) { if (F.tid < 32) hist[F.tid] = 0; }
    bf16x8 whi[2][4], wlo[2][4];
    if (ROUT) {
        const float* wrp = F.in[I_RW] + (size_t)layer * D * NE;
#pragma unroll
        for (int eh = 0; eh < 2; ++eh)
#pragma unroll
            for (int s = 0; s < 4; ++s) { float v[8];
#pragma unroll
                for (int j = 0; j < 8; ++j) v[j] = wrp[(size_t)(kb + 32 * s + j) * NE + 16 * eh + row];
                u32x4 hi, lo;
#pragma unroll
                for (int p = 0; p < 4; ++p) { const unsigned h2 = cvt_pk(v[2 * p], v[2 * p + 1]); hi[p] = h2; lo[p] = cvt_pk(v[2 * p] - bf_lo(h2), v[2 * p + 1] - bf_hi(h2)); }
                whi[eh][s] = __builtin_bit_cast(bf16x8, hi); wlo[eh][s] = __builtin_bit_cast(bf16x8, lo); }
    }
    LAS float* Gl = (LAS float*)(F.lds + 32768); LAS float* Sl = Gl + D; LAS float* Fl = Sl + D;
    constexpr int GU = (XF32 || ROUT) ? 2 : 4;
#define UNPK0(v) ((f32x4){bf_lo((v).x), bf_hi((v).x), bf_lo((v).y), bf_hi((v).y)})
#define UNPK1(v) ((f32x4){bf_lo((v).z), bf_hi((v).z), bf_lo((v).w), bf_hi((v).w)})
    int curb = -1;
    for (int grp0 = g0; grp0 < g1; grp0 += GU) {
        const int b = (grp0 * 16) / SEQ, par = ((grp0 - g0) / GU) & 1;
        if (b != curb) { curb = b;
            const float* mb = mod + ((size_t)layer * NBATCH + b) * (6 * D);
            wg_barrier();
            for (int k = F.tid; k < D; k += NTHR) { const float gm = gamma[k];
                if (FIN) { Gl[k] = gm; Sl[k] = 0.f; }
                else { const float* shp = mb + (ROUT ? 3 * D : 0); const float* scp = mb + (ROUT ? 4 * D : D); Gl[k] = gm * (scp[k] + 1.0f); Sl[k] = shp[k]; }
                if (COMB) { const float* gf = mod + ((size_t)(layer - 1) * NBATCH + b) * (6 * D) + 5 * D; Fl[k] = gf[k]; } }
            wg_barrier();
        }
        u32x4 xb[GU][4]; int tks[GU][4];
#pragma unroll
        for (int u = 0; u < GU; ++u) { const int t = (grp0 + u < g1 ? grp0 + u : g1 - 1) * 16 + row;
            if (COMB) { const int* TK = WSP(const int, WS_TK);
#pragma unroll
                for (int kk = 0; kk < 4; ++kk) tks[u][kk] = TK[t * 4 + kk]; }
#pragma unroll
            for (int s = 0; s < 4; ++s) {
                if (XF32) { const f32x4 x0 = *(const f32x4*)(xin + (size_t)t * D + kb + KS * s), x1 = *(const f32x4*)(xin + (size_t)t * D + kb + KS * s + 4);
                    xb[u][s].x = cvt_pk(x0[0], x0[1]); xb[u][s].y = cvt_pk(x0[2], x0[3]); xb[u][s].z = cvt_pk(x1[0], x1[1]); xb[u][s].w = cvt_pk(x1[2], x1[3]); }
                else xb[u][s] = *(const u32x4*)(X + (size_t)t * D + kb + KS * s); } }
        if (COMB) {
            const unsigned char* YS = WSP(const unsigned char, WS_YS);
#pragma unroll
            for (int u = 0; u < GU; ++u) { const int t = (grp0 + u < g1 ? grp0 + u : g1 - 1) * 16 + row;
                size_t yoff[4];
#pragma unroll
                for (int kk = 0; kk < 4; ++kk) { const int tk = tks[u][kk]; yoff[kk] = (size_t)(EX[64 + (tk >> 16)] + (tk & 0xffff)) * D + kb; }
                u32x2 yv[4][4];
#pragma unroll
                for (int s = 0; s < 4; ++s)
#pragma unroll
                    for (int kk = 0; kk < 4; ++kk) yv[s][kk] = *(const u32x2*)(YS + yoff[kk] + KS * s);
#pragma unroll
                for (int s = 0; s < 4; ++s) { f32x4 a0 = (f32x4){0.f, 0.f, 0.f, 0.f}, a1 = a0;
#pragma unroll
                    for (int kk = 0; kk < 4; ++kk) { a0 += fp8x4_to_f32(yv[s][kk].x); a1 += fp8x4_to_f32(yv[s][kk].y); }
                    const f32x4 x0 = UNPK0(xb[u][s]) + *(const LAS f32x4*)(Fl + kb + KS * s) * a0 * (1.0f / F8_SY), x1 = UNPK1(xb[u][s]) + *(const LAS f32x4*)(Fl + kb + KS * s + 4) * a1 * (1.0f / F8_SY);
                    xb[u][s].x = cvt_pk(x0[0], x0[1]); xb[u][s].y = cvt_pk(x0[2], x0[3]); xb[u][s].z = cvt_pk(x1[0], x1[1]); xb[u][s].w = cvt_pk(x1[2], x1[3]);
                    if (!FIN && grp0 + u < g1) *(u32x4*)(X + (size_t)t * D + kb + KS * s) = xb[u][s]; } }
        }
#pragma unroll
        for (int u = 0; u < GU; ++u) { float ss = 0.f;
#pragma unroll
            for (int s = 0; s < 4; ++s) { const f32x4 v0 = UNPK0(xb[u][s]), v1 = UNPK1(xb[u][s]); ss += (v0[0] * v0[0] + v0[1] * v0[1]) + (v0[2] * v0[2] + v0[3] * v0[3]) + (v1[0] * v1[0] + v1[1] * v1[1]) + (v1[2] * v1[2] + v1[3] * v1[3]); }
            ss += __shfl_xor(ss, 16); ss += __shfl_xor(ss, 32);
            if (kq == 0) red[(par * GU + u) * 128 + w * 16 + row] = ss; }
        wg_barrier();
        f32x4 acc[GU][2];
#pragma unroll
        for (int u = 0; u < GU; ++u) { const int t = (grp0 + u < g1 ? grp0 + u : g1 - 1) * 16 + row; const bool live = grp0 + u < g1;
            float tot = 0.f;
#pragma unroll
            for (int ww = 0; ww < 8; ++ww) tot += red[(par * GU + u) * 128 + ww * 16 + row];
            const float rstd = rsqrtf(tot * (1.0f / D) + 1e-5f);
            acc[u][0] = (f32x4){0.f, 0.f, 0.f, 0.f}; acc[u][1] = acc[u][0];
#pragma unroll
            for (int s = 0; s < 4; ++s) {
                const f32x4 h0 = UNPK0(xb[u][s]) * rstd * *(const LAS f32x4*)(Gl + kb + KS * s) + *(const LAS f32x4*)(Sl + kb + KS * s), h1 = UNPK1(xb[u][s]) * rstd * *(const LAS f32x4*)(Gl + kb + KS * s + 4) + *(const LAS f32x4*)(Sl + kb + KS * s + 4);
                if (FIN) { if (live) { *(f32x4*)(F.out + (size_t)t * D + kb + KS * s) = h0; *(f32x4*)(F.out + (size_t)t * D + kb + KS * s + 4) = h1; } }
                else {
                    u32x4 hi; hi.x = cvt_pk(h0[0], h0[1]); hi.y = cvt_pk(h0[2], h0[3]); hi.z = cvt_pk(h1[0], h1[1]); hi.w = cvt_pk(h1[2], h1[3]);
                    if (!ROUT) { if (live) *(u32x4*)(H + (size_t)t * D + kb + KS * s) = hi; }
                    else { u32x2 q8; q8.x = cvt_pk4_fp8(h0[0] * F8_SH, h0[1] * F8_SH, h0[2] * F8_SH, h0[3] * F8_SH); q8.y = cvt_pk4_fp8(h1[0] * F8_SH, h1[1] * F8_SH, h1[2] * F8_SH, h1[3] * F8_SH);
                        if (live) *(u32x2*)((unsigned char*)H + (size_t)t * D + kb + KS * s) = q8; }
                    if (ROUT) {
                        u32x4 lo; lo.x = cvt_pk(h0[0] - bf_lo(hi.x), h0[1] - bf_hi(hi.x)); lo.y = cvt_pk(h0[2] - bf_lo(hi.y), h0[3] - bf_hi(hi.y));
                        lo.z = cvt_pk(h1[0] - bf_lo(hi.z), h1[1] - bf_hi(hi.z)); lo.w = cvt_pk(h1[2] - bf_lo(hi.w), h1[3] - bf_hi(hi.w));
                        const bf16x8 ah = __builtin_bit_cast(bf16x8, hi), al = __builtin_bit_cast(bf16x8, lo);
#pragma unroll
                        for (int eh = 0; eh < 2; ++eh) {
                            acc[u][eh] = __builtin_amdgcn_mfma_f32_16x16x32_bf16(ah, whi[eh][s], acc[u][eh], 0, 0, 0);
                            acc[u][eh] = __builtin_amdgcn_mfma_f32_16x16x32_bf16(ah, wlo[eh][s], acc[u][eh], 0, 0, 0);
                            acc[u][eh] = __builtin_amdgcn_mfma_f32_16x16x32_bf16(al, whi[eh][s], acc[u][eh], 0, 0, 0); }
                    }
                }
            }
        }
        if (ROUT) {
#pragma unroll
            for (int u = 0; u < GU; ++u)
#pragma unroll
                for (int eh = 0; eh < 2; ++eh)
#pragma unroll
                    for (int i = 0; i < 4; ++i) part[((u * 8 + w) * 16 + 4 * kq + i) * 32 + 16 * eh + row] = acc[u][eh][i];
            wg_barrier();
#pragma unroll
            for (int u = 0; u < GU; ++u) { const int r = F.tid >> 5, e = F.tid & 31; float v = F.in[I_RB][layer * NE + e];
#pragma unroll
                for (int ww = 0; ww < 8; ++ww) v += part[((u * 8 + ww) * 16 + r) * 32 + e];
                lg[(u * 16 + r) * 32 + e] = v; }
            wg_barrier();
            if (F.tid < 16 * GU && grp0 + (F.tid >> 4) < g1) {
                const int u = F.tid >> 4, r = F.tid & 15; unsigned used = 0u; int ids[4]; float vals[4];
#pragma unroll
                for (int k = 0; k < 4; ++k) { int bi = 0; float bv = -3.0e38f;
                    for (int e = 0; e < 32; ++e) { const float v = lg[(u * 16 + r) * 32 + e]; if (!((used >> e) & 1u) && v > bv) { bv = v; bi = e; } }
                    used |= 1u << bi; ids[k] = bi; vals[k] = bv; }
                const float e1 = __expf(vals[1] - vals[0]), e2 = __expf(vals[2] - vals[0]), e3 = __expf(vals[3] - vals[0]), inv = 1.0f / (1.0f + e1 + e2 + e3);
                const float gs[4] = {inv, e1 * inv, e2 * inv, e3 * inv};
#pragma unroll
                for (int k = 0; k < 4; ++k) { const int lp = atomicAdd((int*)&hist[ids[k]], 1); const int idx = ((grp0 + u - g0) * 16 + r) * 4 + k; pend[2 * idx] = ids[k] | (lp << 8); pend[2 * idx + 1] = __float_as_int(gs[k]); }
            }
        }
    }
#undef UNPK0
#undef UNPK1
    if (ROUT) {
        wg_barrier();
        if (F.tid < 32) { const int n = hist[F.tid]; gbase[F.tid] = n > 0 ? (int)__hip_atomic_fetch_add(F.ctl + CW_CNT + 64 * layer + F.tid, (unsigned)n, RLX_AGENT) : 0; }
        wg_barrier();
        int* LIST = WSP(int, WS_LIST); float* GL = WSP(float, WS_GLIST); int* TK = WSP(int, WS_TK);
        const int nent = (g1 - g0) * 64;
        for (int idx = F.tid; idx < nent; idx += NTHR) { const int pw = pend[2 * idx], e = pw & 0xff, pos = gbase[e] + (pw >> 8), tok = g0 * 16 + (idx >> 2);
            LIST[(size_t)e * T + pos] = tok; GL[(size_t)e * T + pos] = __int_as_float(pend[2 * idx + 1]); TK[tok * 4 + (idx & 3)] = (e << 16) | pos; }
    }
    wg_barrier();
}
__device__ const unsigned char kBucket[128] = {0, 1, 2, 3, 4, 5, 6, 7, 8, 9, 10, 11, 12, 13, 14, 15, 16, 16, 16, 17, 17, 18, 18, 18, 19, 19, 19, 20, 20, 20, 20, 21, 21, 21, 21, 22, 22, 22, 22, 22, 23, 23, 23, 23, 23, 23, 24, 24, 24, 24, 24, 24, 25, 25, 25, 25, 25, 25, 25, 26, 26, 26, 26, 26, 26, 26, 26, 27, 27, 27, 27, 27, 27, 27, 27, 27, 27, 28, 28, 28, 28, 28, 28, 28, 28, 28, 28, 29, 29, 29, 29, 29, 29, 29, 29, 29, 29, 29, 29, 30, 30, 30, 30, 30, 30, 30, 30, 30, 30, 30, 30, 30, 30, 31, 31, 31, 31, 31, 31, 31, 31, 31, 31, 31, 31, 31, 31, 31};
constexpr int KP = 144, VP = 192;
constexpr int ATT_K = 0, ATT_V = 256 * KP, ATT_B = ATT_V + 256 * VP;
__device__ __forceinline__ int crow(int r, int hi) { return (r & 3) + 8 * (r >> 2) + 4 * hi; }
typedef short v4i16_t __attribute__((ext_vector_type(4)));
__device__ __forceinline__ s16x4 vtr(const LAS unsigned char* p) { return __builtin_bit_cast(s16x4, __builtin_amdgcn_ds_read_tr16_b64_v4i16((LAS v4i16_t*)p)); }

__device__ __forceinline__ void attn_phase(Frame& F, int j) {
    const bf16_t* QKV = WSP(const bf16_t, WS_QKV); bf16_t* AO = WSP(bf16_t, WS_AO);
    LAS unsigned char* Kl = F.lds + ATT_K; LAS unsigned char* Vl = F.lds + ATT_V; LAS float* Bl = (LAS float*)(F.lds + ATT_B);
    const int lane = F.lane, w = F.wave, r = lane & 31, hh = lane >> 5;
    const float c1 = 0.125f * LOG2E;
    const int u_beg = F.loc ? F.xcc * 64 + F.rank : F.c, u_step = F.loc ? 32 : F.G, u_end = F.loc ? F.xcc * 64 + 64 : NBATCH * 16 * 4;
    for (int unit = u_beg; unit < u_end; unit += u_step) {
        const int kvh = unit & 3, n = (unit >> 2) & 15, b = unit >> 6;
        const int krow0 = b * SEQ + (n > 0 ? (n - 1) * 128 : 0);
#pragma unroll
        for (int it = 0; it < 4; ++it) { const int ch = F.tid + NTHR * it, s = ch >> 3, c8 = ch & 7;
            const int grow = (n > 0 || s >= 128) ? (b * SEQ + (n - 1) * 128 + s) : (krow0 + s);
            const u32x4 kv = *(const u32x4*)(QKV + (size_t)grow * 1536 + 1024 + kvh * 64 + 8 * c8); const u32x4 vv = *(const u32x4*)(QKV + (size_t)grow * 1536 + 1280 + kvh * 64 + 8 * c8);
            *(LAS u32x4*)(Kl + s * KP + 16 * c8) = kv; *(LAS u32x4*)(Vl + s * VP + 16 * c8) = vv; }
        { const int g = F.tid >> 7, dist = F.tid & 127; Bl[F.tid] = F.in[I_RELB][kBucket[dist] * 16 + kvh * 4 + g] * LOG2E; }
        wg_barrier();
        const int g = w >> 1, hq = kvh * 4 + g; const float sink2 = F.in[I_SINK][j * 16 + hq] * LOG2E;
#pragma unroll 1
        for (int grp = 0; grp < 2; ++grp) {
            const int a0 = (w & 1) * 64 + grp * 32, a = a0 + r; const size_t tok = (size_t)b * SEQ + n * 128 + a;
            bf16x8 qf[4];
#pragma unroll
            for (int d0 = 0; d0 < 4; ++d0) qf[d0] = *(const bf16x8*)(QKV + tok * 1536 + hq * 64 + 16 * d0 + 8 * hh);
            const int kt0 = a0 >> 5;
            f32x16 S[5];
#pragma unroll
            for (int t = 0; t < 5; ++t) {
#pragma unroll
                for (int i = 0; i < 16; ++i) S[t][i] = 0.f;
                const LAS unsigned char* kp = Kl + (32 * (kt0 + t) + r) * KP + 16 * hh;
#pragma unroll
                for (int d0 = 0; d0 < 4; ++d0) { const bf16x8 kf = *(const LAS bf16x8*)(kp + 32 * d0); S[t] = __builtin_amdgcn_mfma_f32_32x32x16_bf16(kf, qf[d0], S[t], 0, 0, 0); }
            }
            float m = sink2;
#pragma unroll
            for (int t = 0; t < 5; ++t)
#pragma unroll
                for (int i = 0; i < 16; ++i) { const int s = 32 * (kt0 + t) + crow(i, hh), dist = a + 128 - s; const bool ok = (dist >= 0) && (dist < 128) && (n > 0 || s >= 128);
                    const float v = ok ? S[t][i] * c1 + Bl[g * 128 + (dist & 127)] : -3.0e38f; S[t][i] = v; m = fmaxf(m, v); }
            m = fmaxf(m, __shfl_xor(m, 32));
            float l = 0.f;
#pragma unroll
            for (int t = 0; t < 5; ++t)
#pragma unroll
                for (int i = 0; i < 16; ++i) { const float p = __builtin_amdgcn_exp2f(S[t][i] - m); S[t][i] = p; l += p; }
            l += __shfl_xor(l, 32); l += __builtin_amdgcn_exp2f(sink2 - m);
            f32x16 O[2];
#pragma unroll
            for (int i = 0; i < 16; ++i) { O[0][i] = 0.f; O[1][i] = 0.f; }
            const int q4 = (lane >> 2) & 3, p4 = lane & 3, blk = (lane >> 4) & 1;
#pragma unroll
            for (int t = 0; t < 5; ++t)
#pragma unroll
                for (int s2 = 0; s2 < 2; ++s2) {
                    u32x4 pk; pk.x = cvt_pk(S[t][8 * s2 + 0], S[t][8 * s2 + 1]); pk.y = cvt_pk(S[t][8 * s2 + 2], S[t][8 * s2 + 3]); pk.z = cvt_pk(S[t][8 * s2 + 4], S[t][8 * s2 + 5]); pk.w = cvt_pk(S[t][8 * s2 + 6], S[t][8 * s2 + 7]);
                    const bf16x8 pb = __builtin_bit_cast(bf16x8, pk);
                    const LAS unsigned char* vp = Vl + (32 * (kt0 + t) + 16 * s2 + 4 * hh + q4) * VP + 32 * blk + 8 * p4;
#pragma unroll
                    for (int dh = 0; dh < 2; ++dh) { const s16x4 lo = vtr(vp + 64 * dh), hi = vtr(vp + 64 * dh + 8 * VP);
                        const bf16x8 va = (bf16x8){lo[0], lo[1], lo[2], lo[3], hi[0], hi[1], hi[2], hi[3]};
                        O[dh] = __builtin_amdgcn_mfma_f32_32x32x16_bf16(va, pb, O[dh], 0, 0, 0); }
                }
            const float inv = 1.0f / l;
#pragma unroll
            for (int dh = 0; dh < 2; ++dh)
#pragma unroll
                for (int g4 = 0; g4 < 4; ++g4) { u32x2 o2; o2.x = cvt_pk(O[dh][4 * g4] * inv, O[dh][4 * g4 + 1] * inv); o2.y = cvt_pk(O[dh][4 * g4 + 2] * inv, O[dh][4 * g4 + 3] * inv);
                    *(u32x2*)(AO + tok * D + hq * 64 + 32 * dh + 8 * g4 + 4 * hh) = o2; }
        }
        wg_barrier();
    }
}

__device__ __forceinline__ float wave_sum63(float v) {
    v += __builtin_bit_cast(float, __builtin_amdgcn_update_dpp(0, __builtin_bit_cast(int, v), 0x111, 0xf, 0xf, true));
    v += __builtin_bit_cast(float, __builtin_amdgcn_update_dpp(0, __builtin_bit_cast(int, v), 0x112, 0xf, 0xf, true));
    v += __builtin_bit_cast(float, __builtin_amdgcn_update_dpp(0, __builtin_bit_cast(int, v), 0x114, 0xf, 0xf, true));
    v += __builtin_bit_cast(float, __builtin_amdgcn_update_dpp(0, __builtin_bit_cast(int, v), 0x118, 0xf, 0xf, true));
    v += __builtin_bit_cast(float, __builtin_amdgcn_update_dpp(0, __builtin_bit_cast(int, v), 0x142, 0xa, 0xf, true));
    v += __builtin_bit_cast(float, __builtin_amdgcn_update_dpp(0, __builtin_bit_cast(int, v), 0x143, 0xc, 0xf, true));
    return v;
}
__device__ __forceinline__ void dwconv_phase(Frame& F, int j, unsigned long long& t_acc) {
#ifndef TIME_KIND
#define TIME_KIND (-1)
#endif
    unsigned long long t_b = 0ull;
#define DT_BEG(k) do { if (TIME_KIND == (k)) t_b = __builtin_amdgcn_s_memrealtime(); } while (0)
#define DT_END(k) do { if (TIME_KIND == (k)) t_acc += __builtin_amdgcn_s_memrealtime() - t_b; } while (0)
    constexpr int PP = 520;
    DT_BEG(16);
    const bf16_t* U = WSP(const bf16_t, WS_U); bf16_t* YC = WSP(bf16_t, WS_AO);
    LAS unsigned char* ut = F.lds; LAS float* P = (LAS float*)F.lds; LAS float* fin = (LAS float*)(F.lds + 64 * PP * 4);
    const int tid = F.tid, lane = F.lane, w = F.wave;
    const float* wd = F.in[I_CWDW] + (size_t)j * 31 * D + 2 * tid;
    f32x2 wk[31];
#pragma unroll
    for (int q = 0; q < 31; ++q) wk[q] = *(const f32x2*)(wd + q * D);
    const f32x2 bdw = *(const f32x2*)(F.in[I_CBDW] + j * D + 2 * tid), lng = *(const f32x2*)(F.in[I_CLNG] + j * D + 2 * tid), lnb = *(const f32x2*)(F.in[I_CLNB] + j * D + 2 * tid);
    const __amdgpu_buffer_rsrc_t rU = __builtin_amdgcn_make_buffer_rsrc((void*)U, 0, 0x7fffffff, 0x00020000);
    asm volatile("s_waitcnt vmcnt(0)" ::: "memory"); DT_END(16);
    const int tl_beg = F.loc ? F.xcc * 64 + F.rank : F.c, tl_step = F.loc ? 32 : F.G, tl_end = F.loc ? F.xcc * 64 + 64 : T / 32;
    for (int tile = tl_beg; tile < tl_end; tile += tl_step) {
        const int t0 = tile * 32, tin0 = t0 % SEQ, rlo = tin0 >= 30 ? 0 : 30 - tin0;
        DT_BEG(12);
        for (int pc = w; pc < 124; pc += NWAVES) { const int rr = pc >> 1;
            if (rr >= rlo) __builtin_amdgcn_raw_ptr_buffer_load_lds(rU, (LAS unsigned*)(ut + pc * 1024), 16, lane * 16, (int)(((size_t)(t0 + rr - 30) * D + (pc & 1) * 512) * 2), 0, 0);
            else *(LAS u32x4*)(ut + pc * 1024 + lane * 16) = (u32x4){0u, 0u, 0u, 0u}; }
        asm volatile("s_waitcnt vmcnt(0)" ::: "memory");
        wg_barrier();
        DT_END(12); DT_BEG(13);
        f32x2 y[32];
#pragma unroll
        for (int blk = 0; blk < 4; ++blk) {
            f32x2 a[8] = {bdw, bdw, bdw, bdw, bdw, bdw, bdw, bdw};
#pragma unroll
            for (int rr = 0; rr < 38; ++rr) { const unsigned uw = *(const LAS unsigned*)(ut + (8 * blk + rr) * 2048 + 4 * tid); const f32x2 uv = (f32x2){bf_lo(uw), bf_hi(uw)};
#pragma unroll
                for (int o = 0; o < 8; ++o) { const int q = rr - o; if (q >= 0 && q < 31) a[o] += wk[q] * uv; } }
#pragma unroll
            for (int o = 0; o < 8; ++o) y[8 * blk + o] = a[o];
        }
        DT_END(13); DT_BEG(14);
        wg_barrier();
#pragma unroll
        for (int tk = 0; tk < 32; ++tk) { P[(2 * tk) * PP + tid] = y[tk].x + y[tk].y; P[(2 * tk + 1) * PP + tid] = y[tk].x * y[tk].x + y[tk].y * y[tk].y; }
        wg_barrier();
        { const int qn = tid >> 3, l8 = tid & 7; float v = 0.f;
#pragma unroll 16
          for (int i2 = 0; i2 < 64; ++i2) v += P[qn * PP + l8 + 8 * i2];
          v += __shfl_xor(v, 1); v += __shfl_xor(v, 2); v += __shfl_xor(v, 4);
          if (l8 == 0) fin[qn] = v; }
        wg_barrier();
        DT_END(14); DT_BEG(15);
#pragma unroll
        for (int tk = 0; tk < 32; ++tk) { const float mean = fin[2 * tk] * (1.0f / D), var = fmaxf(fin[2 * tk + 1] * (1.0f / D) - mean * mean, 0.f), rstd = rsqrtf(var + 1e-5f);
            const float v0 = (y[tk].x - mean) * rstd * lng.x + lnb.x, v1 = (y[tk].y - mean) * rstd * lng.y + lnb.y;
            *(unsigned*)(YC + (size_t)(t0 + tk) * D + 2 * tid) = cvt_pk(v0 * sigmoid_f(v0), v1 * sigmoid_f(v1)); }
        asm volatile("s_waitcnt vmcnt(0)" ::: "memory");
        wg_barrier();
        DT_END(15);
    }
#undef DT_BEG
#undef DT_END
}
__device__ __forceinline__ void p0_mod_task(Frame& F, int task) {
    LAS float* cact = (LAS float*)F.lds; LAS float* part = (LAS float*)(F.lds + 32768);
    const int i = task / 24, n0 = (task % 24) * 256, tid = F.tid, lane = F.lane, w = F.wave;
    for (int q = tid; q < NBATCH * D; q += NTHR) { const float cv = F.in[I_C][q]; cact[q] = cv * sigmoid_f(cv); }
    wg_barrier();
    f32x4 acc[8];
#pragma unroll
    for (int b = 0; b < 8; ++b) acc[b] = (f32x4){0.f, 0.f, 0.f, 0.f};
    const float* Wp = F.in[I_WMOD] + ((size_t)i * D + 128 * w) * (6 * D) + n0 + 4 * lane;
#pragma unroll 4
    for (int k = 0; k < 128; ++k) { const f32x4 wv = __builtin_nontemporal_load((const f32x4*)(Wp + (size_t)k * (6 * D)));
#pragma unroll
        for (int b = 0; b < 8; ++b) acc[b] += wv * cact[b * D + 128 * w + k]; }
#pragma unroll
    for (int b = 0; b < 8; ++b) *(LAS f32x4*)(part + (w * 8 + b) * 256 + 4 * lane) = acc[b];
    wg_barrier();
    float* mod = WSP(float, WS_MOD);
#pragma unroll
    for (int q = 0; q < 4; ++q) { const int o = tid + NTHR * q, b = o >> 8, n = o & 255; float s = F.in[I_BMOD][i * 6 * D + n0 + n];
#pragma unroll
        for (int ww = 0; ww < 8; ++ww) s += part[(ww * 8 + b) * 256 + n];
        mod[((size_t)i * NBATCH + b) * (6 * D) + n0 + n] = s; }
    wg_barrier();
}
struct TItem { const float* W; bf16_t* Dst; int N, paired, kb, nb, f8; };
constexpr int CV_DENSE = 352, CV_MOE = 3072;
__device__ __forceinline__ bool cv_item(Frame& F, int q, int it, TItem& x) {
    if (it < 0) return false;
    if (q == 0) {
        const int NQ = 96, NO = 64, NCI = 128, NCO = 64;
        if (it < NQ) { const int j = it / 48, r = it % 48; x.W = F.in[I_AWQKV] + (size_t)j * D * 1536; x.Dst = WSP(bf16_t, WS_WQKV) + (size_t)j * 1536 * D; x.N = 1536; x.paired = 0; x.f8 = 0; x.kb = r / 6; x.nb = r % 6; return true; } it -= NQ;
        if (it < NO) { const int j = it / 32, r = it % 32; x.W = F.in[I_AWO] + (size_t)j * D * D; x.Dst = WSP(bf16_t, WS_WO) + (size_t)j * D * D; x.N = 1024; x.paired = 0; x.f8 = 0; x.kb = r / 4; x.nb = r % 4; return true; } it -= NO;
        if (it < NCI) { const int j = it / 64, r = it % 64; x.W = F.in[I_CWIN] + (size_t)j * D * 2048; x.Dst = WSP(bf16_t, WS_CWIN) + (size_t)j * 2048 * D; x.N = 2048; x.paired = 1; x.f8 = 0; x.kb = r / 8; x.nb = r % 8; return true; } it -= NCI;
        if (it < NCO) { const int j = it / 32, r = it % 32; x.W = F.in[I_CWOUT] + (size_t)j * D * D; x.Dst = WSP(bf16_t, WS_CWOUT) + (size_t)j * D * D; x.N = 1024; x.paired = 0; x.f8 = 0; x.kb = r / 4; x.nb = r % 4; return true; } it -= NCO;
    }
    if (it < 2048) { const int m = q * NE + it / 64, r = it % 64; x.W = F.in[I_MWIN] + (size_t)m * D * 2048; x.Dst = (bf16_t*)(WSP(unsigned char, WS_MWIN) + (size_t)m * 2048 * D); x.N = 2048; x.paired = 1; x.f8 = 1; x.kb = r / 8; x.nb = r % 8; return true; } it -= 2048;
    if (it < 1024) { const int m = q * NE + it / 32, r = it % 32; x.W = F.in[I_MWOUT] + (size_t)m * D * D; x.Dst = (bf16_t*)(WSP(unsigned char, WS_MWOUT) + (size_t)m * D * D); x.N = 1024; x.paired = 0; x.f8 = 1; x.kb = r / 4; x.nb = r % 4; return true; }
    return false;
}
__device__ __forceinline__ void cv_run(Frame& F, int q, int max_items) {
    if (q > 3 || max_items <= 0) return;
    LAS float* tile = (LAS float*)F.lds;
    volatile LAS int* qslot = (volatile LAS int*)(F.lds + 128 * 257 * 4 + 64);
    const int tid = F.tid, lane = F.lane, w = F.wave; gu32* qc = F.ctl + CW_P0Q + 64 * q;
    int claimed = 1;
    wg_barrier();
    if (tid == 0) qslot[0] = (int)__hip_atomic_fetch_add(qc, 1u, RLX_AGENT);
    wg_barrier();
    int it = qslot[0]; TItem cur; bool valid = cv_item(F, q, it, cur);
    f32x4 rg[16];
    if (valid) {
#pragma unroll
        for (int qq = 0; qq < 16; ++qq) rg[qq] = __builtin_nontemporal_load((const f32x4*)(cur.W + (size_t)(cur.kb * 128 + w * 16 + qq) * cur.N + cur.nb * 256 + 4 * lane)); }
    wg_barrier();
    while (valid) {
        const bool more = claimed < max_items;
        if (tid == 0) qslot[0] = more ? (int)__hip_atomic_fetch_add(qc, 1u, RLX_AGENT) : -1;
        ++claimed;
#pragma unroll
        for (int qq = 0; qq < 16; ++qq) { LAS float* tp = tile + (w * 16 + qq) * 257 + 4 * lane; tp[0] = rg[qq][0]; tp[1] = rg[qq][1]; tp[2] = rg[qq][2]; tp[3] = rg[qq][3]; }
        wg_barrier();
        const int nit = qslot[0]; TItem nx; const bool nvalid = cv_item(F, q, nit, nx);
        if (nvalid) {
#pragma unroll
            for (int qq = 0; qq < 16; ++qq) rg[qq] = __builtin_nontemporal_load((const f32x4*)(nx.W + (size_t)(nx.kb * 128 + w * 16 + qq) * nx.N + nx.nb * 256 + 4 * lane)); }
        const int kc = lane >> 3;
#pragma unroll
        for (int r4 = 0; r4 < 4; ++r4) { const int nl = 32 * w + 8 * r4 + (lane & 7), n = cur.nb * 256 + nl; const LAS float* sp = tile + (16 * kc) * 257 + nl;
            float v[16];
#pragma unroll
            for (int jj = 0; jj < 16; ++jj) v[jj] = sp[jj * 257];
            int nd = n; if (cur.paired) { const int half = n >> 10, rem = n & 1023; nd = ((rem >> 7) << 8) + (half << 7) + (rem & 127); }
            if (cur.f8) { u32x4 o; o.x = cvt_pk4_fp8(v[0] * F8_SW, v[1] * F8_SW, v[2] * F8_SW, v[3] * F8_SW); o.y = cvt_pk4_fp8(v[4] * F8_SW, v[5] * F8_SW, v[6] * F8_SW, v[7] * F8_SW);
                o.z = cvt_pk4_fp8(v[8] * F8_SW, v[9] * F8_SW, v[10] * F8_SW, v[11] * F8_SW); o.w = cvt_pk4_fp8(v[12] * F8_SW, v[13] * F8_SW, v[14] * F8_SW, v[15] * F8_SW);
                __builtin_nontemporal_store(o, (u32x4*)((unsigned char*)cur.Dst + (size_t)nd * D + cur.kb * 128 + 16 * kc)); }
            else { u32x4 o0, o1; o0.x = cvt_pk(v[0], v[1]); o0.y = cvt_pk(v[2], v[3]); o0.z = cvt_pk(v[4], v[5]); o0.w = cvt_pk(v[6], v[7]); o1.x = cvt_pk(v[8], v[9]); o1.y = cvt_pk(v[10], v[11]); o1.z = cvt_pk(v[12], v[13]); o1.w = cvt_pk(v[14], v[15]);
                bf16_t* dp = cur.Dst + (size_t)nd * D + cur.kb * 128 + 16 * kc; __builtin_nontemporal_store(o0, (u32x4*)dp); __builtin_nontemporal_store(o1, (u32x4*)(dp + 8)); } }
        wg_barrier();
        cur = nx; valid = nvalid;
    }
}
#ifndef CV_OVERLAP
#define CV_OVERLAP 1
#endif
__device__ __forceinline__ void p0_phase(Frame& F) {
    for (int task = F.c; task < 96; task += F.G) p0_mod_task(F, task);
    cv_run(F, 0, 1 << 30);
    if (!CV_OVERLAP) { cv_run(F, 1, 1 << 30); cv_run(F, 2, 1 << 30); cv_run(F, 3, 1 << 30); }
}

template <bool GATHER> __device__ __forceinline__ int moe_build_units(Frame& F, int layer, int npn, int total_tiles, int ubase) {
    const LAS int* EX = (const LAS int*)(F.lds + LDS_EXP); LAS int* UT = (LAS int*)(F.lds + LDS_UT); LAS int* TOK = (LAS int*)(F.lds + LDS_TOK);
    const int tps = 32 / npn, nsb = (total_tiles + tps - 1) / tps;
    const bool xcd_ok = (F.G % 256) == 0 || F.G == 256;
    int n = 0;
    if (xcd_ok && F.G == 256) {
        const int x = F.c & 7, jx = F.c >> 3;
        const int mine = x < nsb ? (nsb - x + 7) / 8 : 0; n = mine - ubase; n = n < 0 ? 0 : (n > 9 ? 9 : n);
        if (F.tid < n) { const int q = (ubase + F.tid) * 8 + x, tau = q * tps + (jx % tps), pn = jx / tps; int e = 0;
            if (tau < total_tiles) { for (int qq = 1; qq < 32; ++qq) if (tau >= EX[32 + qq]) e = qq; } else e = -1;
            const int mt = e >= 0 ? tau - EX[32 + e] : 0, om = e >= 0 ? EX[64 + e] + 256 * mt : 0;
            UT[4 * F.tid] = GATHER ? 256 * F.tid : om; UT[4 * F.tid + 1] = om; UT[4 * F.tid + 2] = e; UT[4 * F.tid + 3] = pn; UT[40 + F.tid] = mt; }
    } else {
        const int U = total_tiles * npn; const int mine = F.c < U ? (U - F.c + F.G - 1) / F.G : 0; n = mine - ubase; n = n < 0 ? 0 : (n > 9 ? 9 : n);
        if (F.tid < n) { const int L = F.c + (ubase + F.tid) * F.G, tau = L / npn, pn = L % npn; int e = 0;
            for (int qq = 1; qq < 32; ++qq) if (tau >= EX[32 + qq]) e = qq;
            const int mt = tau - EX[32 + e], om = EX[64 + e] + 256 * mt;
            UT[4 * F.tid] = GATHER ? 256 * F.tid : om; UT[4 * F.tid + 1] = om; UT[4 * F.tid + 2] = e; UT[4 * F.tid + 3] = pn; UT[40 + F.tid] = mt; }
    }
    wg_barrier();
    if (F.tid == 0) { int w = 0; for (int r = 0; r < n; ++r) { if (UT[4 * r + 2] >= 0) { if (w != r) { UT[4 * w] = GATHER ? 256 * w : UT[4 * r]; UT[4 * w + 1] = UT[4 * r + 1]; UT[4 * w + 2] = UT[4 * r + 2]; UT[4 * w + 3] = UT[4 * r + 3]; UT[40 + w] = UT[40 + r]; } ++w; } } UT[60] = w; UT[61] = n; }
    wg_barrier();
    const int nv = UT[60];
    if (GATHER) { const int* LIST = WSP(const int, WS_LIST);
        for (int q = F.tid; q < nv * 256; q += NTHR) { const int ui = q >> 8, rr = q & 255, e = UT[4 * ui + 2], pos = 256 * UT[40 + ui] + rr; TOK[q] = pos < EX[e] ? LIST[(size_t)e * T + pos] : 0; }
        wg_barrier(); }
    return nv | (n << 8);
}

constexpr int N_PHASES = 30;
struct Args { const float* in[27]; float* out; unsigned char* ws; int ph_lo, ph_hi; };
__global__ void __launch_bounds__(NTHR, 2) mega(const Args args) {
    extern __shared__ __attribute__((aligned(16))) unsigned char lds_raw[];
    Frame F; F.lds = (LAS unsigned char*)lds_raw; F.MISC = (volatile LAS unsigned*)(F.lds + LDS_MISC); F.ws = args.ws; F.ctl = (gu32*)(args.ws + WS_CTL);
    F.tid = threadIdx.x; F.lane = F.tid & 63; F.wave = __builtin_amdgcn_readfirstlane(F.tid >> 6); F.G = gridDim.x; F.c = blockIdx.x; F.out = args.out;
    F.in = args.in;
    if (F.tid < 32) F.MISC[F.tid] = 0u;
    __syncthreads();
    const int lo = args.ph_lo, hi = args.ph_hi;
    F.xcc = (int)xb_xcc_id(); F.rank = 0; F.loc = 0;
#ifndef XCC_LOCAL
#define XCC_LOCAL 1
#endif
    if (XCC_LOCAL && hi - lo > 1 && F.G == 256) {
        if (F.tid == 0) { const unsigned r = __hip_atomic_fetch_add(F.ctl + CW_XC + 64 * F.xcc, 1u, RLX_AGENT); unsigned ok = 0u, sp = 0u;
            for (;;) { unsigned sum = 0u, good = 0u;
#pragma unroll
                for (int jx = 0; jx < 16; ++jx) { const unsigned cj = __hip_atomic_load(F.ctl + CW_XC + 64 * jx, RLX_AGENT); sum += cj; good += (jx < 8 ? (cj == 32u) : (cj == 0u)) ? 1u : 0u; }
                if (sum == 256u) { ok = (good == 16u) ? 1u : 0u; break; }
                __builtin_amdgcn_s_sleep(1); if (++sp > XB_SPIN_CAP) { ok = 0u; break; } }
            F.MISC[20] = r; F.MISC[21] = ok; }
        __syncthreads();
        F.rank = (int)F.MISC[20]; F.loc = (int)F.MISC[21];
        if (F.loc) F.c = F.rank * 8 + F.xcc;
    }
    XcdBarrier bar; bar.bar = (unsigned*)(F.ctl + CW_BAR); bar.x = 0; bar.st = F.MISC + 8;
    if (hi - lo > 1) bar = xcd_barrier_post((unsigned*)(F.ctl + CW_BAR), F.MISC + 8);
#ifndef CVQ_QKV
#define CVQ_QKV 4
#endif
#ifndef CVQ_MOE
#define CVQ_MOE 2
#endif
#ifndef PH_MASK
#define PH_MASK 0xFFFF
#endif
#define IN(k) (lo <= (k) && (k) < hi)
#define HAS(b) (((PH_MASK) >> (b)) & 1)
#define PHASE_ENTER() do { int _t = F.tid; asm volatile("" : "+v"(_t)); F.tid = _t; F.lane = _t & 63; F.wave = __builtin_amdgcn_readfirstlane(_t >> 6); unsigned char* _w = F.ws; asm volatile("" : "+s"(_w)); F.ws = _w; int _g = F.G; asm volatile("" : "+s"(_g)); F.G = _g; } while (0)
    unsigned long long t_acc = 0ull, t_beg = 0ull, g_ticks = 0ull, g_cyc = 0ull;
#define TBEG(kind) do { if (TIME_KIND == (kind)) t_beg = __builtin_amdgcn_s_memrealtime(); } while (0)
#define TEND(kind) do { if (TIME_KIND == (kind)) t_acc += __builtin_amdgcn_s_memrealtime() - t_beg; } while (0)
#define SEAM(k) do { if ((k) + 1 < hi) xcd_barrier(bar); } while (0)
#define SEAM_L(k) do { if ((k) + 1 < hi) { if (F.loc) xcc_local_barrier((unsigned*)(F.ctl + CW_LB + 64 * F.xcc), 32u, (unsigned*)(F.ctl + CW_TMO)); else xcd_barrier(bar); } } while (0)
    const LAS int* toktab = (const LAS int*)(F.lds + LDS_TOK);
    if (HAS(0) && IN(0)) { TBEG(0); p0_phase(F); SEAM(0); TEND(0); }
    for (int i = 0; i < DEPTH; ++i) {
        const int pb = 1 + 7 * i, j = i >> 1; const bool conv = (i & 1) != 0;
        const float* modl = WSP(const float, WS_MOD) + (size_t)i * NBATCH * (6 * D);
        if (IN(pb)) { PHASE_ENTER(); TBEG(1); if (i == 0) { if (HAS(1)) row_phase<0>(F, 0); } else { TBEG(7); if (HAS(2)) row_phase<1>(F, i); TEND(7); } SEAM_L(pb); TEND(1); }
        if (IN(pb + 1)) { PHASE_ENTER(); TBEG(2);
            if (!conv) { if (HAS(3)) { Gemm g{WSP(const bf16_t, WS_H), WSP(const bf16_t, WS_WQKV) + (size_t)j * 1536 * D, D, 0}; DenseOrder S; S.init(1536, F.G, F.c);
                EpiBias16 E{WSP(bf16_t, WS_QKV), 1536, F.in[I_ABQKV] + j * 1536}; gemm_phase<EpiBias16, DenseOrder, false>(F.lds, g, S, E, toktab, F.tid, 40, t_acc, g_ticks, g_cyc);
                if (CV_OVERLAP && (long)F.c + F.G >= 384) cv_run(F, i + 1, CVQ_QKV); } }
            else if (HAS(4)) { Gemm g{WSP(const bf16_t, WS_H), WSP(const bf16_t, WS_CWIN) + (size_t)j * 2048 * D, D, 0}; DenseOrder S; S.init(2048, F.G, F.c);
                EpiPair<0> E{WSP(void, WS_U), F.in[I_CBIN] + j * 2048, 0}; gemm_phase<EpiPair<0>, DenseOrder, false>(F.lds, g, S, E, toktab, F.tid, 50, t_acc, g_ticks, g_cyc); }
            SEAM_L(pb + 1); TEND(2); }
        if (IN(pb + 2)) { PHASE_ENTER(); TBEG(3); if (!conv) { TBEG(6); if (HAS(5)) attn_phase(F, j); TEND(6); } else { if (HAS(6)) dwconv_phase(F, j, t_acc); TBEG(17); } SEAM_L(pb + 2); if (conv) TEND(17); TEND(3); }
        if (IN(pb + 3)) { PHASE_ENTER(); TBEG(2); if (HAS(7)) {
            Gemm g{WSP(const bf16_t, WS_AO), (conv ? WSP(const bf16_t, WS_CWOUT) : WSP(const bf16_t, WS_WO)) + (size_t)j * D * D, D, 0}; DenseOrder S; S.init(1024, F.G, F.c);
            const float* bias2 = (conv ? F.in[I_CBOUT] : F.in[I_ABO]) + j * D;
            if (i == 0) { EpiResid<true> E{F.in[I_X], WSP(bf16_t, WS_X), bias2, modl + 2 * D}; gemm_phase<EpiResid<true>, DenseOrder, false>(F.lds, g, S, E, toktab, F.tid, 60, t_acc, g_ticks, g_cyc); }
            else { EpiResid<false> E{WSP(const bf16_t, WS_X), WSP(bf16_t, WS_X), bias2, modl + 2 * D}; gemm_phase<EpiResid<false>, DenseOrder, false>(F.lds, g, S, E, toktab, F.tid, 60, t_acc, g_ticks, g_cyc); } }
            SEAM_L(pb + 3); TEND(2); }
        if (IN(pb + 4)) { PHASE_ENTER(); TBEG(1); if (CV_OVERLAP && i > 0) cv_run(F, i, 1 << 30); TBEG(8); if (HAS(8)) row_phase<2>(F, i); TEND(8); SEAM(pb + 4); TEND(1); }
        if (IN(pb + 5)) { PHASE_ENTER(); TBEG(4); if (HAS(9)) {
            const int tt = build_exp_tables(F, i);
            Gemm g{WSP(const bf16_t, WS_H), (const bf16_t*)(WSP(const unsigned char, WS_MWIN) + (size_t)i * NE * 2048 * D), D / 2, (size_t)2048 * D / 2};
            EpiPair<1> E{WSP(void, WS_ACT), F.in[I_MBIN] + (size_t)i * NE * 2048, 2048};
            for (int ub = 0;; ub += 9) { const int nn = moe_build_units<true>(F, i, 8, tt, ub); const int n = nn >> 8, nv = nn & 255; if (n == 0) break;
                TableOrder S{(const LAS int*)(F.lds + LDS_UT), nv}; gemm_phase<EpiPair<1>, TableOrder, true, true>(F.lds, g, S, E, toktab, F.tid, 20, t_acc, g_ticks, g_cyc); wg_barrier();
                if (n < 9) { if (CV_OVERLAP && ub + nv < (((tt + 3) / 4) + 7) / 8) cv_run(F, i + 1, CVQ_MOE); break; } } }
            SEAM(pb + 5); TEND(4); }
        if (IN(pb + 6)) { PHASE_ENTER(); TBEG(5); if (HAS(10)) {
            const int tt = build_exp_tables(F, i);
            Gemm g{WSP(const bf16_t, WS_ACT), (const bf16_t*)(WSP(const unsigned char, WS_MWOUT) + (size_t)i * NE * D * D), D / 2, (size_t)D * D / 2};
            EpiMoeOut E{WSP(bf16_t, WS_YS), F.in[I_MBOUT] + (size_t)i * NE * D, WSP(const float, WS_GLIST), (const LAS int*)(F.lds + LDS_EXP + 256)};
            for (int ub = 0;; ub += 9) { const int nn = moe_build_units<false>(F, i, 4, tt, ub); const int n = nn >> 8, nv = nn & 255; if (n == 0) break;
                TableOrder S{(const LAS int*)(F.lds + LDS_UT), nv}; gemm_phase<EpiMoeOut, TableOrder, false, true>(F.lds, g, S, E, toktab, F.tid, 30, t_acc, g_ticks, g_cyc); wg_barrier();
                if (n < 9) { if (CV_OVERLAP && ub + nv < (((tt + 7) / 8) + 7) / 8) cv_run(F, i + 1, CVQ_MOE); break; } } }
            SEAM(pb + 6); TEND(5); }
    }
    if (HAS(11) && IN(29)) { PHASE_ENTER(); TBEG(1); row_phase<5>(F, DEPTH); TEND(1); }
    if (TIME_KIND >= 20 && (TIME_KIND % 10) == 5 && g_ticks > 0) t_acc = (g_cyc * 1000ull) / g_ticks;
    if (TIME_KIND >= 0 && blockIdx.x == 0) { const unsigned long long t0 = __builtin_amdgcn_s_memrealtime(); while (__builtin_amdgcn_s_memrealtime() - t0 < t_acc) __builtin_amdgcn_s_sleep(8); }
#undef IN
#undef SEAM
}

inline void launch_range(void* const* d_in, void* d_out, void* d_ws, int grid, int lo, int hi, hipStream_t stream) {
    Args a{}; for (int i = 0; i < 27; ++i) a.in[i] = (const float*)d_in[i];
    a.out = (float*)d_out; a.ws = (unsigned char*)d_ws; a.ph_lo = lo; a.ph_hi = hi;
    hipLaunchKernelGGL(mega, dim3(grid), dim3(NTHR), LDS_BYTES, stream, a);
}
inline int setup_grid() {
    static int grid = 0;
    if (grid == 0) {
        int dev = 0, cus = 0;
        if (hipGetDevice(&dev) != hipSuccess || hipDeviceGetAttribute(&cus, hipDeviceAttributeMultiprocessorCount, dev) != hipSuccess) { grid = -1; return grid; }
        if (hipFuncSetAttribute((const void*)mega, hipFuncAttributeMaxDynamicSharedMemorySize, LDS_BYTES) != hipSuccess) { grid = -1; return grid; }
        int per_cu = 0; (void)hipOccupancyMaxActiveBlocksPerMultiprocessor(&per_cu, (const void*)mega, NTHR, LDS_BYTES); (void)hipGetLastError();
        if (per_cu < 1) fprintf(stderr, "kernel_launch: occupancy query reports %d blocks per CU\n", per_cu);
        grid = cus;
    }
    return grid;
}
}
#ifndef FAST_LAUNCH_MODE
#define FAST_LAUNCH_MODE 1
#endif
extern "C" void kernel_launch(void* const* d_in, const int* in_sizes, int n_in, void* d_out, int out_size, void* d_ws, size_t ws_size, hipStream_t stream) {
    if (n_in != 27 || out_size != fk::T * fk::D || ws_size < fk::WS_END) { fprintf(stderr, "kernel_launch: unexpected shapes (n_in %d out %d ws %zu)\n", n_in, out_size, ws_size); return; }
    const int grid = fk::setup_grid(); if (grid <= 0) return;
    (void)hipMemsetAsync((char*)d_ws + fk::WS_CTL, 0, fk::CTL_ZERO_BYTES, stream);
#if FAST_LAUNCH_MODE == 1
    fk::launch_range(d_in, d_out, d_ws, grid, 0, fk::N_PHASES, stream);
#else
    for (int k = 0; k < fk::N_PHASES; ++k) fk::launch_range(d_in, d_out, d_ws, grid, k, k + 1, stream);
#endif
}
```

```cpp
#include <hip/hip_runtime.h>
#include <cstdio>
#include <cstdint>
namespace fk {
#define LAS __attribute__((address_space(3)))
#define GAS __attribute__((address_space(1)))
typedef unsigned short bf16_t;
typedef short bf16x8 __attribute__((ext_vector_type(8)));
typedef short s16x4 __attribute__((ext_vector_type(4)));
typedef float f32x4 __attribute__((ext_vector_type(4)));
typedef float f32x2 __attribute__((ext_vector_type(2)));
typedef float f32x16 __attribute__((ext_vector_type(16)));
typedef float f32x8 __attribute__((ext_vector_type(8)));
typedef unsigned u32x4 __attribute__((ext_vector_type(4)));
typedef unsigned u32x2 __attribute__((ext_vector_type(2)));
typedef __bf16 bf16x2_t __attribute__((ext_vector_type(2)));
typedef int v4i __attribute__((ext_vector_type(4)));
typedef int v8i __attribute__((ext_vector_type(8)));
typedef GAS unsigned gu32;
#define RLX_AGENT __ATOMIC_RELAXED, __HIP_MEMORY_SCOPE_AGENT
#define LDS_WAIT() asm volatile("s_waitcnt lgkmcnt(0)" ::: "memory")
#define VM_WAIT() asm volatile("s_waitcnt vmcnt(0)" ::: "memory")

constexpr int T = 16384, D = 1024, SEQ = 2048, NBATCH = 8, NE = 32, DEPTH = 4;
constexpr int NWAVES = 8, NTHR = 512;
constexpr int SLOTCAP = T * 4 + NE * 256;
constexpr float LOG2E = 1.4426950408889634f;

__device__ __forceinline__ unsigned cvt_pk(float lo, float hi) { f32x2 v = {lo, hi}; bf16x2_t b = __builtin_convertvector(v, bf16x2_t); return __builtin_bit_cast(unsigned, b); }
__device__ __forceinline__ float bf_lo(unsigned w) { return __uint_as_float(w << 16); }
__device__ __forceinline__ float bf_hi(unsigned w) { return __uint_as_float(w & 0xffff0000u); }
__device__ __forceinline__ unsigned cvt_pk4_fp8(float a, float b, float c, float d) {
    a = __builtin_amdgcn_fmed3f(a, -448.f, 448.f); b = __builtin_amdgcn_fmed3f(b, -448.f, 448.f); c = __builtin_amdgcn_fmed3f(c, -448.f, 448.f); d = __builtin_amdgcn_fmed3f(d, -448.f, 448.f);
    int w = 0; w = __builtin_amdgcn_cvt_pk_fp8_f32(a, b, w, false); w = __builtin_amdgcn_cvt_pk_fp8_f32(c, d, w, true); return (unsigned)w; }
__device__ __forceinline__ unsigned cvt_pk4_fp8_nc(float a, float b, float c, float d) { int w = 0; w = __builtin_amdgcn_cvt_pk_fp8_f32(a, b, w, false); w = __builtin_amdgcn_cvt_pk_fp8_f32(c, d, w, true); return (unsigned)w; }
constexpr float F8_SH = 8.0f, F8_SW = 64.0f, F8_SACT = 4.0f, F8_SY = 16.0f;
__device__ __forceinline__ f32x4 fp8x4_to_f32(unsigned w) { const f32x2 lo = __builtin_amdgcn_cvt_pk_f32_fp8((int)w, false), hi = __builtin_amdgcn_cvt_pk_f32_fp8((int)w, true); return (f32x4){lo.x, lo.y, hi.x, hi.y}; }
__device__ __forceinline__ float sigmoid_f(float v) { return __builtin_amdgcn_rcpf(1.0f + __builtin_amdgcn_exp2f(-LOG2E * v)); }

constexpr size_t MiB = (size_t)1 << 20;
constexpr size_t WS_CTL = 0, CTL_ZERO_BYTES = MiB / 8;
constexpr size_t WS_MOD = 1 * MiB;
constexpr size_t WS_WQKV = 2 * MiB;
constexpr size_t WS_WO = 8 * MiB;
constexpr size_t WS_CWIN = 12 * MiB;
constexpr size_t WS_CWOUT = 20 * MiB;
constexpr size_t WS_MWIN = 24 * MiB;
constexpr size_t WS_MWOUT = WS_MWIN + 512 * MiB;
constexpr size_t WS_X = WS_MWOUT + 256 * MiB;
constexpr size_t WS_H = WS_X + 64 * MiB;
constexpr size_t WS_QKV = WS_H + 32 * MiB;
constexpr size_t WS_AO = WS_QKV + 48 * MiB;
constexpr size_t WS_U = WS_AO + 32 * MiB;
constexpr size_t WS_LIST = WS_U + 32 * MiB;
constexpr size_t WS_GLIST = WS_LIST + 2 * MiB;
constexpr size_t WS_TK = WS_GLIST + 2 * MiB;
constexpr size_t WS_ACT = WS_TK + 1 * MiB;
constexpr size_t WS_YS = WS_ACT + 144 * MiB;
constexpr size_t WS_END = WS_YS + 144 * MiB;
constexpr int CW_TMO = 0, CW_P0Q = 64, CW_XC = 1024, CW_LB = 2048, CW_BAR = 4096, CW_CNT = 16384;
#define XCD_BAR_WORDS 3456

constexpr int RING_BYTES = 131072;
constexpr int LDS_TOK = RING_BYTES;
constexpr int LDS_UT = LDS_TOK + 9216;
constexpr int LDS_EXP = LDS_UT + 256;
constexpr int LDS_BYTES = 163840;
constexpr int LDS_MISC = LDS_BYTES - 128;
static_assert(LDS_EXP + 512 <= LDS_MISC, "LDS map");

#define XB_TMO      128
#define XB_XCNT(j)  (256  + 64 * (j))
#define XB_XSUB(j)  (1280 + 64 * (j))
#define XB_XGEN(j)  (2304 + 64 * (j))
#define XB_TOP      3328
#define XB_TOPGEN   3392
#define XB_SPIN_CAP (1u << 18)
__device__ __forceinline__ unsigned xb_ld(unsigned* p)              { return __hip_atomic_load(p, __ATOMIC_RELAXED, __HIP_MEMORY_SCOPE_AGENT); }
__device__ __forceinline__ unsigned xb_add(unsigned* p, unsigned v) { return __hip_atomic_fetch_add(p, v, __ATOMIC_RELAXED, __HIP_MEMORY_SCOPE_AGENT); }
__device__ __forceinline__ unsigned xb_xcc_id() { return (unsigned)__builtin_amdgcn_s_getreg((3 << 11) | 20) & 0xFu; }
#define XB_SPIN(cond, bar) do { unsigned _sp = 0; while (cond) { __builtin_amdgcn_s_sleep(1); \
    if ((++_sp & 255u) == 0u) { if (xb_ld(&(bar)[XB_TMO])) break; if (_sp > XB_SPIN_CAP) { atomicAdd(&(bar)[XB_TMO], 1u); break; } } } } while (0)
struct XcdBarrier { unsigned* bar; unsigned x; volatile LAS unsigned* st; };
__device__ __forceinline__ XcdBarrier xcd_barrier_post(unsigned* bar, volatile LAS unsigned* st) {
    XcdBarrier b; b.bar = bar; b.x = xb_xcc_id(); b.st = st;
    if (threadIdx.x == 0) (void)xb_add(&bar[XB_XCNT(b.x)], 1u);
    return b;
}
__device__ __forceinline__ void xcd_barrier_complete(unsigned* bar, unsigned x, unsigned& nloc, unsigned& nx) {
    const unsigned G = gridDim.x * gridDim.y * gridDim.z;
    unsigned sum, cnt, mine, sp = 0u;
    for (;;) {
        sum = 0u; cnt = 0u; mine = 0u;
#pragma unroll
        for (unsigned j = 0; j < 16; ++j) { const unsigned c = xb_ld(&bar[XB_XCNT(j)]); sum += c; cnt += (c > 0u) ? 1u : 0u; mine = (j == x) ? c : mine; }
        if (sum == G) break;
        __builtin_amdgcn_s_sleep(1);
        if ((++sp & 255u) == 0u) { if (xb_ld(&bar[XB_TMO])) break; if (sp > XB_SPIN_CAP) { atomicAdd(&bar[XB_TMO], 1u); break; } }
    }
    nloc = mine > 0u ? mine : 1u; nx = cnt > 0u ? cnt : 1u;
}
__device__ __forceinline__ void xcd_barrier(const XcdBarrier& b) {
    asm volatile("s_waitcnt vmcnt(0)" ::: "memory");
    __syncthreads();
    if (threadIdx.x == 0) {
        unsigned* bar = b.bar;
        __builtin_amdgcn_s_waitcnt(0);
        unsigned nloc = b.st[0], nx = b.st[1];
        if (nloc == 0u) { xcd_barrier_complete(bar, b.x, nloc, nx); b.st[0] = nloc; b.st[1] = nx; }
        const unsigned old = xb_add(&bar[XB_XSUB(b.x)], 1u);
        const unsigned gen = old / nloc;
        if (old + 1u == (gen + 1u) * nloc) {
            __builtin_amdgcn_fence(__ATOMIC_RELEASE, "agent");
            asm volatile("s_waitcnt vmcnt(0)" ::: "memory");
            const unsigned og = xb_add(&bar[XB_TOP], 1u);
            const unsigned tg = og / nx;
            if (og + 1u == (tg + 1u) * nx) xb_add(&bar[XB_TOPGEN], 1u);
            else XB_SPIN(xb_ld(&bar[XB_TOPGEN]) == tg, bar);
            __builtin_amdgcn_fence(__ATOMIC_ACQUIRE, "agent");
            xb_add(&bar[XB_XGEN(b.x)], 1u);
            asm volatile("s_waitcnt vmcnt(0)" ::: "memory");
        } else {
            XB_SPIN(xb_ld(&bar[XB_XGEN(b.x)]) == gen, bar);
            __builtin_amdgcn_fence(__ATOMIC_ACQUIRE, "agent");
            asm volatile("s_waitcnt vmcnt(0)" ::: "memory");
        }
    }
    __syncthreads();
}

__device__ __forceinline__ void xcc_local_barrier(unsigned* cnt, unsigned nloc, unsigned* tmo) {
    asm volatile("s_waitcnt vmcnt(0)" ::: "memory");
    __syncthreads();
    if (threadIdx.x == 0) {
        const unsigned old = __hip_atomic_fetch_add(cnt, 1u, __ATOMIC_RELAXED, __HIP_MEMORY_SCOPE_AGENT), target = (old / nloc + 1u) * nloc; unsigned sp = 0u;
        while (__hip_atomic_load(cnt, __ATOMIC_RELAXED, __HIP_MEMORY_SCOPE_AGENT) < target) { __builtin_amdgcn_s_sleep(1);
            if ((++sp & 255u) == 0u) { if (__hip_atomic_load(tmo, __ATOMIC_RELAXED, __HIP_MEMORY_SCOPE_AGENT)) break; if (sp > XB_SPIN_CAP) { atomicAdd(tmo, 1u); break; } } }
        __builtin_amdgcn_fence(__ATOMIC_ACQUIRE, "agent");
        asm volatile("s_waitcnt vmcnt(0)" ::: "memory");
    }
    __syncthreads();
}

constexpr int BM = 256, BK = 64, HALF = 128, HTB = HALF * BK * 2, NXCD = 8, WGM = 8;
__host__ __device__ __forceinline__ int lds_byte(int r, int c) { const int st = (r >> 4) * 2 + (c >> 5), rr = r & 15, cc = c & 31, ob = rr * 64 + cc * 2; return st * 1024 + (ob ^ (((ob >> 9) & 1) << 5)); }
__host__ __device__ __forceinline__ void stage_rc(int b, int& R, int& C) { const int st = b / 1024, sb = b % 1024, swz = sb ^ (((sb >> 9) & 1) << 5); R = (st >> 1) * 16 + swz / 64; C = (st & 1) * 32 + (swz % 64) / 2; }
__host__ __device__ __forceinline__ int perm32(int rho) { const int n = rho >> 4, i = rho & 15; return 8 * (i >> 2) + 4 * n + (i & 3); }

struct Unit { int am, om, e, pn; };
struct Gemm { const bf16_t* A; const bf16_t* Bt; int K; size_t b_estride; };

struct DenseOrder {
    int nM, nN, nwg, G, c;
    __device__ void init(int N, int G_, int c_) { nM = T / BM; nN = N / BM; nwg = nM * nN; G = G_; c = c_; }
    __device__ __forceinline__ bool next(int i, Unit& u) const {
        const long L = (long)i * G + c; if (L >= nwg) return false;
        int wgid = (int)L; { const int q = nwg / NXCD, r = nwg % NXCD, xcd = wgid % NXCD, off = wgid / NXCD; wgid = (xcd < r ? xcd * (q + 1) : r * (q + 1) + (xcd - r) * q) + off; }
        const int nig = WGM * nN, gid = wgid / nig, fm = gid * WGM, gsz = (nM - fm) < WGM ? (nM - fm) : WGM;
        const int pm = fm + ((wgid % nig) % gsz); u.pn = (wgid % nig) / gsz; u.am = pm * BM; u.om = pm * BM; u.e = 0; return true;
    }
};
struct TableOrder {
    const LAS int* ut; int n;
    __device__ __forceinline__ bool next(int i, Unit& u) const {
        if (i >= n) return false;
        u.am = __builtin_amdgcn_readfirstlane(ut[4 * i]); u.om = __builtin_amdgcn_readfirstlane(ut[4 * i + 1]); u.e = __builtin_amdgcn_readfirstlane(ut[4 * i + 2]); u.pn = __builtin_amdgcn_readfirstlane(ut[4 * i + 3]); return true;
    }
};

template <class Epi, class Sched, bool GATHER, bool F8 = false>
__device__ __forceinline__ void gemm_phase(LAS unsigned char* lds, const Gemm g, const Sched& S, const Epi& E, const LAS int* toktab, const int tid, const int tkb, unsigned long long& t_acc, unsigned long long& g_ticks, unsigned long long& g_cyc) {
    unsigned long long t_b = 0ull, c_b = 0ull; static_assert(true, "");
#ifndef TIME_KIND
#define TIME_KIND (-1)
#endif
#define GT_BEG(k) do { if (TIME_KIND >= 20 && TIME_KIND == tkb + (k)) t_b = __builtin_amdgcn_s_memrealtime(); if ((k) == 0 && TIME_KIND == tkb + 5) { t_b = __builtin_amdgcn_s_memrealtime(); c_b = __builtin_readcyclecounter(); } } while (0)
#define GT_END(k) do { if (TIME_KIND >= 20 && TIME_KIND == tkb + (k)) t_acc += __builtin_amdgcn_s_memrealtime() - t_b; if ((k) == 0 && TIME_KIND == tkb + 5) { g_ticks += __builtin_amdgcn_s_memrealtime() - t_b; g_cyc += __builtin_readcyclecounter() - c_b; } } while (0)
    const int wid = __builtin_amdgcn_readfirstlane(tid >> 6), lane = tid & 63, wr = wid >> 2, wc = wid & 3, fr = lane & 15, fq = lane >> 4;
    const int K = g.K, nt = K / BK;
    int Rr[2], Cc[2]; unsigned voffB[2];
#pragma unroll
    for (int i = 0; i < 2; ++i) { int R, C; stage_rc(tid * 16 + i * 8192, R, C); Rr[i] = R; Cc[i] = C; const int Rb = Epi::PERM ? ((R & ~31) + perm32(R & 31)) : R; voffB[i] = (unsigned)(Rb * K + C) * 2u; }
    const unsigned ldsw = (unsigned)wid * 1024u;
    const int aoff = lds_byte(wr * 64 + fr, fq * 8), boff = lds_byte(wc * 32 + fr, fq * 8);
#define PG8_SA(b, h) (((b) * 2 + (h)) * HTB)
#define PG8_SB(b, h) ((4 + (b) * 2 + (h)) * HTB)
#ifndef USE_BUFFER_LDS
#define USE_BUFFER_LDS 1
#endif
#if USE_BUFFER_LDS
#define PG8_STAGE(bufoff, rsrc, soff, voff) do { _Pragma("unroll") for (int _i = 0; _i < 2; ++_i) \
        __builtin_amdgcn_raw_ptr_buffer_load_lds(rsrc, (LAS unsigned*)(lds + (bufoff) + ldsw + _i * 8192), 16, (int)(voff)[_i], (int)(soff), 0, 0); } while (0)
#else
#define PG8_STAGE(bufoff, rsrc, soff, voff) do { _Pragma("unroll") for (int _i = 0; _i < 2; ++_i) \
        __builtin_amdgcn_global_load_lds((const unsigned*)((const char*)(rsrc##_base) + (size_t)(soff) + (voff)[_i]), (LAS unsigned*)(lds + (bufoff) + ldsw + _i * 8192), 16, 0, 0); } while (0)
#endif
#define CAT8(l, h) __builtin_shufflevector((l), (h), 0, 1, 2, 3, 4, 5, 6, 7)
#define LO4(x) __builtin_shufflevector((x), (x), 0, 1, 2, 3)
#define HI4(x) __builtin_shufflevector((x), (x), 4, 5, 6, 7)
#define PG8_LDA(dst, b, h) do { _Pragma("unroll") for (int m = 0; m < 4; ++m) dst[m] = CAT8(*(const LAS v4i*)(lds + PG8_SA(b, h) + aoff + m * 2048), *(const LAS v4i*)(lds + PG8_SA(b, h) + aoff + m * 2048 + 1024)); } while (0)
#define PG8_LDB(dst, b, h) do { _Pragma("unroll") for (int n = 0; n < 2; ++n) dst[n] = CAT8(*(const LAS v4i*)(lds + PG8_SB(b, h) + boff + n * 2048), *(const LAS v4i*)(lds + PG8_SB(b, h) + boff + n * 2048 + 1024)); } while (0)
#define PG8_MMA(ai, bj, At, Bt) do { __builtin_amdgcn_s_setprio(1); \
        if constexpr (F8) { _Pragma("unroll") for (int m = 0; m < 4; ++m) { f32x4 _l = LO4(acc8[ai][bj][m]), _h = HI4(acc8[ai][bj][m]); \
            _l = __builtin_amdgcn_mfma_scale_f32_16x16x128_f8f6f4(Bt[0], At[m], _l, 0, 0, 0, 0x7f7f7f7f, 0, 0x7f7f7f7f); \
            _h = __builtin_amdgcn_mfma_scale_f32_16x16x128_f8f6f4(Bt[1], At[m], _h, 0, 0, 0, 0x7f7f7f7f, 0, 0x7f7f7f7f); acc8[ai][bj][m] = CAT8(_l, _h); } \
              \
            asm volatile("" : "+v"(acc8[ai][bj][0]), "+v"(acc8[ai][bj][1]), "+v"(acc8[ai][bj][2]), "+v"(acc8[ai][bj][3])); } \
        else { _Pragma("unroll") for (int m = 0; m < 4; ++m) { f32x4 _l = LO4(acc8[ai][bj][m]), _h = HI4(acc8[ai][bj][m]); \
            _l = __builtin_amdgcn_mfma_f32_16x16x32_bf16(__builtin_bit_cast(bf16x8, LO4(Bt[0])), __builtin_bit_cast(bf16x8, LO4(At[m])), _l, 0, 0, 0); \
            _l = __builtin_amdgcn_mfma_f32_16x16x32_bf16(__builtin_bit_cast(bf16x8, HI4(Bt[0])), __builtin_bit_cast(bf16x8, HI4(At[m])), _l, 0, 0, 0); \
            _h = __builtin_amdgcn_mfma_f32_16x16x32_bf16(__builtin_bit_cast(bf16x8, LO4(Bt[1])), __builtin_bit_cast(bf16x8, LO4(At[m])), _h, 0, 0, 0); \
            _h = __builtin_amdgcn_mfma_f32_16x16x32_bf16(__builtin_bit_cast(bf16x8, HI4(Bt[1])), __builtin_bit_cast(bf16x8, HI4(At[m])), _h, 0, 0, 0); acc8[ai][bj][m] = CAT8(_l, _h); } } \
        __builtin_amdgcn_s_setprio(0); } while (0)
#define PG8_WAIT_V(n) asm volatile("s_waitcnt vmcnt(" #n ")" ::: "memory")
#define PG8_WAIT_L(n) asm volatile("s_waitcnt lgkmcnt(" #n ")" ::: "memory")
#define PG8_BAR __builtin_amdgcn_s_barrier()
#define PG8_SCHED __builtin_amdgcn_sched_barrier(0)
#define A_OFFS(dst, u) do { _Pragma("unroll") for (int _h = 0; _h < 2; ++_h) _Pragma("unroll") for (int _i = 0; _i < 2; ++_i) { \
        const int _row = GATHER ? toktab[(u).am + _h * HALF + Rr[_i]] : ((u).am + _h * HALF + Rr[_i]); dst[_h][_i] = (unsigned)(_row * K + Cc[_i]) * 2u; } } while (0)
    Unit cur, nxt; int ui = 0;
    if (!S.next(0, cur)) return;
    f32x8 acc8[2][2][4];
#pragma unroll
    for (int a = 0; a < 2; ++a)
#pragma unroll
        for (int b = 0; b < 2; ++b)
#pragma unroll
            for (int m = 0; m < 4; ++m) acc8[a][b][m] = (f32x8){0.f, 0.f, 0.f, 0.f, 0.f, 0.f, 0.f, 0.f};
    v8i At[4], B0[2], B1[2];
    unsigned ao[2][2]; A_OFFS(ao, cur);
    const __amdgpu_buffer_rsrc_t rA = __builtin_amdgcn_make_buffer_rsrc((void*)g.A, 0, 0x7fffffff, 0x00020000), rB = __builtin_amdgcn_make_buffer_rsrc((void*)g.Bt, 0, 0x7fffffff, 0x00020000);
    const char* const rA_base = (const char*)g.A; const char* const rB_base = (const char*)g.Bt; (void)rA_base; (void)rB_base;
    const unsigned kstep = (unsigned)(BK * 2), hstep = (unsigned)HALF * K * 2;
    unsigned cB = (unsigned)(((size_t)cur.e * g.b_estride + (size_t)cur.pn * BM * K) * 2);
    PG8_STAGE(PG8_SB(0, 0), rB, cB, voffB); PG8_STAGE(PG8_SB(0, 1), rB, cB + hstep, voffB); PG8_STAGE(PG8_SA(0, 0), rA, 0u, ao[0]); PG8_STAGE(PG8_SA(0, 1), rA, 0u, ao[1]);
    if (wr == 1) PG8_BAR;
    PG8_WAIT_V(2); PG8_BAR;
    PG8_STAGE(PG8_SB(1, 0), rB, cB + kstep, voffB); PG8_STAGE(PG8_SA(1, 0), rA, kstep, ao[0]); PG8_STAGE(PG8_SB(1, 1), rB, cB + hstep + kstep, voffB);
    PG8_WAIT_V(6); PG8_BAR;
    for (;;) {
        const bool has_next = S.next(ui + 1, nxt);
        const unsigned nB = has_next ? (unsigned)(((size_t)nxt.e * g.b_estride + (size_t)nxt.pn * BM * K) * 2) : cB;
        GT_BEG(0);
#pragma unroll 1
        for (int t = 0; t < nt; t += 2) {
            const bool last = (t == nt - 2);
            const unsigned a1 = (unsigned)(t + 1) * kstep;
            const unsigned a2 = last ? 0u : (unsigned)(t + 2) * kstep, b2 = last ? nB : cB + (unsigned)(t + 2) * kstep;
            const unsigned a3 = a2 + kstep, b3 = b2 + kstep;
            unsigned a2o[2][2];
            if (last && has_next) { A_OFFS(a2o, nxt); }
            else {
#pragma unroll
                for (int _h = 0; _h < 2; ++_h)
#pragma unroll
                    for (int _i = 0; _i < 2; ++_i) a2o[_h][_i] = ao[_h][_i]; }
            PG8_LDB(B0, 0, 0); PG8_LDB(B1, 0, 1); PG8_SCHED; PG8_LDA(At, 0, 0); PG8_STAGE(PG8_SA(1, 1), rA, a1, ao[1]);
            PG8_WAIT_V(8); PG8_WAIT_L(0); PG8_BAR; PG8_MMA(0, 0, At, B0); PG8_MMA(0, 1, At, B1); PG8_BAR; PG8_SCHED;
            PG8_LDA(At, 0, 1); PG8_STAGE(PG8_SB(0, 0), rB, b2, voffB); PG8_STAGE(PG8_SB(0, 1), rB, b2 + hstep, voffB); PG8_STAGE(PG8_SA(0, 0), rA, a2, a2o[0]);
            PG8_WAIT_V(8); PG8_WAIT_L(0); PG8_BAR; PG8_MMA(1, 0, At, B0); PG8_MMA(1, 1, At, B1); PG8_BAR; PG8_SCHED;
            PG8_LDB(B0, 1, 0); PG8_LDB(B1, 1, 1); PG8_SCHED; PG8_LDA(At, 1, 0); PG8_STAGE(PG8_SA(0, 1), rA, a2, a2o[1]);
            PG8_WAIT_V(8); PG8_WAIT_L(0); PG8_BAR; PG8_MMA(0, 0, At, B0); PG8_MMA(0, 1, At, B1); PG8_BAR; PG8_SCHED;
            PG8_LDA(At, 1, 1); PG8_STAGE(PG8_SB(1, 0), rB, b3, voffB); PG8_STAGE(PG8_SB(1, 1), rB, b3 + hstep, voffB); PG8_STAGE(PG8_SA(1, 0), rA, a3, a2o[0]);
            PG8_WAIT_V(8); PG8_WAIT_L(0); PG8_BAR; PG8_MMA(1, 0, At, B0); PG8_MMA(1, 1, At, B1); PG8_BAR; PG8_SCHED;
            if (last) {
#pragma unroll
                for (int _h = 0; _h < 2; ++_h)
#pragma unroll
                    for (int _i = 0; _i < 2; ++_i) ao[_h][_i] = a2o[_h][_i]; }
        }
        GT_END(0); GT_BEG(1);
        if (wr == 0) PG8_BAR;
        { f32x4 acc[2][2][4][2];
#pragma unroll
          for (int a = 0; a < 2; ++a)
#pragma unroll
              for (int b = 0; b < 2; ++b)
#pragma unroll
                  for (int m = 0; m < 4; ++m) { acc[a][b][m][0] = LO4(acc8[a][b][m]); acc[a][b][m][1] = HI4(acc8[a][b][m]); }
          E(acc, cur, wr, wc, fr, fq); }
        GT_END(1);
        if (!has_next) break;
#pragma unroll
        for (int a = 0; a < 2; ++a)
#pragma unroll
            for (int b = 0; b < 2; ++b)
#pragma unroll
                for (int m = 0; m < 4; ++m) acc8[a][b][m] = (f32x8){0.f, 0.f, 0.f, 0.f, 0.f, 0.f, 0.f, 0.f};
        cur = nxt; cB = nB; ++ui;
        if (wr == 1) PG8_BAR;
    }
    PG8_WAIT_V(0);
    PG8_BAR;
#undef PG8_SA
#undef PG8_SB
#undef PG8_STAGE
#undef PG8_LDA
#undef PG8_LDB
#undef PG8_MMA
#undef PG8_WAIT_V
#undef PG8_WAIT_L
#undef PG8_BAR
#undef PG8_SCHED
#undef A_OFFS
#undef GT_BEG
#undef GT_END
#undef CAT8
#undef LO4
#undef HI4
}
struct EpiBias16 {
    static constexpr bool PERM = true;
    bf16_t* O; int ldc; const float* bias;
    __device__ __forceinline__ void operator()(const f32x4 (&acc)[2][2][4][2], const Unit& u, int wr, int wc, int fr, int fq) const {
        const int row0 = u.om + wr * 64 + fr, col0 = u.pn * BM + wc * 32 + 8 * fq;
        f32x4 bv[2][2];
#pragma unroll
        for (int bj = 0; bj < 2; ++bj)
#pragma unroll
            for (int n = 0; n < 2; ++n) bv[bj][n] = *(const f32x4*)(bias + col0 + bj * HALF + 4 * n);
#pragma unroll
        for (int ai = 0; ai < 2; ++ai)
#pragma unroll
            for (int m = 0; m < 4; ++m) { bf16_t* rowp = O + (size_t)(row0 + ai * HALF + m * 16) * ldc + col0;
#pragma unroll
                for (int bj = 0; bj < 2; ++bj) { const f32x4 v0 = acc[ai][bj][m][0] + bv[bj][0], v1 = acc[ai][bj][m][1] + bv[bj][1];
                    u32x4 w; w.x = cvt_pk(v0[0], v0[1]); w.y = cvt_pk(v0[2], v0[3]); w.z = cvt_pk(v1[0], v1[1]); w.w = cvt_pk(v1[2], v1[3]);
                    *(u32x4*)(rowp + bj * HALF) = w; } }
    }
};
template <bool XF32> struct EpiResid {
    static constexpr bool PERM = true;
    const void* Xin; bf16_t* X; const float* bias; const float* gate;
    __device__ __forceinline__ void operator()(const f32x4 (&acc)[2][2][4][2], const Unit& u, int wr, int wc, int fr, int fq) const {
        const int row0 = u.om + wr * 64 + fr, col0 = u.pn * BM + wc * 32 + 8 * fq; const float* gb = gate + (size_t)(u.om / SEQ) * (6 * D);
        f32x4 bv[2][2], gv[2][2];
#pragma unroll
        for (int bj = 0; bj < 2; ++bj)
#pragma unroll
            for (int n = 0; n < 2; ++n) { bv[bj][n] = *(const f32x4*)(bias + col0 + bj * HALF + 4 * n); gv[bj][n] = *(const f32x4*)(gb + col0 + bj * HALF + 4 * n); }
#pragma unroll
        for (int ai = 0; ai < 2; ++ai)
#pragma unroll
            for (int m = 0; m < 4; ++m) { const size_t off = (size_t)(row0 + ai * HALF + m * 16) * D + col0;
#pragma unroll
                for (int bj = 0; bj < 2; ++bj) { f32x4 x0, x1;
                    if (XF32) { x0 = *(const f32x4*)((const float*)Xin + off + bj * HALF); x1 = *(const f32x4*)((const float*)Xin + off + bj * HALF + 4); }
                    else { const u32x4 xb = *(const u32x4*)((const bf16_t*)Xin + off + bj * HALF); x0 = (f32x4){bf_lo(xb.x), bf_hi(xb.x), bf_lo(xb.y), bf_hi(xb.y)}; x1 = (f32x4){bf_lo(xb.z), bf_hi(xb.z), bf_lo(xb.w), bf_hi(xb.w)}; }
                    const f32x4 v0 = x0 + gv[bj][0] * (acc[ai][bj][m][0] + bv[bj][0]), v1 = x1 + gv[bj][1] * (acc[ai][bj][m][1] + bv[bj][1]);
                    u32x4 w; w.x = cvt_pk(v0[0], v0[1]); w.y = cvt_pk(v0[2], v0[3]); w.z = cvt_pk(v1[0], v1[1]); w.w = cvt_pk(v1[2], v1[3]);
                    *(u32x4*)(X + off + bj * HALF) = w; }
                asm volatile("" ::: "memory"); }
    }
};
template <int MODE> struct EpiPair {
    static constexpr bool PERM = true;
    void* O; const float* bias; int b_estride;
    __device__ __forceinline__ void operator()(const f32x4 (&acc)[2][2][4][2], const Unit& u, int wr, int wc, int fr, int fq) const {
        const int row0 = u.om + wr * 64 + fr, col0 = u.pn * HALF + wc * 32 + 8 * fq; const float* bb = bias + (size_t)u.e * b_estride;
        constexpr float ASC = MODE == 1 ? 1.0f / (F8_SH * F8_SW) : 1.0f;
        f32x4 bv[2][2];
#pragma unroll
        for (int bj = 0; bj < 2; ++bj)
#pragma unroll
            for (int n = 0; n < 2; ++n) bv[bj][n] = *(const f32x4*)(bb + bj * D + col0 + 4 * n);
#pragma unroll
        for (int ai = 0; ai < 2; ++ai)
#pragma unroll
            for (int m = 0; m < 4; ++m) { float r[8];
#pragma unroll
                for (int n = 0; n < 2; ++n) { const f32x4 a = acc[ai][0][m][n] * ASC + bv[0][n], g = acc[ai][1][m][n] * ASC + bv[1][n];
#pragma unroll
                    for (int jp = 0; jp < 2; ++jp) {
                        f32x2 av = (f32x2){a[2 * jp], a[2 * jp + 1]}, gv = (f32x2){g[2 * jp], g[2 * jp + 1]}, o;
                        if (MODE == 0) { const f32x2 x = gv * (-LOG2E); f32x2 e; e.x = __builtin_amdgcn_exp2f(x.x); e.y = __builtin_amdgcn_exp2f(x.y); const f32x2 d = e + 1.0f;
                            f32x2 rc; rc.x = __builtin_amdgcn_rcpf(d.x); rc.y = __builtin_amdgcn_rcpf(d.y); o = av * rc; }
                        else { f32x2 glu, lin; glu.x = fminf(av.x, 7.0f); glu.y = fminf(av.y, 7.0f); lin.x = __builtin_amdgcn_fmed3f(gv.x, -7.0f, 7.0f); lin.y = __builtin_amdgcn_fmed3f(gv.y, -7.0f, 7.0f);
                            const f32x2 x = glu * (-1.702f * LOG2E); f32x2 e; e.x = __builtin_amdgcn_exp2f(x.x); e.y = __builtin_amdgcn_exp2f(x.y); const f32x2 d = e + 1.0f;
                            f32x2 rc; rc.x = __builtin_amdgcn_rcpf(d.x); rc.y = __builtin_amdgcn_rcpf(d.y); o = (glu * rc) * (lin * F8_SACT + F8_SACT); }
                        r[4 * n + 2 * jp] = o.x; r[4 * n + 2 * jp + 1] = o.y; } }
                if (MODE == 0) { bf16_t* rowp = (bf16_t*)O + (size_t)(row0 + ai * HALF + m * 16) * D + col0;
                    u32x4 w; w.x = cvt_pk(r[0], r[1]); w.y = cvt_pk(r[2], r[3]); w.z = cvt_pk(r[4], r[5]); w.w = cvt_pk(r[6], r[7]); *(u32x4*)rowp = w; }
                else { unsigned char* rowp = (unsigned char*)O + (size_t)(row0 + ai * HALF + m * 16) * D + col0;
                    u32x2 w; w.x = cvt_pk4_fp8_nc(r[0], r[1], r[2], r[3]); w.y = cvt_pk4_fp8_nc(r[4], r[5], r[6], r[7]); *(u32x2*)rowp = w; } }
    }
};
struct EpiMoeOut {
    static constexpr bool PERM = true;
    bf16_t* O; const float* bias; const float* gl; const LAS int* exoff;
    __device__ __forceinline__ void operator()(const f32x4 (&acc)[2][2][4][2], const Unit& u, int wr, int wc, int fr, int fq) const {
        const int row0 = u.om + wr * 64 + fr, col0 = u.pn * BM + wc * 32 + 8 * fq; const float* bb = bias + (size_t)u.e * D;
        const GAS float* gp = (const GAS float*)(gl + (size_t)u.e * T + (u.om - exoff[u.e]) + wr * 64 + fr);
        f32x4 bv[2][2]; float gt[2][4];
#pragma unroll
        for (int ai = 0; ai < 2; ++ai)
#pragma unroll
            for (int m = 0; m < 4; ++m) gt[ai][m] = gp[ai * HALF + m * 16];
#pragma unroll
        for (int bj = 0; bj < 2; ++bj)
#pragma unroll
            for (int n = 0; n < 2; ++n) bv[bj][n] = *(const GAS f32x4*)(bb + col0 + bj * HALF + 4 * n);
#pragma unroll
        for (int ai = 0; ai < 2; ++ai)
#pragma unroll
            for (int m = 0; m < 4; ++m) { GAS unsigned char* rowp = (GAS unsigned char*)O + (size_t)(row0 + ai * HALF + m * 16) * D + col0; const float g16 = gt[ai][m] * F8_SY;
#pragma unroll
                for (int bj = 0; bj < 2; ++bj) { const f32x4 v0 = (acc[ai][bj][m][0] * (1.0f / (F8_SACT * F8_SW)) + bv[bj][0]) * g16, v1 = (acc[ai][bj][m][1] * (1.0f / (F8_SACT * F8_SW)) + bv[bj][1]) * g16;
                    u32x2 w; w.x = cvt_pk4_fp8(v0[0], v0[1], v0[2], v0[3]); w.y = cvt_pk4_fp8(v1[0], v1[1], v1[2], v1[3]);
                    *(GAS u32x2*)(rowp + bj * HALF) = w; } }
    }
};

struct Frame {
    LAS unsigned char* lds; volatile LAS unsigned* MISC; gu32* ctl; unsigned char* ws;
    int tid, lane, wave, G, c;
    int xcc, rank, loc;
    const float* const* in;
    float* out;
};
enum { I_X = 0, I_C, I_WMOD, I_BMOD, I_NMG, I_NFG, I_AWQKV, I_ABQKV, I_AWO, I_ABO, I_SINK, I_RELB, I_CWIN, I_CBIN, I_CWDW, I_CBDW, I_CLNG, I_CLNB, I_CWOUT, I_CBOUT, I_RW, I_RB, I_MWIN, I_MBIN, I_MWOUT, I_MBOUT, I_FNG };
#define WSP(type, off) ((type*)(F.ws + (off)))
__device__ __forceinline__ void wg_barrier() { __syncthreads(); }

__device__ __forceinline__ int build_exp_tables(Frame& F, int layer) {
    LAS int* EX = (LAS int*)(F.lds + LDS_EXP);
    if (F.MISC[22] == (unsigned)(layer + 1)) return EX[96];
    if (F.tid < 64) {
        const int e = F.tid & 31; const int cnt = (int)__hip_atomic_load(F.ctl + CW_CNT + 64 * layer + e, RLX_AGENT); const int tiles = (cnt + 255) >> 8;
        int pre = tiles;
#pragma unroll
        for (int o = 1; o < 32; o <<= 1) { const int v = __shfl_up(pre, o, 32); if (e >= o) pre += v; }
        if (F.tid < 32) { EX[e] = cnt; EX[32 + e] = pre - tiles; EX[64 + e] = (pre - tiles) * 256; if (e == 31) EX[96] = pre; }
    }
    wg_barrier();
    if (F.tid == 0) F.MISC[22] = (unsigned)(layer + 1);
    return EX[96];
}
template <int MODE> __device__ __forceinline__ void row_phase(Frame& F, int layer) {
    constexpr bool COMB = (MODE & 1) != 0, ROUT = (MODE & 2) != 0, FIN = (MODE & 4) != 0;
    LAS float* red = (LAS float*)(F.lds); LAS float* part = (LAS float*)(F.lds + 49152); LAS float* lg = (LAS float*)(F.lds + 49152 + 65536);
    LAS int* hist = (LAS int*)(F.lds + 4608); LAS int* gbase = hist + 32; LAS int* pend = (LAS int*)(F.lds + 8192);
    const LAS int* EX = (const LAS int*)(F.lds + LDS_EXP);
    const int lane = F.lane, w = F.wave, row = lane & 15, kq = lane >> 4;
    constexpr int KS = (MODE & 2) ? 32 : 8;
    const int kb = (MODE & 2) ? 128 * w + 8 * kq : 128 * w + 32 * kq;
    constexpr bool XF32 = (MODE == 0);
    const float* xin = F.in[I_X]; bf16_t* X = WSP(bf16_t, WS_X); bf16_t* H = WSP(bf16_t, WS_H);
    const float* mod = WSP(const float, WS_MOD);
    const float* gamma = FIN ? F.in[I_FNG] : (ROUT ? F.in[I_NFG] + layer * D : F.in[I_NMG] + layer * D);
    const int ngrp = T / 16; int g0 = (int)((long)F.c * ngrp / F.G), g1 = (int)((long)(F.c + 1) * ngrp / F.G);
    if (F.loc) { g0 = F.xcc * (SEQ / 16) + 4 * F.rank; g1 = g0 + 4; }
    if (COMB) build_exp_tables(F, layer - 1);
    if (ROUT) { if (F.tid < 32) hist[F.tid] = 0; }
    bf16x8 whi[2][4], wlo[2][4];
    if (ROUT) {
        const float* wrp = F.in[I_RW] + (size_t)layer * D * NE;
#pragma unroll
        for (int eh = 0; eh < 2; ++eh)
#pragma unroll
            for (int s = 0; s < 4; ++s) { float v[8];
#pragma unroll
                for (int j = 0; j < 8; ++j) v[j] = wrp[(size_t)(kb + 32 * s + j) * NE + 16 * eh + row];
                u32x4 hi, lo;
#pragma unroll
                for (int p = 0; p < 4; ++p) { const unsigned h2 = cvt_pk(v[2 * p], v[2 * p + 1]); hi[p] = h2; lo[p] = cvt_pk(v[2 * p] - bf_lo(h2), v[2 * p + 1] - bf_hi(h2)); }
                whi[eh][s] = __builtin_bit_cast(bf16x8, hi); wlo[eh][s] = __builtin_bit_cast(bf16x8, lo); }
    }
    LAS float* Gl = (LAS float*)(F.lds + 32768); LAS float* Sl = Gl + D; LAS float* Fl = Sl + D;
    constexpr int GU = (XF32 || ROUT) ? 2 : 4;
#define UNPK0(v) ((f32x4){bf_lo((v).x), bf_hi((v).x), bf_lo((v).y), bf_hi((v).y)})
#define UNPK1(v) ((f32x4){bf_lo((v).z), bf_hi((v).z), bf_lo((v).w), bf_hi((v).w)})
    int curb = -1;
    for (int grp0 = g0; grp0 < g1; grp0 += GU) {
        const int b = (grp0 * 16) / SEQ, par = ((grp0 - g0) / GU) & 1;
        if (b != curb) { curb = b;
            const float* mb = mod + ((size_t)layer * NBATCH + b) * (6 * D);
            wg_barrier();
            for (int k = F.tid; k < D; k += NTHR) { const float gm = gamma[k];
                if (FIN) { Gl[k] = gm; Sl[k] = 0.f; }
                else { const float* shp = mb + (ROUT ? 3 * D : 0); const float* scp = mb + (ROUT ? 4 * D : D); Gl[k] = gm * (scp[k] + 1.0f); Sl[k] = shp[k]; }
                if (COMB) { const float* gf = mod + ((size_t)(layer - 1) * NBATCH + b) * (6 * D) + 5 * D; Fl[k] = gf[k]; } }
            wg_barrier();
        }
        u32x4 xb[GU][4]; int tks[GU][4];
#pragma unroll
        for (int u = 0; u < GU; ++u) { const int t = (grp0 + u < g1 ? grp0 + u : g1 - 1) * 16 + row;
            if (COMB) { const int* TK = WSP(const int, WS_TK);
#pragma unroll
                for (int kk = 0; kk < 4; ++kk) tks[u][kk] = TK[t * 4 + kk]; }
#pragma unroll
            for (int s = 0; s < 4; ++s) {
                if (XF32) { const f32x4 x0 = *(const f32x4*)(xin + (size_t)t * D + kb + KS * s), x1 = *(const f32x4*)(xin + (size_t)t * D + kb + KS * s + 4);
                    xb[u][s].x = cvt_pk(x0[0], x0[1]); xb[u][s].y = cvt_pk(x0[2], x0[3]); xb[u][s].z = cvt_pk(x1[0], x1[1]); xb[u][s].w = cvt_pk(x1[2], x1[3]); }
                else xb[u][s] = *(const u32x4*)(X + (size_t)t * D + kb + KS * s); } }
        if (COMB) {
            const unsigned char* YS = WSP(const unsigned char, WS_YS);
#pragma unroll
            for (int u = 0; u < GU; ++u) { const int t = (grp0 + u < g1 ? grp0 + u : g1 - 1) * 16 + row;
                size_t yoff[4];
#pragma unroll
                for (int kk = 0; kk < 4; ++kk) { const int tk = tks[u][kk]; yoff[kk] = (size_t)(EX[64 + (tk >> 16)] + (tk & 0xffff)) * D + kb; }
                u32x2 yv[4][4];
#pragma unroll
                for (int s = 0; s < 4; ++s)
#pragma unroll
                    for (int kk = 0; kk < 4; ++kk) yv[s][kk] = *(const u32x2*)(YS + yoff[kk] + KS * s);
#pragma unroll
                for (int s = 0; s < 4; ++s) { f32x4 a0 = (f32x4){0.f, 0.f, 0.f, 0.f}, a1 = a0;
#pragma unroll
                    for (int kk = 0; kk < 4; ++kk) { a0 += fp8x4_to_f32(yv[s][kk].x); a1 += fp8x4_to_f32(yv[s][kk].y); }
                    const f32x4 x0 = UNPK0(xb[u][s]) + *(const LAS f32x4*)(Fl + kb + KS * s) * a0 * (1.0f / F8_SY), x1 = UNPK1(xb[u][s]) + *(const LAS f32x4*)(Fl + kb + KS * s + 4) * a1 * (1.0f / F8_SY);
                    xb[u][s].x = cvt_pk(x0[0], x0[1]); xb[u][s].y = cvt_pk(x0[2], x0[3]); xb[u][s].z = cvt_pk(x1[0], x1[1]); xb[u][s].w = cvt_pk(x1[2], x1[3]);
                    if (!FIN && grp0 + u < g1) *(u32x4*)(X + (size_t)t * D + kb + KS * s) = xb[u][s]; } }
        }
#pragma unroll
        for (int u = 0; u < GU; ++u) { float ss = 0.f;
#pragma unroll
            for (int s = 0; s < 4; ++s) { const f32x4 v0 = UNPK0(xb[u][s]), v1 = UNPK1(xb[u][s]); ss += (v0[0] * v0[0] + v0[1] * v0[1]) + (v0[2] * v0[2] + v0[3] * v0[3]) + (v1[0] * v1[0] + v1[1] * v1[1]) + (v1[2] * v1[2] + v1[3] * v1[3]); }
            ss += __shfl_xor(ss, 16); ss += __shfl_xor(ss, 32);
            if (kq == 0) red[(par * GU + u) * 128 + w * 16 + row] = ss; }
        wg_barrier();
        f32x4 acc[GU][2];
#pragma unroll
        for (int u = 0; u < GU; ++u) { const int t = (grp0 + u < g1 ? grp0 + u : g1 - 1) * 16 + row; const bool live = grp0 + u < g1;
            float tot = 0.f;
#pragma unroll
            for (int ww = 0; ww < 8; ++ww) tot += red[(par * GU + u) * 128 + ww * 16 + row];
            const float rstd = rsqrtf(tot * (1.0f / D) + 1e-5f);
            acc[u][0] = (f32x4){0.f, 0.f, 0.f, 0.f}; acc[u][1] = acc[u][0];
#pragma unroll
            for (int s = 0; s < 4; ++s) {
                const f32x4 h0 = UNPK0(xb[u][s]) * rstd * *(const LAS f32x4*)(Gl + kb + KS * s) + *(const LAS f32x4*)(Sl + kb + KS * s), h1 = UNPK1(xb[u][s]) * rstd * *(const LAS f32x4*)(Gl + kb + KS * s + 4) + *(const LAS f32x4*)(Sl + kb + KS * s + 4);
                if (FIN) { if (live) { *(f32x4*)(F.out + (size_t)t * D + kb + KS * s) = h0; *(f32x4*)(F.out + (size_t)t * D + kb + KS * s + 4) = h1; } }
                else {
                    u32x4 hi; hi.x = cvt_pk(h0[0], h0[1]); hi.y = cvt_pk(h0[2], h0[3]); hi.z = cvt_pk(h1[0], h1[1]); hi.w = cvt_pk(h1[2], h1[3]);
                    if (!ROUT) { if (live) *(u32x4*)(H + (size_t)t * D + kb + KS * s) = hi; }
                    else { u32x2 q8; q8.x = cvt_pk4_fp8(h0[0] * F8_SH, h0[1] * F8_SH, h0[2] * F8_SH, h0[3] * F8_SH); q8.y = cvt_pk4_fp8(h1[0] * F8_SH, h1[1] * F8_SH, h1[2] * F8_SH, h1[3] * F8_SH);
                        if (live) *(u32x2*)((unsigned char*)H + (size_t)t * D + kb + KS * s) = q8; }
                    if (ROUT) {
                        u32x4 lo; lo.x = cvt_pk(h0[0] - bf_lo(hi.x), h0[1] - bf_hi(hi.x)); lo.y = cvt_pk(h0[2] - bf_lo(hi.y), h0[3] - bf_hi(hi.y));
                        lo.z = cvt_pk(h1[0] - bf_lo(hi.z), h1[1] - bf_hi(hi.z)); lo.w = cvt_pk(h1[2] - bf_lo(hi.w), h1[3] - bf_hi(hi.w));
                        const bf16x8 ah = __builtin_bit_cast(bf16x8, hi), al = __builtin_bit_cast(bf16x8, lo);
#pragma unroll
                        for (int eh = 0; eh < 2; ++eh) {
                            acc[u][eh] = __builtin_amdgcn_mfma_f32_16x16x32_bf16(ah, whi[eh][s], acc[u][eh], 0, 0, 0);
                            acc[u][eh] = __builtin_amdgcn_mfma_f32_16x16x32_bf16(ah, wlo[eh][s], acc[u][eh], 0, 0, 0);
                            acc[u][eh] = __builtin_amdgcn_mfma_f32_16x16x32_bf16(al, whi[eh][s], acc[u][eh], 0, 0, 0); }
                    }
                }
            }
        }
        if (ROUT) {
#pragma unroll
            for (int u = 0; u < GU; ++u)
#pragma unroll
                for (int eh = 0; eh < 2; ++eh)
#pragma unroll
                    for (int i = 0; i < 4; ++i) part[((u * 8 + w) * 16 + 4 * kq + i) * 32 + 16 * eh + row] = acc[u][eh][i];
            wg_barrier();
#pragma unroll
            for (int u = 0; u < GU; ++u) { const int r = F.tid >> 5, e = F.tid & 31; float v = F.in[I_RB][layer * NE + e];
#pragma unroll
                for (int ww = 0; ww < 8; ++ww) v += part[((u * 8 + ww) * 16 + r) * 32 + e];
                lg[(u * 16 + r) * 32 + e] = v; }
            wg_barrier();
            if (F.tid < 16 * GU && grp0 + (F.tid >> 4) < g1) {
                const int u = F.tid >> 4, r = F.tid & 15; unsigned used = 0u; int ids[4]; float vals[4];
#pragma unroll
                for (int k = 0; k < 4; ++k) { int bi = 0; float bv = -3.0e38f;
                    for (int e = 0; e < 32; ++e) { const float v = lg[(u * 16 + r) * 32 + e]; if (!((used >> e) & 1u) && v > bv) { bv = v; bi = e; } }
                    used |= 1u << bi; ids[k] = bi; vals[k] = bv; }
                const float e1 = __expf(vals[1] - vals[0]), e2 = __expf(vals[2] - vals[0]), e3 = __expf(vals[3] - vals[0]), inv = 1.0f / (1.0f + e1 + e2 + e3);
                const float gs[4] = {inv, e1 * inv, e2 * inv, e3 * inv};
#pragma unroll
                for (int k = 0; k < 4; ++k) { const int lp = atomicAdd((int*)&hist[ids[k]], 1); const int idx = ((grp0 + u - g0) * 16 + r) * 4 + k; pend[2 * idx] = ids[k] | (lp << 8); pend[2 * idx + 1] = __float_as_int(gs[k]); }
            }
        }
    }
#undef UNPK0
#undef UNPK1
    if (ROUT) {
        wg_barrier();
        if (F.tid < 32) { const int n = hist[F.tid]; gbase[F.tid] = n > 0 ? (int)__hip_atomic_fetch_add(F.ctl + CW_CNT + 64 * layer + F.tid, (unsigned)n, RLX_AGENT) : 0; }
        wg_barrier();
        int* LIST = WSP(int, WS_LIST); float* GL = WSP(float, WS_GLIST); int* TK = WSP(int, WS_TK);
        const int nent = (g1 - g0) * 64;
        for (int idx = F.tid; idx < nent; idx += NTHR) { const int pw = pend[2 * idx], e = pw & 0xff, pos = gbase[e] + (pw >> 8), tok = g0 * 16 + (idx >> 2);
            LIST[(size_t)e * T + pos] = tok; GL[(size_t)e * T + pos] = __int_as_float(pend[2 * idx + 1]); TK[tok * 4 + (idx & 3)] = (e << 16) | pos; }
    }
    wg_barrier();
}
__device__ const unsigned char kBucket[128] = {0, 1, 2, 3, 4, 5, 6, 7, 8, 9, 10, 11, 12, 13, 14, 15, 16, 16, 16, 17, 17, 18, 18, 18, 19, 19, 19, 20, 20, 20, 20, 21, 21, 21, 21, 22, 22, 22, 22, 22, 23, 23, 23, 23, 23, 23, 24, 24, 24, 24, 24, 24, 25, 25, 25, 25, 25, 25, 25, 26, 26, 26, 26, 26, 26, 26, 26, 27, 27, 27, 27, 27, 27, 27, 27, 27, 27, 28, 28, 28, 28, 28, 28, 28, 28, 28, 28, 29, 29, 29, 29, 29, 29, 29, 29, 29, 29, 29, 29, 30, 30, 30, 30, 30, 30, 30, 30, 30, 30, 30, 30, 30, 30, 31, 31, 31, 31, 31, 31, 31, 31, 31, 31, 31, 31, 31, 31, 31};
constexpr int KP = 144, VP = 192;
constexpr int ATT_K = 0, ATT_V = 256 * KP, ATT_B = ATT_V + 256 * VP;
__device__ __forceinline__ int crow(int r, int hi) { return (r & 3) + 8 * (r >> 2) + 4 * hi; }
typedef short v4i16_t __attribute__((ext_vector_type(4)));
__device__ __forceinline__ s16x4 vtr(const LAS unsigned char* p) { return __builtin_bit_cast(s16x4, __builtin_amdgcn_ds_read_tr16_b64_v4i16((LAS v4i16_t*)p)); }

__device__ __forceinline__ void attn_phase(Frame& F, int j) {
    const bf16_t* QKV = WSP(const bf16_t, WS_QKV); bf16_t* AO = WSP(bf16_t, WS_AO);
    LAS unsigned char* Kl = F.lds + ATT_K; LAS unsigned char* Vl = F.lds + ATT_V; LAS float* Bl = (LAS float*)(F.lds + ATT_B);
    const int lane = F.lane, w = F.wave, r = lane & 31, hh = lane >> 5;
    const float c1 = 0.125f * LOG2E;
    const int u_beg = F.loc ? F.xcc * 64 + F.rank : F.c, u_step = F.loc ? 32 : F.G, u_end = F.loc ? F.xcc * 64 + 64 : NBATCH * 16 * 4;
    for (int unit = u_beg; unit < u_end; unit += u_step) {
        const int kvh = unit & 3, n = (unit >> 2) & 15, b = unit >> 6;
        const int krow0 = b * SEQ + (n > 0 ? (n - 1) * 128 : 0);
#pragma unroll
        for (int it = 0; it < 4; ++it) { const int ch = F.tid + NTHR * it, s = ch >> 3, c8 = ch & 7;
            const int grow = (n > 0 || s >= 128) ? (b * SEQ + (n - 1) * 128 + s) : (krow0 + s);
            const u32x4 kv = *(const u32x4*)(QKV + (size_t)grow * 1536 + 1024 + kvh * 64 + 8 * c8); const u32x4 vv = *(const u32x4*)(QKV + (size_t)grow * 1536 + 1280 + kvh * 64 + 8 * c8);
            *(LAS u32x4*)(Kl + s * KP + 16 * c8) = kv; *(LAS u32x4*)(Vl + s * VP + 16 * c8) = vv; }
        { const int g = F.tid >> 7, dist = F.tid & 127; Bl[F.tid] = F.in[I_RELB][kBucket[dist] * 16 + kvh * 4 + g] * LOG2E; }
        wg_barrier();
        const int g = w >> 1, hq = kvh * 4 + g; const float sink2 = F.in[I_SINK][j * 16 + hq] * LOG2E;
#pragma unroll 1
        for (int grp = 0; grp < 2; ++grp) {
            const int a0 = (w & 1) * 64 + grp * 32, a = a0 + r; const size_t tok = (size_t)b * SEQ + n * 128 + a;
            bf16x8 qf[4];
#pragma unroll
            for (int d0 = 0; d0 < 4; ++d0) qf[d0] = *(const bf16x8*)(QKV + tok * 1536 + hq * 64 + 16 * d0 + 8 * hh);
            const int kt0 = a0 >> 5;
            f32x16 S[5];
#pragma unroll
            for (int t = 0; t < 5; ++t) {
#pragma unroll
                for (int i = 0; i < 16; ++i) S[t][i] = 0.f;
                const LAS unsigned char* kp = Kl + (32 * (kt0 + t) + r) * KP + 16 * hh;
#pragma unroll
                for (int d0 = 0; d0 < 4; ++d0) { const bf16x8 kf = *(const LAS bf16x8*)(kp + 32 * d0); S[t] = __builtin_amdgcn_mfma_f32_32x32x16_bf16(kf, qf[d0], S[t], 0, 0, 0); }
            }
            float m = sink2;
#pragma unroll
            for (int t = 0; t < 5; ++t)
#pragma unroll
                for (int i = 0; i < 16; ++i) { const int s = 32 * (kt0 + t) + crow(i, hh), dist = a + 128 - s; const bool ok = (dist >= 0) && (dist < 128) && (n > 0 || s >= 128);
                    const float v = ok ? S[t][i] * c1 + Bl[g * 128 + (dist & 127)] : -3.0e38f; S[t][i] = v; m = fmaxf(m, v); }
            m = fmaxf(m, __shfl_xor(m, 32));
            float l = 0.f;
#pragma unroll
            for (int t = 0; t < 5; ++t)
#pragma unroll
                for (int i = 0; i < 16; ++i) { const float p = __builtin_amdgcn_exp2f(S[t][i] - m); S[t][i] = p; l += p; }
            l += __shfl_xor(l, 32); l += __builtin_amdgcn_exp2f(sink2 - m);
            f32x16 O[2];
#pragma unroll
            for (int i = 0; i < 16; ++i) { O[0][i] = 0.f; O[1][i] = 0.f; }
            const int q4 = (lane >> 2) & 3, p4 = lane & 3, blk = (lane >> 4) & 1;
#pragma unroll
            for (int t = 0; t < 5; ++t)
#pragma unroll
                for (int s2 = 0; s2 < 2; ++s2) {
                    u32x4 pk; pk.x = cvt_pk(S[t][8 * s2 + 0], S[t][8 * s2 + 1]); pk.y = cvt_pk(S[t][8 * s2 + 2], S[t][8 * s2 + 3]); pk.z = cvt_pk(S[t][8 * s2 + 4], S[t][8 * s2 + 5]); pk.w = cvt_pk(S[t][8 * s2 + 6], S[t][8 * s2 + 7]);
                    const bf16x8 pb = __builtin_bit_cast(bf16x8, pk);
                    const LAS unsigned char* vp = Vl + (32 * (kt0 + t) + 16 * s2 + 4 * hh + q4) * VP + 32 * blk + 8 * p4;
#pragma unroll
                    for (int dh = 0; dh < 2; ++dh) { const s16x4 lo = vtr(vp + 64 * dh), hi = vtr(vp + 64 * dh + 8 * VP);
                        const bf16x8 va = (bf16x8){lo[0], lo[1], lo[2], lo[3], hi[0], hi[1], hi[2], hi[3]};
                        O[dh] = __builtin_amdgcn_mfma_f32_32x32x16_bf16(va, pb, O[dh], 0, 0, 0); }
                }
            const float inv = 1.0f / l;
#pragma unroll
            for (int dh = 0; dh < 2; ++dh)
#pragma unroll
                for (int g4 = 0; g4 < 4; ++g4) { u32x2 o2; o2.x = cvt_pk(O[dh][4 * g4] * inv, O[dh][4 * g4 + 1] * inv); o2.y = cvt_pk(O[dh][4 * g4 + 2] * inv, O[dh][4 * g4 + 3] * inv);
                    *(u32x2*)(AO + tok * D + hq * 64 + 32 * dh + 8 * g4 + 4 * hh) = o2; }
        }
        wg_barrier();
    }
}

__device__ __forceinline__ float wave_sum63(float v) {
    v += __builtin_bit_cast(float, __builtin_amdgcn_update_dpp(0, __builtin_bit_cast(int, v), 0x111, 0xf, 0xf, true));
    v += __builtin_bit_cast(float, __builtin_amdgcn_update_dpp(0, __builtin_bit_cast(int, v), 0x112, 0xf, 0xf, true));
    v += __builtin_bit_cast(float, __builtin_amdgcn_update_dpp(0, __builtin_bit_cast(int, v), 0x114, 0xf, 0xf, true));
    v += __builtin_bit_cast(float, __builtin_amdgcn_update_dpp(0, __builtin_bit_cast(int, v), 0x118, 0xf, 0xf, true));
    v += __builtin_bit_cast(float, __builtin_amdgcn_update_dpp(0, __builtin_bit_cast(int, v), 0x142, 0xa, 0xf, true));
    v += __builtin_bit_cast(float, __builtin_amdgcn_update_dpp(0, __builtin_bit_cast(int, v), 0x143, 0xc, 0xf, true));
    return v;
}
__device__ __forceinline__ void dwconv_phase(Frame& F, int j, unsigned long long& t_acc) {
#ifndef TIME_KIND
#define TIME_KIND (-1)
#endif
    unsigned long long t_b = 0ull;
#define DT_BEG(k) do { if (TIME_KIND == (k)) t_b = __builtin_amdgcn_s_memrealtime(); } while (0)
#define DT_END(k) do { if (TIME_KIND == (k)) t_acc += __builtin_amdgcn_s_memrealtime() - t_b; } while (0)
    constexpr int PP = 520;
    DT_BEG(16);
    const bf16_t* U = WSP(const bf16_t, WS_U); bf16_t* YC = WSP(bf16_t, WS_AO);
    LAS unsigned char* ut = F.lds; LAS float* P = (LAS float*)F.lds; LAS float* fin = (LAS float*)(F.lds + 64 * PP * 4);
    const int tid = F.tid, lane = F.lane, w = F.wave;
    const float* wd = F.in[I_CWDW] + (size_t)j * 31 * D + 2 * tid;
    f32x2 wk[31];
#pragma unroll
    for (int q = 0; q < 31; ++q) wk[q] = *(const f32x2*)(wd + q * D);
    const f32x2 bdw = *(const f32x2*)(F.in[I_CBDW] + j * D + 2 * tid), lng = *(const f32x2*)(F.in[I_CLNG] + j * D + 2 * tid), lnb = *(const f32x2*)(F.in[I_CLNB] + j * D + 2 * tid);
    const __amdgpu_buffer_rsrc_t rU = __builtin_amdgcn_make_buffer_rsrc((void*)U, 0, 0x7fffffff, 0x00020000);
    asm volatile("s_waitcnt vmcnt(0)" ::: "memory"); DT_END(16);
    const int tl_beg = F.loc ? F.xcc * 64 + F.rank : F.c, tl_step = F.loc ? 32 : F.G, tl_end = F.loc ? F.xcc * 64 + 64 : T / 32;
    for (int tile = tl_beg; tile < tl_end; tile += tl_step) {
        const int t0 = tile * 32, tin0 = t0 % SEQ, rlo = tin0 >= 30 ? 0 : 30 - tin0;
        DT_BEG(12);
        for (int pc = w; pc < 124; pc += NWAVES) { const int rr = pc >> 1;
            if (rr >= rlo) __builtin_amdgcn_raw_ptr_buffer_load_lds(rU, (LAS unsigned*)(ut + pc * 1024), 16, lane * 16, (int)(((size_t)(t0 + rr - 30) * D + (pc & 1) * 512) * 2), 0, 0);
            else *(LAS u32x4*)(ut + pc * 1024 + lane * 16) = (u32x4){0u, 0u, 0u, 0u}; }
        asm volatile("s_waitcnt vmcnt(0)" ::: "memory");
        wg_barrier();
        DT_END(12); DT_BEG(13);
        f32x2 y[32];
#pragma unroll
        for (int blk = 0; blk < 4; ++blk) {
            f32x2 a[8] = {bdw, bdw, bdw, bdw, bdw, bdw, bdw, bdw};
#pragma unroll
            for (int rr = 0; rr < 38; ++rr) { const unsigned uw = *(const LAS unsigned*)(ut + (8 * blk + rr) * 2048 + 4 * tid); const f32x2 uv = (f32x2){bf_lo(uw), bf_hi(uw)};
#pragma unroll
                for (int o = 0; o < 8; ++o) { const int q = rr - o; if (q >= 0 && q < 31) a[o] += wk[q] * uv; } }
#pragma unroll
            for (int o = 0; o < 8; ++o) y[8 * blk + o] = a[o];
        }
        DT_END(13); DT_BEG(14);
        wg_barrier();
#pragma unroll
        for (int tk = 0; tk < 32; ++tk) { P[(2 * tk) * PP + tid] = y[tk].x + y[tk].y; P[(2 * tk + 1) * PP + tid] = y[tk].x * y[tk].x + y[tk].y * y[tk].y; }
        wg_barrier();
        { const int qn = tid >> 3, l8 = tid & 7; float v = 0.f;
#pragma unroll 16
          for (int i2 = 0; i2 < 64; ++i2) v += P[qn * PP + l8 + 8 * i2];
          v += __shfl_xor(v, 1); v += __shfl_xor(v, 2); v += __shfl_xor(v, 4);
          if (l8 == 0) fin[qn] = v; }
        wg_barrier();
        DT_END(14); DT_BEG(15);
#pragma unroll
        for (int tk = 0; tk < 32; ++tk) { const float mean = fin[2 * tk] * (1.0f / D), var = fmaxf(fin[2 * tk + 1] * (1.0f / D) - mean * mean, 0.f), rstd = rsqrtf(var + 1e-5f);
            const float v0 = (y[tk].x - mean) * rstd * lng.x + lnb.x, v1 = (y[tk].y - mean) * rstd * lng.y + lnb.y;
            *(unsigned*)(YC + (size_t)(t0 + tk) * D + 2 * tid) = cvt_pk(v0 * sigmoid_f(v0), v1 * sigmoid_f(v1)); }
        asm volatile("s_waitcnt vmcnt(0)" ::: "memory");
        wg_barrier();
        DT_END(15);
    }
#undef DT_BEG
#undef DT_END
}
__device__ __forceinline__ void p0_mod_task(Frame& F, int task) {
    LAS float* cact = (LAS float*)F.lds; LAS float* part = (LAS float*)(F.lds + 32768);
    const int i = task / 24, n0 = (task % 24) * 256, tid = F.tid, lane = F.lane, w = F.wave;
    for (int q = tid; q < NBATCH * D; q += NTHR) { const float cv = F.in[I_C][q]; cact[q] = cv * sigmoid_f(cv); }
    wg_barrier();
    f32x4 acc[8];
#pragma unroll
    for (int b = 0; b < 8; ++b) acc[b] = (f32x4){0.f, 0.f, 0.f, 0.f};
    const float* Wp = F.in[I_WMOD] + ((size_t)i * D + 128 * w) * (6 * D) + n0 + 4 * lane;
#pragma unroll 4
    for (int k = 0; k < 128; ++k) { const f32x4 wv = __builtin_nontemporal_load((const f32x4*)(Wp + (size_t)k * (6 * D)));
#pragma unroll
        for (int b = 0; b < 8; ++b) acc[b] += wv * cact[b * D + 128 * w + k]; }
#pragma unroll
    for (int b = 0; b < 8; ++b) *(LAS f32x4*)(part + (w * 8 + b) * 256 + 4 * lane) = acc[b];
    wg_barrier();
    float* mod = WSP(float, WS_MOD);
#pragma unroll
    for (int q = 0; q < 4; ++q) { const int o = tid + NTHR * q, b = o >> 8, n = o & 255; float s = F.in[I_BMOD][i * 6 * D + n0 + n];
#pragma unroll
        for (int ww = 0; ww < 8; ++ww) s += part[(ww * 8 + b) * 256 + n];
        mod[((size_t)i * NBATCH + b) * (6 * D) + n0 + n] = s; }
    wg_barrier();
}
struct TItem { const float* W; bf16_t* Dst; int N, paired, kb, nb, f8; };
constexpr int CV_DENSE = 352, CV_MOE = 3072;
__device__ __forceinline__ bool cv_item(Frame& F, int q, int it, TItem& x) {
    if (it < 0) return false;
    if (q == 0) {
        const int NQ = 96, NO = 64, NCI = 128, NCO = 64;
        if (it < NQ) { const int j = it / 48, r = it % 48; x.W = F.in[I_AWQKV] + (size_t)j * D * 1536; x.Dst = WSP(bf16_t, WS_WQKV) + (size_t)j * 1536 * D; x.N = 1536; x.paired = 0; x.f8 = 0; x.kb = r / 6; x.nb = r % 6; return true; } it -= NQ;
        if (it < NO) { const int j = it / 32, r = it % 32; x.W = F.in[I_AWO] + (size_t)j * D * D; x.Dst = WSP(bf16_t, WS_WO) + (size_t)j * D * D; x.N = 1024; x.paired = 0; x.f8 = 0; x.kb = r / 4; x.nb = r % 4; return true; } it -= NO;
        if (it < NCI) { const int j = it / 64, r = it % 64; x.W = F.in[I_CWIN] + (size_t)j * D * 2048; x.Dst = WSP(bf16_t, WS_CWIN) + (size_t)j * 2048 * D; x.N = 2048; x.paired = 1; x.f8 = 0; x.kb = r / 8; x.nb = r % 8; return true; } it -= NCI;
        if (it < NCO) { const int j = it / 32, r = it % 32; x.W = F.in[I_CWOUT] + (size_t)j * D * D; x.Dst = WSP(bf16_t, WS_CWOUT) + (size_t)j * D * D; x.N = 1024; x.paired = 0; x.f8 = 0; x.kb = r / 4; x.nb = r % 4; return true; } it -= NCO;
    }
    if (it < 2048) { const int m = q * NE + it / 64, r = it % 64; x.W = F.in[I_MWIN] + (size_t)m * D * 2048; x.Dst = (bf16_t*)(WSP(unsigned char, WS_MWIN) + (size_t)m * 2048 * D); x.N = 2048; x.paired = 1; x.f8 = 1; x.kb = r / 8; x.nb = r % 8; return true; } it -= 2048;
    if (it < 1024) { const int m = q * NE + it / 32, r = it % 32; x.W = F.in[I_MWOUT] + (size_t)m * D * D; x.Dst = (bf16_t*)(WSP(unsigned char, WS_MWOUT) + (size_t)m * D * D); x.N = 1024; x.paired = 0; x.f8 = 1; x.kb = r / 4; x.nb = r % 4; return true; }
    return false;
}
__device__ __forceinline__ void cv_run(Frame& F, int q, int max_items) {
    if (q > 3 || max_items <= 0) return;
    LAS float* tile = (LAS float*)F.lds;
    volatile LAS int* qslot = (volatile LAS int*)(F.lds + 128 * 257 * 4 + 64);
    const int tid = F.tid, lane = F.lane, w = F.wave; gu32* qc = F.ctl + CW_P0Q + 64 * q;
    int claimed = 1;
    wg_barrier();
    if (tid == 0) qslot[0] = (int)__hip_atomic_fetch_add(qc, 1u, RLX_AGENT);
    wg_barrier();
    int it = qslot[0]; TItem cur; bool valid = cv_item(F, q, it, cur);
    f32x4 rg[16];
    if (valid) {
#pragma unroll
        for (int qq = 0; qq < 16; ++qq) rg[qq] = __builtin_nontemporal_load((const f32x4*)(cur.W + (size_t)(cur.kb * 128 + w * 16 + qq) * cur.N + cur.nb * 256 + 4 * lane)); }
    wg_barrier();
    while (valid) {
        const bool more = claimed < max_items;
        if (tid == 0) qslot[0] = more ? (int)__hip_atomic_fetch_add(qc, 1u, RLX_AGENT) : -1;
        ++claimed;
#pragma unroll
        for (int qq = 0; qq < 16; ++qq) { LAS float* tp = tile + (w * 16 + qq) * 257 + 4 * lane; tp[0] = rg[qq][0]; tp[1] = rg[qq][1]; tp[2] = rg[qq][2]; tp[3] = rg[qq][3]; }
        wg_barrier();
        const int nit = qslot[0]; TItem nx; const bool nvalid = cv_item(F, q, nit, nx);
        if (nvalid) {
#pragma unroll
            for (int qq = 0; qq < 16; ++qq) rg[qq] = __builtin_nontemporal_load((const f32x4*)(nx.W + (size_t)(nx.kb * 128 + w * 16 + qq) * nx.N + nx.nb * 256 + 4 * lane)); }
        const int kc = lane >> 3;
#pragma unroll
        for (int r4 = 0; r4 < 4; ++r4) { const int nl = 32 * w + 8 * r4 + (lane & 7), n = cur.nb * 256 + nl; const LAS float* sp = tile + (16 * kc) * 257 + nl;
            float v[16];
#pragma unroll
            for (int jj = 0; jj < 16; ++jj) v[jj] = sp[jj * 257];
            int nd = n; if (cur.paired) { const int half = n >> 10, rem = n & 1023; nd = ((rem >> 7) << 8) + (half << 7) + (rem & 127); }
            if (cur.f8) { u32x4 o; o.x = cvt_pk4_fp8(v[0] * F8_SW, v[1] * F8_SW, v[2] * F8_SW, v[3] * F8_SW); o.y = cvt_pk4_fp8(v[4] * F8_SW, v[5] * F8_SW, v[6] * F8_SW, v[7] * F8_SW);
                o.z = cvt_pk4_fp8(v[8] * F8_SW, v[9] * F8_SW, v[10] * F8_SW, v[11] * F8_SW); o.w = cvt_pk4_fp8(v[12] * F8_SW, v[13] * F8_SW, v[14] * F8_SW, v[15] * F8_SW);
                __builtin_nontemporal_store(o, (u32x4*)((unsigned char*)cur.Dst + (size_t)nd * D + cur.kb * 128 + 16 * kc)); }
            else { u32x4 o0, o1; o0.x = cvt_pk(v[0], v[1]); o0.y = cvt_pk(v[2], v[3]); o0.z = cvt_pk(v[4], v[5]); o0.w = cvt_pk(v[6], v[7]); o1.x = cvt_pk(v[8], v[9]); o1.y = cvt_pk(v[10], v[11]); o1.z = cvt_pk(v[12], v[13]); o1.w = cvt_pk(v[14], v[15]);
                bf16_t* dp = cur.Dst + (size_t)nd * D + cur.kb * 128 + 16 * kc; __builtin_nontemporal_store(o0, (u32x4*)dp); __builtin_nontemporal_store(o1, (u32x4*)(dp + 8)); } }
        wg_barrier();
        cur = nx; valid = nvalid;
    }
}
#ifndef CV_OVERLAP
#define CV_OVERLAP 1
#endif
__device__ __forceinline__ void p0_phase(Frame& F) {
    for (int task = F.c; task < 96; task += F.G) p0_mod_task(F, task);
    cv_run(F, 0, 1 << 30);
    if (!CV_OVERLAP) { cv_run(F, 1, 1 << 30); cv_run(F, 2, 1 << 30); cv_run(F, 3, 1 << 30); }
}

template <bool GATHER> __device__ __forceinline__ int moe_build_units(Frame& F, int layer, int npn, int total_tiles, int ubase) {
    const LAS int* EX = (const LAS int*)(F.lds + LDS_EXP); LAS int* UT = (LAS int*)(F.lds + LDS_UT); LAS int* TOK = (LAS int*)(F.lds + LDS_TOK);
    const int tps = 32 / npn, nsb = (total_tiles + tps - 1) / tps;
    const bool xcd_ok = (F.G % 256) == 0 || F.G == 256;
    int n = 0;
    if (xcd_ok && F.G == 256) {
        const int x = F.c & 7, jx = F.c >> 3;
        const int mine = x < nsb ? (nsb - x + 7) / 8 : 0; n = mine - ubase; n = n < 0 ? 0 : (n > 9 ? 9 : n);
        if (F.tid < n) { const int q = (ubase + F.tid) * 8 + x, tau = q * tps + (jx % tps), pn = jx / tps; int e = 0;
            if (tau < total_tiles) { for (int qq = 1; qq < 32; ++qq) if (tau >= EX[32 + qq]) e = qq; } else e = -1;
            const int mt = e >= 0 ? tau - EX[32 + e] : 0, om = e >= 0 ? EX[64 + e] + 256 * mt : 0;
            UT[4 * F.tid] = GATHER ? 256 * F.tid : om; UT[4 * F.tid + 1] = om; UT[4 * F.tid + 2] = e; UT[4 * F.tid + 3] = pn; UT[40 + F.tid] = mt; }
    } else {
        const int U = total_tiles * npn; const int mine = F.c < U ? (U - F.c + F.G - 1) / F.G : 0; n = mine - ubase; n = n < 0 ? 0 : (n > 9 ? 9 : n);
        if (F.tid < n) { const int L = F.c + (ubase + F.tid) * F.G, tau = L / npn, pn = L % npn; int e = 0;
            for (int qq = 1; qq < 32; ++qq) if (tau >= EX[32 + qq]) e = qq;
            const int mt = tau - EX[32 + e], om = EX[64 + e] + 256 * mt;
            UT[4 * F.tid] = GATHER ? 256 * F.tid : om; UT[4 * F.tid + 1] = om; UT[4 * F.tid + 2] = e; UT[4 * F.tid + 3] = pn; UT[40 + F.tid] = mt; }
    }
    wg_barrier();
    if (F.tid == 0) { int w = 0; for (int r = 0; r < n; ++r) { if (UT[4 * r + 2] >= 0) { if (w != r) { UT[4 * w] = GATHER ? 256 * w : UT[4 * r]; UT[4 * w + 1] = UT[4 * r + 1]; UT[4 * w + 2] = UT[4 * r + 2]; UT[4 * w + 3] = UT[4 * r + 3]; UT[40 + w] = UT[40 + r]; } ++w; } } UT[60] = w; UT[61] = n; }
    wg_barrier();
    const int nv = UT[60];
    if (GATHER) { const int* LIST = WSP(const int, WS_LIST);
        for (int q = F.tid; q < nv * 256; q += NTHR) { const int ui = q >> 8, rr = q & 255, e = UT[4 * ui + 2], pos = 256 * UT[40 + ui] + rr; TOK[q] = pos < EX[e] ? LIST[(size_t)e * T + pos] : 0; }
        wg_barrier(); }
    return nv | (n << 8);
}

constexpr int N_PHASES = 30;
struct Args { const float* in[27]; float* out; unsigned char* ws; int ph_lo, ph_hi; };
__global__ void __launch_bounds__(NTHR, 2) mega(const Args args) {
    extern __shared__ __attribute__((aligned(16))) unsigned char lds_raw[];
    Frame F; F.lds = (LAS unsigned char*)lds_raw; F.MISC = (volatile LAS unsigned*)(F.lds + LDS_MISC); F.ws = args.ws; F.ctl = (gu32*)(args.ws + WS_CTL);
    F.tid = threadIdx.x; F.lane = F.tid & 63; F.wave = __builtin_amdgcn_readfirstlane(F.tid >> 6); F.G = gridDim.x; F.c = blockIdx.x; F.out = args.out;
    F.in = args.in;
    if (F.tid < 32) F.MISC[F.tid] = 0u;
    __syncthreads();
    const int lo = args.ph_lo, hi = args.ph_hi;
    F.xcc = (int)xb_xcc_id(); F.rank = 0; F.loc = 0;
#ifndef XCC_LOCAL
#define XCC_LOCAL 1
#endif
    if (XCC_LOCAL && hi - lo > 1 && F.G == 256) {
        if (F.tid == 0) { const unsigned r = __hip_atomic_fetch_add(F.ctl + CW_XC + 64 * F.xcc, 1u, RLX_AGENT); unsigned ok = 0u, sp = 0u;
            for (;;) { unsigned sum = 0u, good = 0u;
#pragma unroll
                for (int jx = 0; jx < 16; ++jx) { const unsigned cj = __hip_atomic_load(F.ctl + CW_XC + 64 * jx, RLX_AGENT); sum += cj; good += (jx < 8 ? (cj == 32u) : (cj == 0u)) ? 1u : 0u; }
                if (sum == 256u) { ok = (good == 16u) ? 1u : 0u; break; }
                __builtin_amdgcn_s_sleep(1); if (++sp > XB_SPIN_CAP) { ok = 0u; break; } }
            F.MISC[20] = r; F.MISC[21] = ok; }
        __syncthreads();
        F.rank = (int)F.MISC[20]; F.loc = (int)F.MISC[21];
        if (F.loc) F.c = F.rank * 8 + F.xcc;
    }
    XcdBarrier bar; bar.bar = (unsigned*)(F.ctl + CW_BAR); bar.x = 0; bar.st = F.MISC + 8;
    if (hi - lo > 1) bar = xcd_barrier_post((unsigned*)(F.ctl + CW_BAR), F.MISC + 8);
#ifndef CVQ_QKV
#define CVQ_QKV 4
#endif
#ifndef CVQ_MOE
#define CVQ_MOE 2
#endif
#ifndef PH_MASK
#define PH_MASK 0xFFFF
#endif
#define IN(k) (lo <= (k) && (k) < hi)
#define HAS(b) (((PH_MASK) >> (b)) & 1)
#define PHASE_ENTER() do { int _t = F.tid; asm volatile("" : "+v"(_t)); F.tid = _t; F.lane = _t & 63; F.wave = __builtin_amdgcn_readfirstlane(_t >> 6); unsigned char* _w = F.ws; asm volatile("" : "+s"(_w)); F.ws = _w; int _g = F.G; asm volatile("" : "+s"(_g)); F.G = _g; } while (0)
    unsigned long long t_acc = 0ull, t_beg = 0ull, g_ticks = 0ull, g_cyc = 0ull;
#define TBEG(kind) do { if (TIME_KIND == (kind)) t_beg = __builtin_amdgcn_s_memrealtime(); } while (0)
#define TEND(kind) do { if (TIME_KIND == (kind)) t_acc += __builtin_amdgcn_s_memrealtime() - t_beg; } while (0)
#define SEAM(k) do { if ((k) + 1 < hi) xcd_barrier(bar); } while (0)
#define SEAM_L(k) do { if ((k) + 1 < hi) { if (F.loc) xcc_local_barrier((unsigned*)(F.ctl + CW_LB + 64 * F.xcc), 32u, (unsigned*)(F.ctl + CW_TMO)); else xcd_barrier(bar); } } while (0)
    const LAS int* toktab = (const LAS int*)(F.lds + LDS_TOK);
    if (HAS(0) && IN(0)) { TBEG(0); p0_phase(F); SEAM(0); TEND(0); }
    for (int i = 0; i < DEPTH; ++i) {
        const int pb = 1 + 7 * i, j = i >> 1; const bool conv = (i & 1) != 0;
        const float* modl = WSP(const float, WS_MOD) + (size_t)i * NBATCH * (6 * D);
        if (IN(pb)) { PHASE_ENTER(); TBEG(1); if (i == 0) { if (HAS(1)) row_phase<0>(F, 0); } else { TBEG(7); if (HAS(2)) row_phase<1>(F, i); TEND(7); } SEAM_L(pb); TEND(1); }
        if (IN(pb + 1)) { PHASE_ENTER(); TBEG(2);
            if (!conv) { if (HAS(3)) { Gemm g{WSP(const bf16_t, WS_H), WSP(const bf16_t, WS_WQKV) + (size_t)j * 1536 * D, D, 0}; DenseOrder S; S.init(1536, F.G, F.c);
                EpiBias16 E{WSP(bf16_t, WS_QKV), 1536, F.in[I_ABQKV] + j * 1536}; gemm_phase<EpiBias16, DenseOrder, false>(F.lds, g, S, E, toktab, F.tid, 40, t_acc, g_ticks, g_cyc);
                if (CV_OVERLAP && (long)F.c + F.G >= 384) cv_run(F, i + 1, CVQ_QKV); } }
            else if (HAS(4)) { Gemm g{WSP(const bf16_t, WS_H), WSP(const bf16_t, WS_CWIN) + (size_t)j * 2048 * D, D, 0}; DenseOrder S; S.init(2048, F.G, F.c);
                EpiPair<0> E{WSP(void, WS_U), F.in[I_CBIN] + j * 2048, 0}; gemm_phase<EpiPair<0>, DenseOrder, false>(F.lds, g, S, E, toktab, F.tid, 50, t_acc, g_ticks, g_cyc); }
            SEAM_L(pb + 1); TEND(2); }
        if (IN(pb + 2)) { PHASE_ENTER(); TBEG(3); if (!conv) { TBEG(6); if (HAS(5)) attn_phase(F, j); TEND(6); } else { if (HAS(6)) dwconv_phase(F, j, t_acc); TBEG(17); } SEAM_L(pb + 2); if (conv) TEND(17); TEND(3); }
        if (IN(pb + 3)) { PHASE_ENTER(); TBEG(2); if (HAS(7)) {
            Gemm g{WSP(const bf16_t, WS_AO), (conv ? WSP(const bf16_t, WS_CWOUT) : WSP(const bf16_t, WS_WO)) + (size_t)j * D * D, D, 0}; DenseOrder S; S.init(1024, F.G, F.c);
            const float* bias2 = (conv ? F.in[I_CBOUT] : F.in[I_ABO]) + j * D;
            if (i == 0) { EpiResid<true> E{F.in[I_X], WSP(bf16_t, WS_X), bias2, modl + 2 * D}; gemm_phase<EpiResid<true>, DenseOrder, false>(F.lds, g, S, E, toktab, F.tid, 60, t_acc, g_ticks, g_cyc); }
            else { EpiResid<false> E{WSP(const bf16_t, WS_X), WSP(bf16_t, WS_X), bias2, modl + 2 * D}; gemm_phase<EpiResid<false>, DenseOrder, false>(F.lds, g, S, E, toktab, F.tid, 60, t_acc, g_ticks, g_cyc); } }
            SEAM_L(pb + 3); TEND(2); }
        if (IN(pb + 4)) { PHASE_ENTER(); TBEG(1); if (CV_OVERLAP && i > 0) cv_run(F, i, 1 << 30); TBEG(8); if (HAS(8)) row_phase<2>(F, i); TEND(8); SEAM(pb + 4); TEND(1); }
        if (IN(pb + 5)) { PHASE_ENTER(); TBEG(4); if (HAS(9)) {
            const int tt = build_exp_tables(F, i);
            Gemm g{WSP(const bf16_t, WS_H), (const bf16_t*)(WSP(const unsigned char, WS_MWIN) + (size_t)i * NE * 2048 * D), D / 2, (size_t)2048 * D / 2};
            EpiPair<1> E{WSP(void, WS_ACT), F.in[I_MBIN] + (size_t)i * NE * 2048, 2048};
            for (int ub = 0;; ub += 9) { const int nn = moe_build_units<true>(F, i, 8, tt, ub); const int n = nn >> 8, nv = nn & 255; if (n == 0) break;
                TableOrder S{(const LAS int*)(F.lds + LDS_UT), nv}; gemm_phase<EpiPair<1>, TableOrder, true, true>(F.lds, g, S, E, toktab, F.tid, 20, t_acc, g_ticks, g_cyc); wg_barrier();
                if (n < 9) { if (CV_OVERLAP && ub + nv < (((tt + 3) / 4) + 7) / 8) cv_run(F, i + 1, CVQ_MOE); break; } } }
            SEAM(pb + 5); TEND(4); }
        if (IN(pb + 6)) { PHASE_ENTER(); TBEG(5); if (HAS(10)) {
            const int tt = build_exp_tables(F, i);
            Gemm g{WSP(const bf16_t, WS_ACT), (const bf16_t*)(WSP(const unsigned char, WS_MWOUT) + (size_t)i * NE * D * D), D / 2, (size_t)D * D / 2};
            EpiMoeOut E{WSP(bf16_t, WS_YS), F.in[I_MBOUT] + (size_t)i * NE * D, WSP(const float, WS_GLIST), (const LAS int*)(F.lds + LDS_EXP + 256)};
            for (int ub = 0;; ub += 9) { const int nn = moe_build_units<false>(F, i, 4, tt, ub); const int n = nn >> 8, nv = nn & 255; if (n == 0) break;
                TableOrder S{(const LAS int*)(F.lds + LDS_UT), nv}; gemm_phase<EpiMoeOut, TableOrder, false, true>(F.lds, g, S, E, toktab, F.tid, 30, t_acc, g_ticks, g_cyc); wg_barrier();
                if (n < 9) { if (CV_OVERLAP && ub + nv < (((tt + 7) / 8) + 7) / 8) cv_run(F, i + 1, CVQ_MOE); break; } } }
            SEAM(pb + 6); TEND(5); }
    }
    if (HAS(11) && IN(29)) { PHASE_ENTER(); TBEG(1); row_phase<5>(F, DEPTH); TEND(1); }
    if (TIME_KIND >= 20 && (TIME_KIND % 10) == 5 && g_ticks > 0) t_acc = (g_cyc * 1000ull) / g_ticks;
    if (TIME_KIND >= 0 && blockIdx.x == 0) { const unsigned long long t0 = __builtin_amdgcn_s_memrealtime(); while (__builtin_amdgcn_s_memrealtime() - t0 < t_acc) __builtin_amdgcn_s_sleep(8); }
#undef IN
#undef SEAM
}

inline void launch_range(void* const* d_in, void* d_out, void* d_ws, int grid, int lo, int hi, hipStream_t stream) {
    Args a{}; for (int i = 0; i < 27; ++i) a.in[i] = (const float*)d_in[i];
    a.out = (float*)d_out; a.ws = (unsigned char*)d_ws; a.ph_lo = lo; a.ph_hi = hi;
    hipLaunchKernelGGL(mega, dim3(grid), dim3(NTHR), LDS_BYTES, stream, a);
}
inline int setup_grid() {
    static int grid = 0;
    if (grid == 0) {
        int dev = 0, cus = 0;
        if (hipGetDevice(&dev) != hipSuccess || hipDeviceGetAttribute(&cus, hipDeviceAttributeMultiprocessorCount, dev) != hipSuccess) { grid = -1; return grid; }
        if (hipFuncSetAttribute((const void*)mega, hipFuncAttributeMaxDynamicSharedMemorySize, LDS_BYTES) != hipSuccess) { grid = -1; return grid; }
        int per_cu = 0; (void)hipOccupancyMaxActiveBlocksPerMultiprocessor(&per_cu, (const void*)mega, NTHR, LDS_BYTES); (void)hipGetLastError();
        if (per_cu < 1) fprintf(stderr, "kernel_launch: occupancy query reports %d blocks per CU\n", per_cu);
        grid = cus;
    }
    return grid;
}
}
#ifndef FAST_LAUNCH_MODE
#define FAST_LAUNCH_MODE 1
#endif
extern "C" void kernel_launch(void* const* d_in, const int* in_sizes, int n_in, void* d_out, int out_size, void* d_ws, size_t ws_size, hipStream_t stream) {
    if (n_in != 27 || out_size != fk::T * fk::D || ws_size < fk::WS_END) { fprintf(stderr, "kernel_launch: unexpected shapes (n_in %d out %d ws %zu)\n", n_in, out_size, ws_size); return; }
    const int grid = fk::setup_grid(); if (grid <= 0) return;
    (void)hipMemsetAsync((char*)d_ws + fk::WS_CTL, 0, fk::CTL_ZERO_BYTES, stream);
#if FAST_LAUNCH_MODE == 1
    fk::launch_range(d_in, d_out, d_ws, grid, 0, fk::N_PHASES, stream);
#else
    for (int k = 0; k < fk::N_PHASES; ++k) fk::launch_range(d_in, d_out, d_ws, grid, k, k + 1, stream);
#endif
}
```

```cpp
#include <hip/hip_runtime.h>
#include <cstdio>
#include <cstdint>
namespace fk {
#define LAS __attribute__((address_space(3)))
#define GAS __attribute__((address_space(1)))
typedef unsigned short bf16_t;
typedef short bf16x8 __attribute__((ext_vector_type(8)));
typedef short s16x4 __attribute__((ext_vector_type(4)));
typedef float f32x4 __attribute__((ext_vector_type(4)));
typedef float f32x2 __attribute__((ext_vector_type(2)));
typedef float f32x16 __attribute__((ext_vector_type(16)));
typedef float f32x8 __attribute__((ext_vector_type(8)));
typedef unsigned u32x4 __attribute__((ext_vector_type(4)));
typedef unsigned u32x2 __attribute__((ext_vector_type(2)));
typedef __bf16 bf16x2_t __attribute__((ext_vector_type(2)));
typedef int v4i __attribute__((ext_vector_type(4)));
typedef int v8i __attribute__((ext_vector_type(8)));
typedef GAS unsigned gu32;
#define RLX_AGENT __ATOMIC_RELAXED, __HIP_MEMORY_SCOPE_AGENT
#define LDS_WAIT() asm volatile("s_waitcnt lgkmcnt(0)" ::: "memory")
#define VM_WAIT() asm volatile("s_waitcnt vmcnt(0)" ::: "memory")

constexpr int T = 16384, D = 1024, SEQ = 2048, NBATCH = 8, NE = 32, DEPTH = 4;
constexpr int NWAVES = 8, NTHR = 512;
constexpr int SLOTCAP = T * 4 + NE * 256;
constexpr float LOG2E = 1.4426950408889634f;

__device__ __forceinline__ unsigned cvt_pk(float lo, float hi) { f32x2 v = {lo, hi}; bf16x2_t b = __builtin_convertvector(v, bf16x2_t); return __builtin_bit_cast(unsigned, b); }
__device__ __forceinline__ float bf_lo(unsigned w) { return __uint_as_float(w << 16); }
__device__ __forceinline__ float bf_hi(unsigned w) { return __uint_as_float(w & 0xffff0000u); }
__device__ __forceinline__ unsigned cvt_pk4_fp8(float a, float b, float c, float d) {
    a = __builtin_amdgcn_fmed3f(a, -448.f, 448.f); b = __builtin_amdgcn_fmed3f(b, -448.f, 448.f); c = __builtin_amdgcn_fmed3f(c, -448.f, 448.f); d = __builtin_amdgcn_fmed3f(d, -448.f, 448.f);
    int w = 0; w = __builtin_amdgcn_cvt_pk_fp8_f32(a, b, w, false); w = __builtin_amdgcn_cvt_pk_fp8_f32(c, d, w, true); return (unsigned)w; }
__device__ __forceinline__ unsigned cvt_pk4_fp8_nc(float a, float b, float c, float d) { int w = 0; w = __builtin_amdgcn_cvt_pk_fp8_f32(a, b, w, false); w = __builtin_amdgcn_cvt_pk_fp8_f32(c, d, w, true); return (unsigned)w; }
constexpr float F8_SH = 8.0f, F8_SW = 64.0f, F8_SACT = 4.0f, F8_SY = 16.0f;
__device__ __forceinline__ f32x4 fp8x4_to_f32(unsigned w) { const f32x2 lo = __builtin_amdgcn_cvt_pk_f32_fp8((int)w, false), hi = __builtin_amdgcn_cvt_pk_f32_fp8((int)w, true); return (f32x4){lo.x, lo.y, hi.x, hi.y}; }
__device__ __forceinline__ float sigmoid_f(float v) { return __builtin_amdgcn_rcpf(1.0f + __builtin_amdgcn_exp2f(-LOG2E * v)); }

constexpr size_t MiB = (size_t)1 << 20;
constexpr size_t WS_CTL = 0, CTL_ZERO_BYTES = MiB / 8;
constexpr size_t WS_MOD = 1 * MiB;
constexpr size_t WS_WQKV = 2 * MiB;
constexpr size_t WS_WO = 8 * MiB;
constexpr size_t WS_CWIN = 12 * MiB;
constexpr size_t WS_CWOUT = 20 * MiB;
constexpr size_t WS_MWIN = 24 * MiB;
constexpr size_t WS_MWOUT = WS_MWIN + 512 * MiB;
constexpr size_t WS_X = WS_MWOUT + 256 * MiB;
constexpr size_t WS_H = WS_X + 64 * MiB;
constexpr size_t WS_QKV = WS_H + 32 * MiB;
constexpr size_t WS_AO = WS_QKV + 48 * MiB;
constexpr size_t WS_U = WS_AO + 32 * MiB;
constexpr size_t WS_LIST = WS_U + 32 * MiB;
constexpr size_t WS_GLIST = WS_LIST + 2 * MiB;
constexpr size_t WS_TK = WS_GLIST + 2 * MiB;
constexpr size_t WS_ACT = WS_TK + 1 * MiB;
constexpr size_t WS_YS = WS_ACT + 144 * MiB;
constexpr size_t WS_END = WS_YS + 144 * MiB;
constexpr int CW_TMO = 0, CW_P0Q = 64, CW_XC = 1024, CW_LB = 2048, CW_BAR = 4096, CW_CNT = 16384;
#define XCD_BAR_WORDS 3456

constexpr int RING_BYTES = 131072;
constexpr int LDS_TOK = RING_BYTES;
constexpr int LDS_UT = LDS_TOK + 9216;
constexpr int LDS_EXP = LDS_UT + 256;
constexpr int LDS_BYTES = 163840;
constexpr int LDS_MISC = LDS_BYTES - 128;
static_assert(LDS_EXP + 512 <= LDS_MISC, "LDS map");

#define XB_TMO      128
#define XB_XCNT(j)  (256  + 64 * (j))
#define XB_XSUB(j)  (1280 + 64 * (j))
#define XB_XGEN(j)  (2304 + 64 * (j))
#define XB_TOP      3328
#define XB_TOPGEN   3392
#define XB_SPIN_CAP (1u << 18)
__device__ __forceinline__ unsigned xb_ld(unsigned* p)              { return __hip_atomic_load(p, __ATOMIC_RELAXED, __HIP_MEMORY_SCOPE_AGENT); }
__device__ __forceinline__ unsigned xb_add(unsigned* p, unsigned v) { return __hip_atomic_fetch_add(p, v, __ATOMIC_RELAXED, __HIP_MEMORY_SCOPE_AGENT); }
__device__ __forceinline__ unsigned xb_xcc_id() { return (unsigned)__builtin_amdgcn_s_getreg((3 << 11) | 20) & 0xFu; }
#define XB_SPIN(cond, bar) do { unsigned _sp = 0; while (cond) { __builtin_amdgcn_s_sleep(1); \
    if ((++_sp & 255u) == 0u) { if (xb_ld(&(bar)[XB_TMO])) break; if (_sp > XB_SPIN_CAP) { atomicAdd(&(bar)[XB_TMO], 1u); break; } } } } while (0)
struct XcdBarrier { unsigned* bar; unsigned x; volatile LAS unsigned* st; };
__device__ __forceinline__ XcdBarrier xcd_barrier_post(unsigned* bar, volatile LAS unsigned* st) {
    XcdBarrier b; b.bar = bar; b.x = xb_xcc_id(); b.st = st;
    if (threadIdx.x == 0) (void)xb_add(&bar[XB_XCNT(b.x)], 1u);
    return b;
}
__device__ __forceinline__ void xcd_barrier_complete(unsigned* bar, unsigned x, unsigned& nloc, unsigned& nx) {
    const unsigned G = gridDim.x * gridDim.y * gridDim.z;
    unsigned sum, cnt, mine, sp = 0u;
    for (;;) {
        sum = 0u; cnt = 0u; mine = 0u;
#pragma unroll
        for (unsigned j = 0; j < 16; ++j) { const unsigned c = xb_ld(&bar[XB_XCNT(j)]); sum += c; cnt += (c > 0u) ? 1u : 0u; mine = (j == x) ? c : mine; }
        if (sum == G) break;
        __builtin_amdgcn_s_sleep(1);
        if ((++sp & 255u) == 0u) { if (xb_ld(&bar[XB_TMO])) break; if (sp > XB_SPIN_CAP) { atomicAdd(&bar[XB_TMO], 1u); break; } }
    }
    nloc = mine > 0u ? mine : 1u; nx = cnt > 0u ? cnt : 1u;
}
__device__ __forceinline__ void xcd_barrier(const XcdBarrier& b) {
    asm volatile("s_waitcnt vmcnt(0)" ::: "memory");
    __syncthreads();
    if (threadIdx.x == 0) {
        unsigned* bar = b.bar;
        __builtin_amdgcn_s_waitcnt(0);
        unsigned nloc = b.st[0], nx = b.st[1];
        if (nloc == 0u) { xcd_barrier_complete(bar, b.x, nloc, nx); b.st[0] = nloc; b.st[1] = nx; }
        const unsigned old = xb_add(&bar[XB_XSUB(b.x)], 1u);
        const unsigned gen = old / nloc;
        if (old + 1u == (gen + 1u) * nloc) {
            __builtin_amdgcn_fence(__ATOMIC_RELEASE, "agent");
            asm volatile("s_waitcnt vmcnt(0)" ::: "memory");
            const unsigned og = xb_add(&bar[XB_TOP], 1u);
            const unsigned tg = og / nx;
            if (og + 1u == (tg + 1u) * nx) xb_add(&bar[XB_TOPGEN], 1u);
            else XB_SPIN(xb_ld(&bar[XB_TOPGEN]) == tg, bar);
            __builtin_amdgcn_fence(__ATOMIC_ACQUIRE, "agent");
            xb_add(&bar[XB_XGEN(b.x)], 1u);
            asm volatile("s_waitcnt vmcnt(0)" ::: "memory");
        } else {
            XB_SPIN(xb_ld(&bar[XB_XGEN(b.x)]) == gen, bar);
            __builtin_amdgcn_fence(__ATOMIC_ACQUIRE, "agent");
            asm volatile("s_waitcnt vmcnt(0)" ::: "memory");
        }
    }
    __syncthreads();
}

__device__ __forceinline__ void xcc_local_barrier(unsigned* cnt, unsigned nloc, unsigned* tmo) {
    asm volatile("s_waitcnt vmcnt(0)" ::: "memory");
    __syncthreads();
    if (threadIdx.x == 0) {
        const unsigned old = __hip_atomic_fetch_add(cnt, 1u, __ATOMIC_RELAXED, __HIP_MEMORY_SCOPE_AGENT), target = (old / nloc + 1u) * nloc; unsigned sp = 0u;
        while (__hip_atomic_load(cnt, __ATOMIC_RELAXED, __HIP_MEMORY_SCOPE_AGENT) < target) { __builtin_amdgcn_s_sleep(1);
            if ((++sp & 255u) == 0u) { if (__hip_atomic_load(tmo, __ATOMIC_RELAXED, __HIP_MEMORY_SCOPE_AGENT)) break; if (sp > XB_SPIN_CAP) { atomicAdd(tmo, 1u); break; } } }
        __builtin_amdgcn_fence(__ATOMIC_ACQUIRE, "agent");
        asm volatile("s_waitcnt vmcnt(0)" ::: "memory");
    }
    __syncthreads();
}

constexpr int BM = 256, BK = 64, HALF = 128, HTB = HALF * BK * 2, NXCD = 8, WGM = 8;
__host__ __device__ __forceinline__ int lds_byte(int r, int c) { const int st = (r >> 4) * 2 + (c >> 5), rr = r & 15, cc = c & 31, ob = rr * 64 + cc * 2; return st * 1024 + (ob ^ (((ob >> 9) & 1) << 5)); }
__host__ __device__ __forceinline__ void stage_rc(int b, int& R, int& C) { const int st = b / 1024, sb = b % 1024, swz = sb ^ (((sb >> 9) & 1) << 5); R = (st >> 1) * 16 + swz / 64; C = (st & 1) * 32 + (swz % 64) / 2; }
__host__ __device__ __forceinline__ int perm32(int rho) { const int n = rho >> 4, i = rho & 15; return 8 * (i >> 2) + 4 * n + (i & 3); }

struct Unit { int am, om, e, pn; };
struct Gemm { const bf16_t* A; const bf16_t* Bt; int K; size_t b_estride; };

struct DenseOrder {
    int nM, nN, nwg, G, c;
    __device__ void init(int N, int G_, int c_) { nM = T / BM; nN = N / BM; nwg = nM * nN; G = G_; c = c_; }
    __device__ __forceinline__ bool next(int i, Unit& u) const {
        const long L = (long)i * G + c; if (L >= nwg) return false;
        int wgid = (int)L; { const int q = nwg / NXCD, r = nwg % NXCD, xcd = wgid % NXCD, off = wgid / NXCD; wgid = (xcd < r ? xcd * (q + 1) : r * (q + 1) + (xcd - r) * q) + off; }
        const int nig = WGM * nN, gid = wgid / nig, fm = gid * WGM, gsz = (nM - fm) < WGM ? (nM - fm) : WGM;
        const int pm = fm + ((wgid % nig) % gsz); u.pn = (wgid % nig) / gsz; u.am = pm * BM; u.om = pm * BM; u.e = 0; return true;
    }
};
struct TableOrder {
    const LAS int* ut; int n;
    __device__ __forceinline__ bool next(int i, Unit& u) const {
        if (i >= n) return false;
        u.am = __builtin_amdgcn_readfirstlane(ut[4 * i]); u.om = __builtin_amdgcn_readfirstlane(ut[4 * i + 1]); u.e = __builtin_amdgcn_readfirstlane(ut[4 * i + 2]); u.pn = __builtin_amdgcn_readfirstlane(ut[4 * i + 3]); return true;
    }
};

template <class Epi, class Sched, bool GATHER, bool F8 = false>
__device__ __forceinline__ void gemm_phase(LAS unsigned char* lds, const Gemm g, const Sched& S, const Epi& E, const LAS int* toktab, const int tid, const int tkb, unsigned long long& t_acc, unsigned long long& g_ticks, unsigned long long& g_cyc) {
    unsigned long long t_b = 0ull, c_b = 0ull; static_assert(true, "");
#ifndef TIME_KIND
#define TIME_KIND (-1)
#endif
#define GT_BEG(k) do { if (TIME_KIND >= 20 && TIME_KIND == tkb + (k)) t_b = __builtin_amdgcn_s_memrealtime(); if ((k) == 0 && TIME_KIND == tkb + 5) { t_b = __builtin_amdgcn_s_memrealtime(); c_b = __builtin_readcyclecounter(); } } while (0)
#define GT_END(k) do { if (TIME_KIND >= 20 && TIME_KIND == tkb + (k)) t_acc += __builtin_amdgcn_s_memrealtime() - t_b; if ((k) == 0 && TIME_KIND == tkb + 5) { g_ticks += __builtin_amdgcn_s_memrealtime() - t_b; g_cyc += __builtin_readcyclecounter() - c_b; } } while (0)
    const int wid = __builtin_amdgcn_readfirstlane(tid >> 6), lane = tid & 63, wr = wid >> 2, wc = wid & 3, fr = lane & 15, fq = lane >> 4;
    const int K = g.K, nt = K / BK;
    int Rr[2], Cc[2]; unsigned voffB[2];
#pragma unroll
    for (int i = 0; i < 2; ++i) { int R, C; stage_rc(tid * 16 + i * 8192, R, C); Rr[i] = R; Cc[i] = C; const int Rb = Epi::PERM ? ((R & ~31) + perm32(R & 31)) : R; voffB[i] = (unsigned)(Rb * K + C) * 2u; }
    const unsigned ldsw = (unsigned)wid * 1024u;
    const int aoff = lds_byte(wr * 64 + fr, fq * 8), boff = lds_byte(wc * 32 + fr, fq * 8);
#define PG8_SA(b, h) (((b) * 2 + (h)) * HTB)
#define PG8_SB(b, h) ((4 + (b) * 2 + (h)) * HTB)
#ifndef USE_BUFFER_LDS
#define USE_BUFFER_LDS 1
#endif
#if USE_BUFFER_LDS
#define PG8_STAGE(bufoff, rsrc, soff, voff) do { _Pragma("unroll") for (int _i = 0; _i < 2; ++_i) \
        __builtin_amdgcn_raw_ptr_buffer_load_lds(rsrc, (LAS unsigned*)(lds + (bufoff) + ldsw + _i * 8192), 16, (int)(voff)[_i], (int)(soff), 0, 0); } while (0)
#else
#define PG8_STAGE(bufoff, rsrc, soff, voff) do { _Pragma("unroll") for (int _i = 0; _i < 2; ++_i) \
        __builtin_amdgcn_global_load_lds((const unsigned*)((const char*)(rsrc##_base) + (size_t)(soff) + (voff)[_i]), (LAS unsigned*)(lds + (bufoff) + ldsw + _i * 8192), 16, 0, 0); } while (0)
#endif
#define CAT8(l, h) __builtin_shufflevector((l), (h), 0, 1, 2, 3, 4, 5, 6, 7)
#define LO4(x) __builtin_shufflevector((x), (x), 0, 1, 2, 3)
#define HI4(x) __builtin_shufflevector((x), (x), 4, 5, 6, 7)
#define PG8_LDA(dst, b, h) do { _Pragma("unroll") for (int m = 0; m < 4; ++m) dst[m] = CAT8(*(const LAS v4i*)(lds + PG8_SA(b, h) + aoff + m * 2048), *(const LAS v4i*)(lds + PG8_SA(b, h) + aoff + m * 2048 + 1024)); } while (0)
#define PG8_LDB(dst, b, h) do { _Pragma("unroll") for (int n = 0; n < 2; ++n) dst[n] = CAT8(*(const LAS v4i*)(lds + PG8_SB(b, h) + boff + n * 2048), *(const LAS v4i*)(lds + PG8_SB(b, h) + boff + n * 2048 + 1024)); } while (0)
#define PG8_MMA(ai, bj, At, Bt) do { __builtin_amdgcn_s_setprio(1); \
        if constexpr (F8) { _Pragma("unroll") for (int m = 0; m < 4; ++m) { f32x4 _l = LO4(acc8[ai][bj][m]), _h = HI4(acc8[ai][bj][m]); \
            _l = __builtin_amdgcn_mfma_scale_f32_16x16x128_f8f6f4(Bt[0], At[m], _l, 0, 0, 0, 0x7f7f7f7f, 0, 0x7f7f7f7f); \
            _h = __builtin_amdgcn_mfma_scale_f32_16x16x128_f8f6f4(Bt[1], At[m], _h, 0, 0, 0, 0x7f7f7f7f, 0, 0x7f7f7f7f); acc8[ai][bj][m] = CAT8(_l, _h); } \
              \
            asm volatile("" : "+v"(acc8[ai][bj][0]), "+v"(acc8[ai][bj][1]), "+v"(acc8[ai][bj][2]), "+v"(acc8[ai][bj][3])); } \
        else { _Pragma("unroll") for (int m = 0; m < 4; ++m) { f32x4 _l = LO4(acc8[ai][bj][m]), _h = HI4(acc8[ai][bj][m]); \
            _l = __builtin_amdgcn_mfma_f32_16x16x32_bf16(__builtin_bit_cast(bf16x8, LO4(Bt[0])), __builtin_bit_cast(bf16x8, LO4(At[m])), _l, 0, 0, 0); \
            _l = __builtin_amdgcn_mfma_f32_16x16x32_bf16(__builtin_bit_cast(bf16x8, HI4(Bt[0])), __builtin_bit_cast(bf16x8, HI4(At[m])), _l, 0, 0, 0); \
            _h = __builtin_amdgcn_mfma_f32_16x16x32_bf16(__builtin_bit_cast(bf16x8, LO4(Bt[1])), __builtin_bit_cast(bf16x8, LO4(At[m])), _h, 0, 0, 0); \
            _h = __builtin_amdgcn_mfma_f32_16x16x32_bf16(__builtin_bit_cast(bf16x8, HI4(Bt[1])), __builtin_bit_cast(bf16x8, HI4(At[m])), _h, 0, 0, 0); acc8[ai][bj][m] = CAT8(_l, _h); } } \
        __builtin_amdgcn_s_setprio(0); } while (0)
#define PG8_WAIT_V(n) asm volatile("s_waitcnt vmcnt(" #n ")" ::: "memory")
#define PG8_WAIT_L(n) asm volatile("s_waitcnt lgkmcnt(" #n ")" ::: "memory")
#define PG8_BAR __builtin_amdgcn_s_barrier()
#define PG8_SCHED __builtin_amdgcn_sched_barrier(0)
#define A_OFFS(dst, u) do { _Pragma("unroll") for (int _h = 0; _h < 2; ++_h) _Pragma("unroll") for (int _i = 0; _i < 2; ++_i) { \
        const int _row = GATHER ? toktab[(u).am + _h * HALF + Rr[_i]] : ((u).am + _h * HALF + Rr[_i]); dst[_h][_i] = (unsigned)(_row * K + Cc[_i]) * 2u; } } while (0)
    Unit cur, nxt; int ui = 0;
    if (!S.next(0, cur)) return;
    f32x8 acc8[2][2][4];
#pragma unroll
    for (int a = 0; a < 2; ++a)
#pragma unroll
        for (int b = 0; b < 2; ++b)
#pragma unroll
            for (int m = 0; m < 4; ++m) acc8[a][b][m] = (f32x8){0.f, 0.f, 0.f, 0.f, 0.f, 0.f, 0.f, 0.f};
    v8i At[4], B0[2], B1[2];
    unsigned ao[2][2]; A_OFFS(ao, cur);
    const __amdgpu_buffer_rsrc_t rA = __builtin_amdgcn_make_buffer_rsrc((void*)g.A, 0, 0x7fffffff, 0x00020000), rB = __builtin_amdgcn_make_buffer_rsrc((void*)g.Bt, 0, 0x7fffffff, 0x00020000);
    const char* const rA_base = (const char*)g.A; const char* const rB_base = (const char*)g.Bt; (void)rA_base; (void)rB_base;
    const unsigned kstep = (unsigned)(BK * 2), hstep = (unsigned)HALF * K * 2;
    unsigned cB = (unsigned)(((size_t)cur.e * g.b_estride + (size_t)cur.pn * BM * K) * 2);
    PG8_STAGE(PG8_SB(0, 0), rB, cB, voffB); PG8_STAGE(PG8_SB(0, 1), rB, cB + hstep, voffB); PG8_STAGE(PG8_SA(0, 0), rA, 0u, ao[0]); PG8_STAGE(PG8_SA(0, 1), rA, 0u, ao[1]);
    if (wr == 1) PG8_BAR;
    PG8_WAIT_V(2); PG8_BAR;
    PG8_STAGE(PG8_SB(1, 0), rB, cB + kstep, voffB); PG8_STAGE(PG8_SA(1, 0), rA, kstep, ao[0]); PG8_STAGE(PG8_SB(1, 1), rB, cB + hstep + kstep, voffB);
    PG8_WAIT_V(6); PG8_BAR;
    for (;;) {
        const bool has_next = S.next(ui + 1, nxt);
        const unsigned nB = has_next ? (unsigned)(((size_t)nxt.e * g.b_estride + (size_t)nxt.pn * BM * K) * 2) : cB;
        GT_BEG(0);
#pragma unroll 1
        for (int t = 0; t < nt; t += 2) {
            const bool last = (t == nt - 2);
            const unsigned a1 = (unsigned)(t + 1) * kstep;
            const unsigned a2 = last ? 0u : (unsigned)(t + 2) * kstep, b2 = last ? nB : cB + (unsigned)(t + 2) * kstep;
            const unsigned a3 = a2 + kstep, b3 = b2 + kstep;
            unsigned a2o[2][2];
            if (last && has_next) { A_OFFS(a2o, nxt); }
            else {
#pragma unroll
                for (int _h = 0; _h < 2; ++_h)
#pragma unroll
                    for (int _i = 0; _i < 2; ++_i) a2o[_h][_i] = ao[_h][_i]; }
            PG8_LDB(B0, 0, 0); PG8_LDB(B1, 0, 1); PG8_SCHED; PG8_LDA(At, 0, 0); PG8_STAGE(PG8_SA(1, 1), rA, a1, ao[1]);
            PG8_WAIT_V(8); PG8_WAIT_L(0); PG8_BAR; PG8_MMA(0, 0, At, B0); PG8_MMA(0, 1, At, B1); PG8_BAR; PG8_SCHED;
            PG8_LDA(At, 0, 1); PG8_STAGE(PG8_SB(0, 0), rB, b2, voffB); PG8_STAGE(PG8_SB(0, 1), rB, b2 + hstep, voffB); PG8_STAGE(PG8_SA(0, 0), rA, a2, a2o[0]);
            PG8_WAIT_V(8); PG8_WAIT_L(0); PG8_BAR; PG8_MMA(1, 0, At, B0); PG8_MMA(1, 1, At, B1); PG8_BAR; PG8_SCHED;
            PG8_LDB(B0, 1, 0); PG8_LDB(B1, 1, 1); PG8_SCHED; PG8_LDA(At, 1, 0); PG8_STAGE(PG8_SA(0, 1), rA, a2, a2o[1]);
            PG8_WAIT_V(8); PG8_WAIT_L(0); PG8_BAR; PG8_MMA(0, 0, At, B0); PG8_MMA(0, 1, At, B1); PG8_BAR; PG8_SCHED;
            PG8_LDA(At, 1, 1); PG8_STAGE(PG8_SB(1, 0), rB, b3, voffB); PG8_STAGE(PG8_SB(1, 1), rB, b3 + hstep, voffB); PG8_STAGE(PG8_SA(1, 0), rA, a3, a2o[0]);
            PG8_WAIT_V(8); PG8_WAIT_L(0); PG8_BAR; PG8_MMA(1, 0, At, B0); PG8_MMA(1, 1, At, B1); PG8_BAR; PG8_SCHED;
            if (last) {
#pragma unroll
                for (int _h = 0; _h < 2; ++_h)
#pragma unroll
                    for (int _i = 0; _i < 2; ++_i) ao[_h][_i] = a2o[_h][_i]; }
        }
        GT_END(0); GT_BEG(1);
        if (wr == 0) PG8_BAR;
        { f32x4 acc[2][2][4][2];
#pragma unroll
          for (int a = 0; a < 2; ++a)
#pragma unroll
              for (int b = 0; b < 2; ++b)
#pragma unroll
                  for (int m = 0; m < 4; ++m) { acc[a][b][m][0] = LO4(acc8[a][b][m]); acc[a][b][m][1] = HI4(acc8[a][b][m]); }
          E(acc, cur, wr, wc, fr, fq); }
        GT_END(1);
        if (!has_next) break;
#pragma unroll
        for (int a = 0; a < 2; ++a)
#pragma unroll
            for (int b = 0; b < 2; ++b)
#pragma unroll
                for (int m = 0; m < 4; ++m) acc8[a][b][m] = (f32x8){0.f, 0.f, 0.f, 0.f, 0.f, 0.f, 0.f, 0.f};
        cur = nxt; cB = nB; ++ui;
        if (wr == 1) PG8_BAR;
    }
    PG8_WAIT_V(0);
    PG8_BAR;
#undef PG8_SA
#undef PG8_SB
#undef PG8_STAGE
#undef PG8_LDA
#undef PG8_LDB
#undef PG8_MMA
#undef PG8_WAIT_V
#undef PG8_WAIT_L
#undef PG8_BAR
#undef PG8_SCHED
#undef A_OFFS
#undef GT_BEG
#undef GT_END
#undef CAT8
#undef LO4
#undef HI4
}
struct EpiBias16 {
    static constexpr bool PERM = true;
    bf16_t* O; int ldc; const float* bias;
    __device__ __forceinline__ void operator()(const f32x4 (&acc)[2][2][4][2], const Unit& u, int wr, int wc, int fr, int fq) const {
        const int row0 = u.om + wr * 64 + fr, col0 = u.pn * BM + wc * 32 + 8 * fq;
        f32x4 bv[2][2];
#pragma unroll
        for (int bj = 0; bj < 2; ++bj)
#pragma unroll
            for (int n = 0; n < 2; ++n) bv[bj][n] = *(const f32x4*)(bias + col0 + bj * HALF + 4 * n);
#pragma unroll
        for (int ai = 0; ai < 2; ++ai)
#pragma unroll
            for (int m = 0; m < 4; ++m) { bf16_t* rowp = O + (size_t)(row0 + ai * HALF + m * 16) * ldc + col0;
#pragma unroll
                for (int bj = 0; bj < 2; ++bj) { const f32x4 v0 = acc[ai][bj][m][0] + bv[bj][0], v1 = acc[ai][bj][m][1] + bv[bj][1];
                    u32x4 w; w.x = cvt_pk(v0[0], v0[1]); w.y = cvt_pk(v0[2], v0[3]); w.z = cvt_pk(v1[0], v1[1]); w.w = cvt_pk(v1[2], v1[3]);
                    *(u32x4*)(rowp + bj * HALF) = w; } }
    }
};
template <bool XF32> struct EpiResid {
    static constexpr bool PERM = true;
    const void* Xin; bf16_t* X; const float* bias; const float* gate;
    __device__ __forceinline__ void operator()(const f32x4 (&acc)[2][2][4][2], const Unit& u, int wr, int wc, int fr, int fq) const {
        const int row0 = u.om + wr * 64 + fr, col0 = u.pn * BM + wc * 32 + 8 * fq; const float* gb = gate + (size_t)(u.om / SEQ) * (6 * D);
        f32x4 bv[2][2], gv[2][2];
#pragma unroll
        for (int bj = 0; bj < 2; ++bj)
#pragma unroll
            for (int n = 0; n < 2; ++n) { bv[bj][n] = *(const f32x4*)(bias + col0 + bj * HALF + 4 * n); gv[bj][n] = *(const f32x4*)(gb + col0 + bj * HALF + 4 * n); }
#pragma unroll
        for (int ai = 0; ai < 2; ++ai)
#pragma unroll
            for (int m = 0; m < 4; ++m) { const size_t off = (size_t)(row0 + ai * HALF + m * 16) * D + col0;
#pragma unroll
                for (int bj = 0; bj < 2; ++bj) { f32x4 x0, x1;
                    if (XF32) { x0 = *(const f32x4*)((const float*)Xin + off + bj * HALF); x1 = *(const f32x4*)((const float*)Xin + off + bj * HALF + 4); }
                    else { const u32x4 xb = *(const u32x4*)((const bf16_t*)Xin + off + bj * HALF); x0 = (f32x4){bf_lo(xb.x), bf_hi(xb.x), bf_lo(xb.y), bf_hi(xb.y)}; x1 = (f32x4){bf_lo(xb.z), bf_hi(xb.z), bf_lo(xb.w), bf_hi(xb.w)}; }
                    const f32x4 v0 = x0 + gv[bj][0] * (acc[ai][bj][m][0] + bv[bj][0]), v1 = x1 + gv[bj][1] * (acc[ai][bj][m][1] + bv[bj][1]);
                    u32x4 w; w.x = cvt_pk(v0[0], v0[1]); w.y = cvt_pk(v0[2], v0[3]); w.z = cvt_pk(v1[0], v1[1]); w.w = cvt_pk(v1[2], v1[3]);
                    *(u32x4*)(X + off + bj * HALF) = w; }
                asm volatile("" ::: "memory"); }
    }
};
template <int MODE> struct EpiPair {
    static constexpr bool PERM = true;
    void* O; const float* bias; int b_estride;
    __device__ __forceinline__ void operator()(const f32x4 (&acc)[2][2][4][2], const Unit& u, int wr, int wc, int fr, int fq) const {
        const int row0 = u.om + wr * 64 + fr, col0 = u.pn * HALF + wc * 32 + 8 * fq; const float* bb = bias + (size_t)u.e * b_estride;
        constexpr float ASC = MODE == 1 ? 1.0f / (F8_SH * F8_SW) : 1.0f;
        f32x4 bv[2][2];
#pragma unroll
        for (int bj = 0; bj < 2; ++bj)
#pragma unroll
            for (int n = 0; n < 2; ++n) bv[bj][n] = *(const f32x4*)(bb + bj * D + col0 + 4 * n);
#pragma unroll
        for (int ai = 0; ai < 2; ++ai)
#pragma unroll
            for (int m = 0; m < 4; ++m) { float r[8];
#pragma unroll
                for (int n = 0; n < 2; ++n) { const f32x4 a = acc[ai][0][m][n] * ASC + bv[0][n], g = acc[ai][1][m][n] * ASC + bv[1][n];
#pragma unroll
                    for (int jp = 0; jp < 2; ++jp) {
                        f32x2 av = (f32x2){a[2 * jp], a[2 * jp + 1]}, gv = (f32x2){g[2 * jp], g[2 * jp + 1]}, o;
                        if (MODE == 0) { const f32x2 x = gv * (-LOG2E); f32x2 e; e.x = __builtin_amdgcn_exp2f(x.x); e.y = __builtin_amdgcn_exp2f(x.y); const f32x2 d = e + 1.0f;
                            f32x2 rc; rc.x = __builtin_amdgcn_rcpf(d.x); rc.y = __builtin_amdgcn_rcpf(d.y); o = av * rc; }
                        else { f32x2 glu, lin; glu.x = fminf(av.x, 7.0f); glu.y = fminf(av.y, 7.0f); lin.x = __builtin_amdgcn_fmed3f(gv.x, -7.0f, 7.0f); lin.y = __builtin_amdgcn_fmed3f(gv.y, -7.0f, 7.0f);
                            const f32x2 x = glu * (-1.702f * LOG2E); f32x2 e; e.x = __builtin_amdgcn_exp2f(x.x); e.y = __builtin_amdgcn_exp2f(x.y); const f32x2 d = e + 1.0f;
                            f32x2 rc; rc.x = __builtin_amdgcn_rcpf(d.x); rc.y = __builtin_amdgcn_rcpf(d.y); o = (glu * rc) * (lin * F8_SACT + F8_SACT); }
                        r[4 * n + 2 * jp] = o.x; r[4 * n + 2 * jp + 1] = o.y; } }
                if (MODE == 0) { bf16_t* rowp = (bf16_t*)O + (size_t)(row0 + ai * HALF + m * 16) * D + col0;
                    u32x4 w; w.x = cvt_pk(r[0], r[1]); w.y = cvt_pk(r[2], r[3]); w.z = cvt_pk(r[4], r[5]); w.w = cvt_pk(r[6], r[7]); *(u32x4*)rowp = w; }
                else { unsigned char* rowp = (unsigned char*)O + (size_t)(row0 + ai * HALF + m * 16) * D + col0;
                    u32x2 w; w.x = cvt_pk4_fp8_nc(r[0], r[1], r[2], r[3]); w.y = cvt_pk4_fp8_nc(r[4], r[5], r[6], r[7]); *(u32x2*)rowp = w; } }
    }
};
struct EpiMoeOut {
    static constexpr bool PERM = true;
    bf16_t* O; const float* bias; const float* gl; const LAS int* exoff;
    __device__ __forceinline__ void operator()(const f32x4 (&acc)[2][2][4][2], const Unit& u, int wr, int wc, int fr, int fq) const {
        const int row0 = u.om + wr * 64 + fr, col0 = u.pn * BM + wc * 32 + 8 * fq; const float* bb = bias + (size_t)u.e * D;
        const GAS float* gp = (const GAS float*)(gl + (size_t)u.e * T + (u.om - exoff[u.e]) + wr * 64 + fr);
        f32x4 bv[2][2]; float gt[2][4];
#pragma unroll
        for (int ai = 0; ai < 2; ++ai)
#pragma unroll
            for (int m = 0; m < 4; ++m) gt[ai][m] = gp[ai * HALF + m * 16];
#pragma unroll
        for (int bj = 0; bj < 2; ++bj)
#pragma unroll
            for (int n = 0; n < 2; ++n) bv[bj][n] = *(const GAS f32x4*)(bb + col0 + bj * HALF + 4 * n);
#pragma unroll
        for (int ai = 0; ai < 2; ++ai)
#pragma unroll
            for (int m = 0; m < 4; ++m) { GAS unsigned char* rowp = (GAS unsigned char*)O + (size_t)(row0 + ai * HALF + m * 16) * D + col0; const float g16 = gt[ai][m] * F8_SY;
#pragma unroll
                for (int bj = 0; bj < 2; ++bj) { const f32x4 v0 = (acc[ai][bj][m][0] * (1.0f / (F8_SACT * F8_SW)) + bv[bj][0]) * g16, v1 = (acc[ai][bj][m][1] * (1.0f / (F8_SACT * F8_SW)) + bv[bj][1]) * g16;
                    u32x2 w; w.x = cvt_pk4_fp8(v0[0], v0[1], v0[2], v0[3]); w.y = cvt_pk4_fp8(v1[0], v1[1], v1[2], v1[3]);
                    *(GAS u32x2*)(rowp + bj * HALF) = w; } }
    }
};

struct Frame {
    LAS unsigned char* lds; volatile LAS unsigned* MISC; gu32* ctl; unsigned char* ws;
    int tid, lane, wave, G, c;
    int xcc, rank, loc;
    const float* const* in;
    float* out;
};
enum { I_X = 0, I_C, I_WMOD, I_BMOD, I_NMG, I_NFG, I_AWQKV, I_ABQKV, I_AWO, I_ABO, I_SINK, I_RELB, I_CWIN, I_CBIN, I_CWDW, I_CBDW, I_CLNG, I_CLNB, I_CWOUT, I_CBOUT, I_RW, I_RB, I_MWIN, I_MBIN, I_MWOUT, I_MBOUT, I_FNG };
#define WSP(type, off) ((type*)(F.ws + (off)))
__device__ __forceinline__ void wg_barrier() { __syncthreads(); }

__device__ __forceinline__ int build_exp_tables(Frame& F, int layer) {
    LAS int* EX = (LAS int*)(F.lds + LDS_EXP);
    if (F.MISC[22] == (unsigned)(layer + 1)) return EX[96];
    if (F.tid < 64) {
        const int e = F.tid & 31; const int cnt = (int)__hip_atomic_load(F.ctl + CW_CNT + 64 * layer + e, RLX_AGENT); const int tiles = (cnt + 255) >> 8;
        int pre = tiles;
#pragma unroll
        for (int o = 1; o < 32; o <<= 1) { const int v = __shfl_up(pre, o, 32); if (e >= o) pre += v; }
        if (F.tid < 32) { EX[e] = cnt; EX[32 + e] = pre - tiles; EX[64 + e] = (pre - tiles) * 256; if (e == 31) EX[96] = pre; }
    }
    wg_barrier();
    if (F.tid == 0) F.MISC[22] = (unsigned)(layer + 1);
    return EX[96];
}
template <int MODE> __device__ __forceinline__ void row_phase(Frame& F, int layer) {
    constexpr bool COMB = (MODE & 1) != 0, ROUT = (MODE & 2) != 0, FIN = (MODE & 4) != 0;
    LAS float* red = (LAS float*)(F.lds); LAS float* part = (LAS float*)(F.lds + 49152); LAS float* lg = (LAS float*)(F.lds + 49152 + 65536);
    LAS int* hist = (LAS int*)(F.lds + 4608); LAS int* gbase = hist + 32; LAS int* pend = (LAS int*)(F.lds + 8192);
    const LAS int* EX = (const LAS int*)(F.lds + LDS_EXP);
    const int lane = F.lane, w = F.wave, row = lane & 15, kq = lane >> 4;
    constexpr int KS = (MODE & 2) ? 32 : 8;
    const int kb = (MODE & 2) ? 128 * w + 8 * kq : 128 * w + 32 * kq;
    constexpr bool XF32 = (MODE == 0);
    const float* xin = F.in[I_X]; bf16_t* X = WSP(bf16_t, WS_X); bf16_t* H = WSP(bf16_t, WS_H);
    const float* mod = WSP(const float, WS_MOD);
    const float* gamma = FIN ? F.in[I_FNG] : (ROUT ? F.in[I_NFG] + layer * D : F.in[I_NMG] + layer * D);
    const int ngrp = T / 16; int g0 = (int)((long)F.c * ngrp / F.G), g1 = (int)((long)(F.c + 1) * ngrp / F.G);
    if (F.loc) { g0 = F.xcc * (SEQ / 16) + 4 * F.rank; g1 = g0 + 4; }
    if (COMB) build_exp_tables(F, layer - 1);
    if (ROUT) { if (F.tid < 32) hist[F.tid] = 0; }
    bf16x8 whi[2][4], wlo[2][4];
    if (ROUT) {
        const float* wrp = F.in[I_RW] + (size_t)layer * D * NE;
#pragma unroll
        for (int eh = 0; eh < 2; ++eh)
#pragma unroll
            for (int s = 0; s < 4; ++s) { float v[8];
#pragma unroll
                for (int j = 0; j < 8; ++j) v[j] = wrp[(size_t)(kb + 32 * s + j) * NE + 16 * eh + row];
                u32x4 hi, lo;
#pragma unroll
                for (int p = 0; p < 4; ++p) { const unsigned h2 = cvt_pk(v[2 * p], v[2 * p + 1]); hi[p] = h2; lo[p] = cvt_pk(v[2 * p] - bf_lo(h2), v[2 * p + 1] - bf_hi(h2)); }
                whi[eh][s] = __builtin_bit_cast(bf16x8, hi); wlo[eh][s] = __builtin_bit_cast(bf16x8, lo); }
    }
    LAS float* Gl = (LAS float*)(F.lds + 32768); LAS float* Sl = Gl + D; LAS float* Fl = Sl + D;
    constexpr int GU = (XF32 || ROUT) ? 2 : 4;
#define UNPK0(v) ((f32x4){bf_lo((v).x), bf_hi((v).x), bf_lo((v).y), bf_hi((v).y)})
#define UNPK1(v) ((f32x4){bf_lo((v).z), bf_hi((v).z), bf_lo((v).w), bf_hi((v).w)})
    int curb = -1;
    for (int grp0 = g0; grp0 < g1; grp0 += GU) {
        const int b = (grp0 * 16) / SEQ, par = ((grp0 - g0) / GU) & 1;
        if (b != curb) { curb = b;
            const float* mb = mod + ((size_t)layer * NBATCH + b) * (6 * D);
            wg_barrier();
            for (int k = F.tid; k < D; k += NTHR) { const float gm = gamma[k];
                if (FIN) { Gl[k] = gm; Sl[k] = 0.f; }
                else { const float* shp = mb + (ROUT ? 3 * D : 0); const float* scp = mb + (ROUT ? 4 * D : D); Gl[k] = gm * (scp[k] + 1.0f); Sl[k] = shp[k]; }
                if (COMB) { const float* gf = mod + ((size_t)(layer - 1) * NBATCH + b) * (6 * D) + 5 * D; Fl[k] = gf[k]; } }
            wg_barrier();
        }
        u32x4 xb[GU][4]; int tks[GU][4];
#pragma unroll
        for (int u = 0; u < GU; ++u) { const int t = (grp0 + u < g1 ? grp0 + u : g1 - 1) * 16 + row;
            if (COMB) { const int* TK = WSP(const int, WS_TK);
#pragma unroll
                for (int kk = 0; kk < 4; ++kk) tks[u][kk] = TK[t * 4 + kk]; }
#pragma unroll
            for (int s = 0; s < 4; ++s) {
                if (XF32) { const f32x4 x0 = *(const f32x4*)(xin + (size_t)t * D + kb + KS * s), x1 = *(const f32x4*)(xin + (size_t)t * D + kb + KS * s + 4);
                    xb[u][s].x = cvt_pk(x0[0], x0[1]); xb[u][s].y = cvt_pk(x0[2], x0[3]); xb[u][s].z = cvt_pk(x1[0], x1[1]); xb[u][s].w = cvt_pk(x1[2], x1[3]); }
                else xb[u][s] = *(const u32x4*)(X + (size_t)t * D + kb + KS * s); } }
        if (COMB) {
            const unsigned char* YS = WSP(const unsigned char, WS_YS);
#pragma unroll
            for (int u = 0; u < GU; ++u) { const int t = (grp0 + u < g1 ? grp0 + u : g1 - 1) * 16 + row;
                size_t yoff[4];
#pragma unroll
                for (int kk = 0; kk < 4; ++kk) { const int tk = tks[u][kk]; yoff[kk] = (size_t)(EX[64 + (tk >> 16)] + (tk & 0xffff)) * D + kb; }
                u32x2 yv[4][4];
#pragma unroll
                for (int s = 0; s < 4; ++s)
#pragma unroll
                    for (int kk = 0; kk < 4; ++kk) yv[s][kk] = *(const u32x2*)(YS + yoff[kk] + KS * s);
#pragma unroll
                for (int s = 0; s < 4; ++s) { f32x4 a0 = (f32x4){0.f, 0.f, 0.f, 0.f}, a1 = a0;
#pragma unroll
                    for (int kk = 0; kk < 4; ++kk) { a0 += fp8x4_to_f32(yv[s][kk].x); a1 += fp8x4_to_f32(yv[s][kk].y); }
                    const f32x4 x0 = UNPK0(xb[u][s]) + *(const LAS f32x4*)(Fl + kb + KS * s) * a0 * (1.0f / F8_SY), x1 = UNPK1(xb[u][s]) + *(const LAS f32x4*)(Fl + kb + KS * s + 4) * a1 * (1.0f / F8_SY);
                    xb[u][s].x = cvt_pk(x0[0], x0[1]); xb[u][s].y = cvt_pk(x0[2], x0[3]); xb[u][s].z = cvt_pk(x1[0], x1[1]); xb[u][s].w = cvt_pk(x1[2], x1[3]);
                    if (!FIN && grp0 + u < g1) *(u32x4*)(X + (size_t)t * D + kb + KS * s) = xb[u][s]; } }
        }
#pragma unroll
        for (int u = 0; u < GU; ++u) { float ss = 0.f;
#pragma unroll
            for (int s = 0; s < 4; ++s) { const f32x4 v0 = UNPK0(xb[u][s]), v1 = UNPK1(xb[u][s]); ss += (v0[0] * v0[0] + v0[1] * v0[1]) + (v0[2] * v0[2] + v0[3] * v0[3]) + (v1[0] * v1[0] + v1[1] * v1[1]) + (v1[2] * v1[2] + v1[3] * v1[3]); }
            ss += __shfl_xor(ss, 16); ss += __shfl_xor(ss, 32);
            if (kq == 0) red[(par * GU + u) * 128 + w * 16 + row] = ss; }
        wg_barrier();
        f32x4 acc[GU][2];
#pragma unroll
        for (int u = 0; u < GU; ++u) { const int t = (grp0 + u < g1 ? grp0 + u : g1 - 1) * 16 + row; const bool live = grp0 + u < g1;
            float tot = 0.f;
#pragma unroll
            for (int ww = 0; ww < 8; ++ww) tot += red[(par * GU + u) * 128 + ww * 16 + row];
            const float rstd = rsqrtf(tot * (1.0f / D) + 1e-5f);
            acc[u][0] = (f32x4){0.f, 0.f, 0.f, 0.f}; acc[u][1] = acc[u][0];
#pragma unroll
            for (int s = 0; s < 4; ++s) {
                const f32x4 h0 = UNPK0(xb[u][s]) * rstd * *(const LAS f32x4*)(Gl + kb + KS * s) + *(const LAS f32x4*)(Sl + kb + KS * s), h1 = UNPK1(xb[u][s]) * rstd * *(const LAS f32x4*)(Gl + kb + KS * s + 4) + *(const LAS f32x4*)(Sl + kb + KS * s + 4);
                if (FIN) { if (live) { *(f32x4*)(F.out + (size_t)t * D + kb + KS * s) = h0; *(f32x4*)(F.out + (size_t)t * D + kb + KS * s + 4) = h1; } }
                else {
                    u32x4 hi; hi.x = cvt_pk(h0[0], h0[1]); hi.y = cvt_pk(h0[2], h0[3]); hi.z = cvt_pk(h1[0], h1[1]); hi.w = cvt_pk(h1[2], h1[3]);
                    if (!ROUT) { if (live) *(u32x4*)(H + (size_t)t * D + kb + KS * s) = hi; }
                    else { u32x2 q8; q8.x = cvt_pk4_fp8(h0[0] * F8_SH, h0[1] * F8_SH, h0[2] * F8_SH, h0[3] * F8_SH); q8.y = cvt_pk4_fp8(h1[0] * F8_SH, h1[1] * F8_SH, h1[2] * F8_SH, h1[3] * F8_SH);
                        if (live) *(u32x2*)((unsigned char*)H + (size_t)t * D + kb + KS * s) = q8; }
                    if (ROUT) {
                        u32x4 lo; lo.x = cvt_pk(h0[0] - bf_lo(hi.x), h0[1] - bf_hi(hi.x)); lo.y = cvt_pk(h0[2] - bf_lo(hi.y), h0[3] - bf_hi(hi.y));
                        lo.z = cvt_pk(h1[0] - bf_lo(hi.z), h1[1] - bf_hi(hi.z)); lo.w = cvt_pk(h1[2] - bf_lo(hi.w), h1[3] - bf_hi(hi.w));
                        const bf16x8 ah = __builtin_bit_cast(bf16x8, hi), al = __builtin_bit_cast(bf16x8, lo);
#pragma unroll
                        for (int eh = 0; eh < 2; ++eh) {
                            acc[u][eh] = __builtin_amdgcn_mfma_f32_16x16x32_bf16(ah, whi[eh][s], acc[u][eh], 0, 0, 0);
                            acc[u][eh] = __builtin_amdgcn_mfma_f32_16x16x32_bf16(ah, wlo[eh][s], acc[u][eh], 0, 0, 0);
                            acc[u][eh] = __builtin_amdgcn_mfma_f32_16x16x32_bf16(al, whi[eh][s], acc[u][eh], 0, 0, 0); }
                    }
                }
            }
        }
        if (ROUT) {
#pragma unroll
            for (int u = 0; u < GU; ++u)
#pragma unroll
                for (int eh = 0; eh < 2; ++eh)
#pragma unroll
                    for (int i = 0; i < 4; ++i) part[((u * 8 + w) * 16 + 4 * kq + i) * 32 + 16 * eh + row] = acc[u][eh][i];
            wg_barrier();
#pragma unroll
            for (int u = 0; u < GU; ++u) { const int r = F.tid >> 5, e = F.tid & 31; float v = F.in[I_RB][layer * NE + e];
#pragma unroll
                for (int ww = 0; ww < 8; ++ww) v += part[((u * 8 + ww) * 16 + r) * 32 + e];
                lg[(u * 16 + r) * 32 + e] = v; }
            wg_barrier();
            if (F.tid < 16 * GU && grp0 + (F.tid >> 4) < g1) {
                const int u = F.tid >> 4, r = F.tid & 15; unsigned used = 0u; int ids[4]; float vals[4];
#pragma unroll
                for (int k = 0; k < 4; ++k) { int bi = 0; float bv = -3.0e38f;
                    for (int e = 0; e < 32; ++e) { const float v = lg[(u * 16 + r) * 32 + e]; if (!((used >> e) & 1u) && v > bv) { bv = v; bi = e; } }
                    used |= 1u << bi; ids[k] = bi; vals[k] = bv; }
                const float e1 = __expf(vals[1] - vals[0]), e2 = __expf(vals[2] - vals[0]), e3 = __expf(vals[3] - vals[0]), inv = 1.0f / (1.0f + e1 + e2 + e3);
                const float gs[4] = {inv, e1 * inv, e2 * inv, e3 * inv};
#pragma unroll
                for (int k = 0; k < 4; ++k) { const int lp = atomicAdd((int*)&hist[ids[k]], 1); const int idx = ((grp0 + u - g0) * 16 + r) * 4 + k; pend[2 * idx] = ids[k] | (lp << 8); pend[2 * idx + 1] = __float_as_int(gs[k]); }
            }
        }
    }
#undef UNPK0
#undef UNPK1
    if (ROUT) {
        wg_barrier();
        if (F.tid < 32) { const int n = hist[F.tid]; gbase[F.tid] = n > 0 ? (int)__hip_atomic_fetch_add(F.ctl + CW_CNT + 64 * layer + F.tid, (unsigned)n, RLX_AGENT) : 0; }
        wg_barrier();
        int* LIST = WSP(int, WS_LIST); float* GL = WSP(float, WS_GLIST); int* TK = WSP(int, WS_TK);
        const int nent = (g1 - g0) * 64;
        for (int idx = F.tid; idx < nent; idx += NTHR) { const int pw = pend[2 * idx], e = pw & 0xff, pos = gbase[e] + (pw >> 8), tok = g0 * 16 + (idx >> 2);
            LIST[(size_t)e * T + pos] = tok; GL[(size_t)e * T + pos] = __int_as_float(pend[2 * idx + 1]); TK[tok * 4 + (idx & 3)] = (e << 16) | pos; }
    }
    wg_barrier();
}
__device__ const unsigned char kBucket[128] = {0, 1, 2, 3, 4, 5, 6, 7, 8, 9, 10, 11, 12, 13, 14, 15, 16, 16, 16, 17, 17, 18, 18, 18, 19, 19, 19, 20, 20, 20, 20, 21, 21, 21, 21, 22, 22, 22, 22, 22, 23, 23, 23, 23, 23, 23, 24, 24, 24, 24, 24, 24, 25, 25, 25, 25, 25, 25, 25, 26, 26, 26, 26, 26, 26, 26, 26, 27, 27, 27, 27, 27, 27, 27, 27, 27, 27, 28, 28, 28, 28, 28, 28, 28, 28, 28, 28, 29, 29, 29, 29, 29, 29, 29, 29, 29, 29, 29, 29, 30, 30, 30, 30, 30, 30, 30, 30, 30, 30, 30, 30, 30, 30, 31, 31, 31, 31, 31, 31, 31, 31, 31, 31, 31, 31, 31, 31, 31};
constexpr int KP = 144, VP = 192;
constexpr int ATT_K = 0, ATT_V = 256 * KP, ATT_B = ATT_V + 256 * VP;
__device__ __forceinline__ int crow(int r, int hi) { return (r & 3) + 8 * (r >> 2) + 4 * hi; }
typedef short v4i16_t __attribute__((ext_vector_type(4)));
__device__ __forceinline__ s16x4 vtr(const LAS unsigned char* p) { return __builtin_bit_cast(s16x4, __builtin_amdgcn_ds_read_tr16_b64_v4i16((LAS v4i16_t*)p)); }

__device__ __forceinline__ void attn_phase(Frame& F, int j) {
    const bf16_t* QKV = WSP(const bf16_t, WS_QKV); bf16_t* AO = WSP(bf16_t, WS_AO);
    LAS unsigned char* Kl = F.lds + ATT_K; LAS unsigned char* Vl = F.lds + ATT_V; LAS float* Bl = (LAS float*)(F.lds + ATT_B);
    const int lane = F.lane, w = F.wave, r = lane & 31, hh = lane >> 5;
    const float c1 = 0.125f * LOG2E;
    const int u_beg = F.loc ? F.xcc * 64 + F.rank : F.c, u_step = F.loc ? 32 : F.G, u_end = F.loc ? F.xcc * 64 + 64 : NBATCH * 16 * 4;
    u32x4 kreg[4], vreg[4];
#define ATT_ISSUE(UNIT) { const int kvh_ = (UNIT) & 3, n_ = ((UNIT) >> 2) & 15, b_ = (UNIT) >> 6; \
        _Pragma("unroll") for (int it = 0; it < 4; ++it) { const int ch = F.tid + NTHR * it, s = ch >> 3, c8 = ch & 7; \
            const int grow = (n_ > 0 || s >= 128) ? (b_ * SEQ + (n_ - 1) * 128 + s) : (b_ * SEQ + s);        \
            kreg[it] = *(const u32x4*)(QKV + (size_t)grow * 1536 + 1024 + kvh_ * 64 + 8 * c8); vreg[it] = *(const u32x4*)(QKV + (size_t)grow * 1536 + 1280 + kvh_ * 64 + 8 * c8); } }
    if (u_beg < u_end) ATT_ISSUE(u_beg);
    for (int unit = u_beg; unit < u_end; unit += u_step) {
        const int kvh = unit & 3, n = (unit >> 2) & 15, b = unit >> 6;
        const int g = w >> 1, hq = kvh * 4 + g; const float sink2 = F.in[I_SINK][j * 16 + hq] * LOG2E;
        bf16x8 qf[4];
        { const size_t tok0 = (size_t)b * SEQ + n * 128 + (w & 1) * 64 + r;
#pragma unroll
            for (int d0 = 0; d0 < 4; ++d0) qf[d0] = *(const bf16x8*)(QKV + tok0 * 1536 + hq * 64 + 16 * d0 + 8 * hh); }
#pragma unroll
        for (int it = 0; it < 4; ++it) { const int ch = F.tid + NTHR * it, s = ch >> 3, c8 = ch & 7;
            *(LAS u32x4*)(Kl + s * KP + 16 * c8) = kreg[it]; *(LAS u32x4*)(Vl + s * VP + 16 * c8) = vreg[it]; }
        { const int gg = F.tid >> 7, dist = F.tid & 127; Bl[F.tid] = F.in[I_RELB][kBucket[dist] * 16 + kvh * 4 + gg] * LOG2E; }
        wg_barrier();
        if (unit + u_step < u_end) ATT_ISSUE(unit + u_step);
#pragma unroll 1
        for (int grp = 0; grp < 2; ++grp) {
            const int a0 = (w & 1) * 64 + grp * 32, a = a0 + r; const size_t tok = (size_t)b * SEQ + n * 128 + a;
            bf16x8 qn[4];
            if (grp == 0) {
#pragma unroll
                for (int d0 = 0; d0 < 4; ++d0) qn[d0] = *(const bf16x8*)(QKV + (tok + 32) * 1536 + hq * 64 + 16 * d0 + 8 * hh); }
            else {
#pragma unroll
                for (int d0 = 0; d0 < 4; ++d0) qn[d0] = qf[d0]; }
            const int kt0 = a0 >> 5;
            f32x16 S[5];
#pragma unroll
            for (int t = 0; t < 5; ++t) {
#pragma unroll
                for (int i = 0; i < 16; ++i) S[t][i] = 0.f;
                const LAS unsigned char* kp = Kl + (32 * (kt0 + t) + r) * KP + 16 * hh;
#pragma unroll
                for (int d0 = 0; d0 < 4; ++d0) { const bf16x8 kf = *(const LAS bf16x8*)(kp + 32 * d0); S[t] = __builtin_amdgcn_mfma_f32_32x32x16_bf16(kf, qf[d0], S[t], 0, 0, 0); }
            }
            const int rr = r - 4 * hh;
            float m = sink2;
#pragma unroll
            for (int t = 0; t < 5; ++t) {
                if (n > 0 || kt0 + t >= 4) {
                    const LAS float* bp = Bl + g * 128 + (rr + 128 - 32 * t);
#pragma unroll
                    for (int i = 0; i < 16; ++i) { const int dc = (i & 3) + 8 * (i >> 2);
                        float v = S[t][i] * c1 + bp[-dc];
                        if (t == 0) v = (dc > rr) ? v : -3.0e38f;
                        if (t == 4) v = (dc <= rr) ? v : -3.0e38f;
                        S[t][i] = v; m = fmaxf(m, v); }
                } else {
#pragma unroll
                    for (int i = 0; i < 16; ++i) S[t][i] = -3.0e38f;
                }
            }
            m = fmaxf(m, __shfl_xor(m, 32));
            float l = 0.f;
#pragma unroll
            for (int t = 0; t < 5; ++t)
#pragma unroll
                for (int i = 0; i < 16; ++i) { const float p = __builtin_amdgcn_exp2f(S[t][i] - m); S[t][i] = p; l += p; }
            l += __shfl_xor(l, 32); l += __builtin_amdgcn_exp2f(sink2 - m);
            f32x16 O[2];
#pragma unroll
            for (int i = 0; i < 16; ++i) { O[0][i] = 0.f; O[1][i] = 0.f; }
            const int q4 = (lane >> 2) & 3, p4 = lane & 3, blk = (lane >> 4) & 1;
#pragma unroll
            for (int t = 0; t < 5; ++t)
#pragma unroll
                for (int s2 = 0; s2 < 2; ++s2) {
                    u32x4 pk; pk.x = cvt_pk(S[t][8 * s2 + 0], S[t][8 * s2 + 1]); pk.y = cvt_pk(S[t][8 * s2 + 2], S[t][8 * s2 + 3]); pk.z = cvt_pk(S[t][8 * s2 + 4], S[t][8 * s2 + 5]); pk.w = cvt_pk(S[t][8 * s2 + 6], S[t][8 * s2 + 7]);
                    const bf16x8 pb = __builtin_bit_cast(bf16x8, pk);
                    const LAS unsigned char* vp = Vl + (32 * (kt0 + t) + 16 * s2 + 4 * hh + q4) * VP + 32 * blk + 8 * p4;
#pragma unroll
                    for (int dh = 0; dh < 2; ++dh) { const s16x4 lo = vtr(vp + 64 * dh), hi = vtr(vp + 64 * dh + 8 * VP);
                        const bf16x8 va = (bf16x8){lo[0], lo[1], lo[2], lo[3], hi[0], hi[1], hi[2], hi[3]};
                        O[dh] = __builtin_amdgcn_mfma_f32_32x32x16_bf16(va, pb, O[dh], 0, 0, 0); }
                }
            const float inv = 1.0f / l;
#pragma unroll
            for (int dh = 0; dh < 2; ++dh)
#pragma unroll
                for (int g4 = 0; g4 < 4; ++g4) { u32x2 o2; o2.x = cvt_pk(O[dh][4 * g4] * inv, O[dh][4 * g4 + 1] * inv); o2.y = cvt_pk(O[dh][4 * g4 + 2] * inv, O[dh][4 * g4 + 3] * inv);
                    *(u32x2*)(AO + tok * D + hq * 64 + 32 * dh + 8 * g4 + 4 * hh) = o2; }
#pragma unroll
            for (int d0 = 0; d0 < 4; ++d0) qf[d0] = qn[d0];
        }
        wg_barrier();
    }
#undef ATT_ISSUE
}

__device__ __forceinline__ float wave_sum63(float v) {
    v += __builtin_bit_cast(float, __builtin_amdgcn_update_dpp(0, __builtin_bit_cast(int, v), 0x111, 0xf, 0xf, true));
    v += __builtin_bit_cast(float, __builtin_amdgcn_update_dpp(0, __builtin_bit_cast(int, v), 0x112, 0xf, 0xf, true));
    v += __builtin_bit_cast(float, __builtin_amdgcn_update_dpp(0, __builtin_bit_cast(int, v), 0x114, 0xf, 0xf, true));
    v += __builtin_bit_cast(float, __builtin_amdgcn_update_dpp(0, __builtin_bit_cast(int, v), 0x118, 0xf, 0xf, true));
    v += __builtin_bit_cast(float, __builtin_amdgcn_update_dpp(0, __builtin_bit_cast(int, v), 0x142, 0xa, 0xf, true));
    v += __builtin_bit_cast(float, __builtin_amdgcn_update_dpp(0, __builtin_bit_cast(int, v), 0x143, 0xc, 0xf, true));
    return v;
}
__device__ __forceinline__ void dwconv_phase(Frame& F, int j, unsigned long long& t_acc) {
#ifndef TIME_KIND
#define TIME_KIND (-1)
#endif
    unsigned long long t_b = 0ull;
#define DT_BEG(k) do { if (TIME_KIND == (k)) t_b = __builtin_amdgcn_s_memrealtime(); } while (0)
#define DT_END(k) do { if (TIME_KIND == (k)) t_acc += __builtin_amdgcn_s_memrealtime() - t_b; } while (0)
    constexpr int PP = 520;
    DT_BEG(16);
    const bf16_t* U = WSP(const bf16_t, WS_U); bf16_t* YC = WSP(bf16_t, WS_AO);
    LAS unsigned char* ut = F.lds; LAS float* P = (LAS float*)F.lds; LAS float* fin = (LAS float*)(F.lds + 64 * PP * 4);
    const int tid = F.tid, lane = F.lane, w = F.wave;
    const float* wd = F.in[I_CWDW] + (size_t)j * 31 * D + 2 * tid;
    f32x2 wk[31];
#pragma unroll
    for (int q = 0; q < 31; ++q) wk[q] = *(const f32x2*)(wd + q * D);
    const f32x2 bdw = *(const f32x2*)(F.in[I_CBDW] + j * D + 2 * tid), lng = *(const f32x2*)(F.in[I_CLNG] + j * D + 2 * tid), lnb = *(const f32x2*)(F.in[I_CLNB] + j * D + 2 * tid);
    const __amdgpu_buffer_rsrc_t rU = __builtin_amdgcn_make_buffer_rsrc((void*)U, 0, 0x7fffffff, 0x00020000);
    asm volatile("s_waitcnt vmcnt(0)" ::: "memory"); DT_END(16);
    const int tl_beg = F.loc ? F.xcc * 64 + F.rank : F.c, tl_step = F.loc ? 32 : F.G, tl_end = F.loc ? F.xcc * 64 + 64 : T / 32;
    for (int tile = tl_beg; tile < tl_end; tile += tl_step) {
        const int t0 = tile * 32, tin0 = t0 % SEQ, rlo = tin0 >= 30 ? 0 : 30 - tin0;
        DT_BEG(12);
        for (int pc = w; pc < 124; pc += NWAVES) { const int rr = pc >> 1;
            if (rr >= rlo) __builtin_amdgcn_raw_ptr_buffer_load_lds(rU, (LAS unsigned*)(ut + pc * 1024), 16, lane * 16, (int)(((size_t)(t0 + rr - 30) * D + (pc & 1) * 512) * 2), 0, 0);
            else *(LAS u32x4*)(ut + pc * 1024 + lane * 16) = (u32x4){0u, 0u, 0u, 0u}; }
        asm volatile("s_waitcnt vmcnt(0)" ::: "memory");
        wg_barrier();
        DT_END(12); DT_BEG(13);
        f32x2 y[32];
#pragma unroll
        for (int blk = 0; blk < 4; ++blk) {
            f32x2 a[8] = {bdw, bdw, bdw, bdw, bdw, bdw, bdw, bdw};
#pragma unroll
            for (int rr = 0; rr < 38; ++rr) { const unsigned uw = *(const LAS unsigned*)(ut + (8 * blk + rr) * 2048 + 4 * tid); const f32x2 uv = (f32x2){bf_lo(uw), bf_hi(uw)};
#pragma unroll
                for (int o = 0; o < 8; ++o) { const int q = rr - o; if (q >= 0 && q < 31) a[o] += wk[q] * uv; } }
#pragma unroll
            for (int o = 0; o < 8; ++o) y[8 * blk + o] = a[o];
        }
        DT_END(13); DT_BEG(14);
        wg_barrier();
#pragma unroll
        for (int tk = 0; tk < 32; ++tk) { P[(2 * tk) * PP + tid] = y[tk].x + y[tk].y; P[(2 * tk + 1) * PP + tid] = y[tk].x * y[tk].x + y[tk].y * y[tk].y; }
        wg_barrier();
        { const int qn = tid >> 3, l8 = tid & 7; float v = 0.f;
#pragma unroll 16
          for (int i2 = 0; i2 < 64; ++i2) v += P[qn * PP + l8 + 8 * i2];
          v += __shfl_xor(v, 1); v += __shfl_xor(v, 2); v += __shfl_xor(v, 4);
          if (l8 == 0) fin[qn] = v; }
        wg_barrier();
        DT_END(14); DT_BEG(15);
#pragma unroll
        for (int tk = 0; tk < 32; ++tk) { const float mean = fin[2 * tk] * (1.0f / D), var = fmaxf(fin[2 * tk + 1] * (1.0f / D) - mean * mean, 0.f), rstd = rsqrtf(var + 1e-5f);
            const float v0 = (y[tk].x - mean) * rstd * lng.x + lnb.x, v1 = (y[tk].y - mean) * rstd * lng.y + lnb.y;
            *(unsigned*)(YC + (size_t)(t0 + tk) * D + 2 * tid) = cvt_pk(v0 * sigmoid_f(v0), v1 * sigmoid_f(v1)); }
        asm volatile("s_waitcnt vmcnt(0)" ::: "memory");
        wg_barrier();
        DT_END(15);
    }
#undef DT_BEG
#undef DT_END
}
__device__ __forceinline__ void p0_mod_task(Frame& F, int task) {
    LAS float* cact = (LAS float*)F.lds; LAS float* part = (LAS float*)(F.lds + 32768);
    const int i = task / 24, n0 = (task % 24) * 256, tid = F.tid, lane = F.lane, w = F.wave;
    for (int q = tid; q < NBATCH * D; q += NTHR) { const float cv = F.in[I_C][q]; cact[q] = cv * sigmoid_f(cv); }
    wg_barrier();
    f32x4 acc[8];
#pragma unroll
    for (int b = 0; b < 8; ++b) acc[b] = (f32x4){0.f, 0.f, 0.f, 0.f};
    const float* Wp = F.in[I_WMOD] + ((size_t)i * D + 128 * w) * (6 * D) + n0 + 4 * lane;
#pragma unroll 4
    for (int k = 0; k < 128; ++k) { const f32x4 wv = __builtin_nontemporal_load((const f32x4*)(Wp + (size_t)k * (6 * D)));
#pragma unroll
        for (int b = 0; b < 8; ++b) acc[b] += wv * cact[b * D + 128 * w + k]; }
#pragma unroll
    for (int b = 0; b < 8; ++b) *(LAS f32x4*)(part + (w * 8 + b) * 256 + 4 * lane) = acc[b];
    wg_barrier();
    float* mod = WSP(float, WS_MOD);
#pragma unroll
    for (int q = 0; q < 4; ++q) { const int o = tid + NTHR * q, b = o >> 8, n = o & 255; float s = F.in[I_BMOD][i * 6 * D + n0 + n];
#pragma unroll
        for (int ww = 0; ww < 8; ++ww) s += part[(ww * 8 + b) * 256 + n];
        mod[((size_t)i * NBATCH + b) * (6 * D) + n0 + n] = s; }
    wg_barrier();
}
struct TItem { const float* W; bf16_t* Dst; int N, paired, kb, nb, f8; };
constexpr int CV_DENSE = 352, CV_MOE = 3072;
__device__ __forceinline__ bool cv_item(Frame& F, int q, int it, TItem& x) {
    if (it < 0) return false;
    if (q == 0) {
        const int NQ = 96, NO = 64, NCI = 128, NCO = 64;
        if (it < NQ) { const int j = it / 48, r = it % 48; x.W = F.in[I_AWQKV] + (size_t)j * D * 1536; x.Dst = WSP(bf16_t, WS_WQKV) + (size_t)j * 1536 * D; x.N = 1536; x.paired = 0; x.f8 = 0; x.kb = r / 6; x.nb = r % 6; return true; } it -= NQ;
        if (it < NO) { const int j = it / 32, r = it % 32; x.W = F.in[I_AWO] + (size_t)j * D * D; x.Dst = WSP(bf16_t, WS_WO) + (size_t)j * D * D; x.N = 1024; x.paired = 0; x.f8 = 0; x.kb = r / 4; x.nb = r % 4; return true; } it -= NO;
        if (it < NCI) { const int j = it / 64, r = it % 64; x.W = F.in[I_CWIN] + (size_t)j * D * 2048; x.Dst = WSP(bf16_t, WS_CWIN) + (size_t)j * 2048 * D; x.N = 2048; x.paired = 1; x.f8 = 0; x.kb = r / 8; x.nb = r % 8; return true; } it -= NCI;
        if (it < NCO) { const int j = it / 32, r = it % 32; x.W = F.in[I_CWOUT] + (size_t)j * D * D; x.Dst = WSP(bf16_t, WS_CWOUT) + (size_t)j * D * D; x.N = 1024; x.paired = 0; x.f8 = 0; x.kb = r / 4; x.nb = r % 4; return true; } it -= NCO;
    }
    if (it < 2048) { const int m = q * NE + it / 64, r = it % 64; x.W = F.in[I_MWIN] + (size_t)m * D * 2048; x.Dst = (bf16_t*)(WSP(unsigned char, WS_MWIN) + (size_t)m * 2048 * D); x.N = 2048; x.paired = 1; x.f8 = 1; x.kb = r / 8; x.nb = r % 8; return true; } it -= 2048;
    if (it < 1024) { const int m = q * NE + it / 32, r = it % 32; x.W = F.in[I_MWOUT] + (size_t)m * D * D; x.Dst = (bf16_t*)(WSP(unsigned char, WS_MWOUT) + (size_t)m * D * D); x.N = 1024; x.paired = 0; x.f8 = 1; x.kb = r / 4; x.nb = r % 4; return true; }
    return false;
}
__device__ __forceinline__ void cv_run(Frame& F, int q, int max_items) {
    if (q > 3 || max_items <= 0) return;
    LAS float* tile = (LAS float*)F.lds;
    volatile LAS int* qslot = (volatile LAS int*)(F.lds + 128 * 257 * 4 + 64);
    const int tid = F.tid, lane = F.lane, w = F.wave; gu32* qc = F.ctl + CW_P0Q + 64 * q;
    int claimed = 1;
    wg_barrier();
    if (tid == 0) qslot[0] = (int)__hip_atomic_fetch_add(qc, 1u, RLX_AGENT);
    wg_barrier();
    int it = qslot[0]; TItem cur; bool valid = cv_item(F, q, it, cur);
    f32x4 rg[16];
    if (valid) {
#pragma unroll
        for (int qq = 0; qq < 16; ++qq) rg[qq] = __builtin_nontemporal_load((const f32x4*)(cur.W + (size_t)(cur.kb * 128 + w * 16 + qq) * cur.N + cur.nb * 256 + 4 * lane)); }
    wg_barrier();
    while (valid) {
        const bool more = claimed < max_items;
        if (tid == 0) qslot[0] = more ? (int)__hip_atomic_fetch_add(qc, 1u, RLX_AGENT) : -1;
        ++claimed;
#pragma unroll
        for (int qq = 0; qq < 16; ++qq) { LAS float* tp = tile + (w * 16 + qq) * 257 + 4 * lane; tp[0] = rg[qq][0]; tp[1] = rg[qq][1]; tp[2] = rg[qq][2]; tp[3] = rg[qq][3]; }
        wg_barrier();
        const int nit = qslot[0]; TItem nx; const bool nvalid = cv_item(F, q, nit, nx);
        if (nvalid) {
#pragma unroll
            for (int qq = 0; qq < 16; ++qq) rg[qq] = __builtin_nontemporal_load((const f32x4*)(nx.W + (size_t)(nx.kb * 128 + w * 16 + qq) * nx.N + nx.nb * 256 + 4 * lane)); }
        const int kc = lane >> 3;
#pragma unroll
        for (int r4 = 0; r4 < 4; ++r4) { const int nl = 32 * w + 8 * r4 + (lane & 7), n = cur.nb * 256 + nl; const LAS float* sp = tile + (16 * kc) * 257 + nl;
            float v[16];
#pragma unroll
            for (int jj = 0; jj < 16; ++jj) v[jj] = sp[jj * 257];
            int nd = n; if (cur.paired) { const int half = n >> 10, rem = n & 1023; nd = ((rem >> 7) << 8) + (half << 7) + (rem & 127); }
            if (cur.f8) { u32x4 o; o.x = cvt_pk4_fp8(v[0] * F8_SW, v[1] * F8_SW, v[2] * F8_SW, v[3] * F8_SW); o.y = cvt_pk4_fp8(v[4] * F8_SW, v[5] * F8_SW, v[6] * F8_SW, v[7] * F8_SW);
                o.z = cvt_pk4_fp8(v[8] * F8_SW, v[9] * F8_SW, v[10] * F8_SW, v[11] * F8_SW); o.w = cvt_pk4_fp8(v[12] * F8_SW, v[13] * F8_SW, v[14] * F8_SW, v[15] * F8_SW);
                __builtin_nontemporal_store(o, (u32x4*)((unsigned char*)cur.Dst + (size_t)nd * D + cur.kb * 128 + 16 * kc)); }
            else { u32x4 o0, o1; o0.x = cvt_pk(v[0], v[1]); o0.y = cvt_pk(v[2], v[3]); o0.z = cvt_pk(v[4], v[5]); o0.w = cvt_pk(v[6], v[7]); o1.x = cvt_pk(v[8], v[9]); o1.y = cvt_pk(v[10], v[11]); o1.z = cvt_pk(v[12], v[13]); o1.w = cvt_pk(v[14], v[15]);
                bf16_t* dp = cur.Dst + (size_t)nd * D + cur.kb * 128 + 16 * kc; __builtin_nontemporal_store(o0, (u32x4*)dp); __builtin_nontemporal_store(o1, (u32x4*)(dp + 8)); } }
        wg_barrier();
        cur = nx; valid = nvalid;
    }
}
#ifndef CV_OVERLAP
#define CV_OVERLAP 1
#endif
__device__ __forceinline__ void p0_phase(Frame& F) {
    for (int task = F.c; task < 96; task += F.G) p0_mod_task(F, task);
    cv_run(F, 0, 1 << 30);
    if (!CV_OVERLAP) { cv_run(F, 1, 1 << 30); cv_run(F, 2, 1 << 30); cv_run(F, 3, 1 << 30); }
}

template <bool GATHER> __device__ __forceinline__ int moe_build_units(Frame& F, int layer, int npn, int total_tiles, int ubase) {
    const LAS int* EX = (const LAS int*)(F.lds + LDS_EXP); LAS int* UT = (LAS int*)(F.lds + LDS_UT); LAS int* TOK = (LAS int*)(F.lds + LDS_TOK);
    const int tps = 32 / npn, nsb = (total_tiles + tps - 1) / tps;
    const bool xcd_ok = (F.G % 256) == 0 || F.G == 256;
    int n = 0;
    if (xcd_ok && F.G == 256) {
        const int x = F.c & 7, jx = F.c >> 3;
        const int mine = x < nsb ? (nsb - x + 7) / 8 : 0; n = mine - ubase; n = n < 0 ? 0 : (n > 9 ? 9 : n);
        if (F.tid < n) { const int q = (ubase + F.tid) * 8 + x, tau = q * tps + (jx % tps), pn = jx / tps; int e = 0;
            if (tau < total_tiles) { for (int qq = 1; qq < 32; ++qq) if (tau >= EX[32 + qq]) e = qq; } else e = -1;
            const int mt = e >= 0 ? tau - EX[32 + e] : 0, om = e >= 0 ? EX[64 + e] + 256 * mt : 0;
            UT[4 * F.tid] = GATHER ? 256 * F.tid : om; UT[4 * F.tid + 1] = om; UT[4 * F.tid + 2] = e; UT[4 * F.tid + 3] = pn; UT[40 + F.tid] = mt; }
    } else {
        const int U = total_tiles * npn; const int mine = F.c < U ? (U - F.c + F.G - 1) / F.G : 0; n = mine - ubase; n = n < 0 ? 0 : (n > 9 ? 9 : n);
        if (F.tid < n) { const int L = F.c + (ubase + F.tid) * F.G, tau = L / npn, pn = L % npn; int e = 0;
            for (int qq = 1; qq < 32; ++qq) if (tau >= EX[32 + qq]) e = qq;
            const int mt = tau - EX[32 + e], om = EX[64 + e] + 256 * mt;
            UT[4 * F.tid] = GATHER ? 256 * F.tid : om; UT[4 * F.tid + 1] = om; UT[4 * F.tid + 2] = e; UT[4 * F.tid + 3] = pn; UT[40 + F.tid] = mt; }
    }
    wg_barrier();
    if (F.tid == 0) { int w = 0; for (int r = 0; r < n; ++r) { if (UT[4 * r + 2] >= 0) { if (w != r) { UT[4 * w] = GATHER ? 256 * w : UT[4 * r]; UT[4 * w + 1] = UT[4 * r + 1]; UT[4 * w + 2] = UT[4 * r + 2]; UT[4 * w + 3] = UT[4 * r + 3]; UT[40 + w] = UT[40 + r]; } ++w; } } UT[60] = w; UT[61] = n; }
    wg_barrier();
    const int nv = UT[60];
    if (GATHER) { const int* LIST = WSP(const int, WS_LIST);
        for (int q = F.tid; q < nv * 256; q += NTHR) { const int ui = q >> 8, rr = q & 255, e = UT[4 * ui + 2], pos = 256 * UT[40 + ui] + rr; TOK[q] = pos < EX[e] ? LIST[(size_t)e * T + pos] : 0; }
        wg_barrier(); }
    return nv | (n << 8);
}

constexpr int N_PHASES = 30;
struct Args { const float* in[27]; float* out; unsigned char* ws; int ph_lo, ph_hi; };
__global__ void __launch_bounds__(NTHR, 2) mega(const Args args) {
    extern __shared__ __attribute__((aligned(16))) unsigned char lds_raw[];
    Frame F; F.lds = (LAS unsigned char*)lds_raw; F.MISC = (volatile LAS unsigned*)(F.lds + LDS_MISC); F.ws = args.ws; F.ctl = (gu32*)(args.ws + WS_CTL);
    F.tid = threadIdx.x; F.lane = F.tid & 63; F.wave = __builtin_amdgcn_readfirstlane(F.tid >> 6); F.G = gridDim.x; F.c = blockIdx.x; F.out = args.out;
    F.in = args.in;
    if (F.tid < 32) F.MISC[F.tid] = 0u;
    __syncthreads();
    const int lo = args.ph_lo, hi = args.ph_hi;
    F.xcc = (int)xb_xcc_id(); F.rank = 0; F.loc = 0;
#ifndef XCC_LOCAL
#define XCC_LOCAL 1
#endif
    if (XCC_LOCAL && hi - lo > 1 && F.G == 256) {
        if (F.tid == 0) { const unsigned r = __hip_atomic_fetch_add(F.ctl + CW_XC + 64 * F.xcc, 1u, RLX_AGENT); unsigned ok = 0u, sp = 0u;
            for (;;) { unsigned sum = 0u, good = 0u;
#pragma unroll
                for (int jx = 0; jx < 16; ++jx) { const unsigned cj = __hip_atomic_load(F.ctl + CW_XC + 64 * jx, RLX_AGENT); sum += cj; good += (jx < 8 ? (cj == 32u) : (cj == 0u)) ? 1u : 0u; }
                if (sum == 256u) { ok = (good == 16u) ? 1u : 0u; break; }
                __builtin_amdgcn_s_sleep(1); if (++sp > XB_SPIN_CAP) { ok = 0u; break; } }
            F.MISC[20] = r; F.MISC[21] = ok; }
        __syncthreads();
        F.rank = (int)F.MISC[20]; F.loc = (int)F.MISC[21];
        if (F.loc) F.c = F.rank * 8 + F.xcc;
    }
    XcdBarrier bar; bar.bar = (unsigned*)(F.ctl + CW_BAR); bar.x = 0; bar.st = F.MISC + 8;
    if (hi - lo > 1) bar = xcd_barrier_post((unsigned*)(F.ctl + CW_BAR), F.MISC + 8);
#ifndef CVQ_QKV
#define CVQ_QKV 4
#endif
#ifndef CVQ_MOE
#define CVQ_MOE 2
#endif
#ifndef PH_MASK
#define PH_MASK 0xFFFF
#endif
#define IN(k) (lo <= (k) && (k) < hi)
#define HAS(b) (((PH_MASK) >> (b)) & 1)
#define PHASE_ENTER() do { int _t = F.tid; asm volatile("" : "+v"(_t)); F.tid = _t; F.lane = _t & 63; F.wave = __builtin_amdgcn_readfirstlane(_t >> 6); unsigned char* _w = F.ws; asm volatile("" : "+s"(_w)); F.ws = _w; int _g = F.G; asm volatile("" : "+s"(_g)); F.G = _g; } while (0)
    unsigned long long t_acc = 0ull, t_beg = 0ull, g_ticks = 0ull, g_cyc = 0ull;
#define TBEG(kind) do { if (TIME_KIND == (kind)) t_beg = __builtin_amdgcn_s_memrealtime(); } while (0)
#define TEND(kind) do { if (TIME_KIND == (kind)) t_acc += __builtin_amdgcn_s_memrealtime() - t_beg; } while (0)
#define SEAM(k) do { if ((k) + 1 < hi) xcd_barrier(bar); } while (0)
#define SEAM_L(k) do { if ((k) + 1 < hi) { if (F.loc) xcc_local_barrier((unsigned*)(F.ctl + CW_LB + 64 * F.xcc), 32u, (unsigned*)(F.ctl + CW_TMO)); else xcd_barrier(bar); } } while (0)
    const LAS int* toktab = (const LAS int*)(F.lds + LDS_TOK);
    if (HAS(0) && IN(0)) { TBEG(0); p0_phase(F); SEAM(0); TEND(0); }
    for (int i = 0; i < DEPTH; ++i) {
        const int pb = 1 + 7 * i, j = i >> 1; const bool conv = (i & 1) != 0;
        const float* modl = WSP(const float, WS_MOD) + (size_t)i * NBATCH * (6 * D);
        if (IN(pb)) { PHASE_ENTER(); TBEG(1); if (i == 0) { if (HAS(1)) row_phase<0>(F, 0); } else { TBEG(7); if (HAS(2)) row_phase<1>(F, i); TEND(7); } SEAM_L(pb); TEND(1); }
        if (IN(pb + 1)) { PHASE_ENTER(); TBEG(2);
            if (!conv) { if (HAS(3)) { Gemm g{WSP(const bf16_t, WS_H), WSP(const bf16_t, WS_WQKV) + (size_t)j * 1536 * D, D, 0}; DenseOrder S; S.init(1536, F.G, F.c);
                EpiBias16 E{WSP(bf16_t, WS_QKV), 1536, F.in[I_ABQKV] + j * 1536}; gemm_phase<EpiBias16, DenseOrder, false>(F.lds, g, S, E, toktab, F.tid, 40, t_acc, g_ticks, g_cyc);
                if (CV_OVERLAP && (long)F.c + F.G >= 384) cv_run(F, i + 1, CVQ_QKV); } }
            else if (HAS(4)) { Gemm g{WSP(const bf16_t, WS_H), WSP(const bf16_t, WS_CWIN) + (size_t)j * 2048 * D, D, 0}; DenseOrder S; S.init(2048, F.G, F.c);
                EpiPair<0> E{WSP(void, WS_U), F.in[I_CBIN] + j * 2048, 0}; gemm_phase<EpiPair<0>, DenseOrder, false>(F.lds, g, S, E, toktab, F.tid, 50, t_acc, g_ticks, g_cyc); }
            SEAM_L(pb + 1); TEND(2); }
        if (IN(pb + 2)) { PHASE_ENTER(); TBEG(3); if (!conv) { TBEG(6); if (HAS(5)) attn_phase(F, j); TEND(6); } else { if (HAS(6)) dwconv_phase(F, j, t_acc); TBEG(17); } SEAM_L(pb + 2); if (conv) TEND(17); TEND(3); }
        if (IN(pb + 3)) { PHASE_ENTER(); TBEG(2); if (HAS(7)) {
            Gemm g{WSP(const bf16_t, WS_AO), (conv ? WSP(const bf16_t, WS_CWOUT) : WSP(const bf16_t, WS_WO)) + (size_t)j * D * D, D, 0}; DenseOrder S; S.init(1024, F.G, F.c);
            const float* bias2 = (conv ? F.in[I_CBOUT] : F.in[I_ABO]) + j * D;
            if (i == 0) { EpiResid<true> E{F.in[I_X], WSP(bf16_t, WS_X), bias2, modl + 2 * D}; gemm_phase<EpiResid<true>, DenseOrder, false>(F.lds, g, S, E, toktab, F.tid, 60, t_acc, g_ticks, g_cyc); }
            else { EpiResid<false> E{WSP(const bf16_t, WS_X), WSP(bf16_t, WS_X), bias2, modl + 2 * D}; gemm_phase<EpiResid<false>, DenseOrder, false>(F.lds, g, S, E, toktab, F.tid, 60, t_acc, g_ticks, g_cyc); } }
            SEAM_L(pb + 3); TEND(2); }
        if (IN(pb + 4)) { PHASE_ENTER(); TBEG(1); if (CV_OVERLAP && i > 0) cv_run(F, i, 1 << 30); TBEG(8); if (HAS(8)) row_phase<2>(F, i); TEND(8); SEAM(pb + 4); TEND(1); }
        if (IN(pb + 5)) { PHASE_ENTER(); TBEG(4); if (HAS(9)) {
            const int tt = build_exp_tables(F, i);
            Gemm g{WSP(const bf16_t, WS_H), (const bf16_t*)(WSP(const unsigned char, WS_MWIN) + (size_t)i * NE * 2048 * D), D / 2, (size_t)2048 * D / 2};
            EpiPair<1> E{WSP(void, WS_ACT), F.in[I_MBIN] + (size_t)i * NE * 2048, 2048};
            for (int ub = 0;; ub += 9) { const int nn = moe_build_units<true>(F, i, 8, tt, ub); const int n = nn >> 8, nv = nn & 255; if (n == 0) break;
                TableOrder S{(const LAS int*)(F.lds + LDS_UT), nv}; gemm_phase<EpiPair<1>, TableOrder, true, true>(F.lds, g, S, E, toktab, F.tid, 20, t_acc, g_ticks, g_cyc); wg_barrier();
                if (n < 9) { if (CV_OVERLAP && ub + nv < (((tt + 3) / 4) + 7) / 8) cv_run(F, i + 1, CVQ_MOE); break; } } }
            SEAM(pb + 5); TEND(4); }
        if (IN(pb + 6)) { PHASE_ENTER(); TBEG(5); if (HAS(10)) {
            const int tt = build_exp_tables(F, i);
            Gemm g{WSP(const bf16_t, WS_ACT), (const bf16_t*)(WSP(const unsigned char, WS_MWOUT) + (size_t)i * NE * D * D), D / 2, (size_t)D * D / 2};
            EpiMoeOut E{WSP(bf16_t, WS_YS), F.in[I_MBOUT] + (size_t)i * NE * D, WSP(const float, WS_GLIST), (const LAS int*)(F.lds + LDS_EXP + 256)};
            for (int ub = 0;; ub += 9) { const int nn = moe_build_units<false>(F, i, 4, tt, ub); const int n = nn >> 8, nv = nn & 255; if (n == 0) break;
                TableOrder S{(const LAS int*)(F.lds + LDS_UT), nv}; gemm_phase<EpiMoeOut, TableOrder, false, true>(F.lds, g, S, E, toktab, F.tid, 30, t_acc, g_ticks, g_cyc); wg_barrier();
                if (n < 9) { if (CV_OVERLAP && ub + nv < (((tt + 7) / 8) + 7) / 8) cv_run(F, i + 1, CVQ_MOE); break; } } }
            SEAM(pb + 6); TEND(5); }
    }
    if (HAS(11) && IN(29)) { PHASE_ENTER(); TBEG(1); row_phase<5>(F, DEPTH); TEND(1); }
    if (TIME_KIND >= 20 && (TIME_KIND % 10) == 5 && g_ticks > 0) t_acc = (g_cyc * 1000ull) / g_ticks;
    if (TIME_KIND >= 0 && blockIdx.x == 0) { const unsigned long long t0 = __builtin_amdgcn_s_memrealtime(); while (__builtin_amdgcn_s_memrealtime() - t0 < t_acc) __builtin_amdgcn_s_sleep(8); }
#undef IN
#undef SEAM
}

inline void launch_range(void* const* d_in, void* d_out, void* d_ws, int grid, int lo, int hi, hipStream_t stream) {
    Args a{}; for (int i = 0; i < 27; ++i) a.in[i] = (const float*)d_in[i];
    a.out = (float*)d_out; a.ws = (unsigned char*)d_ws; a.ph_lo = lo; a.ph_hi = hi;
    hipLaunchKernelGGL(mega, dim3(grid), dim3(NTHR), LDS_BYTES, stream, a);
}
inline int setup_grid() {
    static int grid = 0;
    if (grid == 0) {
        int dev = 0, cus = 0;
        if (hipGetDevice(&dev) != hipSuccess || hipDeviceGetAttribute(&cus, hipDeviceAttributeMultiprocessorCount, dev) != hipSuccess) { grid = -1; return grid; }
        if (hipFuncSetAttribute((const void*)mega, hipFuncAttributeMaxDynamicSharedMemorySize, LDS_BYTES) != hipSuccess) { grid = -1; return grid; }
        int per_cu = 0; (void)hipOccupancyMaxActiveBlocksPerMultiprocessor(&per_cu, (const void*)mega, NTHR, LDS_BYTES); (void)hipGetLastError();
        if (per_cu < 1) fprintf(stderr, "kernel_launch: occupancy query reports %d blocks per CU\n", per_cu);
        grid = cus;
    }
    return grid;
}
}
#ifndef FAST_LAUNCH_MODE
#define FAST_LAUNCH_MODE 1
#endif
extern "C" void kernel_launch(void* const* d_in, const int* in_sizes, int n_in, void* d_out, int out_size, void* d_ws, size_t ws_size, hipStream_t stream) {
    if (n_in != 27 || out_size != fk::T * fk::D || ws_size < fk::WS_END) { fprintf(stderr, "kernel_launch: unexpected shapes (n_in %d out %d ws %zu)\n", n_in, out_size, ws_size); return; }
    const int grid = fk::setup_grid(); if (grid <= 0) return;
    (void)hipMemsetAsync((char*)d_ws + fk::WS_CTL, 0, fk::CTL_ZERO_BYTES, stream);
#if FAST_LAUNCH_MODE == 1
    fk::launch_range(d_in, d_out, d_ws, grid, 0, fk::N_PHASES, stream);
#else
    for (int k = 0; k < fk::N_PHASES; ++k) fk::launch_range(d_in, d_out, d_ws, grid, k, k + 1, stream);
#endif
}
```

```cpp
#include <hip/hip_runtime.h>
#include <cstdio>
#include <cstdint>
namespace fk {
#define LAS __attribute__((address_space(3)))
#define GAS __attribute__((address_space(1)))
typedef unsigned short bf16_t;
typedef short bf16x8 __attribute__((ext_vector_type(8)));
typedef short s16x4 __attribute__((ext_vector_type(4)));
typedef float f32x4 __attribute__((ext_vector_type(4)));
typedef float f32x2 __attribute__((ext_vector_type(2)));
typedef float f32x16 __attribute__((ext_vector_type(16)));
typedef float f32x8 __attribute__((ext_vector_type(8)));
typedef unsigned u32x4 __attribute__((ext_vector_type(4)));
typedef unsigned u32x2 __attribute__((ext_vector_type(2)));
typedef __bf16 bf16x2_t __attribute__((ext_vector_type(2)));
typedef int v4i __attribute__((ext_vector_type(4)));
typedef int v8i __attribute__((ext_vector_type(8)));
typedef GAS unsigned gu32;
#define RLX_AGENT __ATOMIC_RELAXED, __HIP_MEMORY_SCOPE_AGENT
#define LDS_WAIT() asm volatile("s_waitcnt lgkmcnt(0)" ::: "memory")
#define VM_WAIT() asm volatile("s_waitcnt vmcnt(0)" ::: "memory")

constexpr int T = 16384, D = 1024, SEQ = 2048, NBATCH = 8, NE = 32, DEPTH = 4;
constexpr int NWAVES = 8, NTHR = 512;
constexpr int SLOTCAP = T * 4 + NE * 256;
constexpr float LOG2E = 1.4426950408889634f;

__device__ __forceinline__ unsigned cvt_pk(float lo, float hi) { f32x2 v = {lo, hi}; bf16x2_t b = __builtin_convertvector(v, bf16x2_t); return __builtin_bit_cast(unsigned, b); }
__device__ __forceinline__ float bf_lo(unsigned w) { return __uint_as_float(w << 16); }
__device__ __forceinline__ float bf_hi(unsigned w) { return __uint_as_float(w & 0xffff0000u); }
__device__ __forceinline__ unsigned cvt_pk4_fp8(float a, float b, float c, float d) {
    a = __builtin_amdgcn_fmed3f(a, -448.f, 448.f); b = __builtin_amdgcn_fmed3f(b, -448.f, 448.f); c = __builtin_amdgcn_fmed3f(c, -448.f, 448.f); d = __builtin_amdgcn_fmed3f(d, -448.f, 448.f);
    int w = 0; w = __builtin_amdgcn_cvt_pk_fp8_f32(a, b, w, false); w = __builtin_amdgcn_cvt_pk_fp8_f32(c, d, w, true); return (unsigned)w; }
__device__ __forceinline__ unsigned cvt_pk4_fp8_nc(float a, float b, float c, float d) { int w = 0; w = __builtin_amdgcn_cvt_pk_fp8_f32(a, b, w, false); w = __builtin_amdgcn_cvt_pk_fp8_f32(c, d, w, true); return (unsigned)w; }
#ifndef F8_QKV
#define F8_QKV 1
#endif
#ifndef F8_WO
#define F8_WO 1
#endif
constexpr float F8_SH = 8.0f, F8_SW = 64.0f, F8_SACT = 4.0f, F8_SY = 16.0f;
__device__ __forceinline__ f32x4 fp8x4_to_f32(unsigned w) { const f32x2 lo = __builtin_amdgcn_cvt_pk_f32_fp8((int)w, false), hi = __builtin_amdgcn_cvt_pk_f32_fp8((int)w, true); return (f32x4){lo.x, lo.y, hi.x, hi.y}; }
__device__ __forceinline__ float sigmoid_f(float v) { return __builtin_amdgcn_rcpf(1.0f + __builtin_amdgcn_exp2f(-LOG2E * v)); }

constexpr size_t MiB = (size_t)1 << 20;
constexpr size_t WS_CTL = 0, CTL_ZERO_BYTES = MiB / 8;
constexpr size_t WS_MOD = 1 * MiB;
constexpr size_t WS_WQKV = 2 * MiB;
constexpr size_t WS_WO = 8 * MiB;
constexpr size_t WS_CWIN = 12 * MiB;
constexpr size_t WS_CWOUT = 20 * MiB;
constexpr size_t WS_MWIN = 24 * MiB;
constexpr size_t WS_MWOUT = WS_MWIN + 512 * MiB;
constexpr size_t WS_X = WS_MWOUT + 256 * MiB;
constexpr size_t WS_H = WS_X + 64 * MiB;
constexpr size_t WS_QKV = WS_H + 32 * MiB;
constexpr size_t WS_AO = WS_QKV + 48 * MiB;
constexpr size_t WS_U = WS_AO + 32 * MiB;
constexpr size_t WS_LIST = WS_U + 32 * MiB;
constexpr size_t WS_GLIST = WS_LIST + 2 * MiB;
constexpr size_t WS_TK = WS_GLIST + 2 * MiB;
constexpr size_t WS_ACT = WS_TK + 1 * MiB;
constexpr size_t WS_YS = WS_ACT + 144 * MiB;
constexpr size_t WS_END = WS_YS + 144 * MiB;
constexpr int CW_TMO = 0, CW_P0Q = 64, CW_XC = 1024, CW_LB = 2048, CW_BAR = 4096, CW_CNT = 16384;
#define XCD_BAR_WORDS 3456

constexpr int RING_BYTES = 131072;
constexpr int LDS_TOK = RING_BYTES;
constexpr int LDS_UT = LDS_TOK + 9216;
constexpr int LDS_EXP = LDS_UT + 256;
constexpr int LDS_BYTES = 163840;
constexpr int LDS_MISC = LDS_BYTES - 128;
constexpr int LDS_EPI = LDS_EXP + 768;
static_assert(LDS_EXP + 512 <= LDS_EPI && LDS_EPI + 9 * 2048 <= LDS_MISC && (LDS_EPI % 16) == 0, "LDS map");

#define XB_TMO      128
#define XB_XCNT(j)  (256  + 64 * (j))
#define XB_XSUB(j)  (1280 + 64 * (j))
#define XB_XGEN(j)  (2304 + 64 * (j))
#define XB_TOP      3328
#define XB_TOPGEN   3392
#define XB_SPIN_CAP (1u << 18)
__device__ __forceinline__ unsigned xb_ld(unsigned* p)              { return __hip_atomic_load(p, __ATOMIC_RELAXED, __HIP_MEMORY_SCOPE_AGENT); }
__device__ __forceinline__ unsigned xb_add(unsigned* p, unsigned v) { return __hip_atomic_fetch_add(p, v, __ATOMIC_RELAXED, __HIP_MEMORY_SCOPE_AGENT); }
__device__ __forceinline__ unsigned xb_xcc_id() { return (unsigned)__builtin_amdgcn_s_getreg((3 << 11) | 20) & 0xFu; }
#define XB_SPIN(cond, bar) do { unsigned _sp = 0; while (cond) { __builtin_amdgcn_s_sleep(1); \
    if ((++_sp & 255u) == 0u) { if (xb_ld(&(bar)[XB_TMO])) break; if (_sp > XB_SPIN_CAP) { atomicAdd(&(bar)[XB_TMO], 1u); break; } } } } while (0)
struct XcdBarrier { unsigned* bar; unsigned x; volatile LAS unsigned* st; };
__device__ __forceinline__ XcdBarrier xcd_barrier_post(unsigned* bar, volatile LAS unsigned* st) {
    XcdBarrier b; b.bar = bar; b.x = xb_xcc_id(); b.st = st;
    if (threadIdx.x == 0) (void)xb_add(&bar[XB_XCNT(b.x)], 1u);
    return b;
}
__device__ __forceinline__ void xcd_barrier_complete(unsigned* bar, unsigned x, unsigned& nloc, unsigned& nx) {
    const unsigned G = gridDim.x * gridDim.y * gridDim.z;
    unsigned sum, cnt, mine, sp = 0u;
    for (;;) {
        sum = 0u; cnt = 0u; mine = 0u;
#pragma unroll
        for (unsigned j = 0; j < 16; ++j) { const unsigned c = xb_ld(&bar[XB_XCNT(j)]); sum += c; cnt += (c > 0u) ? 1u : 0u; mine = (j == x) ? c : mine; }
        if (sum == G) break;
        __builtin_amdgcn_s_sleep(1);
        if ((++sp & 255u) == 0u) { if (xb_ld(&bar[XB_TMO])) break; if (sp > XB_SPIN_CAP) { atomicAdd(&bar[XB_TMO], 1u); break; } }
    }
    nloc = mine > 0u ? mine : 1u; nx = cnt > 0u ? cnt : 1u;
}
__device__ __forceinline__ void xcd_barrier(const XcdBarrier& b) {
    asm volatile("s_waitcnt vmcnt(0)" ::: "memory");
    __syncthreads();
    if (threadIdx.x == 0) {
        unsigned* bar = b.bar;
        __builtin_amdgcn_s_waitcnt(0);
        unsigned nloc = b.st[0], nx = b.st[1];
        if (nloc == 0u) { xcd_barrier_complete(bar, b.x, nloc, nx); b.st[0] = nloc; b.st[1] = nx; }
        const unsigned old = xb_add(&bar[XB_XSUB(b.x)], 1u);
        const unsigned gen = old / nloc;
        if (old + 1u == (gen + 1u) * nloc) {
            __builtin_amdgcn_fence(__ATOMIC_RELEASE, "agent");
            asm volatile("s_waitcnt vmcnt(0)" ::: "memory");
            const unsigned og = xb_add(&bar[XB_TOP], 1u);
            const unsigned tg = og / nx;
            if (og + 1u == (tg + 1u) * nx) xb_add(&bar[XB_TOPGEN], 1u);
            else XB_SPIN(xb_ld(&bar[XB_TOPGEN]) == tg, bar);
            __builtin_amdgcn_fence(__ATOMIC_ACQUIRE, "agent");
            xb_add(&bar[XB_XGEN(b.x)], 1u);
            asm volatile("s_waitcnt vmcnt(0)" ::: "memory");
        } else {
            XB_SPIN(xb_ld(&bar[XB_XGEN(b.x)]) == gen, bar);
            __builtin_amdgcn_fence(__ATOMIC_ACQUIRE, "agent");
            asm volatile("s_waitcnt vmcnt(0)" ::: "memory");
        }
    }
    __syncthreads();
}

__device__ __forceinline__ void xcc_local_barrier(unsigned* cnt, unsigned nloc, unsigned* tmo) {
    asm volatile("s_waitcnt vmcnt(0)" ::: "memory");
    __syncthreads();
    if (threadIdx.x == 0) {
        const unsigned old = __hip_atomic_fetch_add(cnt, 1u, __ATOMIC_RELAXED, __HIP_MEMORY_SCOPE_AGENT), target = (old / nloc + 1u) * nloc; unsigned sp = 0u;
        while (__hip_atomic_load(cnt, __ATOMIC_RELAXED, __HIP_MEMORY_SCOPE_AGENT) < target) { __builtin_amdgcn_s_sleep(1);
            if ((++sp & 255u) == 0u) { if (__hip_atomic_load(tmo, __ATOMIC_RELAXED, __HIP_MEMORY_SCOPE_AGENT)) break; if (sp > XB_SPIN_CAP) { atomicAdd(tmo, 1u); break; } } }
        __builtin_amdgcn_fence(__ATOMIC_ACQUIRE, "agent");
        asm volatile("s_waitcnt vmcnt(0)" ::: "memory");
    }
    __syncthreads();
}

constexpr int BM = 256, BK = 64, HALF = 128, HTB = HALF * BK * 2, NXCD = 8, WGM = 8;
__host__ __device__ __forceinline__ int lds_byte(int r, int c) { const int st = (r >> 4) * 2 + (c >> 5), rr = r & 15, cc = c & 31, ob = rr * 64 + cc * 2; return st * 1024 + (ob ^ (((ob >> 9) & 1) << 5)); }
__host__ __device__ __forceinline__ void stage_rc(int b, int& R, int& C) { const int st = b / 1024, sb = b % 1024, swz = sb ^ (((sb >> 9) & 1) << 5); R = (st >> 1) * 16 + swz / 64; C = (st & 1) * 32 + (swz % 64) / 2; }
__host__ __device__ __forceinline__ int perm32(int rho) { const int n = rho >> 4, i = rho & 15; return 8 * (i >> 2) + 4 * n + (i & 3); }

struct Unit { int am, om, e, pn, ix; };
struct Gemm { const bf16_t* A; const bf16_t* Bt; int K; size_t b_estride; };

struct DenseOrder {
    int nM, nN, nwg, G, c;
    __device__ void init(int N, int G_, int c_) { nM = T / BM; nN = N / BM; nwg = nM * nN; G = G_; c = c_; }
    __device__ __forceinline__ bool next(int i, Unit& u) const {
        const long L = (long)i * G + c; if (L >= nwg) return false;
        int wgid = (int)L; { const int q = nwg / NXCD, r = nwg % NXCD, xcd = wgid % NXCD, off = wgid / NXCD; wgid = (xcd < r ? xcd * (q + 1) : r * (q + 1) + (xcd - r) * q) + off; }
        const int nig = WGM * nN, gid = wgid / nig, fm = gid * WGM, gsz = (nM - fm) < WGM ? (nM - fm) : WGM;
        const int pm = fm + ((wgid % nig) % gsz); u.pn = (wgid % nig) / gsz; u.am = pm * BM; u.om = pm * BM; u.e = 0; u.ix = 0; return true;
    }
};
struct TableOrder {
    const LAS int* ut; int n;
    __device__ __forceinline__ bool next(int i, Unit& u) const {
        if (i >= n) return false;
        u.am = __builtin_amdgcn_readfirstlane(ut[4 * i]); u.om = __builtin_amdgcn_readfirstlane(ut[4 * i + 1]); u.e = __builtin_amdgcn_readfirstlane(ut[4 * i + 2]); u.pn = __builtin_amdgcn_readfirstlane(ut[4 * i + 3]); u.ix = i; return true;
    }
};

template <class Epi, class Sched, bool GATHER, bool F8 = false>
__device__ __forceinline__ void gemm_phase(LAS unsigned char* lds, const Gemm g, const Sched& S, const Epi& E, const LAS int* toktab, const int tid, const int tkb, unsigned long long& t_acc, unsigned long long& g_ticks, unsigned long long& g_cyc) {
    unsigned long long t_b = 0ull, c_b = 0ull; static_assert(true, "");
#ifndef TIME_KIND
#define TIME_KIND (-1)
#endif
#define GT_BEG(k) do { if (TIME_KIND >= 20 && TIME_KIND == tkb + (k)) t_b = __builtin_amdgcn_s_memrealtime(); if ((k) == 0 && TIME_KIND == tkb + 5) { t_b = __builtin_amdgcn_s_memrealtime(); c_b = __builtin_readcyclecounter(); } } while (0)
#define GT_END(k) do { if (TIME_KIND >= 20 && TIME_KIND == tkb + (k)) t_acc += __builtin_amdgcn_s_memrealtime() - t_b; if ((k) == 0 && TIME_KIND == tkb + 5) { g_ticks += __builtin_amdgcn_s_memrealtime() - t_b; g_cyc += __builtin_readcyclecounter() - c_b; } } while (0)
    const int wid = __builtin_amdgcn_readfirstlane(tid >> 6), lane = tid & 63, wr = wid >> 2, wc = wid & 3, fr = lane & 15, fq = lane >> 4;
    const int K = g.K, nt = K / BK;
    int Rr[2], Cc[2]; unsigned voffB[2];
#pragma unroll
    for (int i = 0; i < 2; ++i) { int R, C; stage_rc(tid * 16 + i * 8192, R, C); Rr[i] = R; Cc[i] = C; const int Rb = Epi::PERM ? ((R & ~31) + perm32(R & 31)) : R; voffB[i] = (unsigned)(Rb * K + C) * 2u; }
    const unsigned ldsw = (unsigned)wid * 1024u;
    const int aoff = lds_byte(wr * 64 + fr, fq * 8), boff = lds_byte(wc * 32 + fr, fq * 8);
#define PG8_SA(b, h) (((b) * 2 + (h)) * HTB)
#define PG8_SB(b, h) ((4 + (b) * 2 + (h)) * HTB)
#ifndef USE_BUFFER_LDS
#define USE_BUFFER_LDS 1
#endif
#if USE_BUFFER_LDS
#define PG8_STAGE(bufoff, rsrc, soff, voff) do { _Pragma("unroll") for (int _i = 0; _i < 2; ++_i) \
        __builtin_amdgcn_raw_ptr_buffer_load_lds(rsrc, (LAS unsigned*)(lds + (bufoff) + ldsw + _i * 8192), 16, (int)(voff)[_i], (int)(soff), 0, 0); } while (0)
#else
#define PG8_STAGE(bufoff, rsrc, soff, voff) do { _Pragma("unroll") for (int _i = 0; _i < 2; ++_i) \
        __builtin_amdgcn_global_load_lds((const unsigned*)((const char*)(rsrc##_base) + (size_t)(soff) + (voff)[_i]), (LAS unsigned*)(lds + (bufoff) + ldsw + _i * 8192), 16, 0, 0); } while (0)
#endif
#define CAT8(l, h) __builtin_shufflevector((l), (h), 0, 1, 2, 3, 4, 5, 6, 7)
#define LO4(x) __builtin_shufflevector((x), (x), 0, 1, 2, 3)
#define HI4(x) __builtin_shufflevector((x), (x), 4, 5, 6, 7)
#define PG8_LDA(dst, b, h) do { _Pragma("unroll") for (int m = 0; m < 4; ++m) dst[m] = CAT8(*(const LAS v4i*)(lds + PG8_SA(b, h) + aoff + m * 2048), *(const LAS v4i*)(lds + PG8_SA(b, h) + aoff + m * 2048 + 1024)); } while (0)
#define PG8_LDB(dst, b, h) do { _Pragma("unroll") for (int n = 0; n < 2; ++n) dst[n] = CAT8(*(const LAS v4i*)(lds + PG8_SB(b, h) + boff + n * 2048), *(const LAS v4i*)(lds + PG8_SB(b, h) + boff + n * 2048 + 1024)); } while (0)
#define PG8_MMA(ai, bj, At, Bt) do { __builtin_amdgcn_s_setprio(1); \
        if constexpr (F8) { _Pragma("unroll") for (int m = 0; m < 4; ++m) { f32x4 _l = LO4(acc8[ai][bj][m]), _h = HI4(acc8[ai][bj][m]); \
            _l = __builtin_amdgcn_mfma_scale_f32_16x16x128_f8f6f4(Bt[0], At[m], _l, 0, 0, 0, 0x7f7f7f7f, 0, 0x7f7f7f7f); \
            _h = __builtin_amdgcn_mfma_scale_f32_16x16x128_f8f6f4(Bt[1], At[m], _h, 0, 0, 0, 0x7f7f7f7f, 0, 0x7f7f7f7f); acc8[ai][bj][m] = CAT8(_l, _h); } \
              \
            asm volatile("" : "+v"(acc8[ai][bj][0]), "+v"(acc8[ai][bj][1]), "+v"(acc8[ai][bj][2]), "+v"(acc8[ai][bj][3])); } \
        else { _Pragma("unroll") for (int m = 0; m < 4; ++m) { f32x4 _l = LO4(acc8[ai][bj][m]), _h = HI4(acc8[ai][bj][m]); \
            _l = __builtin_amdgcn_mfma_f32_16x16x32_bf16(__builtin_bit_cast(bf16x8, LO4(Bt[0])), __builtin_bit_cast(bf16x8, LO4(At[m])), _l, 0, 0, 0); \
            _l = __builtin_amdgcn_mfma_f32_16x16x32_bf16(__builtin_bit_cast(bf16x8, HI4(Bt[0])), __builtin_bit_cast(bf16x8, HI4(At[m])), _l, 0, 0, 0); \
            _h = __builtin_amdgcn_mfma_f32_16x16x32_bf16(__builtin_bit_cast(bf16x8, LO4(Bt[1])), __builtin_bit_cast(bf16x8, LO4(At[m])), _h, 0, 0, 0); \
            _h = __builtin_amdgcn_mfma_f32_16x16x32_bf16(__builtin_bit_cast(bf16x8, HI4(Bt[1])), __builtin_bit_cast(bf16x8, HI4(At[m])), _h, 0, 0, 0); acc8[ai][bj][m] = CAT8(_l, _h); } } \
        __builtin_amdgcn_s_setprio(0); } while (0)
#define PG8_WAIT_V(n) asm volatile("s_waitcnt vmcnt(" #n ")" ::: "memory")
#define PG8_WAIT_L(n) asm volatile("s_waitcnt lgkmcnt(" #n ")" ::: "memory")
#define PG8_BAR __builtin_amdgcn_s_barrier()
#define PG8_SCHED __builtin_amdgcn_sched_barrier(0)
#define A_OFFS(dst, u) do { _Pragma("unroll") for (int _h = 0; _h < 2; ++_h) _Pragma("unroll") for (int _i = 0; _i < 2; ++_i) { \
        const int _row = GATHER ? toktab[(u).am + _h * HALF + Rr[_i]] : ((u).am + _h * HALF + Rr[_i]); dst[_h][_i] = (unsigned)(_row * K + Cc[_i]) * 2u; } } while (0)
    Unit cur, nxt; int ui = 0;
    if (!S.next(0, cur)) return;
    f32x8 acc8[2][2][4];
#pragma unroll
    for (int a = 0; a < 2; ++a)
#pragma unroll
        for (int b = 0; b < 2; ++b)
#pragma unroll
            for (int m = 0; m < 4; ++m) acc8[a][b][m] = (f32x8){0.f, 0.f, 0.f, 0.f, 0.f, 0.f, 0.f, 0.f};
    v8i At[4], B0[2], B1[2];
    unsigned ao[2][2]; A_OFFS(ao, cur);
    const __amdgpu_buffer_rsrc_t rA = __builtin_amdgcn_make_buffer_rsrc((void*)g.A, 0, 0x7fffffff, 0x00020000), rB = __builtin_amdgcn_make_buffer_rsrc((void*)g.Bt, 0, 0x7fffffff, 0x00020000);
    const char* const rA_base = (const char*)g.A; const char* const rB_base = (const char*)g.Bt; (void)rA_base; (void)rB_base;
    const unsigned kstep = (unsigned)(BK * 2), hstep = (unsigned)HALF * K * 2;
    unsigned cB = (unsigned)(((size_t)cur.e * g.b_estride + (size_t)cur.pn * BM * K) * 2);
    PG8_STAGE(PG8_SB(0, 0), rB, cB, voffB); PG8_STAGE(PG8_SB(0, 1), rB, cB + hstep, voffB); PG8_STAGE(PG8_SA(0, 0), rA, 0u, ao[0]); PG8_STAGE(PG8_SA(0, 1), rA, 0u, ao[1]);
    if (wr == 1) PG8_BAR;
    PG8_WAIT_V(2); PG8_BAR;
    PG8_STAGE(PG8_SB(1, 0), rB, cB + kstep, voffB); PG8_STAGE(PG8_SA(1, 0), rA, kstep, ao[0]); PG8_STAGE(PG8_SB(1, 1), rB, cB + hstep + kstep, voffB);
    PG8_WAIT_V(6); PG8_BAR;
    for (;;) {
        const bool has_next = S.next(ui + 1, nxt);
        const unsigned nB = has_next ? (unsigned)(((size_t)nxt.e * g.b_estride + (size_t)nxt.pn * BM * K) * 2) : cB;
        GT_BEG(0);
#pragma unroll 1
        for (int t = 0; t < nt; t += 2) {
            const bool last = (t == nt - 2);
            const unsigned a1 = (unsigned)(t + 1) * kstep;
            const unsigned a2 = last ? 0u : (unsigned)(t + 2) * kstep, b2 = last ? nB : cB + (unsigned)(t + 2) * kstep;
            const unsigned a3 = a2 + kstep, b3 = b2 + kstep;
            unsigned a2o[2][2];
            if (last && has_next) { A_OFFS(a2o, nxt); }
            else {
#pragma unroll
                for (int _h = 0; _h < 2; ++_h)
#pragma unroll
                    for (int _i = 0; _i < 2; ++_i) a2o[_h][_i] = ao[_h][_i]; }
            PG8_LDB(B0, 0, 0); PG8_LDB(B1, 0, 1); PG8_SCHED; PG8_LDA(At, 0, 0); PG8_STAGE(PG8_SA(1, 1), rA, a1, ao[1]);
            PG8_WAIT_V(8); PG8_WAIT_L(0); PG8_BAR; PG8_MMA(0, 0, At, B0); PG8_MMA(0, 1, At, B1); PG8_BAR; PG8_SCHED;
            PG8_LDA(At, 0, 1); PG8_STAGE(PG8_SB(0, 0), rB, b2, voffB); PG8_STAGE(PG8_SB(0, 1), rB, b2 + hstep, voffB); PG8_STAGE(PG8_SA(0, 0), rA, a2, a2o[0]);
            PG8_WAIT_V(8); PG8_WAIT_L(0); PG8_BAR; PG8_MMA(1, 0, At, B0); PG8_MMA(1, 1, At, B1); PG8_BAR; PG8_SCHED;
            PG8_LDB(B0, 1, 0); PG8_LDB(B1, 1, 1); PG8_SCHED; PG8_LDA(At, 1, 0); PG8_STAGE(PG8_SA(0, 1), rA, a2, a2o[1]);
            PG8_WAIT_V(8); PG8_WAIT_L(0); PG8_BAR; PG8_MMA(0, 0, At, B0); PG8_MMA(0, 1, At, B1); PG8_BAR; PG8_SCHED;
            PG8_LDA(At, 1, 1); PG8_STAGE(PG8_SB(1, 0), rB, b3, voffB); PG8_STAGE(PG8_SB(1, 1), rB, b3 + hstep, voffB); PG8_STAGE(PG8_SA(1, 0), rA, a3, a2o[0]);
            PG8_WAIT_V(8); PG8_WAIT_L(0); PG8_BAR; PG8_MMA(1, 0, At, B0); PG8_MMA(1, 1, At, B1); PG8_BAR; PG8_SCHED;
            if (last) {
#pragma unroll
                for (int _h = 0; _h < 2; ++_h)
#pragma unroll
                    for (int _i = 0; _i < 2; ++_i) ao[_h][_i] = a2o[_h][_i]; }
        }
        GT_END(0); GT_BEG(1);
        if (wr == 0) PG8_BAR;
        { f32x4 acc[2][2][4][2];
#pragma unroll
          for (int a = 0; a < 2; ++a)
#pragma unroll
              for (int b = 0; b < 2; ++b)
#pragma unroll
                  for (int m = 0; m < 4; ++m) { acc[a][b][m][0] = LO4(acc8[a][b][m]); acc[a][b][m][1] = HI4(acc8[a][b][m]); }
          E(acc, cur, wr, wc, fr, fq); }
        GT_END(1);
        if (!has_next) break;
#pragma unroll
        for (int a = 0; a < 2; ++a)
#pragma unroll
            for (int b = 0; b < 2; ++b)
#pragma unroll
                for (int m = 0; m < 4; ++m) acc8[a][b][m] = (f32x8){0.f, 0.f, 0.f, 0.f, 0.f, 0.f, 0.f, 0.f};
        cur = nxt; cB = nB; ++ui;
        if (wr == 1) PG8_BAR;
    }
    PG8_WAIT_V(0);
    PG8_BAR;
#undef PG8_SA
#undef PG8_SB
#undef PG8_STAGE
#undef PG8_LDA
#undef PG8_LDB
#undef PG8_MMA
#undef PG8_WAIT_V
#undef PG8_WAIT_L
#undef PG8_BAR
#undef PG8_SCHED
#undef A_OFFS
#undef GT_BEG
#undef GT_END
#undef CAT8
#undef LO4
#undef HI4
}
template <bool F8IN> struct EpiBias16 {
    static constexpr bool PERM = true;
    bf16_t* O; int ldc; const float* bias;
    __device__ __forceinline__ void operator()(const f32x4 (&acc)[2][2][4][2], const Unit& u, int wr, int wc, int fr, int fq) const {
        const int row0 = u.om + wr * 64 + fr, col0 = u.pn * BM + wc * 32 + 8 * fq;
        f32x4 bv[2][2];
#pragma unroll
        for (int bj = 0; bj < 2; ++bj)
#pragma unroll
            for (int n = 0; n < 2; ++n) bv[bj][n] = *(const f32x4*)(bias + col0 + bj * HALF + 4 * n);
#pragma unroll
        for (int ai = 0; ai < 2; ++ai)
#pragma unroll
            for (int m = 0; m < 4; ++m) { bf16_t* rowp = O + (size_t)(row0 + ai * HALF + m * 16) * ldc + col0;
#pragma unroll
                for (int bj = 0; bj < 2; ++bj) { constexpr float ASC = F8IN ? 1.0f / (F8_SH * F8_SW) : 1.0f; const f32x4 v0 = acc[ai][bj][m][0] * ASC + bv[bj][0], v1 = acc[ai][bj][m][1] * ASC + bv[bj][1];
                    u32x4 w; w.x = cvt_pk(v0[0], v0[1]); w.y = cvt_pk(v0[2], v0[3]); w.z = cvt_pk(v1[0], v1[1]); w.w = cvt_pk(v1[2], v1[3]);
                    *(u32x4*)(rowp + bj * HALF) = w; } }
    }
};
template <bool XF32, bool F8IN> struct EpiResid {
    static constexpr bool PERM = true;
    const void* Xin; bf16_t* X; const float* bias; const float* gate;
    __device__ __forceinline__ void operator()(const f32x4 (&acc)[2][2][4][2], const Unit& u, int wr, int wc, int fr, int fq) const {
        const int row0 = u.om + wr * 64 + fr, col0 = u.pn * BM + wc * 32 + 8 * fq; const float* gb = gate + (size_t)(u.om / SEQ) * (6 * D);
        f32x4 bv[2][2], gv[2][2];
#pragma unroll
        for (int bj = 0; bj < 2; ++bj)
#pragma unroll
            for (int n = 0; n < 2; ++n) { bv[bj][n] = *(const f32x4*)(bias + col0 + bj * HALF + 4 * n); gv[bj][n] = *(const f32x4*)(gb + col0 + bj * HALF + 4 * n); }
#pragma unroll
        for (int ai = 0; ai < 2; ++ai)
#pragma unroll
            for (int m = 0; m < 4; ++m) { const size_t off = (size_t)(row0 + ai * HALF + m * 16) * D + col0;
#pragma unroll
                for (int bj = 0; bj < 2; ++bj) { f32x4 x0, x1;
                    if (XF32) { x0 = *(const f32x4*)((const float*)Xin + off + bj * HALF); x1 = *(const f32x4*)((const float*)Xin + off + bj * HALF + 4); }
                    else { const u32x4 xb = *(const u32x4*)((const bf16_t*)Xin + off + bj * HALF); x0 = (f32x4){bf_lo(xb.x), bf_hi(xb.x), bf_lo(xb.y), bf_hi(xb.y)}; x1 = (f32x4){bf_lo(xb.z), bf_hi(xb.z), bf_lo(xb.w), bf_hi(xb.w)}; }
                    constexpr float ASC = F8IN ? 1.0f / (F8_SH * F8_SW) : 1.0f;
                    const f32x4 v0 = x0 + gv[bj][0] * (acc[ai][bj][m][0] * ASC + bv[bj][0]), v1 = x1 + gv[bj][1] * (acc[ai][bj][m][1] * ASC + bv[bj][1]);
                    u32x4 w; w.x = cvt_pk(v0[0], v0[1]); w.y = cvt_pk(v0[2], v0[3]); w.z = cvt_pk(v1[0], v1[1]); w.w = cvt_pk(v1[2], v1[3]);
                    *(u32x4*)(X + off + bj * HALF) = w; }
                asm volatile("" ::: "memory"); }
    }
};
template <int MODE> struct EpiPair {
    static constexpr bool PERM = true;
    void* O; const float* bias; int b_estride; const LAS float* lb;
    __device__ __forceinline__ void operator()(const f32x4 (&acc)[2][2][4][2], const Unit& u, int wr, int wc, int fr, int fq) const {
        const int row0 = u.om + wr * 64 + fr, col0 = u.pn * HALF + wc * 32 + 8 * fq; const float* bb = bias + (size_t)u.e * b_estride;
        constexpr float ASC = 1.0f / (F8_SH * F8_SW);
        f32x4 bv[2][2];
#pragma unroll
        for (int bj = 0; bj < 2; ++bj)
#pragma unroll
            for (int n = 0; n < 2; ++n) bv[bj][n] = MODE == 1 ? *(const LAS f32x4*)(lb + u.ix * 512 + bj * HALF + wc * 32 + 8 * fq + 4 * n) : *(const f32x4*)(bb + bj * D + col0 + 4 * n);
#pragma unroll
        for (int ai = 0; ai < 2; ++ai)
#pragma unroll
            for (int m = 0; m < 4; ++m) { float r[8];
#pragma unroll
                for (int n = 0; n < 2; ++n) { const f32x4 a = acc[ai][0][m][n] * ASC + bv[0][n], g = acc[ai][1][m][n] * ASC + bv[1][n];
#pragma unroll
                    for (int jp = 0; jp < 2; ++jp) {
                        f32x2 av = (f32x2){a[2 * jp], a[2 * jp + 1]}, gv = (f32x2){g[2 * jp], g[2 * jp + 1]}, o;
                        if (MODE == 0) { const f32x2 x = gv * (-LOG2E); f32x2 e; e.x = __builtin_amdgcn_exp2f(x.x); e.y = __builtin_amdgcn_exp2f(x.y); const f32x2 d = e + 1.0f;
                            f32x2 rc; rc.x = __builtin_amdgcn_rcpf(d.x); rc.y = __builtin_amdgcn_rcpf(d.y); o = av * rc; }
                        else { f32x2 glu, lin; glu.x = fminf(av.x, 7.0f); glu.y = fminf(av.y, 7.0f); lin.x = __builtin_amdgcn_fmed3f(gv.x, -7.0f, 7.0f); lin.y = __builtin_amdgcn_fmed3f(gv.y, -7.0f, 7.0f);
                            const f32x2 x = glu * (-1.702f * LOG2E); f32x2 e; e.x = __builtin_amdgcn_exp2f(x.x); e.y = __builtin_amdgcn_exp2f(x.y); const f32x2 d = e + 1.0f;
                            f32x2 rc; rc.x = __builtin_amdgcn_rcpf(d.x); rc.y = __builtin_amdgcn_rcpf(d.y); o = (glu * rc) * (lin * F8_SACT + F8_SACT); }
                        r[4 * n + 2 * jp] = o.x; r[4 * n + 2 * jp + 1] = o.y; } }
                if (MODE == 0) { unsigned char* rowp = (unsigned char*)O + (size_t)(row0 + ai * HALF + m * 16) * D + col0;
                    u32x2 w; w.x = cvt_pk4_fp8(r[0] * F8_SH, r[1] * F8_SH, r[2] * F8_SH, r[3] * F8_SH); w.y = cvt_pk4_fp8(r[4] * F8_SH, r[5] * F8_SH, r[6] * F8_SH, r[7] * F8_SH); *(u32x2*)rowp = w; }
                else { unsigned char* rowp = (unsigned char*)O + (size_t)(row0 + ai * HALF + m * 16) * D + col0;
                    u32x2 w; w.x = cvt_pk4_fp8_nc(r[0], r[1], r[2], r[3]); w.y = cvt_pk4_fp8_nc(r[4], r[5], r[6], r[7]); *(u32x2*)rowp = w; } }
    }
};
struct EpiMoeOut {
    static constexpr bool PERM = true;
    bf16_t* O; const LAS float* lv;
    __device__ __forceinline__ void operator()(const f32x4 (&acc)[2][2][4][2], const Unit& u, int wr, int wc, int fr, int fq) const {
        const int row0 = u.om + wr * 64 + fr, col0 = u.pn * BM + wc * 32 + 8 * fq;
        const LAS float* gp = lv + u.ix * 512 + wr * 64 + fr; const LAS float* bb = lv + u.ix * 512 + 256 + wc * 32 + 8 * fq;
        f32x4 bv[2][2]; float gt[2][4];
#pragma unroll
        for (int ai = 0; ai < 2; ++ai)
#pragma unroll
            for (int m = 0; m < 4; ++m) gt[ai][m] = gp[ai * HALF + m * 16];
#pragma unroll
        for (int bj = 0; bj < 2; ++bj)
#pragma unroll
            for (int n = 0; n < 2; ++n) bv[bj][n] = *(const LAS f32x4*)(bb + bj * HALF + 4 * n);
#pragma unroll
        for (int ai = 0; ai < 2; ++ai)
#pragma unroll
            for (int m = 0; m < 4; ++m) { GAS unsigned char* rowp = (GAS unsigned char*)O + (size_t)(row0 + ai * HALF + m * 16) * D + col0; const float g16 = gt[ai][m] * F8_SY;
#pragma unroll
                for (int bj = 0; bj < 2; ++bj) { const f32x4 v0 = (acc[ai][bj][m][0] * (1.0f / (F8_SACT * F8_SW)) + bv[bj][0]) * g16, v1 = (acc[ai][bj][m][1] * (1.0f / (F8_SACT * F8_SW)) + bv[bj][1]) * g16;
                    u32x2 w; w.x = cvt_pk4_fp8(v0[0], v0[1], v0[2], v0[3]); w.y = cvt_pk4_fp8(v1[0], v1[1], v1[2], v1[3]);
                    *(GAS u32x2*)(rowp + bj * HALF) = w; } }
    }
};

struct Frame {
    LAS unsigned char* lds; volatile LAS unsigned* MISC; gu32* ctl; unsigned char* ws;
    int tid, lane, wave, G, c;
    int xcc, rank, loc;
    const float* const* in;
    float* out;
};
enum { I_X = 0, I_C, I_WMOD, I_BMOD, I_NMG, I_NFG, I_AWQKV, I_ABQKV, I_AWO, I_ABO, I_SINK, I_RELB, I_CWIN, I_CBIN, I_CWDW, I_CBDW, I_CLNG, I_CLNB, I_CWOUT, I_CBOUT, I_RW, I_RB, I_MWIN, I_MBIN, I_MWOUT, I_MBOUT, I_FNG };
#define WSP(type, off) ((type*)(F.ws + (off)))
__device__ __forceinline__ void wg_barrier() { __syncthreads(); }

__device__ __forceinline__ int build_exp_tables(Frame& F, int layer) {
    LAS int* EX = (LAS int*)(F.lds + LDS_EXP);
    if (F.MISC[22] == (unsigned)(layer + 1)) return EX[96];
    if (F.tid < 64) {
        const int e = F.tid & 31; const int cnt = (int)__hip_atomic_load(F.ctl + CW_CNT + 64 * layer + e, RLX_AGENT); const int tiles = (cnt + 255) >> 8;
        int pre = tiles;
#pragma unroll
        for (int o = 1; o < 32; o <<= 1) { const int v = __shfl_up(pre, o, 32); if (e >= o) pre += v; }
        if (F.tid < 32) { EX[e] = cnt; EX[32 + e] = pre - tiles; EX[64 + e] = (pre - tiles) * 256; if (e == 31) EX[96] = pre; }
    }
    wg_barrier();
    if (F.tid == 0) F.MISC[22] = (unsigned)(layer + 1);
    return EX[96];
}
template <int MODE> __device__ __forceinline__ void row_phase(Frame& F, int layer) {
    constexpr bool COMB = (MODE & 1) != 0, ROUT = (MODE & 2) != 0, FIN = (MODE & 4) != 0;
    LAS float* red = (LAS float*)(F.lds); LAS float* part = (LAS float*)(F.lds + 49152); LAS float* lg = (LAS float*)(F.lds + 49152 + 65536);
    LAS int* hist = (LAS int*)(F.lds + 4608); LAS int* gbase = hist + 32; LAS int* pend = (LAS int*)(F.lds + 8192);
    const LAS int* EX = (const LAS int*)(F.lds + LDS_EXP);
    const int lane = F.lane, w = F.wave, row = lane & 15, kq = lane >> 4;
    constexpr int KS = (MODE & 2) ? 32 : 8;
    const int kb = (MODE & 2) ? 128 * w + 8 * kq : 128 * w + 32 * kq;
    constexpr bool XF32 = (MODE == 0);
    const float* xin = F.in[I_X]; bf16_t* X = WSP(bf16_t, WS_X); bf16_t* H = WSP(bf16_t, WS_H);
    const float* mod = WSP(const float, WS_MOD);
    const float* gamma = FIN ? F.in[I_FNG] : (ROUT ? F.in[I_NFG] + layer * D : F.in[I_NMG] + layer * D);
    const int ngrp = T / 16; int g0 = (int)((long)F.c * ngrp / F.G), g1 = (int)((long)(F.c + 1) * ngrp / F.G);
    if (F.loc) { g0 = F.xcc * (SEQ / 16) + 4 * F.rank; g1 = g0 + 4; }
    if (COMB) build_exp_tables(F, layer - 1);
    if (ROUT) { if (F.tid < 32) hist[F.tid] = 0; }
    bf16x8 whi[2][4], wlo[2][4];
    if (ROUT) {
        const float* wrp = F.in[I_RW] + (size_t)layer * D * NE;
#pragma unroll
        for (int eh = 0; eh < 2; ++eh)
#pragma unroll
            for (int s = 0; s < 4; ++s) { float v[8];
#pragma unroll
                for (int j = 0; j < 8; ++j) v[j] = wrp[(size_t)(kb + 32 * s + j) * NE + 16 * eh + row];
                u32x4 hi, lo;
#pragma unroll
                for (int p = 0; p < 4; ++p) { const unsigned h2 = cvt_pk(v[2 * p], v[2 * p + 1]); hi[p] = h2; lo[p] = cvt_pk(v[2 * p] - bf_lo(h2), v[2 * p + 1] - bf_hi(h2)); }
                whi[eh][s] = __builtin_bit_cast(bf16x8, hi); wlo[eh][s] = __builtin_bit_cast(bf16x8, lo); }
    }
    LAS float* Gl = (LAS float*)(F.lds + 32768); LAS float* Sl = Gl + D; LAS float* Fl = Sl + D;
    constexpr int GU = (XF32 || ROUT) ? 2 : 4;
#define UNPK0(v) ((f32x4){bf_lo((v).x), bf_hi((v).x), bf_lo((v).y), bf_hi((v).y)})
#define UNPK1(v) ((f32x4){bf_lo((v).z), bf_hi((v).z), bf_lo((v).w), bf_hi((v).w)})
    int curb = -1;
    for (int grp0 = g0; grp0 < g1; grp0 += GU) {
        const int b = (grp0 * 16) / SEQ, par = ((grp0 - g0) / GU) & 1;
        if (b != curb) { curb = b;
            const float* mb = mod + ((size_t)layer * NBATCH + b) * (6 * D);
            wg_barrier();
            for (int k = F.tid; k < D; k += NTHR) { const float gm = gamma[k];
                if (FIN) { Gl[k] = gm; Sl[k] = 0.f; }
                else { const float* shp = mb + (ROUT ? 3 * D : 0); const float* scp = mb + (ROUT ? 4 * D : D); Gl[k] = gm * (scp[k] + 1.0f); Sl[k] = shp[k]; }
                if (COMB) { const float* gf = mod + ((size_t)(layer - 1) * NBATCH + b) * (6 * D) + 5 * D; Fl[k] = gf[k]; } }
            wg_barrier();
        }
        u32x4 xb[GU][4]; int tks[GU][4];
#pragma unroll
        for (int u = 0; u < GU; ++u) { const int t = (grp0 + u < g1 ? grp0 + u : g1 - 1) * 16 + row;
            if (COMB) { const int* TK = WSP(const int, WS_TK);
#pragma unroll
                for (int kk = 0; kk < 4; ++kk) tks[u][kk] = TK[t * 4 + kk]; }
#pragma unroll
            for (int s = 0; s < 4; ++s) {
                if (XF32) { const f32x4 x0 = *(const f32x4*)(xin + (size_t)t * D + kb + KS * s), x1 = *(const f32x4*)(xin + (size_t)t * D + kb + KS * s + 4);
                    xb[u][s].x = cvt_pk(x0[0], x0[1]); xb[u][s].y = cvt_pk(x0[2], x0[3]); xb[u][s].z = cvt_pk(x1[0], x1[1]); xb[u][s].w = cvt_pk(x1[2], x1[3]); }
                else xb[u][s] = *(const u32x4*)(X + (size_t)t * D + kb + KS * s); } }
        if (COMB) {
            const GAS unsigned char* YS = (const GAS unsigned char*)WSP(const unsigned char, WS_YS);
            u32x2 yv2[2][4][4];
#define YS_ISSUE(U_, B_) do { size_t yoff[4]; \
                _Pragma("unroll") for (int kk = 0; kk < 4; ++kk) { const int tk = tks[U_][kk]; yoff[kk] = (size_t)(EX[64 + (tk >> 16)] + (tk & 0xffff)) * D + kb; } \
                _Pragma("unroll") for (int s = 0; s < 4; ++s) _Pragma("unroll") for (int kk = 0; kk < 4; ++kk) yv2[B_][s][kk] = *(const GAS u32x2*)(YS + yoff[kk] + KS * s); } while (0)
            YS_ISSUE(0, 0);
#pragma unroll
            for (int u = 0; u < GU; ++u) { const int t = (grp0 + u < g1 ? grp0 + u : g1 - 1) * 16 + row;
                if (u + 1 < GU) YS_ISSUE(u + 1, (u + 1) & 1);
                const u32x2 (&yv)[4][4] = yv2[u & 1];
#pragma unroll
                for (int s = 0; s < 4; ++s) { f32x4 a0 = (f32x4){0.f, 0.f, 0.f, 0.f}, a1 = a0;
#pragma unroll
                    for (int kk = 0; kk < 4; ++kk) { a0 += fp8x4_to_f32(yv[s][kk].x); a1 += fp8x4_to_f32(yv[s][kk].y); }
                    const f32x4 x0 = UNPK0(xb[u][s]) + *(const LAS f32x4*)(Fl + kb + KS * s) * a0 * (1.0f / F8_SY), x1 = UNPK1(xb[u][s]) + *(const LAS f32x4*)(Fl + kb + KS * s + 4) * a1 * (1.0f / F8_SY);
                    xb[u][s].x = cvt_pk(x0[0], x0[1]); xb[u][s].y = cvt_pk(x0[2], x0[3]); xb[u][s].z = cvt_pk(x1[0], x1[1]); xb[u][s].w = cvt_pk(x1[2], x1[3]);
                    if (!FIN && grp0 + u < g1) *(u32x4*)(X + (size_t)t * D + kb + KS * s) = xb[u][s]; } }
        }
#pragma unroll
        for (int u = 0; u < GU; ++u) { float ss = 0.f;
#pragma unroll
            for (int s = 0; s < 4; ++s) { const f32x4 v0 = UNPK0(xb[u][s]), v1 = UNPK1(xb[u][s]); ss += (v0[0] * v0[0] + v0[1] * v0[1]) + (v0[2] * v0[2] + v0[3] * v0[3]) + (v1[0] * v1[0] + v1[1] * v1[1]) + (v1[2] * v1[2] + v1[3] * v1[3]); }
            ss += __shfl_xor(ss, 16); ss += __shfl_xor(ss, 32);
            if (kq == 0) red[(par * GU + u) * 128 + w * 16 + row] = ss; }
        wg_barrier();
        f32x4 acc[GU][2];
#pragma unroll
        for (int u = 0; u < GU; ++u) { const int t = (grp0 + u < g1 ? grp0 + u : g1 - 1) * 16 + row; const bool live = grp0 + u < g1;
            float tot = 0.f;
#pragma unroll
            for (int ww = 0; ww < 8; ++ww) tot += red[(par * GU + u) * 128 + ww * 16 + row];
            const float rstd = rsqrtf(tot * (1.0f / D) + 1e-5f);
            acc[u][0] = (f32x4){0.f, 0.f, 0.f, 0.f}; acc[u][1] = acc[u][0];
#pragma unroll
            for (int s = 0; s < 4; ++s) {
                const f32x4 h0 = UNPK0(xb[u][s]) * rstd * *(const LAS f32x4*)(Gl + kb + KS * s) + *(const LAS f32x4*)(Sl + kb + KS * s), h1 = UNPK1(xb[u][s]) * rstd * *(const LAS f32x4*)(Gl + kb + KS * s + 4) + *(const LAS f32x4*)(Sl + kb + KS * s + 4);
                if (FIN) { if (live) { *(f32x4*)(F.out + (size_t)t * D + kb + KS * s) = h0; *(f32x4*)(F.out + (size_t)t * D + kb + KS * s + 4) = h1; } }
                else {
                    u32x4 hi; hi.x = cvt_pk(h0[0], h0[1]); hi.y = cvt_pk(h0[2], h0[3]); hi.z = cvt_pk(h1[0], h1[1]); hi.w = cvt_pk(h1[2], h1[3]);
                    if (!ROUT) {
                        if (F8_QKV || (COMB && (layer & 1))) {
                            u32x2 q8; q8.x = cvt_pk4_fp8(h0[0] * F8_SH, h0[1] * F8_SH, h0[2] * F8_SH, h0[3] * F8_SH); q8.y = cvt_pk4_fp8(h1[0] * F8_SH, h1[1] * F8_SH, h1[2] * F8_SH, h1[3] * F8_SH);
                            if (live) *(u32x2*)((unsigned char*)H + (size_t)t * D + kb + KS * s) = q8; }
                        else if (live) *(u32x4*)(H + (size_t)t * D + kb + KS * s) = hi; }
                    else { u32x2 q8; q8.x = cvt_pk4_fp8(h0[0] * F8_SH, h0[1] * F8_SH, h0[2] * F8_SH, h0[3] * F8_SH); q8.y = cvt_pk4_fp8(h1[0] * F8_SH, h1[1] * F8_SH, h1[2] * F8_SH, h1[3] * F8_SH);
                        if (live) *(u32x2*)((unsigned char*)H + (size_t)t * D + kb + KS * s) = q8; }
                    if (ROUT) {
                        u32x4 lo; lo.x = cvt_pk(h0[0] - bf_lo(hi.x), h0[1] - bf_hi(hi.x)); lo.y = cvt_pk(h0[2] - bf_lo(hi.y), h0[3] - bf_hi(hi.y));
                        lo.z = cvt_pk(h1[0] - bf_lo(hi.z), h1[1] - bf_hi(hi.z)); lo.w = cvt_pk(h1[2] - bf_lo(hi.w), h1[3] - bf_hi(hi.w));
                        const bf16x8 ah = __builtin_bit_cast(bf16x8, hi), al = __builtin_bit_cast(bf16x8, lo);
#pragma unroll
                        for (int eh = 0; eh < 2; ++eh) {
                            acc[u][eh] = __builtin_amdgcn_mfma_f32_16x16x32_bf16(ah, whi[eh][s], acc[u][eh], 0, 0, 0);
                            acc[u][eh] = __builtin_amdgcn_mfma_f32_16x16x32_bf16(ah, wlo[eh][s], acc[u][eh], 0, 0, 0);
                            acc[u][eh] = __builtin_amdgcn_mfma_f32_16x16x32_bf16(al, whi[eh][s], acc[u][eh], 0, 0, 0); }
                    }
                }
            }
        }
        if (ROUT) {
#pragma unroll
            for (int u = 0; u < GU; ++u)
#pragma unroll
                for (int eh = 0; eh < 2; ++eh)
#pragma unroll
                    for (int i = 0; i < 4; ++i) part[((u * 8 + w) * 16 + 4 * kq + i) * 32 + 16 * eh + row] = acc[u][eh][i];
            wg_barrier();
#pragma unroll
            for (int u = 0; u < GU; ++u) { const int r = F.tid >> 5, e = F.tid & 31; float v = F.in[I_RB][layer * NE + e];
#pragma unroll
                for (int ww = 0; ww < 8; ++ww) v += part[((u * 8 + ww) * 16 + r) * 32 + e];
                lg[(u * 16 + r) * 32 + e] = v; }
            wg_barrier();
            if (F.tid < 16 * GU && grp0 + (F.tid >> 4) < g1) {
                const int u = F.tid >> 4, r = F.tid & 15; unsigned used = 0u; int ids[4]; float vals[4];
#pragma unroll
                for (int k = 0; k < 4; ++k) { int bi = 0; float bv = -3.0e38f;
                    for (int e = 0; e < 32; ++e) { const float v = lg[(u * 16 + r) * 32 + e]; if (!((used >> e) & 1u) && v > bv) { bv = v; bi = e; } }
                    used |= 1u << bi; ids[k] = bi; vals[k] = bv; }
                const float e1 = __expf(vals[1] - vals[0]), e2 = __expf(vals[2] - vals[0]), e3 = __expf(vals[3] - vals[0]), inv = 1.0f / (1.0f + e1 + e2 + e3);
                const float gs[4] = {inv, e1 * inv, e2 * inv, e3 * inv};
#pragma unroll
                for (int k = 0; k < 4; ++k) { const int lp = atomicAdd((int*)&hist[ids[k]], 1); const int idx = ((grp0 + u - g0) * 16 + r) * 4 + k; pend[2 * idx] = ids[k] | (lp << 8); pend[2 * idx + 1] = __float_as_int(gs[k]); }
            }
        }
    }
#undef UNPK0
#undef UNPK1
    if (ROUT) {
        wg_barrier();
        if (F.tid < 32) { const int n = hist[F.tid]; gbase[F.tid] = n > 0 ? (int)__hip_atomic_fetch_add(F.ctl + CW_CNT + 64 * layer + F.tid, (unsigned)n, RLX_AGENT) : 0; }
        wg_barrier();
        int* LIST = WSP(int, WS_LIST); float* GL = WSP(float, WS_GLIST); int* TK = WSP(int, WS_TK);
        const int nent = (g1 - g0) * 64;
        for (int idx = F.tid; idx < nent; idx += NTHR) { const int pw = pend[2 * idx], e = pw & 0xff, pos = gbase[e] + (pw >> 8), tok = g0 * 16 + (idx >> 2);
            LIST[(size_t)e * T + pos] = tok; GL[(size_t)e * T + pos] = __int_as_float(pend[2 * idx + 1]); TK[tok * 4 + (idx & 3)] = (e << 16) | pos; }
    }
    wg_barrier();
}
__device__ const unsigned char kBucket[128] = {0, 1, 2, 3, 4, 5, 6, 7, 8, 9, 10, 11, 12, 13, 14, 15, 16, 16, 16, 17, 17, 18, 18, 18, 19, 19, 19, 20, 20, 20, 20, 21, 21, 21, 21, 22, 22, 22, 22, 22, 23, 23, 23, 23, 23, 23, 24, 24, 24, 24, 24, 24, 25, 25, 25, 25, 25, 25, 25, 26, 26, 26, 26, 26, 26, 26, 26, 27, 27, 27, 27, 27, 27, 27, 27, 27, 27, 28, 28, 28, 28, 28, 28, 28, 28, 28, 28, 29, 29, 29, 29, 29, 29, 29, 29, 29, 29, 29, 29, 30, 30, 30, 30, 30, 30, 30, 30, 30, 30, 30, 30, 30, 30, 31, 31, 31, 31, 31, 31, 31, 31, 31, 31, 31, 31, 31, 31, 31};
constexpr int KP = 144, VP = 192;
constexpr int ATT_K = 0, ATT_V = 256 * KP, ATT_B = ATT_V + 256 * VP;
__device__ __forceinline__ int crow(int r, int hi) { return (r & 3) + 8 * (r >> 2) + 4 * hi; }
typedef short v4i16_t __attribute__((ext_vector_type(4)));
__device__ __forceinline__ s16x4 vtr(const LAS unsigned char* p) { return __builtin_bit_cast(s16x4, __builtin_amdgcn_ds_read_tr16_b64_v4i16((LAS v4i16_t*)p)); }

__device__ __forceinline__ void attn_phase(Frame& F, int j, unsigned long long& t_acc) {
#ifndef TIME_KIND
#define TIME_KIND (-1)
#endif
    unsigned long long t_b = 0ull;
#define AT_BEG(k) do { if (TIME_KIND == (k)) t_b = __builtin_amdgcn_s_memrealtime(); } while (0)
#define AT_END(k) do { if (TIME_KIND == (k)) t_acc += __builtin_amdgcn_s_memrealtime() - t_b; } while (0)
    const bf16_t* QKV = WSP(const bf16_t, WS_QKV); bf16_t* AO = WSP(bf16_t, WS_AO);
    LAS unsigned char* Kl = F.lds + ATT_K; LAS unsigned char* Vl = F.lds + ATT_V; LAS float* Bl = (LAS float*)(F.lds + ATT_B);
    const int lane = F.lane, w = F.wave, r = lane & 31, hh = lane >> 5;
    const float c1 = 0.125f * LOG2E;
    const int u_beg = F.loc ? F.xcc * 64 + F.rank : F.c, u_step = F.loc ? 32 : F.G, u_end = F.loc ? F.xcc * 64 + 64 : NBATCH * 16 * 4;
    u32x4 kreg[4], vreg[4];
#define ATT_ISSUE(UNIT) { const int kvh_ = (UNIT) & 3, n_ = ((UNIT) >> 2) & 15, b_ = (UNIT) >> 6; \
        _Pragma("unroll") for (int it = 0; it < 4; ++it) { const int ch = F.tid + NTHR * it, s = ch >> 3, c8 = ch & 7; \
            const int grow = (n_ > 0 || s >= 128) ? (b_ * SEQ + (n_ - 1) * 128 + s) : (b_ * SEQ + s);        \
            kreg[it] = *(const u32x4*)(QKV + (size_t)grow * 1536 + 1024 + kvh_ * 64 + 8 * c8); vreg[it] = *(const u32x4*)(QKV + (size_t)grow * 1536 + 1280 + kvh_ * 64 + 8 * c8); } }
    if (u_beg < u_end) ATT_ISSUE(u_beg);
    for (int unit = u_beg; unit < u_end; unit += u_step) {
        const int kvh = unit & 3, n = (unit >> 2) & 15, b = unit >> 6;
        AT_BEG(70);
        const int g = w >> 1, hq = kvh * 4 + g; const float sink2 = F.in[I_SINK][j * 16 + hq] * LOG2E;
        bf16x8 qf[4];
        { const size_t tok0 = (size_t)b * SEQ + n * 128 + (w & 1) * 64 + r;
#pragma unroll
            for (int d0 = 0; d0 < 4; ++d0) qf[d0] = *(const bf16x8*)(QKV + tok0 * 1536 + hq * 64 + 16 * d0 + 8 * hh); }
#pragma unroll
        for (int it = 0; it < 4; ++it) { const int ch = F.tid + NTHR * it, s = ch >> 3, c8 = ch & 7;
            *(LAS u32x4*)(Kl + s * KP + 16 * c8) = kreg[it]; *(LAS u32x4*)(Vl + s * VP + 16 * c8) = vreg[it]; }
        { const int gg = F.tid >> 7, dist = F.tid & 127; Bl[F.tid] = F.in[I_RELB][kBucket[dist] * 16 + kvh * 4 + gg] * LOG2E; }
        wg_barrier();
        AT_END(70); AT_BEG(71);
        if (unit + u_step < u_end) ATT_ISSUE(unit + u_step);
#pragma unroll 1
        for (int grp = 0; grp < 2; ++grp) {
            const int a0 = (w & 1) * 64 + grp * 32, a = a0 + r; const size_t tok = (size_t)b * SEQ + n * 128 + a;
            bf16x8 qn[4];
            if (grp == 0) {
#pragma unroll
                for (int d0 = 0; d0 < 4; ++d0) qn[d0] = *(const bf16x8*)(QKV + (tok + 32) * 1536 + hq * 64 + 16 * d0 + 8 * hh); }
            else {
#pragma unroll
                for (int d0 = 0; d0 < 4; ++d0) qn[d0] = qf[d0]; }
            const int kt0 = a0 >> 5;
            f32x16 S[5];
#pragma unroll
            for (int t = 0; t < 5; ++t) {
#pragma unroll
                for (int i = 0; i < 16; ++i) S[t][i] = 0.f;
                const LAS unsigned char* kp = Kl + (32 * (kt0 + t) + r) * KP + 16 * hh;
#pragma unroll
                for (int d0 = 0; d0 < 4; ++d0) { const bf16x8 kf = *(const LAS bf16x8*)(kp + 32 * d0); S[t] = __builtin_amdgcn_mfma_f32_32x32x16_bf16(kf, qf[d0], S[t], 0, 0, 0); }
            }
            const int rr = r - 4 * hh;
            float m = sink2;
#pragma unroll
            for (int t = 0; t < 5; ++t) {
                if (n > 0 || kt0 + t >= 4) {
                    const LAS float* bp = Bl + g * 128 + (rr + 128 - 32 * t);
#pragma unroll
                    for (int i = 0; i < 16; ++i) { const int dc = (i & 3) + 8 * (i >> 2);
                        float v = S[t][i] * c1 + bp[-dc];
                        if (t == 0) v = (dc > rr) ? v : -3.0e38f;
                        if (t == 4) v = (dc <= rr) ? v : -3.0e38f;
                        S[t][i] = v; m = fmaxf(m, v); }
                } else {
#pragma unroll
                    for (int i = 0; i < 16; ++i) S[t][i] = -3.0e38f;
                }
            }
            m = fmaxf(m, __shfl_xor(m, 32));
            float l = 0.f;
#pragma unroll
            for (int t = 0; t < 5; ++t)
#pragma unroll
                for (int i = 0; i < 16; ++i) { const float p = __builtin_amdgcn_exp2f(S[t][i] - m); S[t][i] = p; l += p; }
            l += __shfl_xor(l, 32); l += __builtin_amdgcn_exp2f(sink2 - m);
            f32x16 O[2];
#pragma unroll
            for (int i = 0; i < 16; ++i) { O[0][i] = 0.f; O[1][i] = 0.f; }
            const int q4 = (lane >> 2) & 3, p4 = lane & 3, blk = (lane >> 4) & 1;
#pragma unroll
            for (int t = 0; t < 5; ++t)
#pragma unroll
                for (int s2 = 0; s2 < 2; ++s2) {
                    u32x4 pk; pk.x = cvt_pk(S[t][8 * s2 + 0], S[t][8 * s2 + 1]); pk.y = cvt_pk(S[t][8 * s2 + 2], S[t][8 * s2 + 3]); pk.z = cvt_pk(S[t][8 * s2 + 4], S[t][8 * s2 + 5]); pk.w = cvt_pk(S[t][8 * s2 + 6], S[t][8 * s2 + 7]);
                    const bf16x8 pb = __builtin_bit_cast(bf16x8, pk);
                    const LAS unsigned char* vp = Vl + (32 * (kt0 + t) + 16 * s2 + 4 * hh + q4) * VP + 32 * blk + 8 * p4;
#pragma unroll
                    for (int dh = 0; dh < 2; ++dh) { const s16x4 lo = vtr(vp + 64 * dh), hi = vtr(vp + 64 * dh + 8 * VP);
                        const bf16x8 va = (bf16x8){lo[0], lo[1], lo[2], lo[3], hi[0], hi[1], hi[2], hi[3]};
                        O[dh] = __builtin_amdgcn_mfma_f32_32x32x16_bf16(va, pb, O[dh], 0, 0, 0); }
                }
            const float inv = 1.0f / l;
#pragma unroll
            for (int dh = 0; dh < 2; ++dh)
#pragma unroll
                for (int g4 = 0; g4 < 4; ++g4) {
                    if (F8_WO) { const float i8 = inv * F8_SH;
                        *(unsigned*)((unsigned char*)AO + tok * D + hq * 64 + 32 * dh + 8 * g4 + 4 * hh) = cvt_pk4_fp8(O[dh][4 * g4] * i8, O[dh][4 * g4 + 1] * i8, O[dh][4 * g4 + 2] * i8, O[dh][4 * g4 + 3] * i8); }
                    else { u32x2 o2; o2.x = cvt_pk(O[dh][4 * g4] * inv, O[dh][4 * g4 + 1] * inv); o2.y = cvt_pk(O[dh][4 * g4 + 2] * inv, O[dh][4 * g4 + 3] * inv);
                        *(u32x2*)(AO + tok * D + hq * 64 + 32 * dh + 8 * g4 + 4 * hh) = o2; } }
#pragma unroll
            for (int d0 = 0; d0 < 4; ++d0) qf[d0] = qn[d0];
        }
        AT_END(71); AT_BEG(72);
        wg_barrier();
        AT_END(72);
    }
#undef ATT_ISSUE
#undef AT_BEG
#undef AT_END
}

__device__ __forceinline__ float wave_sum63(float v) {
    v += __builtin_bit_cast(float, __builtin_amdgcn_update_dpp(0, __builtin_bit_cast(int, v), 0x111, 0xf, 0xf, true));
    v += __builtin_bit_cast(float, __builtin_amdgcn_update_dpp(0, __builtin_bit_cast(int, v), 0x112, 0xf, 0xf, true));
    v += __builtin_bit_cast(float, __builtin_amdgcn_update_dpp(0, __builtin_bit_cast(int, v), 0x114, 0xf, 0xf, true));
    v += __builtin_bit_cast(float, __builtin_amdgcn_update_dpp(0, __builtin_bit_cast(int, v), 0x118, 0xf, 0xf, true));
    v += __builtin_bit_cast(float, __builtin_amdgcn_update_dpp(0, __builtin_bit_cast(int, v), 0x142, 0xa, 0xf, true));
    v += __builtin_bit_cast(float, __builtin_amdgcn_update_dpp(0, __builtin_bit_cast(int, v), 0x143, 0xc, 0xf, true));
    return v;
}
__device__ __forceinline__ void dwconv_phase(Frame& F, int j, unsigned long long& t_acc) {
#ifndef TIME_KIND
#define TIME_KIND (-1)
#endif
    unsigned long long t_b = 0ull;
#define DT_BEG(k) do { if (TIME_KIND == (k)) t_b = __builtin_amdgcn_s_memrealtime(); } while (0)
#define DT_END(k) do { if (TIME_KIND == (k)) t_acc += __builtin_amdgcn_s_memrealtime() - t_b; } while (0)
    constexpr int PP = 520;
    DT_BEG(16);
    const bf16_t* U = WSP(const bf16_t, WS_U); bf16_t* YC = WSP(bf16_t, WS_AO);
    LAS unsigned char* ut = F.lds; LAS float* P = (LAS float*)F.lds; LAS float* fin = (LAS float*)(F.lds + 64 * PP * 4);
    const int tid = F.tid, lane = F.lane, w = F.wave;
    const float* wd = F.in[I_CWDW] + (size_t)j * 31 * D + 2 * tid;
    f32x2 wk[31];
#pragma unroll
    for (int q = 0; q < 31; ++q) wk[q] = *(const f32x2*)(wd + q * D) * (1.0f / F8_SH);
    const f32x2 bdw = *(const f32x2*)(F.in[I_CBDW] + j * D + 2 * tid), lng = *(const f32x2*)(F.in[I_CLNG] + j * D + 2 * tid), lnb = *(const f32x2*)(F.in[I_CLNB] + j * D + 2 * tid);
    const __amdgpu_buffer_rsrc_t rU = __builtin_amdgcn_make_buffer_rsrc((void*)U, 0, 0x7fffffff, 0x00020000);
    asm volatile("s_waitcnt vmcnt(0)" ::: "memory"); DT_END(16);
    const int tl_beg = F.loc ? F.xcc * 64 + F.rank : F.c, tl_step = F.loc ? 32 : F.G, tl_end = F.loc ? F.xcc * 64 + 64 : T / 32;
    for (int tile = tl_beg; tile < tl_end; tile += tl_step) {
        const int t0 = tile * 32, tin0 = t0 % SEQ, rlo = tin0 >= 30 ? 0 : 30 - tin0;
        DT_BEG(12);
        for (int pc = w; pc < 62; pc += NWAVES) { const int rr = pc;
            if (rr >= rlo) __builtin_amdgcn_raw_ptr_buffer_load_lds(rU, (LAS unsigned*)(ut + pc * 1024), 16, lane * 16, (int)((size_t)(t0 + rr - 30) * D), 0, 0);
            else *(LAS u32x4*)(ut + pc * 1024 + lane * 16) = (u32x4){0u, 0u, 0u, 0u}; }
        asm volatile("s_waitcnt vmcnt(0)" ::: "memory");
        wg_barrier();
        DT_END(12); DT_BEG(13);
        f32x2 y[32];
#pragma unroll
        for (int blk = 0; blk < 4; ++blk) {
            f32x2 a[8] = {bdw, bdw, bdw, bdw, bdw, bdw, bdw, bdw};
#pragma unroll
            for (int rr = 0; rr < 38; ++rr) { const unsigned uw = *(const LAS unsigned short*)(ut + (8 * blk + rr) * 1024 + 2 * tid); const f32x2 uv = __builtin_amdgcn_cvt_pk_f32_fp8((int)uw, false);
#pragma unroll
                for (int o = 0; o < 8; ++o) { const int q = rr - o; if (q >= 0 && q < 31) a[o] += wk[q] * uv; } }
#pragma unroll
            for (int o = 0; o < 8; ++o) y[8 * blk + o] = a[o];
        }
        DT_END(13); DT_BEG(14);
        wg_barrier();
#pragma unroll
        for (int tk = 0; tk < 32; ++tk) { P[(2 * tk) * PP + tid] = y[tk].x + y[tk].y; P[(2 * tk + 1) * PP + tid] = y[tk].x * y[tk].x + y[tk].y * y[tk].y; }
        wg_barrier();
        { const int qn = tid >> 3, l8 = tid & 7; float v = 0.f;
#pragma unroll 16
          for (int i2 = 0; i2 < 64; ++i2) v += P[qn * PP + l8 + 8 * i2];
          v += __shfl_xor(v, 1); v += __shfl_xor(v, 2); v += __shfl_xor(v, 4);
          if (l8 == 0) fin[qn] = v; }
        wg_barrier();
        DT_END(14); DT_BEG(15);
#pragma unroll
        for (int tk = 0; tk < 32; ++tk) { const float mean = fin[2 * tk] * (1.0f / D), var = fmaxf(fin[2 * tk + 1] * (1.0f / D) - mean * mean, 0.f), rstd = rsqrtf(var + 1e-5f);
            const float v0 = (y[tk].x - mean) * rstd * lng.x + lnb.x, v1 = (y[tk].y - mean) * rstd * lng.y + lnb.y;
            const float o0 = __builtin_amdgcn_fmed3f(v0 * sigmoid_f(v0) * F8_SH, -448.f, 448.f), o1 = __builtin_amdgcn_fmed3f(v1 * sigmoid_f(v1) * F8_SH, -448.f, 448.f);
            *(unsigned short*)((unsigned char*)YC + (size_t)(t0 + tk) * D + 2 * tid) = (unsigned short)__builtin_amdgcn_cvt_pk_fp8_f32(o0, o1, 0, false); }
        asm volatile("s_waitcnt vmcnt(0)" ::: "memory");
        wg_barrier();
        DT_END(15);
    }
#undef DT_BEG
#undef DT_END
}
__device__ __forceinline__ void p0_mod_task(Frame& F, int task) {
    LAS float* cact = (LAS float*)F.lds; LAS float* part = (LAS float*)(F.lds + 32768);
    const int i = task / 24, n0 = (task % 24) * 256, tid = F.tid, lane = F.lane, w = F.wave;
    for (int q = tid; q < NBATCH * D; q += NTHR) { const float cv = F.in[I_C][q]; cact[q] = cv * sigmoid_f(cv); }
    wg_barrier();
    f32x4 acc[8];
#pragma unroll
    for (int b = 0; b < 8; ++b) acc[b] = (f32x4){0.f, 0.f, 0.f, 0.f};
    const float* Wp = F.in[I_WMOD] + ((size_t)i * D + 128 * w) * (6 * D) + n0 + 4 * lane;
#pragma unroll 4
    for (int k = 0; k < 128; ++k) { const f32x4 wv = __builtin_nontemporal_load((const f32x4*)(Wp + (size_t)k * (6 * D)));
#pragma unroll
        for (int b = 0; b < 8; ++b) acc[b] += wv * cact[b * D + 128 * w + k]; }
#pragma unroll
    for (int b = 0; b < 8; ++b) *(LAS f32x4*)(part + (w * 8 + b) * 256 + 4 * lane) = acc[b];
    wg_barrier();
    float* mod = WSP(float, WS_MOD);
#pragma unroll
    for (int q = 0; q < 4; ++q) { const int o = tid + NTHR * q, b = o >> 8, n = o & 255; float s = F.in[I_BMOD][i * 6 * D + n0 + n];
#pragma unroll
        for (int ww = 0; ww < 8; ++ww) s += part[(ww * 8 + b) * 256 + n];
        mod[((size_t)i * NBATCH + b) * (6 * D) + n0 + n] = s; }
    wg_barrier();
}
struct TItem { const float* W; bf16_t* Dst; int N, paired, kb, nb, f8; };
constexpr int CV_DENSE = 352, CV_MOE = 3072;
__device__ __forceinline__ bool cv_item(Frame& F, int q, int it, TItem& x) {
    if (it < 0) return false;
    if (q == 0) {
        const int NQ = 96, NO = 64, NCI = 128, NCO = 64;
        if (it < NQ) { const int j = it / 48, r = it % 48; x.W = F.in[I_AWQKV] + (size_t)j * D * 1536; x.Dst = F8_QKV ? (bf16_t*)(WSP(unsigned char, WS_WQKV) + (size_t)j * 1536 * D) : WSP(bf16_t, WS_WQKV) + (size_t)j * 1536 * D; x.N = 1536; x.paired = 0; x.f8 = F8_QKV; x.kb = r / 6; x.nb = r % 6; return true; } it -= NQ;
        if (it < NO) { const int j = it / 32, r = it % 32; x.W = F.in[I_AWO] + (size_t)j * D * D; x.Dst = F8_WO ? (bf16_t*)(WSP(unsigned char, WS_WO) + (size_t)j * D * D) : WSP(bf16_t, WS_WO) + (size_t)j * D * D; x.N = 1024; x.paired = 0; x.f8 = F8_WO; x.kb = r / 4; x.nb = r % 4; return true; } it -= NO;
        if (it < NCI) { const int j = it / 64, r = it % 64; x.W = F.in[I_CWIN] + (size_t)j * D * 2048; x.Dst = (bf16_t*)(WSP(unsigned char, WS_CWIN) + (size_t)j * 2048 * D); x.N = 2048; x.paired = 1; x.f8 = 1; x.kb = r / 8; x.nb = r % 8; return true; } it -= NCI;
        if (it < NCO) { const int j = it / 32, r = it % 32; x.W = F.in[I_CWOUT] + (size_t)j * D * D; x.Dst = (bf16_t*)(WSP(unsigned char, WS_CWOUT) + (size_t)j * D * D); x.N = 1024; x.paired = 0; x.f8 = 1; x.kb = r / 4; x.nb = r % 4; return true; } it -= NCO;
    }
    if (it < 2048) { const int m = q * NE + it / 64, r = it % 64; x.W = F.in[I_MWIN] + (size_t)m * D * 2048; x.Dst = (bf16_t*)(WSP(unsigned char, WS_MWIN) + (size_t)m * 2048 * D); x.N = 2048; x.paired = 1; x.f8 = 1; x.kb = r / 8; x.nb = r % 8; return true; } it -= 2048;
    if (it < 1024) { const int m = q * NE + it / 32, r = it % 32; x.W = F.in[I_MWOUT] + (size_t)m * D * D; x.Dst = (bf16_t*)(WSP(unsigned char, WS_MWOUT) + (size_t)m * D * D); x.N = 1024; x.paired = 0; x.f8 = 1; x.kb = r / 4; x.nb = r % 4; return true; }
    return false;
}
__device__ __forceinline__ void cv_run(Frame& F, int q, int max_items) {
    if (q > 3 || max_items <= 0) return;
    LAS float* tile = (LAS float*)F.lds;
    volatile LAS int* qslot = (volatile LAS int*)(F.lds + 128 * 257 * 4 + 64);
    const int tid = F.tid, lane = F.lane, w = F.wave; gu32* qc = F.ctl + CW_P0Q + 64 * q;
    int claimed = 1;
    wg_barrier();
    if (tid == 0) qslot[0] = (int)__hip_atomic_fetch_add(qc, 1u, RLX_AGENT);
    wg_barrier();
    int it = qslot[0]; TItem cur; bool valid = cv_item(F, q, it, cur);
    f32x4 rg[16];
    if (valid) {
#pragma unroll
        for (int qq = 0; qq < 16; ++qq) rg[qq] = __builtin_nontemporal_load((const f32x4*)(cur.W + (size_t)(cur.kb * 128 + w * 16 + qq) * cur.N + cur.nb * 256 + 4 * lane)); }
    wg_barrier();
    while (valid) {
        const bool more = claimed < max_items;
        if (tid == 0) qslot[0] = more ? (int)__hip_atomic_fetch_add(qc, 1u, RLX_AGENT) : -1;
        ++claimed;
#pragma unroll
        for (int qq = 0; qq < 16; ++qq) { LAS float* tp = tile + (w * 16 + qq) * 257 + 4 * lane; tp[0] = rg[qq][0]; tp[1] = rg[qq][1]; tp[2] = rg[qq][2]; tp[3] = rg[qq][3]; }
        wg_barrier();
        const int nit = qslot[0]; TItem nx; const bool nvalid = cv_item(F, q, nit, nx);
        if (nvalid) {
#pragma unroll
            for (int qq = 0; qq < 16; ++qq) rg[qq] = __builtin_nontemporal_load((const f32x4*)(nx.W + (size_t)(nx.kb * 128 + w * 16 + qq) * nx.N + nx.nb * 256 + 4 * lane)); }
        const int kc = lane >> 3;
#pragma unroll
        for (int r4 = 0; r4 < 4; ++r4) { const int nl = 32 * w + 8 * r4 + (lane & 7), n = cur.nb * 256 + nl; const LAS float* sp = tile + (16 * kc) * 257 + nl;
            float v[16];
#pragma unroll
            for (int jj = 0; jj < 16; ++jj) v[jj] = sp[jj * 257];
            int nd = n; if (cur.paired) { const int half = n >> 10, rem = n & 1023; nd = ((rem >> 7) << 8) + (half << 7) + (rem & 127); }
            if (cur.f8) { u32x4 o; o.x = cvt_pk4_fp8(v[0] * F8_SW, v[1] * F8_SW, v[2] * F8_SW, v[3] * F8_SW); o.y = cvt_pk4_fp8(v[4] * F8_SW, v[5] * F8_SW, v[6] * F8_SW, v[7] * F8_SW);
                o.z = cvt_pk4_fp8(v[8] * F8_SW, v[9] * F8_SW, v[10] * F8_SW, v[11] * F8_SW); o.w = cvt_pk4_fp8(v[12] * F8_SW, v[13] * F8_SW, v[14] * F8_SW, v[15] * F8_SW);
                __builtin_nontemporal_store(o, (u32x4*)((unsigned char*)cur.Dst + (size_t)nd * D + cur.kb * 128 + 16 * kc)); }
            else { u32x4 o0, o1; o0.x = cvt_pk(v[0], v[1]); o0.y = cvt_pk(v[2], v[3]); o0.z = cvt_pk(v[4], v[5]); o0.w = cvt_pk(v[6], v[7]); o1.x = cvt_pk(v[8], v[9]); o1.y = cvt_pk(v[10], v[11]); o1.z = cvt_pk(v[12], v[13]); o1.w = cvt_pk(v[14], v[15]);
                bf16_t* dp = cur.Dst + (size_t)nd * D + cur.kb * 128 + 16 * kc; __builtin_nontemporal_store(o0, (u32x4*)dp); __builtin_nontemporal_store(o1, (u32x4*)(dp + 8)); } }
        wg_barrier();
        cur = nx; valid = nvalid;
    }
}
#ifndef CV_OVERLAP
#define CV_OVERLAP 1
#endif
__device__ __forceinline__ void p0_phase(Frame& F) {
    for (int task = F.c; task < 96; task += F.G) p0_mod_task(F, task);
    cv_run(F, 0, 1 << 30);
    if (!CV_OVERLAP) { cv_run(F, 1, 1 << 30); cv_run(F, 2, 1 << 30); cv_run(F, 3, 1 << 30); }
}

#define PHASE_ENTER_LITE() do { int _t = F.tid; asm volatile("" : "+v"(_t)); F.tid = _t; } while (0)
template <bool GATHER> __device__ __forceinline__ int moe_build_units(Frame& F, int layer, int npn, int total_tiles, int ubase) {
    const LAS int* EX = (const LAS int*)(F.lds + LDS_EXP); LAS int* UT = (LAS int*)(F.lds + LDS_UT); LAS int* TOK = (LAS int*)(F.lds + LDS_TOK); LAS float* ev = (LAS float*)(F.lds + LDS_EPI);
    const int tps = 32 / npn, nsb = (total_tiles + tps - 1) / tps;
    const bool xcd_ok = (F.G % 256) == 0 || F.G == 256;
    int n = 0;
    if (xcd_ok && F.G == 256) {
        const int x = F.c & 7, jx = F.c >> 3;
        const int nsb4 = (total_tiles + 3) / 4, m4 = x < nsb4 ? (nsb4 - x + 7) / 8 : 0;
        const int mine = GATHER ? (x < nsb ? (nsb - x + 7) / 8 : 0) : (m4 + 1) / 2; n = mine - ubase; n = n < 0 ? 0 : (n > 9 ? 9 : n);
        const int j8 = jx & 7;
#define MBU_TAU(r) (GATHER ? ((ubase + (r)) * 8 + x) * tps + (jx % tps) : 4 * ((2 * (ubase + (r)) + (j8 >> 2)) * 8 + x) + (j8 & 3))
        if (F.tid < n) { const int tau = MBU_TAU(F.tid), pn = GATHER ? jx / tps : jx >> 3; int e = 0;
            if (tau < total_tiles) { for (int qq = 1; qq < 32; ++qq) if (tau >= EX[32 + qq]) e = qq; } else e = -1;
            const int mt = e >= 0 ? tau - EX[32 + e] : 0, om = e >= 0 ? EX[64 + e] + 256 * mt : 0;
            UT[4 * F.tid] = GATHER ? 256 * F.tid : om; UT[4 * F.tid + 1] = om; UT[4 * F.tid + 2] = e; UT[4 * F.tid + 3] = pn; UT[40 + F.tid] = mt;
            const bool nxt_valid = (F.tid + 1 < n) && (MBU_TAU(F.tid + 1) < total_tiles);
            if (e >= 0 && !nxt_valid) UT[60] = F.tid + 1;
            if (F.tid == 0 && e < 0) UT[60] = 0; }
#undef MBU_TAU
    } else {
        const int U = total_tiles * npn; const int mine = F.c < U ? (U - F.c + F.G - 1) / F.G : 0; n = mine - ubase; n = n < 0 ? 0 : (n > 9 ? 9 : n);
        if (F.tid < n) { const int L = F.c + (ubase + F.tid) * F.G, tau = L / npn, pn = L % npn; int e = 0;
            for (int qq = 1; qq < 32; ++qq) if (tau >= EX[32 + qq]) e = qq;
            const int mt = tau - EX[32 + e], om = EX[64 + e] + 256 * mt;
            UT[4 * F.tid] = GATHER ? 256 * F.tid : om; UT[4 * F.tid + 1] = om; UT[4 * F.tid + 2] = e; UT[4 * F.tid + 3] = pn; UT[40 + F.tid] = mt;
            if (F.tid == n - 1) UT[60] = n; }
    }
    if (n == 0 && F.tid == 0) UT[60] = 0;
    wg_barrier();
    const int nv = UT[60];
    PHASE_ENTER_LITE();
    if (GATHER) { const int* LIST = WSP(const int, WS_LIST); const float* mb = F.in[I_MBIN] + (size_t)layer * NE * 2048;
        int tv[5]; float bvv[5];
#pragma unroll
        for (int it = 0; it < 5; ++it) { const int q = F.tid + NTHR * it; tv[it] = 0; bvv[it] = 0.f;
            if (q < nv * 256) { const int ui = q >> 8, rr = q & 255, e = UT[4 * ui + 2], pos = 256 * UT[40 + ui] + rr; if (pos < EX[e]) tv[it] = LIST[(size_t)e * T + pos];
                bvv[it] = mb[(size_t)e * 2048 + (rr >> 7) * D + UT[4 * ui + 3] * HALF + (rr & 127)]; } }
#pragma unroll
        for (int it = 0; it < 5; ++it) { const int q = F.tid + NTHR * it; if (q < nv * 256) { TOK[q] = tv[it]; ev[(q >> 8) * 512 + (q & 255)] = bvv[it]; } }
    } else { const LAS int* exoff = EX + 64; const float* mb = F.in[I_MBOUT] + (size_t)layer * NE * D; const float* gl = WSP(const float, WS_GLIST);
        float vv[9];
#pragma unroll
        for (int it = 0; it < 9; ++it) { const int q = F.tid + NTHR * it; vv[it] = 0.f;
            if (q < nv * 512) { const int ui = q >> 9, c = q & 511, e = UT[4 * ui + 2]; vv[it] = c < 256 ? gl[(size_t)e * T + (UT[4 * ui + 1] - exoff[e]) + c] : mb[(size_t)e * D + UT[4 * ui + 3] * BM + (c - 256)]; } }
#pragma unroll
        for (int it = 0; it < 9; ++it) { const int q = F.tid + NTHR * it; if (q < nv * 512) ev[q] = vv[it]; }
    }
    wg_barrier();
    return nv | (n << 8);
}

template <bool FIN> __device__ __forceinline__ void comb_rows(Frame& F, int layer, int r0) {
    build_exp_tables(F, layer - 1);
    const LAS int* EX = (const LAS int*)(F.lds + LDS_EXP);
    const int lane = F.lane, w = F.wave, k0 = 16 * lane;
    const GAS bf16_t* Xr = (const GAS bf16_t*)WSP(const bf16_t, WS_X); GAS bf16_t* Xw = (GAS bf16_t*)WSP(bf16_t, WS_X);
    GAS unsigned char* H = (GAS unsigned char*)WSP(unsigned char, WS_H); const GAS unsigned char* YS = (const GAS unsigned char*)WSP(const unsigned char, WS_YS);
    const GAS int* TK = (const GAS int*)WSP(const int, WS_TK); const float* mod = WSP(const float, WS_MOD);
    const bool h8 = F8_QKV || (layer & 1);
    const int b = r0 / SEQ;
    u32x4 xa[3][2], ys[3][4]; u32x4 tkv[3];
#define CR_ROW(i) (r0 + 8 * w + (i))
#define CR_A(i) do { const int t_ = CR_ROW(i); xa[(i) % 3][0] = *(const GAS u32x4*)(Xr + (size_t)t_ * D + k0); xa[(i) % 3][1] = *(const GAS u32x4*)(Xr + (size_t)t_ * D + k0 + 8); \
        tkv[(i) % 3] = *(const GAS u32x4*)(TK + t_ * 4); } while (0)
#define CR_B(i) do { _Pragma("unroll") for (int kk = 0; kk < 4; ++kk) { const int tk = __builtin_amdgcn_readfirstlane((int)tkv[(i) % 3][kk]); \
            const int slot = __builtin_amdgcn_readfirstlane(EX[64 + (tk >> 16)]) + (tk & 0xffff); ys[(i) % 3][kk] = __builtin_nontemporal_load((const GAS u32x4*)(YS + (size_t)slot * D + k0)); } } while (0)
#define CR_C(i) do { const int t_ = CR_ROW(i); f32x4 x[4]; \
        { const u32x4 p0 = xa[(i) % 3][0], p1 = xa[(i) % 3][1]; \
          x[0] = (f32x4){bf_lo(p0.x), bf_hi(p0.x), bf_lo(p0.y), bf_hi(p0.y)}; x[1] = (f32x4){bf_lo(p0.z), bf_hi(p0.z), bf_lo(p0.w), bf_hi(p0.w)}; \
          x[2] = (f32x4){bf_lo(p1.x), bf_hi(p1.x), bf_lo(p1.y), bf_hi(p1.y)}; x[3] = (f32x4){bf_lo(p1.z), bf_hi(p1.z), bf_lo(p1.w), bf_hi(p1.w)}; } \
        _Pragma("unroll") for (int q = 0; q < 4; ++q) { f32x4 a = (f32x4){0.f, 0.f, 0.f, 0.f}; \
            _Pragma("unroll") for (int kk = 0; kk < 4; ++kk) a += fp8x4_to_f32(ys[(i) % 3][kk][q]); \
            x[q] += Fv[q] * a; } \
        u32x4 o0, o1; o0.x = cvt_pk(x[0][0], x[0][1]); o0.y = cvt_pk(x[0][2], x[0][3]); o0.z = cvt_pk(x[1][0], x[1][1]); o0.w = cvt_pk(x[1][2], x[1][3]); \
        o1.x = cvt_pk(x[2][0], x[2][1]); o1.y = cvt_pk(x[2][2], x[2][3]); o1.z = cvt_pk(x[3][0], x[3][1]); o1.w = cvt_pk(x[3][2], x[3][3]); \
        if (!FIN) { *(GAS u32x4*)(Xw + (size_t)t_ * D + k0) = o0; *(GAS u32x4*)(Xw + (size_t)t_ * D + k0 + 8) = o1; } \
        x[0] = (f32x4){bf_lo(o0.x), bf_hi(o0.x), bf_lo(o0.y), bf_hi(o0.y)}; x[1] = (f32x4){bf_lo(o0.z), bf_hi(o0.z), bf_lo(o0.w), bf_hi(o0.w)};     \
        x[2] = (f32x4){bf_lo(o1.x), bf_hi(o1.x), bf_lo(o1.y), bf_hi(o1.y)}; x[3] = (f32x4){bf_lo(o1.z), bf_hi(o1.z), bf_lo(o1.w), bf_hi(o1.w)}; \
        float ss = 0.f; \
        _Pragma("unroll") for (int q = 0; q < 4; ++q) ss += (x[q][0] * x[q][0] + x[q][1] * x[q][1]) + (x[q][2] * x[q][2] + x[q][3] * x[q][3]); \
        const float tot = __builtin_bit_cast(float, __builtin_amdgcn_readlane(__builtin_bit_cast(int, wave_sum63(ss)), 63)); \
        const float rstd = rsqrtf(tot * (1.0f / D) + 1e-5f); \
        f32x4 h[4]; \
        _Pragma("unroll") for (int q = 0; q < 4; ++q) h[q] = x[q] * rstd * Gv[q] + Sv[q]; \
        if (FIN) { _Pragma("unroll") for (int q = 0; q < 4; ++q) *(GAS f32x4*)((GAS float*)F.out + (size_t)t_ * D + k0 + 4 * q) = h[q]; } \
        else if (h8) { u32x4 q8; _Pragma("unroll") for (int q = 0; q < 4; ++q) q8[q] = cvt_pk4_fp8(h[q][0] * F8_SH, h[q][1] * F8_SH, h[q][2] * F8_SH, h[q][3] * F8_SH); \
            *(GAS u32x4*)(H + (size_t)t_ * D + k0) = q8; } \
        else { u32x4 b0, b1; b0.x = cvt_pk(h[0][0], h[0][1]); b0.y = cvt_pk(h[0][2], h[0][3]); b0.z = cvt_pk(h[1][0], h[1][1]); b0.w = cvt_pk(h[1][2], h[1][3]); \
            b1.x = cvt_pk(h[2][0], h[2][1]); b1.y = cvt_pk(h[2][2], h[2][3]); b1.z = cvt_pk(h[3][0], h[3][1]); b1.w = cvt_pk(h[3][2], h[3][3]); \
            *(GAS u32x4*)((GAS bf16_t*)H + (size_t)t_ * D + k0) = b0; *(GAS u32x4*)((GAS bf16_t*)H + (size_t)t_ * D + k0 + 8) = b1; } } while (0)
    CR_A(0); CR_A(1);
    f32x4 Gv[4], Sv[4], Fv[4];
    { const GAS float* gm = (const GAS float*)(FIN ? F.in[I_FNG] : F.in[I_NMG] + layer * D) + k0;
      const GAS float* mb = (const GAS float*)(mod + ((size_t)(FIN ? 0 : layer) * NBATCH + b) * (6 * D)) + k0;
      const GAS float* gf = (const GAS float*)(mod + ((size_t)(layer - 1) * NBATCH + b) * (6 * D) + 5 * D) + k0;
#pragma unroll
      for (int q = 0; q < 4; ++q) { const f32x4 g = *(const GAS f32x4*)(gm + 4 * q);
          if (FIN) { Gv[q] = g; Sv[q] = (f32x4){0.f, 0.f, 0.f, 0.f}; }
          else { Gv[q] = g * (*(const GAS f32x4*)(mb + D + 4 * q) + 1.0f); Sv[q] = *(const GAS f32x4*)(mb + 4 * q); }
          Fv[q] = *(const GAS f32x4*)(gf + 4 * q) * (1.0f / F8_SY); } }
    CR_B(0);
#pragma unroll
    for (int i = 0; i < 8; ++i) {
        if (i + 2 < 8) CR_A(i + 2);
        if (i + 1 < 8) CR_B(i + 1);
        CR_C(i);
        asm volatile("" ::: "memory");
    }
#undef CR_ROW
#undef CR_A
#undef CR_B
#undef CR_C
    wg_barrier();
}

__device__ __forceinline__ void norm0_rows(Frame& F, int r0) {
    const int lane = F.lane, w = F.wave, k0 = 4 * lane;
    const GAS float* xin = (const GAS float*)F.in[I_X]; GAS unsigned char* H = (GAS unsigned char*)WSP(unsigned char, WS_H); const float* mod = WSP(const float, WS_MOD);
    const int b = r0 / SEQ;
    f32x4 xr[3][4];
#define N0_A(i) do { const GAS float* p_ = xin + (size_t)(r0 + 8 * w + (i)) * D + k0; _Pragma("unroll") for (int q = 0; q < 4; ++q) xr[(i) % 3][q] = *(const GAS f32x4*)(p_ + 256 * q); } while (0)
    N0_A(0); N0_A(1);
    f32x4 Gv[4], Sv[4];
    { const GAS float* gm = (const GAS float*)F.in[I_NMG] + k0; const GAS float* mb = (const GAS float*)(mod + (size_t)b * (6 * D)) + k0;
#pragma unroll
      for (int q = 0; q < 4; ++q) { Gv[q] = *(const GAS f32x4*)(gm + 256 * q) * (*(const GAS f32x4*)(mb + D + 256 * q) + 1.0f); Sv[q] = *(const GAS f32x4*)(mb + 256 * q); } }
#pragma unroll
    for (int i = 0; i < 8; ++i) {
        if (i + 2 < 8) N0_A(i + 2);
        const int t = r0 + 8 * w + i; f32x4 x[4];
#pragma unroll
        for (int q = 0; q < 4; ++q) { const u32x2 pk = (u32x2){cvt_pk(xr[i % 3][q][0], xr[i % 3][q][1]), cvt_pk(xr[i % 3][q][2], xr[i % 3][q][3])};
            x[q] = (f32x4){bf_lo(pk.x), bf_hi(pk.x), bf_lo(pk.y), bf_hi(pk.y)}; }
        float ss = 0.f;
#pragma unroll
        for (int q = 0; q < 4; ++q) ss += (x[q][0] * x[q][0] + x[q][1] * x[q][1]) + (x[q][2] * x[q][2] + x[q][3] * x[q][3]);
        const float tot = __builtin_bit_cast(float, __builtin_amdgcn_readlane(__builtin_bit_cast(int, wave_sum63(ss)), 63));
        const float rstd = rsqrtf(tot * (1.0f / D) + 1e-5f);
#pragma unroll
        for (int q = 0; q < 4; ++q) { const f32x4 h = x[q] * rstd * Gv[q] + Sv[q];
            if (F8_QKV) *(GAS unsigned*)(H + (size_t)t * D + k0 + 256 * q) = cvt_pk4_fp8(h[0] * F8_SH, h[1] * F8_SH, h[2] * F8_SH, h[3] * F8_SH);
            else *(GAS u32x2*)((GAS bf16_t*)H + (size_t)t * D + k0 + 256 * q) = (u32x2){cvt_pk(h[0], h[1]), cvt_pk(h[2], h[3])}; }
        asm volatile("" ::: "memory");
    }
#undef N0_A
    wg_barrier();
}

constexpr int N_PHASES = 30;
struct Args { const float* in[27]; float* out; unsigned char* ws; int ph_lo, ph_hi; };
__global__ void __launch_bounds__(NTHR, 2) mega(const Args args) {
    extern __shared__ __attribute__((aligned(16))) unsigned char lds_raw[];
    Frame F; F.lds = (LAS unsigned char*)lds_raw; F.MISC = (volatile LAS unsigned*)(F.lds + LDS_MISC); F.ws = args.ws; F.ctl = (gu32*)(args.ws + WS_CTL);
    F.tid = threadIdx.x; F.lane = F.tid & 63; F.wave = __builtin_amdgcn_readfirstlane(F.tid >> 6); F.G = gridDim.x; F.c = blockIdx.x; F.out = args.out;
    F.in = args.in;
    if (F.tid < 32) F.MISC[F.tid] = 0u;
    __syncthreads();
    const int lo = args.ph_lo, hi = args.ph_hi;
    F.xcc = (int)xb_xcc_id(); F.rank = 0; F.loc = 0;
#ifndef XCC_LOCAL
#define XCC_LOCAL 1
#endif
    if (XCC_LOCAL && hi - lo > 1 && F.G == 256) {
        if (F.tid == 0) { const unsigned r = __hip_atomic_fetch_add(F.ctl + CW_XC + 64 * F.xcc, 1u, RLX_AGENT); unsigned ok = 0u, sp = 0u;
            for (;;) { unsigned sum = 0u, good = 0u;
#pragma unroll
                for (int jx = 0; jx < 16; ++jx) { const unsigned cj = __hip_atomic_load(F.ctl + CW_XC + 64 * jx, RLX_AGENT); sum += cj; good += (jx < 8 ? (cj == 32u) : (cj == 0u)) ? 1u : 0u; }
                if (sum == 256u) { ok = (good == 16u) ? 1u : 0u; break; }
                __builtin_amdgcn_s_sleep(1); if (++sp > XB_SPIN_CAP) { ok = 0u; break; } }
            F.MISC[20] = r; F.MISC[21] = ok; }
        __syncthreads();
        F.rank = __builtin_amdgcn_readfirstlane((int)F.MISC[20]); F.loc = __builtin_amdgcn_readfirstlane((int)F.MISC[21]);
        if (F.loc) F.c = F.rank * 8 + F.xcc;
    }
    XcdBarrier bar; bar.bar = (unsigned*)(F.ctl + CW_BAR); bar.x = 0; bar.st = F.MISC + 8;
    if (hi - lo > 1) bar = xcd_barrier_post((unsigned*)(F.ctl + CW_BAR), F.MISC + 8);
#ifndef CVQ_QKV
#define CVQ_QKV 3
#endif
#ifndef CVQ_MOE
#define CVQ_MOE 3
#endif
#ifndef PH_MASK
#define PH_MASK 0xFFFF
#endif
#define IN(k) (lo <= (k) && (k) < hi)
#define HAS(b) (((PH_MASK) >> (b)) & 1)
#define PHASE_ENTER() do { int _t = F.tid; asm volatile("" : "+v"(_t)); F.tid = _t; F.lane = _t & 63; F.wave = __builtin_amdgcn_readfirstlane(_t >> 6); unsigned char* _w = F.ws; asm volatile("" : "+s"(_w)); F.ws = _w; int _g = F.G; asm volatile("" : "+s"(_g)); F.G = _g; } while (0)
    unsigned long long t_acc = 0ull, t_beg = 0ull, g_ticks = 0ull, g_cyc = 0ull;
#define TBEG(kind) do { if (TIME_KIND == (kind)) t_beg = __builtin_amdgcn_s_memrealtime(); } while (0)
#define TEND(kind) do { if (TIME_KIND == (kind)) t_acc += __builtin_amdgcn_s_memrealtime() - t_beg; } while (0)
#define SEAM(k) do { if ((k) + 1 < hi) xcd_barrier(bar); } while (0)
#define SEAM_L(k) do { if ((k) + 1 < hi) { if (F.loc) xcc_local_barrier((unsigned*)(F.ctl + CW_LB + 64 * F.xcc), 32u, (unsigned*)(F.ctl + CW_TMO)); else xcd_barrier(bar); } } while (0)
    const LAS int* toktab = (const LAS int*)(F.lds + LDS_TOK);
    if (HAS(0) && IN(0)) { TBEG(0); p0_phase(F); SEAM(0); TEND(0); }
    for (int i = 0; i < DEPTH; ++i) {
        const int pb = 1 + 7 * i, j = i >> 1; const bool conv = (i & 1) != 0;
        const float* modl = WSP(const float, WS_MOD) + (size_t)i * NBATCH * (6 * D);
        if (IN(pb)) { PHASE_ENTER(); TBEG(1); if (i == 0) { if (HAS(1)) { if (F.loc || F.G == 256) norm0_rows(F, (F.loc ? F.xcc * (SEQ / 16) + 4 * F.rank : 4 * F.c) * 16); else row_phase<0>(F, 0); } } else { TBEG(7); if (HAS(2)) { if (F.loc || F.G == 256) comb_rows<false>(F, i, (F.loc ? F.xcc * (SEQ / 16) + 4 * F.rank : 4 * F.c) * 16); else row_phase<1>(F, i); } TEND(7); } SEAM_L(pb); TEND(1); }
        if (IN(pb + 1)) { PHASE_ENTER(); TBEG(2);
            if (!conv) { if (HAS(3)) { Gemm g{WSP(const bf16_t, WS_H), F8_QKV ? (const bf16_t*)(WSP(const unsigned char, WS_WQKV) + (size_t)j * 1536 * D) : WSP(const bf16_t, WS_WQKV) + (size_t)j * 1536 * D, F8_QKV ? D / 2 : D, 0}; DenseOrder S; S.init(1536, F.G, F.c);
                EpiBias16<F8_QKV != 0> E{WSP(bf16_t, WS_QKV), 1536, F.in[I_ABQKV] + j * 1536}; gemm_phase<EpiBias16<F8_QKV != 0>, DenseOrder, false, F8_QKV != 0>(F.lds, g, S, E, toktab, F.tid, 40, t_acc, g_ticks, g_cyc);
                if (CV_OVERLAP && (long)F.c + F.G >= 384) cv_run(F, i + 1, CVQ_QKV); } }
            else if (HAS(4)) { Gemm g{WSP(const bf16_t, WS_H), (const bf16_t*)(WSP(const unsigned char, WS_CWIN) + (size_t)j * 2048 * D), D / 2, 0}; DenseOrder S; S.init(2048, F.G, F.c);
                EpiPair<0> E{WSP(void, WS_U), F.in[I_CBIN] + j * 2048, 0, nullptr}; gemm_phase<EpiPair<0>, DenseOrder, false, true>(F.lds, g, S, E, toktab, F.tid, 50, t_acc, g_ticks, g_cyc); }
            SEAM_L(pb + 1); TEND(2); }
        if (IN(pb + 2)) { PHASE_ENTER(); TBEG(3); if (!conv) { TBEG(6); if (HAS(5)) attn_phase(F, j, t_acc); TEND(6); } else { if (HAS(6)) dwconv_phase(F, j, t_acc); TBEG(17); } SEAM_L(pb + 2); if (conv) TEND(17); TEND(3); }
        if (IN(pb + 3)) { PHASE_ENTER(); TBEG(2); if (HAS(7)) {
            DenseOrder S; S.init(1024, F.G, F.c);
            const float* bias2 = (conv ? F.in[I_CBOUT] : F.in[I_ABO]) + j * D;
            if (conv) {
                Gemm g{WSP(const bf16_t, WS_AO), (const bf16_t*)(WSP(const unsigned char, WS_CWOUT) + (size_t)j * D * D), D / 2, 0};
                EpiResid<false, true> E{WSP(const bf16_t, WS_X), WSP(bf16_t, WS_X), bias2, modl + 2 * D}; gemm_phase<EpiResid<false, true>, DenseOrder, false, true>(F.lds, g, S, E, toktab, F.tid, 60, t_acc, g_ticks, g_cyc); }
            else { constexpr bool W8 = F8_WO != 0;
                Gemm g{WSP(const bf16_t, WS_AO), W8 ? (const bf16_t*)(WSP(const unsigned char, WS_WO) + (size_t)j * D * D) : WSP(const bf16_t, WS_WO) + (size_t)j * D * D, W8 ? D / 2 : D, 0};
                if (i == 0) { EpiResid<true, W8> E{F.in[I_X], WSP(bf16_t, WS_X), bias2, modl + 2 * D}; gemm_phase<EpiResid<true, W8>, DenseOrder, false, W8>(F.lds, g, S, E, toktab, F.tid, 60, t_acc, g_ticks, g_cyc); }
                else { EpiResid<false, W8> E{WSP(const bf16_t, WS_X), WSP(bf16_t, WS_X), bias2, modl + 2 * D}; gemm_phase<EpiResid<false, W8>, DenseOrder, false, W8>(F.lds, g, S, E, toktab, F.tid, 60, t_acc, g_ticks, g_cyc); } } }
            SEAM_L(pb + 3); TEND(2); }
        if (IN(pb + 4)) { PHASE_ENTER(); TBEG(1); if (CV_OVERLAP && i > 0) cv_run(F, i, 1 << 30); TBEG(8); if (HAS(8)) row_phase<2>(F, i); TEND(8); SEAM(pb + 4); TEND(1); }
        if (IN(pb + 5)) { PHASE_ENTER(); TBEG(4); if (HAS(9)) {
            const int tt = build_exp_tables(F, i);
            Gemm g{WSP(const bf16_t, WS_H), (const bf16_t*)(WSP(const unsigned char, WS_MWIN) + (size_t)i * NE * 2048 * D), D / 2, (size_t)2048 * D / 2};
            EpiPair<1> E{WSP(void, WS_ACT), F.in[I_MBIN] + (size_t)i * NE * 2048, 2048, (const LAS float*)(F.lds + LDS_EPI)};
            for (int ub = 0;; ub += 9) { const int nn = moe_build_units<true>(F, i, 8, tt, ub); const int n = nn >> 8, nv = nn & 255; if (n == 0) break;
                TableOrder S{(const LAS int*)(F.lds + LDS_UT), nv}; gemm_phase<EpiPair<1>, TableOrder, true, true>(F.lds, g, S, E, toktab, F.tid, 20, t_acc, g_ticks, g_cyc); wg_barrier();
                if (n < 9) { if (CV_OVERLAP && ub + nv < (((tt + 3) / 4) + 7) / 8) cv_run(F, i + 1, CVQ_MOE); break; } } }
            SEAM_L(pb + 5); TEND(4); }
        if (IN(pb + 6)) { PHASE_ENTER(); TBEG(5); if (HAS(10)) {
            const int tt = build_exp_tables(F, i);
            Gemm g{WSP(const bf16_t, WS_ACT), (const bf16_t*)(WSP(const unsigned char, WS_MWOUT) + (size_t)i * NE * D * D), D / 2, (size_t)D * D / 2};
            EpiMoeOut E{WSP(bf16_t, WS_YS), (const LAS float*)(F.lds + LDS_EPI)};
            for (int ub = 0;; ub += 9) { const int nn = moe_build_units<false>(F, i, 4, tt, ub); const int n = nn >> 8, nv = nn & 255; if (n == 0) break;
                TableOrder S{(const LAS int*)(F.lds + LDS_UT), nv}; gemm_phase<EpiMoeOut, TableOrder, false, true>(F.lds, g, S, E, toktab, F.tid, 30, t_acc, g_ticks, g_cyc); wg_barrier();
                if (n < 9) { if (CV_OVERLAP && ub + nv < ((((tt + 3) / 4) + 7) / 8 + 1) / 2) cv_run(F, i + 1, CVQ_MOE); break; } } }
            SEAM(pb + 6); TEND(5); }
    }
    if (HAS(11) && IN(29)) { PHASE_ENTER(); TBEG(1);
        if (F.loc || F.G == 256) comb_rows<true>(F, DEPTH, (F.loc ? F.xcc * (SEQ / 16) + 4 * F.rank : 4 * F.c) * 16); else row_phase<5>(F, DEPTH);
        TEND(1); }
    if (TIME_KIND >= 20 && (TIME_KIND % 10) == 5 && g_ticks > 0) t_acc = (g_cyc * 1000ull) / g_ticks;
    if (TIME_KIND >= 0 && blockIdx.x == 0) { const unsigned long long t0 = __builtin_amdgcn_s_memrealtime(); while (__builtin_amdgcn_s_memrealtime() - t0 < t_acc) __builtin_amdgcn_s_sleep(8); }
#undef IN
#undef SEAM
}

inline void launch_range(void* const* d_in, void* d_out, void* d_ws, int grid, int lo, int hi, hipStream_t stream) {
    Args a{}; for (int i = 0; i < 27; ++i) a.in[i] = (const float*)d_in[i];
    a.out = (float*)d_out; a.ws = (unsigned char*)d_ws; a.ph_lo = lo; a.ph_hi = hi;
    hipLaunchKernelGGL(mega, dim3(grid), dim3(NTHR), LDS_BYTES, stream, a);
}
inline int setup_grid() {
    static int grid = 0;
    if (grid == 0) {
        int dev = 0, cus = 0;
        if (hipGetDevice(&dev) != hipSuccess || hipDeviceGetAttribute(&cus, hipDeviceAttributeMultiprocessorCount, dev) != hipSuccess) { grid = -1; return grid; }
        if (hipFuncSetAttribute((const void*)mega, hipFuncAttributeMaxDynamicSharedMemorySize, LDS_BYTES) != hipSuccess) { grid = -1; return grid; }
        int per_cu = 0; (void)hipOccupancyMaxActiveBlocksPerMultiprocessor(&per_cu, (const void*)mega, NTHR, LDS_BYTES); (void)hipGetLastError();
        if (per_cu < 1) fprintf(stderr, "kernel_launch: occupancy query reports %d blocks per CU\n", per_cu);
        grid = cus;
    }
    return grid;
}
}
#ifndef FAST_LAUNCH_MODE
#define FAST_LAUNCH_MODE 1
#endif
extern "C" void kernel_launch(void* const* d_in, const int* in_sizes, int n_in, void* d_out, int out_size, void* d_ws, size_t ws_size, hipStream_t stream) {
    if (n_in != 27 || out_size != fk::T * fk::D || ws_size < fk::WS_END) { fprintf(stderr, "kernel_launch: unexpected shapes (n_in %d out %d ws %zu)\n", n_in, out_size, ws_size); return; }
    const int grid = fk::setup_grid(); if (grid <= 0) return;
    (void)hipMemsetAsync((char*)d_ws + fk::WS_CTL, 0, fk::CTL_ZERO_BYTES, stream);
#if FAST_LAUNCH_MODE == 1
    fk::launch_range(d_in, d_out, d_ws, grid, 0, fk::N_PHASES, stream);
#else
    for (int k = 0; k < fk::N_PHASES; ++k) fk::launch_range(d_in, d_out, d_ws, grid, k, k + 1, stream);
#endif
}
```
